# Optimizing an MI355X kernel written in HIP

```python
import math
import jax, jax.numpy as jnp
from jax import lax
import numpy as np

D_MODEL = 1024
BATCH = 4
SEQ = 4096
DEPTH = 1
DEC_BATCH = 128
DEC_SEQ = 8
PAST_LEN = 8192
PAGE_SIZE = 128

N_Q_HEADS = 8
N_KV_HEADS = 2
GROUP = N_Q_HEADS // N_KV_HEADS
HEAD_DIM = 64
WINDOW = 128
N_BUCKETS = 32
MAX_DISTANCE = 128
ATTN_WIDTH = N_Q_HEADS * HEAD_DIM
KV_WIDTH = N_KV_HEADS * HEAD_DIM
HG_HEADS = 4
HG_KDIM = 128
HG_VDIM = 128
HG_WIDTH = HG_HEADS * HG_KDIM
HG_VWIDTH = HG_HEADS * HG_VDIM
HG_CHUNK = 64
D_FF = 2816
EPS = 1e-6
F_TINY = 1e-30
SPLIT_SIZES = (ATTN_WIDTH, KV_WIDTH, KV_WIDTH, HG_WIDTH, HG_WIDTH, HG_VWIDTH, HG_VWIDTH, D_MODEL, D_MODEL)
IN_WIDTH = sum(SPLIT_SIZES)

kernel_name = "hybrid_swa_sink_hgrn2_macaron_step"


def _rmsnorm(x, g):
    xf = x.astype(jnp.float32)
    y = xf * lax.rsqrt(jnp.mean(xf * xf, axis=-1, keepdims=True) + EPS)
    return (y * g.astype(jnp.float32)).astype(x.dtype)


def _swiglu(x, w1, w3, w2):
    return (jax.nn.silu(x @ w1) * (x @ w3)) @ w2


def _t5_bucket(dist):
    max_exact = N_BUCKETS // 2
    d = np.maximum(dist, 0)
    large = max_exact + (np.log(np.maximum(d, 1) / max_exact) / np.log(MAX_DISTANCE / max_exact)
                         * (N_BUCKETS - max_exact)).astype(np.int32)
    large = np.minimum(large, N_BUCKETS - 1)
    return np.where(d < max_exact, d, large).astype(np.int32)


def _rel_bias(table, dist):
    b = table.astype(jnp.float32)[_t5_bucket(dist)]
    return jnp.transpose(b, (2, 0, 1)).reshape(N_KV_HEADS, GROUP, dist.shape[0], dist.shape[1])


def _sink_softmax(s, sinks):
    sk = sinks.astype(jnp.float32).reshape(N_KV_HEADS, GROUP, 1, 1)
    m = jnp.maximum(jnp.max(s, axis=-1, keepdims=True), sk)
    e = jnp.exp(s - m)
    return e / (jnp.sum(e, axis=-1, keepdims=True) + jnp.exp(sk - m))


def _swa_prompt(q, k, v, table, sinks):
    B, L = q.shape[:2]
    nb = L // WINDOW
    qb = q.reshape(B, nb, WINDOW, N_KV_HEADS, GROUP, HEAD_DIM)
    kb = k.reshape(B, nb, WINDOW, N_KV_HEADS, HEAD_DIM)
    vb = v.reshape(B, nb, WINDOW, N_KV_HEADS, HEAD_DIM)
    kk = jnp.concatenate([jnp.concatenate([jnp.zeros_like(kb[:, :1]), kb[:, :-1]], axis=1), kb], axis=2)
    vv = jnp.concatenate([jnp.concatenate([jnp.zeros_like(vb[:, :1]), vb[:, :-1]], axis=1), vb], axis=2)
    s = jnp.einsum('bnqkgd,bnjkd->bnkgqj', qb, kk).astype(jnp.float32) * (HEAD_DIM ** -0.5)
    dist = np.arange(WINDOW)[:, None] + WINDOW - np.arange(2 * WINDOW)[None, :]
    valid = (dist >= 0) & (dist <= WINDOW)
    blk_valid = valid[None] & ((np.arange(nb)[:, None, None] > 0) | (np.arange(2 * WINDOW) >= WINDOW)[None, None, :])
    s = jnp.where(blk_valid[None, :, None, None], s + _rel_bias(table, dist)[None, None], -jnp.inf)
    p = _sink_softmax(s, sinks)
    o = jnp.einsum('bnkgqj,bnjkd->bnqkgd', p.astype(v.dtype), vv)
    return o.reshape(B, L, ATTN_WIDTH)


def _swa_sample(q, k, v, win_k, win_v, table, sinks):
    Bd, Ld = q.shape[:2]
    kk = jnp.concatenate([win_k.astype(k.dtype), k], axis=1)
    vv = jnp.concatenate([win_v.astype(v.dtype), v], axis=1)
    qg = q.reshape(Bd, Ld, N_KV_HEADS, GROUP, HEAD_DIM)
    s = jnp.einsum('bqkgd,bjkd->bkgqj', qg, kk).astype(jnp.float32) * (HEAD_DIM ** -0.5)
    dist = np.arange(Ld)[:, None] + WINDOW - np.arange(WINDOW + Ld)[None, :]
    valid = (dist >= 0) & (dist <= WINDOW)
    s = jnp.where(valid, s + _rel_bias(table, dist)[None], -jnp.inf)
    p = _sink_softmax(s, sinks)
    o = jnp.einsum('bkgqj,bjkd->bqkgd', p.astype(v.dtype), vv)
    return o.reshape(Bd, Ld, ATTN_WIDTH), kk[:, -WINDOW:], vv[:, -WINDOW:]


def _hgrn2(q, f_logit, v, lb, S0):
    B, L = q.shape[:2]
    C = math.gcd(L, HG_CHUNK)
    n = L // C
    f = lb + (1.0 - lb) * jax.nn.sigmoid(f_logit.astype(jnp.float32))
    log_f = jnp.log(jnp.maximum(f, F_TINY))
    k = 1.0 - f
    qf = jax.nn.silu(q.astype(jnp.float32))
    vf = v.astype(jnp.float32)

    def chunks(t, d):
        return t.reshape(B, n, C, HG_HEADS, d).transpose(1, 0, 3, 2, 4)

    tri = jnp.tril(jnp.ones((C, C), dtype=bool))[:, :, None]

    def step(S, inp):
        qc, kc, vc, lc = inp
        G = jnp.cumsum(lc, axis=2)
        inter = jnp.einsum('bhtk,bhkv->bhtv', qc * jnp.exp(G), S)
        diff = G[:, :, :, None, :] - G[:, :, None, :, :]
        decay = jnp.exp(jnp.where(tri, diff, -jnp.inf))
        att = jnp.einsum('bhtk,bhtsk->bhts', qc, decay * kc[:, :, None, :, :])
        out = inter + jnp.einsum('bhts,bhsv->bhtv', att, vc)
        G_last = G[:, :, -1:, :]
        S = jnp.exp(G_last[:, :, 0, :, None]) * S + jnp.einsum('bhsk,bhsv->bhkv', kc * jnp.exp(G_last - G), vc)
        return S, out

    S, o = lax.scan(step, S0.astype(jnp.float32),
                    (chunks(qf, HG_KDIM), chunks(k, HG_KDIM), chunks(vf, HG_VDIM), chunks(log_f, HG_KDIM)))
    o = o.transpose(1, 0, 3, 2, 4).reshape(B, L, HG_HEADS, HG_VDIM)
    return o, S


def _layer(x, win_k, win_v, S0, lb, table, w):
    B, L = x.shape[:2]
    h = x + 0.5 * _swiglu(_rmsnorm(x, w['ffn1_norm']), w['ffn1_w1'], w['ffn1_w3'], w['ffn1_w2'])
    u = _rmsnorm(h, w['mix_norm'])
    proj = u @ w['w_in']
    pts = np.cumsum(np.array(SPLIT_SIZES[:-1])).tolist()
    qa, ka, va, qr, fr, ir, gr, gate_a, gate_r = jnp.split(proj, pts, axis=-1)
    qa = _rmsnorm(qa.reshape(B, L, N_Q_HEADS, HEAD_DIM), w['q_norm'])
    ka = _rmsnorm(ka.reshape(B, L, N_KV_HEADS, HEAD_DIM), w['k_norm'])
    va = va.reshape(B, L, N_KV_HEADS, HEAD_DIM)
    if win_k is None:
        att = _swa_prompt(qa, ka, va, table, w['sinks'])
        new_k, new_v = ka[:, -WINDOW:], va[:, -WINDOW:]
    else:
        att, new_k, new_v = _swa_sample(qa, ka, va, win_k, win_v, table, w['sinks'])
    o_r, S = _hgrn2(qr, fr, ir, lb, S0)
    o_r = (_rmsnorm(o_r, w['hg_norm']).reshape(B, L, HG_VWIDTH).astype(x.dtype)) * jax.nn.silu(gr)
    merged = jax.nn.sigmoid(gate_a) * (att @ w['w_up_attn']) + jax.nn.sigmoid(gate_r) * (o_r @ w['w_up_hgrn'])
    h = h + merged @ w['w_out']
    y = h + 0.5 * _swiglu(_rmsnorm(h, w['ffn2_norm']), w['ffn2_w1'], w['ffn2_w3'], w['ffn2_w2'])
    return y, new_k, new_v, S.astype(x.dtype)


def setup_inputs(seed: int = 0) -> dict:
    key = jax.random.key(seed)
    ks = iter(jax.random.split(key, 32))

    def nrm(shape, scale):
        return jax.random.normal(next(ks), shape, jnp.float32) * scale

    def gain(shape):
        return 1.0 + nrm(shape, 0.02)

    return {
        "x_prompt": nrm((BATCH, SEQ, D_MODEL), 1.0),
        "x_sample": nrm((DEC_BATCH, DEC_SEQ, D_MODEL), 1.0),
        "cache_win_k": nrm((DEPTH, DEC_BATCH, WINDOW, N_KV_HEADS, HEAD_DIM), 1.0),
        "cache_win_v": nrm((DEPTH, DEC_BATCH, WINDOW, N_KV_HEADS, HEAD_DIM), 1.0),
        "state_hgrn": nrm((DEPTH, DEC_BATCH, HG_HEADS, HG_KDIM, HG_VDIM), 0.5),
        "ffn1_norm": gain((DEPTH, D_MODEL)),
        "ffn1_w1": nrm((DEPTH, D_MODEL, D_FF), D_MODEL ** -0.5),
        "ffn1_w3": nrm((DEPTH, D_MODEL, D_FF), D_MODEL ** -0.5),
        "ffn1_w2": nrm((DEPTH, D_FF, D_MODEL), D_FF ** -0.5),
        "mix_norm": gain((DEPTH, D_MODEL)),
        "w_in": nrm((DEPTH, D_MODEL, IN_WIDTH), D_MODEL ** -0.5),
        "q_norm": gain((DEPTH, HEAD_DIM)),
        "k_norm": gain((DEPTH, HEAD_DIM)),
        "sinks": nrm((DEPTH, N_Q_HEADS), 0.5),
        "rel_bias_table": nrm((N_BUCKETS, N_Q_HEADS), 0.5),
        "hgrn_lb_logits": nrm((DEPTH + 1, HG_WIDTH), 0.5),
        "hg_norm": gain((DEPTH, HG_VDIM)),
        "w_up_attn": nrm((DEPTH, ATTN_WIDTH, D_MODEL), ATTN_WIDTH ** -0.5),
        "w_up_hgrn": nrm((DEPTH, HG_VWIDTH, D_MODEL), HG_VWIDTH ** -0.5),
        "w_out": nrm((DEPTH, D_MODEL, D_MODEL), D_MODEL ** -0.5),
        "ffn2_norm": gain((DEPTH, D_MODEL)),
        "ffn2_w1": nrm((DEPTH, D_MODEL, D_FF), D_MODEL ** -0.5),
        "ffn2_w3": nrm((DEPTH, D_MODEL, D_FF), D_MODEL ** -0.5),
        "ffn2_w2": nrm((DEPTH, D_FF, D_MODEL), D_FF ** -0.5),
    }


def reference(x_prompt, x_sample, cache_win_k, cache_win_v, state_hgrn,
              ffn1_norm, ffn1_w1, ffn1_w3, ffn1_w2, mix_norm, w_in, q_norm, k_norm, sinks,
              rel_bias_table, hgrn_lb_logits, hg_norm, w_up_attn, w_up_hgrn, w_out,
              ffn2_norm, ffn2_w1, ffn2_w3, ffn2_w2):
    lb_all = jnp.cumsum(jax.nn.softmax(hgrn_lb_logits.astype(jnp.float32), axis=0), axis=0)
    yp, ys = x_prompt, x_sample
    pk, pv, ps, sk, sv, ss = [], [], [], [], [], []
    for l in range(DEPTH):
        w = {
            'ffn1_norm': ffn1_norm[l], 'ffn1_w1': ffn1_w1[l], 'ffn1_w3': ffn1_w3[l], 'ffn1_w2': ffn1_w2[l],
            'mix_norm': mix_norm[l], 'w_in': w_in[l], 'q_norm': q_norm[l], 'k_norm': k_norm[l],
            'sinks': sinks[l], 'hg_norm': hg_norm[l], 'w_up_attn': w_up_attn[l], 'w_up_hgrn': w_up_hgrn[l],
            'w_out': w_out[l], 'ffn2_norm': ffn2_norm[l], 'ffn2_w1': ffn2_w1[l], 'ffn2_w3': ffn2_w3[l],
            'ffn2_w2': ffn2_w2[l],
        }
        S0 = jnp.zeros((yp.shape[0], HG_HEADS, HG_KDIM, HG_VDIM), jnp.float32)
        yp, k1, v1, s1 = _layer(yp, None, None, S0, lb_all[l], rel_bias_table, w)
        ys, k2, v2, s2 = _layer(ys, cache_win_k[l], cache_win_v[l], state_hgrn[l], lb_all[l], rel_bias_table, w)
        pk.append(k1); pv.append(v1); ps.append(s1)
        sk.append(k2); sv.append(v2); ss.append(s2)
    return (yp, ys, jnp.stack(pk), jnp.stack(pv), jnp.stack(ps), jnp.stack(sk), jnp.stack(sv), jnp.stack(ss))
```

```cpp
#include <hip/hip_runtime.h>
#include <cstdint>
#include <cstdio>

namespace nv {
constexpr int D = 1024, SEQ = 4096, NB = 4, DB = 128, DL = 8, MP = NB * SEQ, MS = DB * DL, M = MP + MS;
constexpr int NQ = 8, NKV = 2, HD = 64, WIN = 128, DFF = 2816, INW = 4864;
constexpr int HGH = 4, HGK = 128, HGV = 128;
constexpr float EPS = 1e-6f;
constexpr int C_QA = 0, C_KA = 512, C_VA = 640, C_QR = 768, C_FR = 1280, C_IR = 1792, C_GR = 2304, C_GA = 2816, C_GRT = 3840;
constexpr size_t O_YP = 0, O_YS = (size_t)MP * D, O_PWK = O_YS + (size_t)MS * D, O_PWV = O_PWK + 65536, O_PST = O_PWV + 65536,
                 O_SWK = O_PST + 262144, O_SWV = O_SWK + 2097152, O_SST = O_SWV + 2097152, O_END = O_SST + 8388608;

__device__ const unsigned char T5LUT[129] = {0, 1, 2, 3, 4, 5, 6, 7, 8, 9, 10, 11, 12, 13, 14, 15, 16, 16, 16, 17, 17, 18, 18, 18, 19, 19, 19, 20, 20, 20, 20, 21, 21, 21, 21, 22, 22, 22, 22, 22, 23, 23, 23, 23, 23, 23, 24, 24, 24, 24, 24, 24, 25, 25, 25, 25, 25, 25, 25, 26, 26, 26, 26, 26, 26, 26, 26, 27, 27, 27, 27, 27, 27, 27, 27, 27, 27, 28, 28, 28, 28, 28, 28, 28, 28, 28, 28, 29, 29, 29, 29, 29, 29, 29, 29, 29, 29, 29, 29, 30, 30, 30, 30, 30, 30, 30, 30, 30, 30, 30, 30, 30, 30, 31, 31, 31, 31, 31, 31, 31, 31, 31, 31, 31, 31, 31, 31, 31, 31};

__device__ __forceinline__ float sigmoidf_(float x) { return 1.f / (1.f + __expf(-x)); }
__device__ __forceinline__ float siluf_(float x) { return x / (1.f + __expf(-x)); }
__device__ __forceinline__ float block_sum256(float v, float* sh) {
    for (int o = 32; o > 0; o >>= 1) v += __shfl_xor(v, o);
    __syncthreads();
    if ((threadIdx.x & 63) == 0) sh[threadIdx.x >> 6] = v;
    __syncthreads();
    return sh[0] + sh[1] + sh[2] + sh[3];
}
__global__ void __launch_bounds__(256) k_rmsnorm(const float* in, const float* g, float* out) {
    __shared__ float sh[4];
    const size_t r = blockIdx.x; const float4 v = ((const float4*)(in + r * D))[threadIdx.x];
    const float ss = block_sum256(v.x * v.x + v.y * v.y + v.z * v.z + v.w * v.w, sh);
    const float rs = rsqrtf(ss * (1.f / D) + EPS); const float4 gg = ((const float4*)g)[threadIdx.x];
    ((float4*)(out + r * D))[threadIdx.x] = make_float4(v.x * rs * gg.x, v.y * rs * gg.y, v.z * rs * gg.z, v.w * rs * gg.w);
}
__global__ void __launch_bounds__(256) k_sgemm(const float* __restrict__ A, int lda, const float* __restrict__ B, int ldb, float* __restrict__ C, int ldc, int K) {
    __shared__ float As[16][64 + 4], Bs[16][64 + 4];
    const int tid = threadIdx.x, tx = tid & 15, ty = tid >> 4;
    const int row0 = blockIdx.y * 64, col0 = blockIdx.x * 64;
    float acc[4][4] = {};
    const int ar = tid >> 2, ak = (tid & 3) * 4, bk = tid >> 4, bc = (tid & 15) * 4;
    for (int k0 = 0; k0 < K; k0 += 16) {
        const float4 a = *(const float4*)(A + (size_t)(row0 + ar) * lda + k0 + ak);
        const float4 b = *(const float4*)(B + (size_t)(k0 + bk) * ldb + col0 + bc);
        __syncthreads();
        As[ak + 0][ar] = a.x; As[ak + 1][ar] = a.y; As[ak + 2][ar] = a.z; As[ak + 3][ar] = a.w;
        Bs[bk][bc + 0] = b.x; Bs[bk][bc + 1] = b.y; Bs[bk][bc + 2] = b.z; Bs[bk][bc + 3] = b.w;
        __syncthreads();
#pragma unroll
        for (int k = 0; k < 16; ++k) {
            float av[4], bv[4];
#pragma unroll
            for (int i = 0; i < 4; ++i) { av[i] = As[k][ty * 4 + i]; bv[i] = Bs[k][tx * 4 + i]; }
#pragma unroll
            for (int i = 0; i < 4; ++i)
#pragma unroll
                for (int j = 0; j < 4; ++j) acc[i][j] += av[i] * bv[j];
        }
    }
#pragma unroll
    for (int i = 0; i < 4; ++i) *(float4*)(C + (size_t)(row0 + ty * 4 + i) * ldc + col0 + tx * 4) = make_float4(acc[i][0], acc[i][1], acc[i][2], acc[i][3]);
}
__global__ void k_swiglu(float* g1, const float* g3, size_t n) { size_t i = (size_t)blockIdx.x * blockDim.x + threadIdx.x; if (i < n) g1[i] = siluf_(g1[i]) * g3[i]; }
__global__ void k_resid(const float* base, const float* f, float scale, float* out, size_t n) { size_t i = (size_t)blockIdx.x * blockDim.x + threadIdx.x; if (i < n) out[i] = base[i] + scale * f[i]; }
__global__ void __launch_bounds__(64) k_qknorm(float* proj, const float* qn, const float* kn) {
    const int r = blockIdx.x, h = blockIdx.y, d = threadIdx.x; float* p = proj + (size_t)r * INW + h * 64 + d;
    const float v = *p; float ss = v * v;
    for (int o = 32; o > 0; o >>= 1) ss += __shfl_xor(ss, o);
    *p = v * rsqrtf(ss * (1.f / 64.f) + EPS) * (h < 8 ? qn[d] : kn[d]);
}
__global__ void __launch_bounds__(64) k_attn_prompt(const float* proj, const float* table, const float* sinks, float* att) {
    __shared__ float q[64], p[132];
    const int t = blockIdx.x, h = blockIdx.y, kvh = h >> 2, lane = threadIdx.x;
    q[lane] = proj[(size_t)t * INW + C_QA + h * 64 + lane];
    __syncthreads();
    const int p0 = t - 128 < 0 ? 0 : t - 128, nk = t - p0 + 1;
    float sc[3]; float mx = sinks[h];
#pragma unroll
    for (int c = 0; c < 3; ++c) {
        const int j = lane + 64 * c; float s = -INFINITY;
        if (j < nk) { const float* kr = proj + (size_t)(p0 + j) * INW + C_KA + kvh * 64; float a = 0.f; for (int d = 0; d < 64; ++d) a += q[d] * kr[d];
            s = a * 0.125f + table[T5LUT[t - (p0 + j)] * NQ + h]; }
        sc[c] = s; mx = fmaxf(mx, s);
    }
    for (int o = 32; o > 0; o >>= 1) mx = fmaxf(mx, __shfl_xor(mx, o));
    float sum = 0.f;
#pragma unroll
    for (int c = 0; c < 3; ++c) { const int j = lane + 64 * c; const float e = (j < nk) ? __expf(sc[c] - mx) : 0.f; if (j < 132) p[j] = e; sum += e; }
    for (int o = 32; o > 0; o >>= 1) sum += __shfl_xor(sum, o);
    const float inv = 1.f / (sum + __expf(sinks[h] - mx));
    __syncthreads();
    float o = 0.f;
    for (int j = 0; j < nk; ++j) o += p[j] * proj[(size_t)(p0 + j) * INW + C_VA + kvh * 64 + lane];
    att[(size_t)t * 512 + h * 64 + lane] = o * inv;
}
__global__ void __launch_bounds__(64) k_attn_sample(const float* proj, const float* wk, const float* wv, const float* table, const float* sinks, float* att) {
    __shared__ float q[64], p[192];
    const int r = blockIdx.x, bd = r >> 3, i = r & 7, h = blockIdx.y, kvh = h >> 2, lane = threadIdx.x;
    q[lane] = proj[(size_t)r * INW + C_QA + h * 64 + lane];
    __syncthreads();
    float sc[3]; float mx = sinks[h];
#pragma unroll
    for (int c = 0; c < 3; ++c) {
        const int j = i + lane + 64 * c; float s = -INFINITY;
        if (j <= i + 128) {
            const float* kr = (j < 128) ? wk + ((size_t)(bd * 128 + j) * 2 + kvh) * 64 : proj + (size_t)(bd * 8 + (j - 128)) * INW + C_KA + kvh * 64;
            float a = 0.f; for (int d = 0; d < 64; ++d) a += q[d] * kr[d];
            s = a * 0.125f + table[T5LUT[i + 128 - j] * NQ + h]; }
        sc[c] = s; mx = fmaxf(mx, s);
    }
    for (int o = 32; o > 0; o >>= 1) mx = fmaxf(mx, __shfl_xor(mx, o));
    float sum = 0.f;
#pragma unroll
    for (int c = 0; c < 3; ++c) { const int jj = lane + 64 * c; const float e = (jj <= 128) ? __expf(sc[c] - mx) : 0.f; p[jj] = e; sum += e; }
    for (int o = 32; o > 0; o >>= 1) sum += __shfl_xor(sum, o);
    const float inv = 1.f / (sum + __expf(sinks[h] - mx));
    __syncthreads();
    float o = 0.f;
    for (int jj = 0; jj <= 128; ++jj) { const int j = i + jj;
        const float v = (j < 128) ? wv[((size_t)(bd * 128 + j) * 2 + kvh) * 64 + lane] : proj[(size_t)(bd * 8 + (j - 128)) * INW + C_VA + kvh * 64 + lane];
        o += p[jj] * v; }
    att[(size_t)r * 512 + h * 64 + lane] = o * inv;
}
__global__ void __launch_bounds__(128) k_hgrn(const float* proj, int L, const float* lbl  , const float* S0, float* Sout, float* o) {
    __shared__ float f[128], kk[128], q[128];
    const int seq = blockIdx.x, h = blockIdx.y, v = threadIdx.x;
    float S[128];
    if (S0) {
#pragma unroll
        for (int k = 0; k < 128; ++k) S[k] = S0[(((size_t)seq * 4 + h) * 128 + k) * 128 + v];
    } else {
#pragma unroll
        for (int k = 0; k < 128; ++k) S[k] = 0.f;
    }
    const float la = lbl[h * 128 + v], lb2 = lbl[512 + h * 128 + v]; const float lb = 1.f / (1.f + __expf(lb2 - la));
    for (int t = 0; t < L; ++t) {
        const float* pr = proj + (size_t)(seq * L + t) * INW;
        __syncthreads();
        { const float fl = pr[C_FR + h * 128 + v]; const float ff = lb + (1.f - lb) * sigmoidf_(fl); f[v] = ff; kk[v] = 1.f - ff; q[v] = siluf_(pr[C_QR + h * 128 + v]); }
        __syncthreads();
        const float vv = pr[C_IR + h * 128 + v]; float acc = 0.f;
#pragma unroll
        for (int k = 0; k < 128; ++k) { S[k] = f[k] * S[k] + kk[k] * vv; acc += q[k] * S[k]; }
        o[(size_t)(seq * L + t) * 512 + h * 128 + v] = acc;
    }
#pragma unroll
    for (int k = 0; k < 128; ++k) Sout[(((size_t)seq * 4 + h) * 128 + k) * 128 + v] = S[k];
}
__global__ void __launch_bounds__(128) k_hgnorm(float* o, const float* proj, const float* hgn) {
    __shared__ float sh[2];
    const int r = blockIdx.x, h = blockIdx.y, v = threadIdx.x; float* p = o + (size_t)r * 512 + h * 128 + v; const float x = *p; float ss = x * x;
    for (int of = 32; of > 0; of >>= 1) ss += __shfl_xor(ss, of);
    if ((v & 63) == 0) sh[v >> 6] = ss;
    __syncthreads();
    const float rs = rsqrtf((sh[0] + sh[1]) * (1.f / 128.f) + EPS);
    *p = x * rs * hgn[v] * siluf_(proj[(size_t)r * INW + C_GR + h * 128 + v]);
}
__global__ void k_merge(float* a1, const float* a2, const float* proj, size_t rows) {
    size_t i = (size_t)blockIdx.x * blockDim.x + threadIdx.x; if (i >= rows * 1024) return; const size_t r = i >> 10, c = i & 1023;
    a1[i] = sigmoidf_(proj[r * INW + C_GA + c]) * a1[i] + sigmoidf_(proj[r * INW + C_GRT + c]) * a2[i];
}
__global__ void k_copy_cols(const float* src, int ld, int col0, int ncols, float* dst, size_t rows) {
    size_t i = (size_t)blockIdx.x * blockDim.x + threadIdx.x; if (i >= rows * ncols) return; const size_t r = i / ncols, c = i % ncols; dst[i] = src[r * ld + col0 + c];
}
__global__ void k_sample_win(const float* win, const float* proj, int col0, float* out) {
    size_t i = (size_t)blockIdx.x * blockDim.x + threadIdx.x; if (i >= (size_t)128 * 128 * 128) return;
    const int d = i & 63, kvh = (i >> 6) & 1, j = (i >> 7) & 127, bd = i >> 14;
    out[i] = (j < 120) ? win[((size_t)(bd * 128 + j + 8) * 2 + kvh) * 64 + d] : proj[(size_t)(bd * 8 + j - 120) * INW + col0 + kvh * 64 + d];
}
}

extern "C" void kernel_launch(void* const* d_in, const int* in_sizes, int n_in, void* d_out, int out_size, void* d_ws, size_t ws_size, hipStream_t stream) {
    using namespace nv;
    const float* xp = (const float*)d_in[0]; const float* xs = (const float*)d_in[1]; const float* cwk = (const float*)d_in[2]; const float* cwv = (const float*)d_in[3];
    const float* st0 = (const float*)d_in[4]; const float* n1 = (const float*)d_in[5]; const float* w11 = (const float*)d_in[6]; const float* w13 = (const float*)d_in[7]; const float* w12 = (const float*)d_in[8];
    const float* nmix = (const float*)d_in[9]; const float* win = (const float*)d_in[10]; const float* qn = (const float*)d_in[11]; const float* kn = (const float*)d_in[12]; const float* sinks = (const float*)d_in[13];
    const float* table = (const float*)d_in[14]; const float* lbl = (const float*)d_in[15]; const float* hgn = (const float*)d_in[16]; const float* wua = (const float*)d_in[17]; const float* wur = (const float*)d_in[18];
    const float* wout = (const float*)d_in[19]; const float* n2 = (const float*)d_in[20]; const float* w21 = (const float*)d_in[21]; const float* w23 = (const float*)d_in[22]; const float* w22 = (const float*)d_in[23];
    float* out = (float*)d_out; float* ws = (float*)d_ws;
    constexpr size_t F4M = (size_t)4096 * 1024;
    float* R1 = ws; float* R4 = ws + F4M; float* BIG = ws + 2 * F4M; float* G1 = BIG; float* G3 = BIG + (size_t)4096 * DFF; float* PROJ = BIG;
    float* ATT = BIG + (size_t)4096 * INW + 1024; float* ORB = ATT + (size_t)4096 * 512;
    for (int g = 0; g < 5; ++g) {
        const int n = g < 4 ? 4096 : 1024; const float* x = g < 4 ? xp + (size_t)g * F4M : xs; float* y = g < 4 ? out + (size_t)g * F4M : out + O_YS;
        const size_t ne = (size_t)n * D; const int eb = (int)((ne + 255) / 256);
        auto ffn = [&](const float* in, const float* gn, const float* w1, const float* w3, const float* w2, float* dst) {
            k_rmsnorm<<<n, 256, 0, stream>>>(in, gn, R1);
            k_sgemm<<<dim3(DFF / 64, n / 64), 256, 0, stream>>>(R1, D, w1, DFF, G1, DFF, D);
            k_sgemm<<<dim3(DFF / 64, n / 64), 256, 0, stream>>>(R1, D, w3, DFF, G3, DFF, D);
            { const size_t nh = (size_t)n * DFF; k_swiglu<<<(int)((nh + 255) / 256), 256, 0, stream>>>(G1, G3, nh); }
            k_sgemm<<<dim3(D / 64, n / 64), 256, 0, stream>>>(G1, DFF, w2, D, R4, D, DFF);
            k_resid<<<eb, 256, 0, stream>>>(in, R4, 0.5f, dst, ne);
        };
        ffn(x, n1, w11, w13, w12, y);
        k_rmsnorm<<<n, 256, 0, stream>>>(y, nmix, R1);
        k_sgemm<<<dim3(INW / 64, n / 64), 256, 0, stream>>>(R1, D, win, INW, PROJ, INW, D);
        k_qknorm<<<dim3(n, 10), 64, 0, stream>>>(PROJ, qn, kn);
        if (g < 4) {
            k_attn_prompt<<<dim3(4096, 8), 64, 0, stream>>>(PROJ, table, sinks, ATT);
            k_hgrn<<<dim3(1, 4), 128, 0, stream>>>(PROJ, 4096, lbl, nullptr, out + O_PST + (size_t)g * 65536, ORB);
            k_copy_cols<<<(128 * 128 + 255) / 256, 256, 0, stream>>>(PROJ + (size_t)3968 * INW, INW, C_KA, 128, out + O_PWK + (size_t)g * 16384, 128);
            k_copy_cols<<<(128 * 128 + 255) / 256, 256, 0, stream>>>(PROJ + (size_t)3968 * INW, INW, C_VA, 128, out + O_PWV + (size_t)g * 16384, 128);
        } else {
            k_attn_sample<<<dim3(1024, 8), 64, 0, stream>>>(PROJ, cwk, cwv, table, sinks, ATT);
            k_hgrn<<<dim3(128, 4), 128, 0, stream>>>(PROJ, 8, lbl, st0, out + O_SST, ORB);
            k_sample_win<<<(128 * 128 * 128 + 255) / 256, 256, 0, stream>>>(cwk, PROJ, C_KA, out + O_SWK);
            k_sample_win<<<(128 * 128 * 128 + 255) / 256, 256, 0, stream>>>(cwv, PROJ, C_VA, out + O_SWV);
        }
        k_hgnorm<<<dim3(n, 4), 128, 0, stream>>>(ORB, PROJ, hgn);
        k_sgemm<<<dim3(D / 64, n / 64), 256, 0, stream>>>(ATT, 512, wua, D, R1, D, 512);
        k_sgemm<<<dim3(D / 64, n / 64), 256, 0, stream>>>(ORB, 512, wur, D, R4, D, 512);
        k_merge<<<eb, 256, 0, stream>>>(R1, R4, PROJ, n);
        k_sgemm<<<dim3(D / 64, n / 64), 256, 0, stream>>>(R1, D, wout, D, R4, D, D);
        k_resid<<<eb, 256, 0, stream>>>(y, R4, 1.0f, y, ne);
        ffn(y, n2, w21, w23, w22, y);
    }
}
```

```cpp
#include <hip/hip_runtime.h>
#include <cstdio>
#include <cstdint>
namespace pg8 {
#define PG8_LAS __attribute__((address_space(3)))
typedef unsigned short bf16_t;
typedef short bf16x8 __attribute__((ext_vector_type(8)));
typedef float f32x4 __attribute__((ext_vector_type(4)));
typedef unsigned u32x4 __attribute__((ext_vector_type(4)));
constexpr int BM = 256, BK = 64, HALF = 128, HTB = HALF * BK * 2  , STAGE_BYTES = 8 * HTB, NXCD = 8, WGM = 8;

__host__ __device__ __forceinline__ int lds_byte(int r, int c) { const int st = (r >> 4) * 2 + (c >> 5), rr = r & 15, cc = c & 31, ob = rr * 64 + cc * 2; return st * 1024 + (ob ^ (((ob >> 9) & 1) << 5)); }
__host__ __device__ __forceinline__ void stage_rc(int b, int& R, int& C) { const int st = b / 1024, sb = b % 1024, swz = sb ^ (((sb >> 9) & 1) << 5); R = (st >> 1) * 16 + swz / 64; C = (st & 1) * 32 + (swz % 64) / 2; }
__host__ __device__ __forceinline__ int perm32(int rho) { const int n = rho >> 4, i = rho & 15; return 8 * (i >> 2) + 4 * n + (i & 3); }

struct Unit { int pm, pn, idx; };
struct Gemm { const bf16_t* A; const bf16_t* Bt; int M, N, K; };

struct StaticOrder {
    int nM, nN, nwg, G, c;
    __host__ __device__ void init(int M, int N, int G_, int c_) { nM = M / BM; nN = N / BM; nwg = nM * nN; G = G_; c = c_; }
    __host__ __device__ bool next(int i, Unit& u) const {
        const long L = (long)i * G + c; if (L >= nwg) return false;
        int wgid = (int)L; { const int q = nwg / NXCD, r = nwg % NXCD, xcd = wgid % NXCD, off = wgid / NXCD; wgid = (xcd < r ? xcd * (q + 1) : r * (q + 1) + (xcd - r) * q) + off; }
        const int nig = WGM * nN, gid = wgid / nig, fm = gid * WGM, gsz = (nM - fm) < WGM ? (nM - fm) : WGM;
        u.pm = fm + ((wgid % nig) % gsz); u.pn = (wgid % nig) / gsz; u.idx = i; return true;
    }
    __device__ __forceinline__ void a_ready(const Unit&) const {}
    __device__ __forceinline__ void done(const Unit&) const {}
};

typedef float f32x2_cv __attribute__((ext_vector_type(2))); typedef __bf16 bf16x2_cv __attribute__((ext_vector_type(2)));
__device__ __forceinline__ unsigned cvt_pk_bf16(float lo, float hi) { const f32x2_cv v = {lo, hi}; const bf16x2_cv b = __builtin_convertvector(v, bf16x2_cv); return __builtin_bit_cast(unsigned, b); }
typedef float f32x2 __attribute__((ext_vector_type(2)));
template <class Epi, class Sched, bool ALIGN_EPI = false, bool SP2 = false>
__device__ __forceinline__ void gemm_phase(PG8_LAS unsigned char* lds, const Gemm g, const Sched& S, const Epi& E) {
    const int tid = threadIdx.x, wid = __builtin_amdgcn_readfirstlane(tid >> 6), lane = tid & 63, wr = wid >> 2, wc = wid & 3, fr = lane & 15, fq = lane >> 4;
    constexpr bool KS = Epi::MIDT > 0;
    const int K = g.K, nt = KS ? Epi::MIDT : K / BK;
    unsigned voffA[2], voffB[2];
#pragma unroll
    for (int i = 0; i < 2; ++i) { int R, C; stage_rc(tid * 16 + i * 8192, R, C); const int Rb = Epi::PERM ? ((R & ~31) + perm32(R & 31)) : R;
        voffA[i] = (unsigned)(R * K + C) * 2u; voffB[i] = (unsigned)(Rb * K + C) * 2u; }
    const size_t kstep = (size_t)(BK * 2);
    const size_t hstep = (size_t)HALF * K * 2;
    const size_t tstep = 2 * hstep;
    const unsigned ldsw = (unsigned)wid * 1024u;
    const int aoff = lds_byte(wr * 64 + fr, fq * 8), boff = lds_byte(wc * 32 + fr, fq * 8);
#define PG8_SA(b, h) (((b) * 2 + (h)) * HTB)
#define PG8_SB(b, h) ((4 + (b) * 2 + (h)) * HTB)
#define PG8_STAGE(bufoff, gbase, voff) do { _Pragma("unroll") for (int _i = 0; _i < 2; ++_i) \
        __builtin_amdgcn_global_load_lds((const unsigned*)((const char*)(gbase) + (voff)[_i]), (PG8_LAS unsigned*)(lds + (bufoff) + ldsw + _i * 8192), 16, 0, 0); } while (0)
#define PG8_LDA(dst, b, h) do { _Pragma("unroll") for (int m = 0; m < 4; ++m) _Pragma("unroll") for (int k = 0; k < 2; ++k) dst[m][k] = *(const PG8_LAS bf16x8*)(lds + PG8_SA(b, h) + aoff + m * 2048 + k * 1024); } while (0)
#define PG8_LDB(dst, b, h) do { _Pragma("unroll") for (int n = 0; n < 2; ++n) _Pragma("unroll") for (int k = 0; k < 2; ++k) dst[n][k] = *(const PG8_LAS bf16x8*)(lds + PG8_SB(b, h) + boff + n * 2048 + k * 1024); } while (0)
#define PG8_MMA(ai, bj, At, Bt) do { __builtin_amdgcn_s_setprio(1); _Pragma("unroll") for (int m = 0; m < 4; ++m) _Pragma("unroll") for (int n = 0; n < 2; ++n) _Pragma("unroll") for (int k = 0; k < 2; ++k) \
        acc[ai][bj][m][n] = __builtin_amdgcn_mfma_f32_16x16x32_bf16(Bt[n][k], At[m][k], acc[ai][bj][m][n], 0, 0, 0); __builtin_amdgcn_s_setprio(0); } while (0)
#define PG8_WAIT_V(n) asm volatile("s_waitcnt vmcnt(" #n ")" ::: "memory")
#define PG8_WAIT_L(n) asm volatile("s_waitcnt lgkmcnt(" #n ")" ::: "memory")
#define PG8_BAR __builtin_amdgcn_s_barrier()
#define PG8_SCHED __builtin_amdgcn_sched_barrier(0)
    Unit cur, nxt; int ui = 0;
    if (!S.next(0, cur)) return;
    f32x4 acc[2][2][4][2];
    u32x4 ipre[Epi::INIT ? 16 : 1];
    if constexpr (Epi::INIT) E.init_issue(ipre, cur, wr, wc, fr, fq);
    else {
#pragma unroll
    for (int a = 0; a < 2; ++a)
#pragma unroll
        for (int b = 0; b < 2; ++b)
#pragma unroll
            for (int m = 0; m < 4; ++m)
#pragma unroll
                for (int n = 0; n < 2; ++n) acc[a][b][m][n] = (f32x4){0.f, 0.f, 0.f, 0.f};
    }
    bf16x8 At[4][2], B0[2][2], B1[2][2];
    const char* cA = (const char*)g.A + (size_t)cur.pm * tstep; const char* cB = (const char*)g.Bt + (size_t)cur.pn * tstep;
    S.a_ready(cur);
    if constexpr (SP2) {
        PG8_STAGE(PG8_SB(0, 0), cB, voffB); PG8_STAGE(PG8_SB(0, 1), cB + hstep, voffB); PG8_STAGE(PG8_SA(0, 0), cA, voffA); PG8_STAGE(PG8_SA(0, 1), cA + hstep, voffA);
        if (wr == 1) PG8_BAR;
        PG8_WAIT_V(2); PG8_BAR;
        PG8_STAGE(PG8_SB(1, 0), cB + kstep, voffB); PG8_STAGE(PG8_SA(1, 0), cA + kstep, voffA); PG8_STAGE(PG8_SB(1, 1), cB + hstep + kstep, voffB);
        PG8_WAIT_V(6); PG8_BAR;
    } else {
        PG8_STAGE(PG8_SB(0, 0), cB, voffB); PG8_STAGE(PG8_SA(0, 0), cA, voffA); PG8_STAGE(PG8_SB(0, 1), cB + hstep, voffB); PG8_STAGE(PG8_SA(0, 1), cA + hstep, voffA);
        if (wr == 1) PG8_BAR;
        PG8_WAIT_V(4); PG8_BAR;
        PG8_STAGE(PG8_SB(1, 0), cB + kstep, voffB); PG8_STAGE(PG8_SA(1, 0), cA + kstep, voffA); PG8_STAGE(PG8_SB(1, 1), cB + hstep + kstep, voffB);
        PG8_WAIT_V(6); PG8_BAR;
    }
    if constexpr (Epi::INIT) E.init_finish(acc, ipre);
    for (;;) {
        const bool has_next = KS ? S.next((ui + 1) >> 1, nxt) : S.next(ui + 1, nxt);
        const size_t nko = (KS && ((ui + 1) & 1)) ? (size_t)nt * kstep : (size_t)0;
        const char* nA = has_next ? (const char*)g.A + (size_t)nxt.pm * tstep + nko : cA; const char* nB = has_next ? (const char*)g.Bt + (size_t)nxt.pn * tstep + nko : cB;
        for (int t = 0; t < nt; t += 2) {
            const bool last = (t == nt - 2);
            const char* a1 = cA + (size_t)(t + 1) * kstep;
            const char* a2 = last ? nA : cA + (size_t)(t + 2) * kstep; const char* b2 = last ? nB : cB + (size_t)(t + 2) * kstep;
            const char* a3 = a2 + kstep; const char* b3 = b2 + kstep;
            if (last && has_next) S.a_ready(nxt);
            if constexpr (SP2) {
            PG8_LDB(B0, 0, 0); PG8_LDB(B1, 0, 1); PG8_SCHED; PG8_LDA(At, 0, 0); PG8_STAGE(PG8_SA(1, 1), a1 + hstep, voffA);
            PG8_WAIT_V(8); PG8_WAIT_L(0); PG8_BAR; PG8_MMA(0, 0, At, B0); PG8_MMA(0, 1, At, B1); PG8_BAR; PG8_SCHED;
            PG8_LDA(At, 0, 1); PG8_STAGE(PG8_SB(0, 0), b2, voffB); PG8_STAGE(PG8_SB(0, 1), b2 + hstep, voffB); PG8_STAGE(PG8_SA(0, 0), a2, voffA);
            PG8_WAIT_V(8); PG8_WAIT_L(0); PG8_BAR; PG8_MMA(1, 0, At, B0); PG8_MMA(1, 1, At, B1); PG8_BAR; PG8_SCHED;
            PG8_LDB(B0, 1, 0); PG8_LDB(B1, 1, 1); PG8_SCHED; PG8_LDA(At, 1, 0); PG8_STAGE(PG8_SA(0, 1), a2 + hstep, voffA);
            PG8_WAIT_V(8); PG8_WAIT_L(0); PG8_BAR; PG8_MMA(0, 0, At, B0); PG8_MMA(0, 1, At, B1); PG8_BAR; PG8_SCHED;
            PG8_LDA(At, 1, 1); PG8_STAGE(PG8_SB(1, 0), b3, voffB); PG8_STAGE(PG8_SB(1, 1), b3 + hstep, voffB); PG8_STAGE(PG8_SA(1, 0), a3, voffA);
            PG8_WAIT_V(8); PG8_WAIT_L(0); PG8_BAR; PG8_MMA(1, 0, At, B0); PG8_MMA(1, 1, At, B1); PG8_BAR; PG8_SCHED;
            } else {
            PG8_LDB(B0, 0, 0); PG8_SCHED; PG8_LDA(At, 0, 0); PG8_STAGE(PG8_SA(1, 1), a1 + hstep, voffA);
            PG8_WAIT_L(8); PG8_BAR; PG8_WAIT_L(0); PG8_MMA(0, 0, At, B0); PG8_BAR; PG8_SCHED;
            PG8_LDB(B1, 0, 1); PG8_STAGE(PG8_SB(0, 0), b2, voffB);
            PG8_BAR; PG8_WAIT_L(0); PG8_MMA(0, 1, At, B1); PG8_BAR;
            PG8_LDA(At, 0, 1); PG8_STAGE(PG8_SA(0, 0), a2, voffA);
            PG8_BAR; PG8_WAIT_L(0); PG8_MMA(1, 0, At, B0); PG8_BAR; PG8_SCHED;
            PG8_STAGE(PG8_SB(0, 1), b2 + hstep, voffB);
            PG8_WAIT_V(6); PG8_BAR; PG8_MMA(1, 1, At, B1); PG8_BAR;
            PG8_LDB(B0, 1, 0); PG8_SCHED; PG8_LDA(At, 1, 0); PG8_STAGE(PG8_SA(0, 1), a2 + hstep, voffA);
            PG8_WAIT_L(8); PG8_BAR; PG8_WAIT_L(0); PG8_MMA(0, 0, At, B0); PG8_BAR; PG8_SCHED;
            PG8_LDB(B1, 1, 1); PG8_STAGE(PG8_SB(1, 0), b3, voffB);
            PG8_BAR; PG8_WAIT_L(0); PG8_MMA(0, 1, At, B1); PG8_BAR;
            PG8_LDA(At, 1, 1); PG8_STAGE(PG8_SA(1, 0), a3, voffA);
            PG8_BAR; PG8_WAIT_L(0); PG8_MMA(1, 0, At, B0); PG8_BAR; PG8_SCHED;
            PG8_STAGE(PG8_SB(1, 1), b3 + hstep, voffB);
            PG8_WAIT_V(6); PG8_BAR; PG8_MMA(1, 1, At, B1); PG8_BAR;
            }
        }
        if constexpr (ALIGN_EPI) { if (wr == 0) PG8_BAR; }
        if constexpr (KS) { if (ui & 1) { E(acc, cur, wr, wc, fr, fq); S.done(cur); } else E.mid(acc, cur, wr, wc, fr, fq); }
        else if constexpr (!Epi::AFTER_DRAIN) { E(acc, cur, wr, wc, fr, fq); S.done(cur); }
        if (!has_next) break;
        if constexpr (Epi::INIT) { E.init_issue(ipre, nxt, wr, wc, fr, fq); E.init_finish(acc, ipre); }
        else if (!KS || (ui & 1)) {
#pragma unroll
        for (int a = 0; a < 2; ++a)
#pragma unroll
            for (int b = 0; b < 2; ++b)
#pragma unroll
                for (int m = 0; m < 4; ++m)
#pragma unroll
                    for (int n = 0; n < 2; ++n) acc[a][b][m][n] = (f32x4){0.f, 0.f, 0.f, 0.f};
        }
        cur = nxt; cA = nA; cB = nB; ++ui;
        if constexpr (ALIGN_EPI) { if (wr == 1) PG8_BAR; }
    }
    PG8_WAIT_V(0);
    if constexpr (!ALIGN_EPI) { if (wr == 0) PG8_BAR; }
    PG8_BAR;
    if constexpr (Epi::AFTER_DRAIN) { E.fused(acc, cur, wr, wc, fr, fq, lds, wid, lane); S.done(cur); }
#undef PG8_SA
#undef PG8_SB
#undef PG8_STAGE
#undef PG8_LDA
#undef PG8_LDB
#undef PG8_MMA
#undef PG8_WAIT_V
#undef PG8_WAIT_L
#undef PG8_BAR
#undef PG8_SCHED
}
}
#define GAS __attribute__((address_space(1)))
#define LAS __attribute__((address_space(3)))
typedef unsigned short bf16;
typedef unsigned v4u __attribute__((ext_vector_type(4)));
typedef float f32x4 __attribute__((ext_vector_type(4)));
typedef short bf16x8 __attribute__((ext_vector_type(8)));
typedef GAS unsigned gu32;
typedef GAS unsigned long long gu64;
#define RLX_AGENT __ATOMIC_RELAXED, __HIP_MEMORY_SCOPE_AGENT
#define LDS_WAIT() asm volatile("s_waitcnt lgkmcnt(0)" ::: "memory")
#define VM_WAIT() asm volatile("s_waitcnt vmcnt(0)" ::: "memory")
__device__ __forceinline__ unsigned long long rt() { return __builtin_amdgcn_s_memrealtime(); }
__device__ __forceinline__ unsigned f2bf(float f) { unsigned u = __builtin_bit_cast(unsigned, f); return (u + 0x7fffu + ((u >> 16) & 1u)) >> 16; }
__device__ __forceinline__ unsigned pk2(float lo, float hi) { return f2bf(lo) | (f2bf(hi) << 16); }
#define XB_TMO      128
#define XB_XCNT(j)  (256  + 64 * (j))
#define XB_XSUB(j)  (1280 + 64 * (j))
#define XB_XGEN(j)  (2304 + 64 * (j))
#define XB_TOP      3328
#define XB_TOPGEN   3392
#define XCD_BAR_WORDS 3456
#define XB_SPIN_CAP (1u << 18)

__device__ __forceinline__ unsigned xb_ld(unsigned* p)              { return __hip_atomic_load(p, __ATOMIC_RELAXED, __HIP_MEMORY_SCOPE_AGENT); }
__device__ __forceinline__ unsigned xb_add(unsigned* p, unsigned v) { return __hip_atomic_fetch_add(p, v, __ATOMIC_RELAXED, __HIP_MEMORY_SCOPE_AGENT); }
__device__ __forceinline__ unsigned xb_xcc_id() { return (unsigned)__builtin_amdgcn_s_getreg((3 << 11) | 20) & 0xFu; }
#define XB_SPIN(cond, bar) do { unsigned _sp = 0; while (cond) { __builtin_amdgcn_s_sleep(1); \
    if ((++_sp & 255u) == 0u) { if (xb_ld(&(bar)[XB_TMO])) break; if (_sp > XB_SPIN_CAP) { atomicAdd(&(bar)[XB_TMO], 1u); break; } } } } while (0)

struct XcdBarrier {
    unsigned* bar; unsigned x;
    volatile LAS unsigned* st;
};

__device__ __forceinline__ XcdBarrier xcd_barrier_post(unsigned* bar, volatile LAS unsigned* st) {
    XcdBarrier b; b.bar = bar; b.x = xb_xcc_id(); b.st = st;
    if (threadIdx.x == 0) (void)xb_add(&bar[XB_XCNT(b.x)], 1u);
    return b;
}
__device__ __forceinline__ void xcd_barrier_complete(unsigned* bar, unsigned x, unsigned& nloc, unsigned& nx) {
    const unsigned G = gridDim.x * gridDim.y * gridDim.z;
    unsigned sum, cnt, mine, sp = 0u;
    for (;;) {
        sum = 0u; cnt = 0u; mine = 0u;
#pragma unroll
        for (unsigned j = 0; j < 16; ++j) { const unsigned c = xb_ld(&bar[XB_XCNT(j)]); sum += c; cnt += (c > 0u) ? 1u : 0u; mine = (j == x) ? c : mine; }
        if (sum == G) break;
        __builtin_amdgcn_s_sleep(1);
        if ((++sp & 255u) == 0u) { if (xb_ld(&bar[XB_TMO])) break; if (sp > XB_SPIN_CAP) { atomicAdd(&bar[XB_TMO], 1u); break; } }
    }
    nloc = mine > 0u ? mine : 1u; nx = cnt > 0u ? cnt : 1u;
}

__device__ __forceinline__ void xcd_barrier(const XcdBarrier& b) {
    asm volatile("s_waitcnt vmcnt(0)" ::: "memory");
    __syncthreads();
    if (threadIdx.x == 0) {
        unsigned* bar = b.bar;
        __builtin_amdgcn_s_waitcnt(0);
        unsigned nloc = b.st[0], nx = b.st[1];
        if (nloc == 0u) { xcd_barrier_complete(bar, b.x, nloc, nx); b.st[0] = nloc; b.st[1] = nx; }
        const unsigned old = xb_add(&bar[XB_XSUB(b.x)], 1u);
        const unsigned gen = old / nloc;
        if (old + 1u == (gen + 1u) * nloc) {
            __builtin_amdgcn_fence(__ATOMIC_RELEASE, "agent");
            asm volatile("s_waitcnt vmcnt(0)" ::: "memory");
            const unsigned og = xb_add(&bar[XB_TOP], 1u);
            const unsigned tg = og / nx;
            if (og + 1u == (tg + 1u) * nx) xb_add(&bar[XB_TOPGEN], 1u);
            else XB_SPIN(xb_ld(&bar[XB_TOPGEN]) == tg, bar);
            __builtin_amdgcn_fence(__ATOMIC_ACQUIRE, "agent");
            xb_add(&bar[XB_XGEN(b.x)], 1u);
            asm volatile("s_waitcnt vmcnt(0)" ::: "memory");
        } else {
            XB_SPIN(xb_ld(&bar[XB_XGEN(b.x)]) == gen, bar);
            __builtin_amdgcn_fence(__ATOMIC_ACQUIRE, "agent");
            asm volatile("s_waitcnt vmcnt(0)" ::: "memory");
        }
    }
    __syncthreads();
}

template <class BG> __device__ __forceinline__ void xcd_barrier_bg(const XcdBarrier& b, const BG& bg) {
    asm volatile("s_waitcnt vmcnt(0)" ::: "memory");
    __syncthreads();
    if (threadIdx.x == 0) {
        unsigned* bar = b.bar;
        __builtin_amdgcn_s_waitcnt(0);
        unsigned nloc = b.st[0], nx = b.st[1];
        if (nloc == 0u) { xcd_barrier_complete(bar, b.x, nloc, nx); b.st[0] = nloc; b.st[1] = nx; }
        const unsigned old = xb_add(&bar[XB_XSUB(b.x)], 1u);
        const unsigned gen = old / nloc;
        if (old + 1u == (gen + 1u) * nloc) {
            __builtin_amdgcn_fence(__ATOMIC_RELEASE, "agent");
            asm volatile("s_waitcnt vmcnt(0)" ::: "memory");
            const unsigned og = xb_add(&bar[XB_TOP], 1u);
            const unsigned tg = og / nx;
            if (og + 1u == (tg + 1u) * nx) xb_add(&bar[XB_TOPGEN], 1u);
            else XB_SPIN(xb_ld(&bar[XB_TOPGEN]) == tg, bar);
            __builtin_amdgcn_fence(__ATOMIC_ACQUIRE, "agent");
            xb_add(&bar[XB_XGEN(b.x)], 1u);
            asm volatile("s_waitcnt vmcnt(0)" ::: "memory");
        } else {
            XB_SPIN(xb_ld(&bar[XB_XGEN(b.x)]) == gen, bar);
            __builtin_amdgcn_fence(__ATOMIC_ACQUIRE, "agent");
            asm volatile("s_waitcnt vmcnt(0)" ::: "memory");
        }
    } else if (threadIdx.x >= 64) bg();
    __syncthreads();
}

constexpr int D = 1024, MP = 16384, MS = 1024, M = MP + MS, DFF = 2816, INW = 4864;
constexpr float EPS = 1e-6f;
constexpr size_t O_YS = (size_t)MP * D, O_PWK = O_YS + (size_t)MS * D, O_PWV = O_PWK + 65536, O_PST = O_PWV + 65536, O_SWK = O_PST + 262144, O_SWV = O_SWK + 2097152, O_SST = O_SWV + 2097152;
constexpr size_t MiB = 1u << 20, HMiB = 1u << 19;
constexpr size_t WS_CTL = 0, CTL_ZERO_BYTES = 1 * MiB;
constexpr size_t WS_W13 = 1 * MiB, WS_W2 = 12 * MiB, WS_WIN = 17 * MiB + HMiB, WS_WUA = 27 * MiB, WS_WUR = 28 * MiB, WS_WOUT = 29 * MiB;
constexpr size_t WS_DEC = 31 * MiB, WS_RSTD1 = 31 * MiB + HMiB, WS_SSQ1 = 32 * MiB, WS_SSQ2 = 34 * MiB;
constexpr size_t WS_AB = 36 * MiB, WS_BIG = 70 * MiB;
constexpr size_t WS_HID = WS_BIG, WS_Q = WS_BIG, WS_KV = WS_BIG + 17 * MiB, WS_QR = WS_KV + 8 * MiB + HMiB, WS_LOGF = WS_QR + 17 * MiB, WS_MRG = WS_LOGF, WS_IR = WS_LOGF + 34 * MiB,
                 WS_GR = WS_IR + 17 * MiB, WS_SGA = WS_GR + 17 * MiB, WS_SGR = WS_SGA + 17 * MiB, WS_AOR = WS_SGR + 17 * MiB, WS_END = WS_AOR + 34 * MiB;
static_assert(WS_END <= 256 * MiB && WS_HID + (size_t)M * DFF * 2 <= WS_END, "ws map");
constexpr int CW_BAR = 4096;
constexpr int RING_OFF = 0, RING_BYTES = 131072, LDSCTL_OFF = 139264, MISC_OFF = LDSCTL_OFF + 320, LDS_BYTES = 147456;
constexpr int NWAVES = 8;

namespace mk {
using pg8::f32x4; using pg8::u32x4; using pg8::Unit; using pg8::bf16_t; using pg8::cvt_pk_bf16;
typedef unsigned u32x2 __attribute__((ext_vector_type(2)));
__device__ __forceinline__ float fsigmoid(float x) { return __builtin_amdgcn_rcpf(1.f + __expf(-x)); }
__device__ __forceinline__ float fsilu(float x) { return x * fsigmoid(x); }
__device__ __forceinline__ float bflo(unsigned w) { return __uint_as_float(w << 16); }
__device__ __forceinline__ float bfhi(unsigned w) { return __uint_as_float(w & 0xffff0000u); }
__device__ __forceinline__ float bf2f(bf16_t h) { return __uint_as_float((unsigned)h << 16); }
__device__ __forceinline__ u32x4 pack8(const f32x4 a, const f32x4 b) { u32x4 w; w.x = cvt_pk_bf16(a[0], a[1]); w.y = cvt_pk_bf16(a[2], a[3]); w.z = cvt_pk_bf16(b[0], b[1]); w.w = cvt_pk_bf16(b[2], b[3]); return w; }
__device__ __forceinline__ float dot4(const f32x4 a) { return (a[0] * a[0] + a[1] * a[1]) + (a[2] * a[2] + a[3] * a[3]); }
__device__ __forceinline__ unsigned q16(float s) { return (unsigned)(s * 65535.f + 0.5f); }
__device__ __forceinline__ unsigned q8(float s) { return (unsigned)(s * 255.f + 0.5f); }
__device__ __forceinline__ unsigned pack4q8(const f32x4 s) { return q8(s[0]) | (q8(s[1]) << 8) | (q8(s[2]) << 16) | (q8(s[3]) << 24); }
__device__ __forceinline__ f32x4 unpack4q8(unsigned w) { return (f32x4){(float)(w & 0xffu), (float)((w >> 8) & 0xffu), (float)((w >> 16) & 0xffu), (float)(w >> 24)} * (1.f / 255.f); }
__device__ __forceinline__ float row_rstd16(const float* ssqp, int r) {
    const f32x4* p = (const f32x4*)(ssqp + (size_t)r * 16); const f32x4 a = p[0], b = p[1], c = p[2], d = p[3]; const f32x4 s = (a + b) + (c + d);
    return rsqrtf(((s[0] + s[1]) + (s[2] + s[3])) * (1.f / 1024.f) + EPS);
}

constexpr int RTAB_OFF = LDSCTL_OFF + 1024;
template <bool FROM_SSQ, class Sched> __device__ __forceinline__ void build_rstd_table(LAS unsigned char* L, const Sched& S, const float* src, int tid) {
    Unit u;
    for (int i = 0; i < 6 && S.next(i, u); ++i) if (tid < 256) *(LAS float*)(L + RTAB_OFF + (i * 256 + tid) * 4) = FROM_SSQ ? row_rstd16(src, u.pm * 256 + tid) : src[u.pm * 256 + tid];
    __syncthreads();
}
template <bool FROM_SSQ> struct EpiSwiglu {
    static constexpr bool PERM = true, AFTER_DRAIN = false, INIT = false; static constexpr int MIDT = 0;
    bf16_t* H; const float* rs; LAS unsigned char* tab;
    __device__ __forceinline__ void operator()(const f32x4 (&acc)[2][2][4][2], const Unit& u, int wr, int wc, int fr, int fq) const {
        const int row0 = u.pm * 256 + wr * 64 + fr, col0 = u.pn * 128 + wc * 32 + 8 * fq;
#pragma unroll
        for (int ai = 0; ai < 2; ++ai)
#pragma unroll
            for (int m = 0; m < 4; ++m) {
                const int r = row0 + ai * 128 + m * 16;
                const float s = u.idx < 6 ? *(const LAS float*)(tab + (u.idx * 256 + (r & 255)) * 4) : (FROM_SSQ ? row_rstd16(rs, r) : rs[r]);
                f32x4 h0, h1;
#pragma unroll
                for (int e = 0; e < 4; ++e) { h0[e] = fsilu(acc[ai][0][m][0][e] * s) * (acc[ai][1][m][0][e] * s); h1[e] = fsilu(acc[ai][0][m][1][e] * s) * (acc[ai][1][m][1][e] * s); }
                *(u32x4*)(H + (size_t)r * DFF + col0) = pack8(h0, h1);
            }
    }
};
template <bool WRITE_B> struct EpiResid {
    static constexpr bool PERM = false, AFTER_DRAIN = false, INIT = false; static constexpr int MIDT = 0;
    const float* xp; const float* xs; float* Hout; bf16_t* HB; float* ssqp; float scale; int base_is_x;
    __device__ __forceinline__ void operator()(const f32x4 (&acc)[2][2][4][2], const Unit& u, int wr, int wc, int fr, int fq) const {
        const int row0 = u.pm * 256 + wr * 64 + fr, col0 = u.pn * 256 + wc * 32 + 4 * fq;
        f32x4 pre[3][4];
#define ER_BASE(g_) (base_is_x ? (row0 + ((g_) >> 2) * 128 + ((g_) & 3) * 16 < MP ? xp + (size_t)(row0 + ((g_) >> 2) * 128 + ((g_) & 3) * 16) * D : xs + (size_t)(row0 + ((g_) >> 2) * 128 + ((g_) & 3) * 16 - MP) * D) : Hout + (size_t)(row0 + ((g_) >> 2) * 128 + ((g_) & 3) * 16) * D)
#define ER_LOAD(g_) do { const float* bp_ = ER_BASE(g_); _Pragma("unroll") for (int q_ = 0; q_ < 4; ++q_) pre[(g_) % 3][q_] = *(const f32x4*)(bp_ + col0 + (q_ >> 1) * 128 + (q_ & 1) * 16); } while (0)
        ER_LOAD(0); ER_LOAD(1);
#pragma unroll
        for (int g = 0; g < 8; ++g) {
            if (g + 2 < 8) ER_LOAD(g + 2);
            const int ai = g >> 2, m = g & 3, r = row0 + ai * 128 + m * 16;
            float* op = Hout + (size_t)r * D; float ss = 0.f;
#pragma unroll
            for (int q = 0; q < 4; ++q) {
                const int bj = q >> 1, n = q & 1, c = col0 + bj * 128 + n * 16; const f32x4 o = pre[g % 3][q] + acc[ai][bj][m][n] * scale;
                if (WRITE_B) *(f32x4*)(op + c) = o; else __builtin_nontemporal_store(o, (f32x4*)(op + c));
                if (WRITE_B) { ss += dot4(o); u32x2 w; w.x = cvt_pk_bf16(o[0], o[1]); w.y = cvt_pk_bf16(o[2], o[3]); *(u32x2*)(HB + (size_t)r * D + c) = w; }
            }
            if (WRITE_B) { ss += __shfl_xor(ss, 16); ss += __shfl_xor(ss, 32); if (fq == 0) ssqp[(size_t)r * 16 + u.pn * 4 + wc] = ss; }
            __builtin_amdgcn_sched_barrier(0);
        }
#undef ER_LOAD
#undef ER_BASE
    }
    __device__ __forceinline__ void tail(const f32x4 (&acc)[4], int r, int c0, int fq) const {
        const float* bp = base_is_x ? (r < MP ? xp + (size_t)r * D : xs + (size_t)(r - MP) * D) : Hout + (size_t)r * D;
        float* op = Hout + (size_t)r * D; float ss = 0.f;
#pragma unroll
        for (int n = 0; n < 4; ++n) {
            const int c = c0 + 16 * n + 4 * fq; const f32x4 b = *(const f32x4*)(bp + c); const f32x4 o = b + acc[n] * scale; if (WRITE_B) *(f32x4*)(op + c) = o; else __builtin_nontemporal_store(o, (f32x4*)(op + c));
            if (WRITE_B) { ss += dot4(o); u32x2 w; w.x = cvt_pk_bf16(o[0], o[1]); w.y = cvt_pk_bf16(o[2], o[3]); *(u32x2*)(HB + (size_t)r * D + c) = w; }
        }
        if (WRITE_B) { ss += __shfl_xor(ss, 16); ss += __shfl_xor(ss, 32); if (fq == 0) ssqp[(size_t)r * 16 + (c0 >> 6)] = ss; }
    }
};
template <bool FINAL> struct EpiResidB {
    static constexpr bool PERM = true, AFTER_DRAIN = false, INIT = true; static constexpr int MIDT = 0;
    bf16_t* HB; float* Y; float* ssqp; float scale;
    __device__ __forceinline__ void init_issue(u32x4 (&pre)[16], const Unit& u, int wr, int wc, int fr, int fq) const {
        const int row0 = u.pm * 256 + wr * 64 + fr, col0 = u.pn * 256 + wc * 32 + 8 * fq;
#pragma unroll
        for (int g = 0; g < 8; ++g)
#pragma unroll
            for (int bj = 0; bj < 2; ++bj) pre[2 * g + bj] = *(const u32x4*)(HB + (size_t)(row0 + (g >> 2) * 128 + (g & 3) * 16) * D + col0 + 128 * bj);
    }
    __device__ __forceinline__ void init_finish(f32x4 (&acc)[2][2][4][2], const u32x4 (&pre)[16]) const {
        const float inv = 1.f / scale;
#pragma unroll
        for (int g = 0; g < 8; ++g)
#pragma unroll
            for (int bj = 0; bj < 2; ++bj) { const u32x4 b = pre[2 * g + bj];
                acc[g >> 2][bj][g & 3][0] = (f32x4){bflo(b.x), bfhi(b.x), bflo(b.y), bfhi(b.y)} * inv; acc[g >> 2][bj][g & 3][1] = (f32x4){bflo(b.z), bfhi(b.z), bflo(b.w), bfhi(b.w)} * inv; }
    }
    __device__ __forceinline__ void operator()(const f32x4 (&acc)[2][2][4][2], const Unit& u, int wr, int wc, int fr, int fq) const {
        const int row0 = u.pm * 256 + wr * 64 + fr, col0 = u.pn * 256 + wc * 32 + 8 * fq;
#pragma unroll
        for (int g = 0; g < 8; ++g) {
            const int ai = g >> 2, m = g & 3, r = row0 + ai * 128 + m * 16; float ss = 0.f;
#pragma unroll
            for (int bj = 0; bj < 2; ++bj) {
                const f32x4 o0 = acc[ai][bj][m][0] * scale, o1 = acc[ai][bj][m][1] * scale;
                if (FINAL) { float* yp = Y + (size_t)r * D + col0 + 128 * bj; __builtin_nontemporal_store(o0, (f32x4*)yp); __builtin_nontemporal_store(o1, (f32x4*)(yp + 4)); }
                else { ss += dot4(o0) + dot4(o1); *(u32x4*)(HB + (size_t)r * D + col0 + 128 * bj) = pack8(o0, o1); }
            }
            if (!FINAL) { ss += __shfl_xor(ss, 16); ss += __shfl_xor(ss, 32); if (fq == 0) ssqp[(size_t)r * 16 + u.pn * 4 + wc] = ss; }
        }
    }
    __device__ __forceinline__ void tail(const f32x4 (&acc)[4], int r, int c0, int fq) const {
        bf16_t* bp = HB + (size_t)r * D + c0 + 4 * fq; float ss = 0.f; u32x2 b[4];
#pragma unroll
        for (int n = 0; n < 4; ++n) b[n] = *(const u32x2*)(bp + 16 * n);
#pragma unroll
        for (int n = 0; n < 4; ++n) {
            const f32x4 o = (f32x4){bflo(b[n].x), bfhi(b[n].x), bflo(b[n].y), bfhi(b[n].y)} + acc[n] * scale;
            if (FINAL) __builtin_nontemporal_store(o, (f32x4*)(Y + (size_t)r * D + c0 + 16 * n + 4 * fq));
            else { ss += dot4(o); u32x2 w; w.x = cvt_pk_bf16(o[0], o[1]); w.y = cvt_pk_bf16(o[2], o[3]); *(u32x2*)(bp + 16 * n) = w; }
        }
        if (!FINAL) { ss += __shfl_xor(ss, 16); ss += __shfl_xor(ss, 32); if (fq == 0) ssqp[(size_t)r * 16 + (c0 >> 6)] = ss; }
    }
};
struct EpiProj {
    static constexpr bool PERM = true, AFTER_DRAIN = false, INIT = false; static constexpr int MIDT = 0;
    const float* ssqp; unsigned char* ws; float* out; const float *qn, *kn, *lbl; LAS unsigned char* tab;
    __device__ __forceinline__ void operator()(const f32x4 (&acc)[2][2][4][2], const Unit& u, int wr, int wc, int fr, int fq) const {
        const int pn = u.pn, row0 = u.pm * 256 + wr * 64 + fr, pc = wc * 32 + 8 * fq;
        bf16_t* const Q = (bf16_t*)(ws + WS_Q); bf16_t* const KV = (bf16_t*)(ws + WS_KV); unsigned short* const LOGF = (unsigned short*)(ws + WS_LOGF);
        if (pn < 3) {
            const bool isv = (pn == 2 && wc >= 2);
            const float* gp = (pn < 2) ? qn : kn;
            f32x4 gn[2][2];
#pragma unroll
            for (int bj = 0; bj < 2; ++bj)
#pragma unroll
                for (int n = 0; n < 2; ++n) gn[bj][n] = isv ? (f32x4){1.f, 1.f, 1.f, 1.f} : *(const f32x4*)(gp + 32 * bj + 8 * fq + 4 * n);
#pragma unroll
            for (int ai = 0; ai < 2; ++ai)
#pragma unroll
                for (int m = 0; m < 4; ++m) {
                    const int r = row0 + ai * 128 + m * 16; const float s = u.idx < 6 ? *(const LAS float*)(tab + (u.idx * 256 + (r & 255)) * 4) : row_rstd16(ssqp, r);
                    f32x4 v[2][2]; float ss = 0.f;
#pragma unroll
                    for (int bj = 0; bj < 2; ++bj)
#pragma unroll
                        for (int n = 0; n < 2; ++n) { v[bj][n] = acc[ai][bj][m][n] * s; ss += dot4(v[bj][n]); }
                    ss += __shfl_xor(ss, 16); ss += __shfl_xor(ss, 32);
                    const float nr = isv ? 1.f : rsqrtf(ss * (1.f / 64.f) + EPS);
#pragma unroll
                    for (int bj = 0; bj < 2; ++bj)
#pragma unroll
                        for (int n = 0; n < 2; ++n) v[bj][n] = v[bj][n] * nr * gn[bj][n];
                    bf16_t* dst = (pn < 2) ? Q + (size_t)r * 512 + (4 * pn + wc) * 64 + 8 * fq : KV + (size_t)r * 256 + wc * 64 + 8 * fq;
#pragma unroll
                    for (int bj = 0; bj < 2; ++bj) *(u32x4*)(dst + 32 * bj) = pack8(v[bj][0], v[bj][1]);
                    if (pn == 2) {
                        float* o = nullptr; const int kvh = wc & 1;
                        if (r < MP) { const int t = r & 4095; if (t >= 3968) o = out + (wc < 2 ? O_PWK : O_PWV) + ((size_t)((r >> 12) * 128 + (t - 3968)) * 2 + kvh) * 64; }
                        else { const int rr = r - MP; o = out + (wc < 2 ? O_SWK : O_SWV) + ((size_t)((rr >> 3) * 128 + 120 + (rr & 7)) * 2 + kvh) * 64; }
                        if (o) {
#pragma unroll
                            for (int bj = 0; bj < 2; ++bj)
#pragma unroll
                                for (int n = 0; n < 2; ++n) *(f32x4*)(o + 32 * bj + 8 * fq + 4 * n) = v[bj][n];
                        }
                    }
                }
        } else if (pn >= 5 && pn < 7) {
            const int tc = (pn - 5) * 256 + pc;
            f32x4 lb[2][2];
#pragma unroll
            for (int bj = 0; bj < 2; ++bj)
#pragma unroll
                for (int n = 0; n < 2; ++n) { const f32x4 l0 = *(const f32x4*)(lbl + tc + 128 * bj + 4 * n), l1 = *(const f32x4*)(lbl + 512 + tc + 128 * bj + 4 * n);
#pragma unroll
                    for (int e = 0; e < 4; ++e) lb[bj][n][e] = 1.f / (1.f + __expf(l1[e] - l0[e])); }
#pragma unroll
            for (int ai = 0; ai < 2; ++ai)
#pragma unroll
                for (int m = 0; m < 4; ++m) {
                    const int r = row0 + ai * 128 + m * 16; const float s = u.idx < 6 ? *(const LAS float*)(tab + (u.idx * 256 + (r & 255)) * 4) : row_rstd16(ssqp, r);
#pragma unroll
                    for (int bj = 0; bj < 2; ++bj)
#pragma unroll
                        for (int n = 0; n < 2; ++n) { f32x4 lf;
#pragma unroll
                            for (int e = 0; e < 4; ++e) { const float f = lb[bj][n][e] + (1.f - lb[bj][n][e]) * fsigmoid(acc[ai][bj][m][n][e] * s); lf[e] = f; }
                            u32x2 w; w.x = q16(lf[0]) | (q16(lf[1]) << 16); w.y = q16(lf[2]) | (q16(lf[3]) << 16);
                            *(u32x2*)(LOGF + (size_t)r * 512 + tc + 128 * bj + 4 * n) = w; }
                }
        } else {
            int act, ld, tc; size_t boff;
            if (pn < 5) { act = 1; boff = WS_QR; ld = 512; tc = (pn - 3) * 256 + pc; }
            else if (pn < 9) { act = 0; boff = WS_IR; ld = 512; tc = (pn - 7) * 256 + pc; }
            else if (pn < 11) { act = 1; boff = WS_GR; ld = 512; tc = (pn - 9) * 256 + pc; }
            else if (pn < 15) { act = 2; boff = WS_SGA; ld = 1024; tc = (pn - 11) * 256 + pc; }
            else { act = 2; boff = WS_SGR; ld = 1024; tc = (pn - 15) * 256 + pc; }
            bf16_t* const base = (bf16_t*)(ws + boff);
#pragma unroll
            for (int ai = 0; ai < 2; ++ai)
#pragma unroll
                for (int m = 0; m < 4; ++m) {
                    const int r = row0 + ai * 128 + m * 16; const float s = u.idx < 6 ? *(const LAS float*)(tab + (u.idx * 256 + (r & 255)) * 4) : row_rstd16(ssqp, r);
#pragma unroll
                    for (int bj = 0; bj < 2; ++bj) { f32x4 a, b;
#pragma unroll
                        for (int e = 0; e < 4; ++e) { const float x0 = acc[ai][bj][m][0][e] * s, x1 = acc[ai][bj][m][1][e] * s;
                            a[e] = act == 0 ? x0 : (act == 1 ? fsilu(x0) : fsigmoid(x0)); b[e] = act == 0 ? x1 : (act == 1 ? fsilu(x1) : fsigmoid(x1)); }
                        if (act == 2) { u32x2 w; w.x = pack4q8(a); w.y = pack4q8(b); *(u32x2*)((unsigned char*)base + (size_t)r * ld + tc + 128 * bj) = w; }
                        else *(u32x4*)(base + (size_t)r * ld + tc + 128 * bj) = pack8(a, b); }
                }
        }
    }
};
struct ProjOrder {
    pg8::StaticOrder P; int G, c;
    __device__ void init(int G_, int c_) { P.init(MP, INW, G_, c_); G = G_; c = c_; }
    __device__ bool next(int i, Unit& u) const {
        if (P.next(i, u)) return true;
        const long L = (long)i * G + c - 1216; if (L >= 64) return false;
        const int q = (int)L & 15; u.pm = 64 + ((int)L >> 4); u.pn = q < 11 ? q : q + 3; u.idx = i; return true;
    }
    __device__ __forceinline__ void a_ready(const Unit&) const {}
    __device__ __forceinline__ void done(const Unit&) const {}
};
struct EpiProjTail {
    static constexpr int MIDT = 0;
    const float* ssqp; bf16_t* SGA;
    __device__ __forceinline__ void tail(const f32x4 (&acc)[4], int r, int c0, int fq) const {
        const float s = row_rstd16(ssqp, r);
#pragma unroll
        for (int n = 0; n < 4; ++n) { f32x4 a;
#pragma unroll
            for (int e = 0; e < 4; ++e) a[e] = fsigmoid(acc[n][e] * s);
            *(unsigned*)((unsigned char*)SGA + (size_t)r * 1024 + c0 + 16 * n + 4 * fq) = pack4q8(a); }
    }
};
template <int PASS> struct EpiUp {
    static constexpr bool PERM = true, AFTER_DRAIN = false, INIT = false; static constexpr int MIDT = 0;
    bf16_t* MRG; const bf16_t* G;
    __device__ __forceinline__ void operator()(const f32x4 (&acc)[2][2][4][2], const Unit& u, int wr, int wc, int fr, int fq) const {
        const int row0 = u.pm * 256 + wr * 64 + fr, c0 = u.pn * 256 + wc * 32 + 8 * fq;
#pragma unroll
        for (int ai = 0; ai < 2; ++ai)
#pragma unroll
            for (int m = 0; m < 4; ++m) {
                const int r = row0 + ai * 128 + m * 16;
#pragma unroll
                for (int bj = 0; bj < 2; ++bj) {
                    const size_t off = (size_t)r * 1024 + c0 + 128 * bj; const u32x2 g = *(const u32x2*)((const unsigned char*)G + off); const f32x4 ga = unpack4q8(g.x), gb = unpack4q8(g.y);
                    f32x4 a = acc[ai][bj][m][0], b = acc[ai][bj][m][1];
                    a = a * ga; b = b * gb;
                    if (PASS == 1) { const u32x4 p = *(const u32x4*)(MRG + off);
                        a[0] += bflo(p.x); a[1] += bfhi(p.x); a[2] += bflo(p.y); a[3] += bfhi(p.y); b[0] += bflo(p.z); b[1] += bfhi(p.z); b[2] += bflo(p.w); b[3] += bfhi(p.w); }
                    *(u32x4*)(MRG + off) = pack8(a, b);
                }
            }
    }
    __device__ __forceinline__ void tail(const f32x4 (&acc)[4], int r, int c0, int fq) const {
#pragma unroll
        for (int n = 0; n < 4; ++n) {
            const size_t off = (size_t)r * 1024 + c0 + 16 * n + 4 * fq; const f32x4 gq = unpack4q8(*(const unsigned*)((const unsigned char*)G + off));
            f32x4 a = acc[n] * gq;
            if (PASS == 1) { const u32x2 p = *(const u32x2*)(MRG + off); a[0] += bflo(p.x); a[1] += bfhi(p.x); a[2] += bflo(p.y); a[3] += bfhi(p.y); }
            u32x2 w; w.x = cvt_pk_bf16(a[0], a[1]); w.y = cvt_pk_bf16(a[2], a[3]); *(u32x2*)(MRG + off) = w;
        }
    }
};
struct EpiUpR {
    static constexpr bool PERM = true, AFTER_DRAIN = false, INIT = false; static constexpr int MIDT = 8;
    static constexpr float EPSQ = 1e-18f;
    bf16_t* MRG; const unsigned char* GA; const unsigned char* GR;
    static __device__ __forceinline__ f32x4 q4(unsigned w) { return (f32x4){(float)(w & 0xffu), (float)((w >> 8) & 0xffu), (float)((w >> 16) & 0xffu), (float)(w >> 24)}; }
    static __device__ __forceinline__ f32x4 ratio4(unsigned wa, unsigned wr_) { const f32x4 a = q4(wa), r = q4(wr_);
        return (f32x4){a[0] * __builtin_amdgcn_rcpf(fmaxf(r[0], EPSQ)), a[1] * __builtin_amdgcn_rcpf(fmaxf(r[1], EPSQ)), a[2] * __builtin_amdgcn_rcpf(fmaxf(r[2], EPSQ)), a[3] * __builtin_amdgcn_rcpf(fmaxf(r[3], EPSQ))}; }
    static __device__ __forceinline__ f32x4 gate4(unsigned wr_) { const f32x4 r = q4(wr_); return (f32x4){fmaxf(r[0], EPSQ), fmaxf(r[1], EPSQ), fmaxf(r[2], EPSQ), fmaxf(r[3], EPSQ)} * (1.f / 255.f); }
    __device__ __forceinline__ void mid(f32x4 (&acc)[2][2][4][2], const Unit& u, int wr, int wc, int fr, int fq) const {
        const int row0 = u.pm * 256 + wr * 64 + fr, c0 = u.pn * 256 + wc * 32 + 8 * fq;
#pragma unroll
        for (int ai = 0; ai < 2; ++ai)
#pragma unroll
            for (int m = 0; m < 4; ++m) {
                const int r = row0 + ai * 128 + m * 16;
#pragma unroll
                for (int bj = 0; bj < 2; ++bj) {
                    const size_t off = (size_t)r * 1024 + c0 + 128 * bj; const u32x2 ga = *(const u32x2*)(GA + off), gr = *(const u32x2*)(GR + off);
                    acc[ai][bj][m][0] = acc[ai][bj][m][0] * ratio4(ga.x, gr.x); acc[ai][bj][m][1] = acc[ai][bj][m][1] * ratio4(ga.y, gr.y);
                }
                if (m == 1 || m == 3) __builtin_amdgcn_sched_barrier(0);
            }
    }
    __device__ __forceinline__ void operator()(const f32x4 (&acc)[2][2][4][2], const Unit& u, int wr, int wc, int fr, int fq) const {
        const int row0 = u.pm * 256 + wr * 64 + fr, c0 = u.pn * 256 + wc * 32 + 8 * fq;
#pragma unroll
        for (int ai = 0; ai < 2; ++ai)
#pragma unroll
            for (int m = 0; m < 4; ++m) {
                const int r = row0 + ai * 128 + m * 16;
#pragma unroll
                for (int bj = 0; bj < 2; ++bj) {
                    const size_t off = (size_t)r * 1024 + c0 + 128 * bj; const u32x2 gr = *(const u32x2*)(GR + off);
                    *(u32x4*)(MRG + off) = pack8(acc[ai][bj][m][0] * gate4(gr.x), acc[ai][bj][m][1] * gate4(gr.y));
                }
            }
    }
    __device__ __forceinline__ void mid_tail(f32x4 (&acc)[4], int r, int c0, int fq) const {
#pragma unroll
        for (int n = 0; n < 4; ++n) { const size_t off = (size_t)r * 1024 + c0 + 16 * n + 4 * fq; acc[n] = acc[n] * ratio4(*(const unsigned*)(GA + off), *(const unsigned*)(GR + off)); }
    }
    __device__ __forceinline__ void tail(const f32x4 (&acc)[4], int r, int c0, int fq) const {
#pragma unroll
        for (int n = 0; n < 4; ++n) { const size_t off = (size_t)r * 1024 + c0 + 16 * n + 4 * fq; const f32x4 a = acc[n] * gate4(*(const unsigned*)(GR + off));
            u32x2 w; w.x = cvt_pk_bf16(a[0], a[1]); w.y = cvt_pk_bf16(a[2], a[3]); *(u32x2*)(MRG + off) = w; }
    }
};
template <class Epi> __device__ __forceinline__ void gemm_tail(LAS unsigned char* L, const bf16_t* A, const bf16_t* Bt, int K, int row_base, int ntr, int ntc, int v, int G, const Epi& E, int tid, int lane, int wave) {
    constexpr int RS = 528, OPB = 64 * RS, BUF = 2 * OPB, XCH = 0;
    static_assert(2 * BUF <= LDSCTL_OFF, "tail buffers must stay below the LDS control words");
    const int fr = lane & 15, fq = lane >> 4, rw = wave & 3, kh = wave >> 2, nc = K / 256;
    const int lrow = tid >> 5, lch = tid & 31;
    for (int tt = v; tt < ntr * ntc; tt += G) {
        int tr = tt / ntc, tc = tt % ntc;
        if (ntr == 16 && ntc == 16 && G == 256) { const int x = tt >> 5, q = tt & 31; tr = (x >> 1) * 4 + (q >> 3); tc = (x & 1) * 8 + (q & 7); }
        const int r0 = row_base + 64 * tr, c0 = 64 * tc;
        const bf16_t* Ag = A + (size_t)(r0 + lrow) * K + 8 * lch; const bf16_t* Bg = Bt + (size_t)(c0 + lrow) * K + 8 * lch; const size_t h16 = (size_t)16 * K;
        u32x4 ra0[4], rb0[4], ra1[4], rb1[4], ra2[4], rb2[4];
#define TL_LOAD(ra, rb, c) do { _Pragma("unroll") for (int j_ = 0; j_ < 4; ++j_) { ra[j_] = *(const u32x4*)(Ag + j_ * h16 + 256 * (c)); rb[j_] = *(const u32x4*)(Bg + j_ * h16 + 256 * (c)); } } while (0)
#define TL_WRITE(ra, rb, b) do { LAS unsigned char* p_ = L + (b) * BUF + lrow * RS + lch * 16; _Pragma("unroll") for (int j_ = 0; j_ < 4; ++j_) { *(LAS u32x4*)(p_ + j_ * 16 * RS) = ra[j_]; *(LAS u32x4*)(p_ + OPB + j_ * 16 * RS) = rb[j_]; } } while (0)
#define TL_COMP(b) do { _Pragma("unroll") for (int i_ = 0; i_ < 4; ++i_) { const int ko_ = (32 * (4 * kh + i_) + 8 * fq) * 2; \
            const pg8::bf16x8 a_ = *(const LAS pg8::bf16x8*)(L + (b) * BUF + (16 * rw + fr) * RS + ko_); \
            _Pragma("unroll") for (int n = 0; n < 4; ++n) { const pg8::bf16x8 b_ = *(const LAS pg8::bf16x8*)(L + (b) * BUF + OPB + (16 * n + fr) * RS + ko_); acc[n] = __builtin_amdgcn_mfma_f32_16x16x32_bf16(b_, a_, acc[n], 0, 0, 0); } } } while (0)
#define TL_STEP(ra, rb, rna, rnb, b, cc) do { if ((cc) < nc) { if ((cc) + 1 < nc) TL_WRITE(rna, rnb, (b) ^ 1); if constexpr (Epi::MIDT > 0) { if ((cc) == Epi::MIDT / 4) E.mid_tail(acc, r0 + 16 * rw + fr, c0, fq); } TL_COMP(b); if ((cc) + 3 < nc) TL_LOAD(ra, rb, (cc) + 3); __syncthreads(); } } while (0)
        f32x4 acc[4];
#pragma unroll
        for (int n = 0; n < 4; ++n) acc[n] = (f32x4){0.f, 0.f, 0.f, 0.f};
        TL_LOAD(ra0, rb0, 0); if (1 < nc) TL_LOAD(ra1, rb1, 1); if (2 < nc) TL_LOAD(ra2, rb2, 2);
        TL_WRITE(ra0, rb0, 0); __syncthreads();
#pragma unroll 1
        for (int c = 0; c < nc; c += 6) { TL_STEP(ra0, rb0, ra1, rb1, 0, c); TL_STEP(ra1, rb1, ra2, rb2, 1, c + 1); TL_STEP(ra2, rb2, ra0, rb0, 0, c + 2); TL_STEP(ra0, rb0, ra1, rb1, 1, c + 3); TL_STEP(ra1, rb1, ra2, rb2, 0, c + 4); TL_STEP(ra2, rb2, ra0, rb0, 1, c + 5); }
#undef TL_STEP
#undef TL_LOAD
#undef TL_WRITE
#undef TL_COMP
        if (kh == 1) {
#pragma unroll
            for (int n = 0; n < 4; ++n) *(LAS f32x4*)(L + XCH + ((rw * 4 + n) * 64 + lane) * 16) = acc[n];
        }
        __syncthreads();
        if (kh == 0) {
#pragma unroll
            for (int n = 0; n < 4; ++n) acc[n] += *(const LAS f32x4*)(L + XCH + ((rw * 4 + n) * 64 + lane) * 16);
            E.tail(acc, r0 + 16 * rw + fr, c0, fq);
        }
        __syncthreads();
    }
}
__device__ __forceinline__ float wave_sum(float v) {
#pragma unroll
    for (int o = 1; o < 64; o <<= 1) v += __shfl_xor(v, o);
    return v;
}
struct WI { const float* W; const float* gain; bf16_t* WT; int ldw, K, dr, sc, k0; };
__device__ __forceinline__ void wi_set(WI& w, int kind, const float* W, const float* W2, int ldw, int K, bf16_t* WT, int nrg, const float* gain, int it) {
    const int kb = it / nrg, rg = it % nrg, p0 = rg * 32; int sc = p0; const float* Ws = W;
    if (kind == 1) { if ((p0 & 255) >> 7) Ws = W2; sc = 128 * (p0 >> 8) + (p0 & 127); }
    else if (kind == 2) { const int tile = p0 >> 8; if (tile < 3) sc = 256 * tile + 64 * ((p0 & 127) >> 5) + 32 * ((p0 & 255) >> 7); }
    w.W = Ws; w.gain = gain; w.WT = WT; w.ldw = ldw; w.K = K; w.dr = p0; w.sc = sc; w.k0 = 64 * kb;
}
__device__ __forceinline__ void wi_load(const WI& w, f32x4 (&r)[8], int lane) {
    const int lr = lane >> 3, lc4 = (lane & 7) * 4;
#pragma unroll
    for (int i = 0; i < 8; ++i) r[i] = __builtin_nontemporal_load((const GAS f32x4*)(w.W + (size_t)(w.k0 + 8 * i + lr) * w.ldw + w.sc + lc4));
}
__device__ __forceinline__ void wi_proc(const WI& w, const f32x4 (&r)[8], LAS float* scr, int lane) {
    const int lr = lane >> 3, lc4 = (lane & 7) * 4;
#pragma unroll
    for (int i = 0; i < 8; ++i) { const int kk = 8 * i + lr; const float gsc = w.gain ? w.gain[w.k0 + kk] : 1.f;
        scr[kk * 33 + lc4 + 0] = r[i][0] * gsc; scr[kk * 33 + lc4 + 1] = r[i][1] * gsc; scr[kk * 33 + lc4 + 2] = r[i][2] * gsc; scr[kk * 33 + lc4 + 3] = r[i][3] * gsc; }
    LDS_WAIT(); asm volatile("" ::: "memory");
    const int c = lane & 7;
#pragma unroll
    for (int j = 0; j < 4; ++j) { const int n = (lane >> 3) + 8 * j; const LAS float* s = scr + (8 * c) * 33 + n;
        v4u o; o.x = pk2(s[0 * 33], s[1 * 33]); o.y = pk2(s[2 * 33], s[3 * 33]); o.z = pk2(s[4 * 33], s[5 * 33]); o.w = pk2(s[6 * 33], s[7 * 33]);
        *(GAS v4u*)(w.WT + (size_t)(w.dr + n) * w.K + w.k0 + 8 * c) = o; }
    LDS_WAIT(); asm volatile("" ::: "memory");
}
}


namespace at {
using pg8::bf16_t; using pg8::bf16x8; using pg8::u32x4; using pg8::cvt_pk_bf16;
typedef float f32x16 __attribute__((ext_vector_type(16)));
typedef short v4i16_t __attribute__((ext_vector_type(4)));
typedef unsigned u32x2 __attribute__((ext_vector_type(2)));
constexpr int KS_OFF = 0, VS_OFF = 46080, LUT_OFF = 87040, KROW = 144;
__device__ const unsigned char T5LUT[129] = {0, 1, 2, 3, 4, 5, 6, 7, 8, 9, 10, 11, 12, 13, 14, 15, 16, 16, 16, 17, 17, 18, 18, 18, 19, 19, 19, 20, 20, 20, 20, 21, 21, 21, 21, 22, 22, 22, 22, 22, 23, 23, 23, 23, 23, 23, 24, 24, 24, 24, 24, 24, 25, 25, 25, 25, 25, 25, 25, 26, 26, 26, 26, 26, 26, 26, 26, 27, 27, 27, 27, 27, 27, 27, 27, 27, 27, 28, 28, 28, 28, 28, 28, 28, 28, 28, 28, 29, 29, 29, 29, 29, 29, 29, 29, 29, 29, 29, 29, 30, 30, 30, 30, 30, 30, 30, 30, 30, 30, 30, 30, 30, 30, 31, 31, 31, 31, 31, 31, 31, 31, 31, 31, 31, 31, 31, 31, 31, 31};
__device__ __forceinline__ v4i16_t trr(LAS const unsigned char* p) { return __builtin_amdgcn_ds_read_tr16_b64_v4i16((LAS v4i16_t*)p); }
__device__ __forceinline__ void attn_wave(const bf16x8 (&qf)[4], LAS const unsigned char* Kt, LAS const unsigned char* Vt, int vdh, LAS const float* lut, float sink, int iq, int jmin, int kb0, int lane, f32x16 (&o)[2]) {
    const int ql = lane & 31, h = lane >> 5;
    f32x16 acc[5];
#pragma unroll
    for (int kb = 0; kb < 5; ++kb) {
        acc[kb] = (f32x16){};
        LAS const unsigned char* kp = Kt + (32 * (kb0 + kb) + ql) * KROW + 16 * h;
#pragma unroll
        for (int ds = 0; ds < 4; ++ds) { const bf16x8 a = *(LAS const bf16x8*)(kp + 32 * ds); acc[kb] = __builtin_amdgcn_mfma_f32_32x32x16_bf16(a, qf[ds], acc[kb], 0, 0, 0); }
    }
    const int base = iq + 128 - 4 * h - 32 * kb0, dmax0 = iq + 128 - jmin; const unsigned dmax = (unsigned)(dmax0 < 128 ? dmax0 : 128);
    const float sink2 = sink * 1.4426950408889634f; float mx = sink2;
#pragma unroll
    for (int kb = 0; kb < 5; ++kb)
#pragma unroll
        for (int r = 0; r < 16; ++r) {
            const int dist = base - (32 * kb + (r & 3) + 8 * (r >> 2));
            const float s = ((unsigned)dist <= dmax) ? __builtin_fmaf(acc[kb][r], 0.125f * 1.4426950408889634f, lut[dist]) : -INFINITY;
            acc[kb][r] = s; mx = fmaxf(mx, s);
        }
    mx = fmaxf(mx, __shfl_xor(mx, 32));
    float l = 0.f;
#pragma unroll
    for (int kb = 0; kb < 5; ++kb)
#pragma unroll
        for (int r = 0; r < 16; ++r) { const float p = __builtin_amdgcn_exp2f(acc[kb][r] - mx); acc[kb][r] = p; l += p; }
    l += __shfl_xor(l, 32);
    l += __builtin_amdgcn_exp2f(sink2 - mx);
    const float inv = 1.f / l;
    o[0] = (f32x16){}; o[1] = (f32x16){};
    const int g16 = (lane >> 4) & 1, q4 = (lane & 15) >> 2, p4 = lane & 3;
#pragma unroll
    for (int kb = 0; kb < 5; ++kb)
#pragma unroll
        for (int s2 = 0; s2 < 2; ++s2) {
            u32x4 pw; pw.x = cvt_pk_bf16(acc[kb][8 * s2 + 0], acc[kb][8 * s2 + 1]); pw.y = cvt_pk_bf16(acc[kb][8 * s2 + 2], acc[kb][8 * s2 + 3]);
            pw.z = cvt_pk_bf16(acc[kb][8 * s2 + 4], acc[kb][8 * s2 + 5]); pw.w = cvt_pk_bf16(acc[kb][8 * s2 + 6], acc[kb][8 * s2 + 7]);
            const bf16x8 pf = __builtin_bit_cast(bf16x8, pw);
            const int key = 32 * (kb0 + kb) + 16 * s2 + 4 * h + q4;
#pragma unroll
            for (int db = 0; db < 2; ++db) {
                LAS const unsigned char* vp = Vt + db * vdh + key * 64 + (16 * g16 + 4 * p4) * 2;
                const v4i16_t lo = trr(vp), hi = trr(vp + 8 * 64);
                const bf16x8 a = (bf16x8){lo[0], lo[1], lo[2], lo[3], hi[0], hi[1], hi[2], hi[3]};
                o[db] = __builtin_amdgcn_mfma_f32_32x32x16_bf16(a, pf, o[db], 0, 0, 0);
            }
        }
#pragma unroll
    for (int db = 0; db < 2; ++db)
#pragma unroll
        for (int r = 0; r < 16; ++r) o[db][r] *= inv;
}
__device__ __forceinline__ void attn_store(bf16_t* dst, const f32x16 (&o)[2], int h) {
#pragma unroll
    for (int db = 0; db < 2; ++db)
#pragma unroll
        for (int rg = 0; rg < 4; ++rg) { u32x2 w; w.x = cvt_pk_bf16(o[db][4 * rg + 0], o[db][4 * rg + 1]); w.y = cvt_pk_bf16(o[db][4 * rg + 2], o[db][4 * rg + 3]);
            *(u32x2*)(dst + 32 * db + 8 * rg + 4 * h) = w; }
}
__device__ __forceinline__ void attn_prompt_task(LAS unsigned char* L, const bf16_t* Q, bf16_t* AOR, const bf16_t* KV, const float* table, const float* sinks, int b, int n, int kvh, int tid, int lane, int wave) {
    const int m0 = b * 4096 + 128 * n;
    const int ql = lane & 31, h = lane >> 5, hl = wave & 3, head = 4 * kvh + hl;
    bf16x8 qf0[4], qf1[4];
#pragma unroll
    for (int ds = 0; ds < 4; ++ds) { qf0[ds] = *(const bf16x8*)(Q + (size_t)(m0 + 32 * (wave >> 2) + ql) * 512 + head * 64 + 16 * ds + 8 * h); qf1[ds] = *(const bf16x8*)(Q + (size_t)(m0 + 32 * ((wave >> 2) + 2) + ql) * 512 + head * 64 + 16 * ds + 8 * h); }
    for (int c = tid; c < 2048; c += 512) {
        const int j = c >> 3, ch = c & 7; u32x4 kx = (u32x4){0u, 0u, 0u, 0u}, vx = kx;
        if (n > 0 || j >= 128) { const bf16_t* src = KV + (size_t)(m0 - 128 + j) * 256 + kvh * 64 + 8 * ch; kx = *(const u32x4*)src; vx = *(const u32x4*)(src + 128); }
        *(LAS u32x4*)(L + KS_OFF + j * KROW + 16 * ch) = kx;
        *(LAS u32x4*)(L + VS_OFF + (ch >> 2) * 16384 + j * 64 + (ch & 3) * 16) = vx;
    }
    for (int e = tid; e < 4 * 129; e += 512) { const int hl = e / 129, d = e % 129; ((LAS float*)(L + LUT_OFF))[hl * 132 + d] = table[T5LUT[d] * 8 + 4 * kvh + hl] * 1.4426950408889634f; }
    __syncthreads();
    const float sink = sinks[head];
#pragma unroll 1
    for (int rep = 0; rep < 2; ++rep) {
        const int qb = (wave >> 2) + 2 * rep, iq = 32 * qb + ql;
        bf16x8 qf[4];
#pragma unroll
        for (int ds = 0; ds < 4; ++ds) qf[ds] = rep ? qf1[ds] : qf0[ds];
        f32x16 o[2];
        attn_wave(qf, L + KS_OFF, L + VS_OFF, 16384, (LAS const float*)(L + LUT_OFF) + hl * 132, sink, iq, n == 0 ? 128 : 0, qb, lane, o);
        attn_store(AOR + (size_t)(m0 + iq) * 1024 + head * 64, o, h);
    }
    __syncthreads();
}
__device__ __forceinline__ void attn_sample_task(LAS unsigned char* L, const bf16_t* Q, bf16_t* AOR, const bf16_t* KV, const float* wk, const float* wv, const float* table, const float* sinks, int bd, int kvh, int tid, int lane, int wave) {
    bf16x8 qf[4];
    if (wave == 0) { const int ql = lane & 31, h = lane >> 5, hl = ql >> 3, iq = ql & 7, head = 4 * kvh + hl; const bf16_t* qp = Q + (size_t)(MP + bd * 8 + iq) * 512 + head * 64;
#pragma unroll
        for (int ds = 0; ds < 4; ++ds) qf[ds] = *(const bf16x8*)(qp + 16 * ds + 8 * h); }
    for (int c = tid; c < 1280; c += 512) {
        const int j = c >> 3, ch = c & 7; u32x4 kx = (u32x4){0u, 0u, 0u, 0u}, vx = kx;
        if (j < 128) {
            const size_t so = ((size_t)(bd * 128 + j) * 2 + kvh) * 64 + 8 * ch;
            const f32x4 k0 = *(const f32x4*)(wk + so), k1 = *(const f32x4*)(wk + so + 4), v0 = *(const f32x4*)(wv + so), v1 = *(const f32x4*)(wv + so + 4);
            kx = mk::pack8(k0, k1); vx = mk::pack8(v0, v1);
        } else if (j < 136) { const bf16_t* src = KV + (size_t)(MP + bd * 8 + (j - 128)) * 256 + kvh * 64 + 8 * ch; kx = *(const u32x4*)src; vx = *(const u32x4*)(src + 128); }
        *(LAS u32x4*)(L + KS_OFF + j * KROW + 16 * ch) = kx;
        *(LAS u32x4*)(L + VS_OFF + (ch >> 2) * 10240 + j * 64 + (ch & 3) * 16) = vx;
    }
    for (int e = tid; e < 4 * 129; e += 512) { const int hl = e / 129, d = e % 129; ((LAS float*)(L + LUT_OFF))[hl * 132 + d] = table[T5LUT[d] * 8 + 4 * kvh + hl] * 1.4426950408889634f; }
    __syncthreads();
    if (wave == 0) {
        const int ql = lane & 31, h = lane >> 5, hl = ql >> 3, iq = ql & 7, head = 4 * kvh + hl;
        f32x16 o[2];
        attn_wave(qf, L + KS_OFF, L + VS_OFF, 10240, (LAS const float*)(L + LUT_OFF) + hl * 132, sinks[head], iq, 0, 0, lane, o);
        attn_store(AOR + (size_t)(MP + bd * 8 + iq) * 1024 + head * 64, o, h);
    }
    __syncthreads();
}
}

namespace hg {
using pg8::bf16_t; using pg8::bf16x8; using pg8::f32x4; using pg8::u32x4; using pg8::cvt_pk_bf16;
typedef short v4i16_t __attribute__((ext_vector_type(4)));
typedef unsigned u32x2 __attribute__((ext_vector_type(2)));
__device__ __forceinline__ v4i16_t trr(LAS const unsigned char* p) { return __builtin_amdgcn_ds_read_tr16_b64_v4i16((LAS v4i16_t*)p); }
constexpr int TS = 288;
constexpr float FQ = 1.f / 65535.f;
struct HaPre { unsigned short lf[16]; u32x4 vch[2]; };
__device__ __forceinline__ void ha_issue(HaPre& P, const unsigned short* LOGF, const bf16_t* IR, int task, int tid) {
    const int bh = task >> 6, c = task & 63, h = bh & 3; const size_t m0 = (size_t)(bh >> 2) * 4096 + 64 * c; const int kd = tid & 127, seg = tid >> 7;
#pragma unroll
    for (int i = 0; i < 16; ++i) P.lf[i] = LOGF[(m0 + 16 * seg + i) * 512 + h * 128 + kd];
#pragma unroll
    for (int q = 0; q < 2; ++q) { const int cid = tid + 512 * q, t = cid >> 4, ch = cid & 15; P.vch[q] = *(const u32x4*)(IR + (m0 + t) * 512 + h * 128 + 8 * ch); }
}
__device__ __forceinline__ void ha_phase(LAS unsigned char* L, HaPre& P, const unsigned short* LOGF, const bf16_t* IR, bf16_t* US, float* DEC, int v, int G, int tid, int lane, int wave) {
    constexpr int KT = 0, VT = 64 * TS, SEG = 2 * 64 * TS, DCS = SEG + 2048;
#pragma unroll 1
    for (int grp = v; grp < 256; grp += G) {
        const int kd = tid & 127, seg = tid >> 7, g = lane >> 4, q4 = (lane & 15) >> 2, p4 = lane & 3;
        f32x4 acc[8];
#pragma unroll
        for (int i = 0; i < 8; ++i) acc[i] = (f32x4){0.f, 0.f, 0.f, 0.f};
        float dg = 1.f;
#pragma unroll 1
        for (int cc = 0; cc < 4; ++cc) {
            float lf[16]; float run = 1.f;
#pragma unroll
            for (int i = 0; i < 16; ++i) { lf[i] = (float)P.lf[i] * FQ; run *= lf[i]; }
            ((LAS float*)(L + SEG))[seg * 128 + kd] = run;
#pragma unroll
            for (int q = 0; q < 2; ++q) { const int cid = tid + 512 * q, t = cid >> 4, ch = cid & 15; *(LAS u32x4*)(L + VT + t * TS + ch * 16) = P.vch[q]; }
            const int nxt = cc < 3 ? 4 * grp + cc + 1 : 4 * (grp + G);
            if (nxt < 1024) ha_issue(P, LOGF, IR, nxt, tid);
            __syncthreads();
            {
                const LAS float* sg = (const LAS float*)(L + SEG);
                const float s0 = sg[kd], s1 = sg[128 + kd], s2 = sg[256 + kd], s3 = sg[384 + kd];
                float suf = seg == 3 ? 1.f : (seg == 2 ? s3 : (seg == 1 ? s2 * s3 : s1 * (s2 * s3)));
#pragma unroll
                for (int i = 15; i >= 0; --i) { const float kt = (1.f - lf[i]) * suf; suf *= lf[i]; *(LAS bf16_t*)(L + KT + (16 * seg + i) * TS + kd * 2) = (bf16_t)cvt_pk_bf16(kt, 0.f); }
                const float dcv = (s0 * s1) * (s2 * s3); dg *= dcv;
                if (seg == 0) ((LAS float*)(L + DCS))[kd] = dcv;
            }
            __syncthreads();
            {
                bf16x8 bv[2];
#pragma unroll
                for (int ks = 0; ks < 2; ++ks) { LAS const unsigned char* vp = L + VT + (32 * ks + 4 * g + q4) * TS + (16 * wave + 4 * p4) * 2; const v4i16_t lo = trr(vp), hi = trr(vp + 16 * TS);
                    bv[ks] = (bf16x8){lo[0], lo[1], lo[2], lo[3], hi[0], hi[1], hi[2], hi[3]}; }
#pragma unroll
                for (int i = 0; i < 8; ++i) {
                    const f32x4 dc = *(const LAS f32x4*)(L + DCS + (16 * i + 4 * g) * 4);
                    acc[i] = acc[i] * dc;
#pragma unroll
                    for (int ks = 0; ks < 2; ++ks) { LAS const unsigned char* kp = L + KT + (32 * ks + 4 * g + q4) * TS + (16 * i + 4 * p4) * 2; const v4i16_t lo = trr(kp), hi = trr(kp + 16 * TS);
                        const bf16x8 a = (bf16x8){lo[0], lo[1], lo[2], lo[3], hi[0], hi[1], hi[2], hi[3]};
                        acc[i] = __builtin_amdgcn_mfma_f32_16x16x32_bf16(a, bv[ks], acc[i], 0, 0, 0); }
                }
            }
            __syncthreads();
        }
        const size_t ub = ((size_t)grp * 128 + 16 * wave + (lane & 15)) * 128 + 4 * g;
#pragma unroll
        for (int i = 0; i < 8; ++i) { u32x2 w; w.x = cvt_pk_bf16(acc[i][0], acc[i][1]); w.y = cvt_pk_bf16(acc[i][2], acc[i][3]); *(u32x2*)(US + ub + 16 * i) = w; }
        if (seg == 0) DEC[(size_t)grp * 128 + kd] = dg;
    }
}
__device__ __forceinline__ void hb_scan(unsigned* US32, const float* DEC, float* out_pst, int idx) {
    const int bh = idx >> 13, pair = idx & 8191, vd = pair >> 6, kd0 = (pair & 63) * 2;
    float s0 = 0.f, s1 = 0.f;
    unsigned* up = US32 + (size_t)bh * 16 * 8192 + pair; const float* dp = DEC + (size_t)bh * 16 * 128 + kd0;
#pragma unroll 1
    for (int c0 = 0; c0 < 16; c0 += 8) {
        unsigned w[8]; float d0[8], d1[8];
#pragma unroll
        for (int i = 0; i < 8; ++i) { w[i] = up[(size_t)(c0 + i) * 8192]; const float2 dd = *(const float2*)(dp + (c0 + i) * 128); d0[i] = dd.x; d1[i] = dd.y; }
#pragma unroll
        for (int i = 0; i < 8; ++i) { up[(size_t)(c0 + i) * 8192] = cvt_pk_bf16(s0, s1); s0 = d0[i] * s0 + mk::bflo(w[i]); s1 = d1[i] * s1 + mk::bfhi(w[i]); }
    }
    out_pst[((size_t)bh * 128 + kd0) * 128 + vd] = s0; out_pst[((size_t)bh * 128 + kd0 + 1) * 128 + vd] = s1;
}
struct HcPre { u32x2 lfc[4]; u32x4 qc[2], vch[2]; u32x2 st[8]; };
__device__ __forceinline__ void hc_issue_prompt(HcPre& P, const unsigned short* LOGF, const bf16_t* QR, const bf16_t* IR, const bf16_t* US, int task, bool st, int tid, int lane, int wave) {
    const int bh = task >> 6, c = task & 63, h = bh & 3; const size_t m0 = (size_t)(bh >> 2) * 4096 + 64 * c;
#pragma unroll
    for (int q = 0; q < 4; ++q) { const int cid = tid + 512 * q, t = cid >> 5, c4 = cid & 31; P.lfc[q] = *(const u32x2*)(LOGF + (m0 + t) * 512 + h * 128 + 4 * c4); }
#pragma unroll
    for (int q = 0; q < 2; ++q) { const int cid = tid + 512 * q, t = cid >> 4, ch = cid & 15; const size_t off = (m0 + t) * 512 + h * 128 + 8 * ch; P.qc[q] = *(const u32x4*)(QR + off); P.vch[q] = *(const u32x4*)(IR + off); }
    if (st) {
        const bf16_t* USt = US + (size_t)(task >> 2) * 16384; const int g = lane >> 4, vd = 16 * wave + (lane & 15);
#pragma unroll
        for (int i = 0; i < 8; ++i) P.st[i] = *(const u32x2*)(USt + (size_t)vd * 128 + 16 * i + 4 * g);
    }
}
__device__ __forceinline__ void hc_phase_prompt(LAS unsigned char* L, const unsigned short* LOGF, const bf16_t* QR, bf16_t* AOR, const bf16_t* IR, const bf16_t* GR, const float* hgn, const bf16_t* US, int v, int G, int tid, int lane, int wave) {
    constexpr int QH = 0, KH = 17408, KT = 34816, VT = 53248, AT = 71680, DECS = 73728, OT = 75776, QT = 109568, QS = 272, OS = 132, LFT = OT, LS = 528;
    const int g = lane >> 4, lc = lane & 15, q4 = lc >> 2, p4 = lane & 3, vd = 16 * wave + lc;
    const int et = tid >> 3, ec = (tid & 7) * 16;
    const f32x4 n0 = *(const f32x4*)(hgn + ec), n1 = *(const f32x4*)(hgn + ec + 4), n2 = *(const f32x4*)(hgn + ec + 8), n3 = *(const f32x4*)(hgn + ec + 12);
    HcPre P;
    if (v < 256) hc_issue_prompt(P, LOGF, QR, IR, US, 4 * v, true, tid, lane, wave);
    f32x4 sacc[8];
#pragma unroll
    for (int i = 0; i < 8; ++i) sacc[i] = (f32x4){0.f, 0.f, 0.f, 0.f};
#pragma unroll 1
    for (int grp = v; grp < 256; grp += G)
#pragma unroll 1
    for (int cc = 0; cc < 4; ++cc) {
        const int task = 4 * grp + cc;
        const int bh = task >> 6, c = task & 63, h = bh & 3; const size_t m0 = (size_t)(bh >> 2) * 4096 + 64 * c;
        if (cc == 0) {
#pragma unroll
            for (int i = 0; i < 8; ++i) sacc[i] = (f32x4){mk::bflo(P.st[i].x), mk::bfhi(P.st[i].x), mk::bflo(P.st[i].y), mk::bfhi(P.st[i].y)};
        }
#pragma unroll
        for (int q = 0; q < 4; ++q) { const int cid = tid + 512 * q, t = cid >> 5, c4 = cid & 31; const u32x2 w = P.lfc[q];
            *(LAS f32x4*)(L + LFT + t * LS + c4 * 16) = (f32x4){(float)(w.x & 0xffffu), (float)(w.x >> 16), (float)(w.y & 0xffffu), (float)(w.y >> 16)} * FQ; }
#pragma unroll
        for (int q = 0; q < 2; ++q) { const int cid = tid + 512 * q, t = cid >> 4, ch = cid & 15; *(LAS u32x4*)(L + QT + t * QS + ch * 16) = P.qc[q]; *(LAS u32x4*)(L + VT + t * TS + ch * 16) = P.vch[q]; }
        const size_t eoff = (m0 + et) * 512 + h * 128 + ec;
        const u32x4 g0 = *(const u32x4*)(GR + eoff), g1 = *(const u32x4*)(GR + eoff + 8);
        { const int nxt = cc < 3 ? task + 1 : 4 * (grp + G); if (nxt < 1024) hc_issue_prompt(P, LOGF, QR, IR, US, nxt, cc == 3, tid, lane, wave); }
        __syncthreads();
        {
            const int kd = tid & 127, sub = tid >> 7; float lf[16], pp[16]; float p = 1.f;
#pragma unroll
            for (int t = 0; t < 16; ++t) { lf[t] = *(const LAS float*)(L + LFT + (16 * sub + t) * LS + kd * 4); p *= lf[t]; pp[t] = p; }
            float suf = 1.f;
#pragma unroll
            for (int t = 15; t >= 0; --t) {
                const float kk = 1.f - lf[t]; const int ro = 16 * sub + t; const float qv = mk::bf2f(*(const LAS bf16_t*)(L + QT + ro * QS + kd * 2));
                *(LAS bf16_t*)(L + QH + ro * QS + kd * 2) = (bf16_t)cvt_pk_bf16(qv * pp[t], 0.f);
                *(LAS bf16_t*)(L + KH + ro * QS + kd * 2) = (bf16_t)cvt_pk_bf16(kk * __builtin_amdgcn_rcpf(fmaxf(pp[t], 1e-30f)), 0.f);
                *(LAS bf16_t*)(L + KT + ro * TS + kd * 2) = (bf16_t)cvt_pk_bf16(kk * suf, 0.f);
                suf *= lf[t];
            }
            *(LAS float*)(L + DECS + (sub * 128 + kd) * 4) = p;
        }
        __syncthreads();
        if (wave < 4) {
            f32x4 acc = (f32x4){0.f, 0.f, 0.f, 0.f};
#pragma unroll
            for (int ks = 0; ks < 4; ++ks) { const bf16x8 a = *(const LAS bf16x8*)(L + QH + (16 * wave + lc) * QS + (32 * ks + 8 * g) * 2), b = *(const LAS bf16x8*)(L + KH + (16 * wave + lc) * QS + (32 * ks + 8 * g) * 2);
                acc = __builtin_amdgcn_mfma_f32_16x16x32_bf16(a, b, acc, 0, 0, 0); }
#pragma unroll
            for (int e = 0; e < 4; ++e) { const int t = 4 * g + e; *(LAS bf16_t*)(L + AT + wave * 512 + t * 32 + lc * 2) = (bf16_t)cvt_pk_bf16(lc <= t ? acc[e] : 0.f, 0.f); }
        }
        __syncthreads();
#pragma unroll 1
        for (int sb = 0; sb < 4; ++sb) {
            f32x4 oacc = (f32x4){0.f, 0.f, 0.f, 0.f};
#pragma unroll
            for (int ks = 0; ks < 4; ++ks) {
                u32x4 bw; bw.x = cvt_pk_bf16(sacc[2 * ks][0], sacc[2 * ks][1]); bw.y = cvt_pk_bf16(sacc[2 * ks][2], sacc[2 * ks][3]); bw.z = cvt_pk_bf16(sacc[2 * ks + 1][0], sacc[2 * ks + 1][1]); bw.w = cvt_pk_bf16(sacc[2 * ks + 1][2], sacc[2 * ks + 1][3]);
                const u32x2 a0 = *(const LAS u32x2*)(L + QH + (16 * sb + lc) * QS + (32 * ks + 4 * g) * 2), a1 = *(const LAS u32x2*)(L + QH + (16 * sb + lc) * QS + (32 * ks + 16 + 4 * g) * 2);
                u32x4 aw; aw.x = a0.x; aw.y = a0.y; aw.z = a1.x; aw.w = a1.y;
                oacc = __builtin_amdgcn_mfma_f32_16x16x32_bf16(__builtin_bit_cast(bf16x8, aw), __builtin_bit_cast(bf16x8, bw), oacc, 0, 0, 0);
            }
            bf16x8 bv;
            { const v4i16_t lo = trr(L + VT + (16 * sb + 4 * g + q4) * TS + (16 * wave + 4 * p4) * 2); bv = (bf16x8){lo[0], lo[1], lo[2], lo[3], 0, 0, 0, 0}; }
            { const u32x2 a0 = *(const LAS u32x2*)(L + AT + sb * 512 + lc * 32 + 8 * g); u32x4 aw; aw.x = a0.x; aw.y = a0.y; aw.z = 0u; aw.w = 0u;
              oacc = __builtin_amdgcn_mfma_f32_16x16x32_bf16(__builtin_bit_cast(bf16x8, aw), bv, oacc, 0, 0, 0); }
#pragma unroll
            for (int e = 0; e < 4; ++e) *(LAS float*)(L + OT + ((16 * sb + 4 * g + e) * OS + vd) * 4) = oacc[e];
            if (sb < 3 || cc < 3) {
#pragma unroll
                for (int i = 0; i < 8; ++i) {
                    const f32x4 dc = *(const LAS f32x4*)(L + DECS + (sb * 128 + 16 * i + 4 * g) * 4);
                    const v4i16_t lo = trr(L + KT + (16 * sb + 4 * g + q4) * TS + (16 * i + 4 * p4) * 2);
                    const bf16x8 a = (bf16x8){lo[0], lo[1], lo[2], lo[3], 0, 0, 0, 0};
                    sacc[i] = __builtin_amdgcn_mfma_f32_16x16x32_bf16(a, bv, sacc[i] * dc, 0, 0, 0);
                }
            }
        }
        __syncthreads();
        {
            f32x4 x[4]; float ss = 0.f;
#pragma unroll
            for (int k = 0; k < 4; ++k) { x[k] = *(const LAS f32x4*)(L + OT + (et * OS + ec + 4 * k) * 4); ss += mk::dot4(x[k]); }
            ss += __shfl_xor(ss, 1); ss += __shfl_xor(ss, 2); ss += __shfl_xor(ss, 4);
            const float rs = rsqrtf(ss * (1.f / 128.f) + EPS);
            const f32x4 y0 = x[0] * rs * n0 * (f32x4){mk::bflo(g0.x), mk::bfhi(g0.x), mk::bflo(g0.y), mk::bfhi(g0.y)}, y1 = x[1] * rs * n1 * (f32x4){mk::bflo(g0.z), mk::bfhi(g0.z), mk::bflo(g0.w), mk::bfhi(g0.w)};
            const f32x4 y2 = x[2] * rs * n2 * (f32x4){mk::bflo(g1.x), mk::bfhi(g1.x), mk::bflo(g1.y), mk::bfhi(g1.y)}, y3 = x[3] * rs * n3 * (f32x4){mk::bflo(g1.z), mk::bfhi(g1.z), mk::bflo(g1.w), mk::bfhi(g1.w)};
            { bf16_t* op = AOR + (m0 + et) * 1024 + 512 + h * 128 + ec; *(u32x4*)op = mk::pack8(y0, y1); *(u32x4*)(op + 8) = mk::pack8(y2, y3); }
        }
        __syncthreads();
    }
}

struct HcPreS { f32x4 sreg[8]; unsigned short lf[8]; unsigned short qv[8]; u32x4 vch; };
__device__ __forceinline__ void hc_issue_sample(HcPreS& P, const unsigned short* LOGF, const bf16_t* QR, const bf16_t* IR, const float* S0, int id, int tid) {
    const int bd = id >> 2, h = id & 3; const size_t m0 = (size_t)MP + bd * 8; const float* s0 = S0 + (size_t)id * 16384;
#pragma unroll
    for (int q = 0; q < 8; ++q) { const int cid = tid + 512 * q; P.sreg[q] = __builtin_nontemporal_load((const f32x4*)(s0 + (size_t)cid * 4)); }
    if (tid < 128) {
#pragma unroll
        for (int t = 0; t < 8; ++t) { const size_t off = (m0 + t) * 512 + h * 128 + tid; P.lf[t] = LOGF[off]; P.qv[t] = QR[off]; }
        P.vch = *(const u32x4*)(IR + (m0 + (tid >> 4)) * 512 + h * 128 + 8 * (tid & 15));
    }
}
__device__ __forceinline__ void hc_phase_sample(LAS unsigned char* L, const unsigned short* LOGF, const bf16_t* QR, bf16_t* AOR, const bf16_t* IR, const bf16_t* GR, const float* hgn, const float* S0, float* Sout, HcPreS& P, int v, int G, int tid, int lane, int wave) {
    constexpr int QH = 0, KH = 4352, KT = 8704, VT = 13312, AT = 17920, DECS = 18432, OT = 18944, ST = 27392, QS = 272, OS = 132, SS = 528;
    const int g = lane >> 4, lc = lane & 15, q4 = lc >> 2, p4 = lane & 3, vd = 16 * wave + lc;
    const int et = tid >> 3, ec = (tid & 7) * 16;
#pragma unroll 1
    for (int id = v; id < 512; id += G) {
        const int bd = id >> 2, h = id & 3; const size_t m0 = (size_t)MP + bd * 8;
#pragma unroll
        for (int q = 0; q < 8; ++q) { const int cid = tid + 512 * q, row = cid >> 5, c4 = cid & 31; *(LAS f32x4*)(L + ST + row * SS + c4 * 16) = P.sreg[q]; }
        if (tid < 128) {
            const int kd = tid; float pp[8], lfs[8]; float p = 1.f;
#pragma unroll
            for (int t = 0; t < 8; ++t) { lfs[t] = (float)P.lf[t] * FQ; p *= lfs[t]; pp[t] = p; }
            float suf = 1.f;
#pragma unroll
            for (int t = 7; t >= 0; --t) {
                const float kk = 1.f - lfs[t];
                *(LAS bf16_t*)(L + QH + t * QS + kd * 2) = (bf16_t)cvt_pk_bf16(mk::bf2f(P.qv[t]) * pp[t], 0.f);
                *(LAS bf16_t*)(L + KH + t * QS + kd * 2) = (bf16_t)cvt_pk_bf16(kk * __builtin_amdgcn_rcpf(fmaxf(pp[t], 1e-30f)), 0.f);
                *(LAS bf16_t*)(L + KT + t * TS + kd * 2) = (bf16_t)cvt_pk_bf16(kk * suf, 0.f);
                suf *= lfs[t];
            }
#pragma unroll
            for (int t = 8; t < 16; ++t) { *(LAS bf16_t*)(L + QH + t * QS + kd * 2) = 0; *(LAS bf16_t*)(L + KH + t * QS + kd * 2) = 0; *(LAS bf16_t*)(L + KT + t * TS + kd * 2) = 0; }
            *(LAS float*)(L + DECS + kd * 4) = p;
            *(LAS u32x4*)(L + VT + (tid >> 4) * TS + (tid & 15) * 16) = P.vch;
        } else if (tid < 256) { const int c = tid - 128; *(LAS u32x4*)(L + VT + (8 + (c >> 4)) * TS + (c & 15) * 16) = (u32x4){0u, 0u, 0u, 0u}; }
        const size_t eoff = (m0 + et) * 512 + h * 128 + ec; u32x4 g0 = (u32x4){0u, 0u, 0u, 0u}, g1 = g0;
        if (tid < 64) { g0 = *(const u32x4*)(GR + eoff); g1 = *(const u32x4*)(GR + eoff + 8); }
        if (id + G < 512) hc_issue_sample(P, LOGF, QR, IR, S0, id + G, tid);
        __syncthreads();
        f32x4 sacc[8];
#pragma unroll
        for (int i = 0; i < 8; ++i)
#pragma unroll
            for (int e = 0; e < 4; ++e) sacc[i][e] = *(const LAS float*)(L + ST + (16 * i + 4 * g + e) * SS + vd * 4);
        if (wave == 0) {
            f32x4 acc = (f32x4){0.f, 0.f, 0.f, 0.f};
#pragma unroll
            for (int ks = 0; ks < 4; ++ks) { const bf16x8 a = *(const LAS bf16x8*)(L + QH + lc * QS + (32 * ks + 8 * g) * 2), b = *(const LAS bf16x8*)(L + KH + lc * QS + (32 * ks + 8 * g) * 2);
                acc = __builtin_amdgcn_mfma_f32_16x16x32_bf16(a, b, acc, 0, 0, 0); }
#pragma unroll
            for (int e = 0; e < 4; ++e) { const int t = 4 * g + e; *(LAS bf16_t*)(L + AT + t * 32 + lc * 2) = (bf16_t)cvt_pk_bf16(lc <= t ? acc[e] : 0.f, 0.f); }
        }
        __syncthreads();
        {
            f32x4 oacc = (f32x4){0.f, 0.f, 0.f, 0.f};
#pragma unroll
            for (int ks = 0; ks < 4; ++ks) {
                u32x4 bw; bw.x = cvt_pk_bf16(sacc[2 * ks][0], sacc[2 * ks][1]); bw.y = cvt_pk_bf16(sacc[2 * ks][2], sacc[2 * ks][3]); bw.z = cvt_pk_bf16(sacc[2 * ks + 1][0], sacc[2 * ks + 1][1]); bw.w = cvt_pk_bf16(sacc[2 * ks + 1][2], sacc[2 * ks + 1][3]);
                const u32x2 a0 = *(const LAS u32x2*)(L + QH + lc * QS + (32 * ks + 4 * g) * 2), a1 = *(const LAS u32x2*)(L + QH + lc * QS + (32 * ks + 16 + 4 * g) * 2);
                u32x4 aw; aw.x = a0.x; aw.y = a0.y; aw.z = a1.x; aw.w = a1.y;
                oacc = __builtin_amdgcn_mfma_f32_16x16x32_bf16(__builtin_bit_cast(bf16x8, aw), __builtin_bit_cast(bf16x8, bw), oacc, 0, 0, 0);
            }
            bf16x8 bv;
            { const v4i16_t lo = trr(L + VT + (4 * g + q4) * TS + (16 * wave + 4 * p4) * 2); bv = (bf16x8){lo[0], lo[1], lo[2], lo[3], 0, 0, 0, 0}; }
            { const u32x2 a0 = *(const LAS u32x2*)(L + AT + lc * 32 + 8 * g); u32x4 aw; aw.x = a0.x; aw.y = a0.y; aw.z = 0u; aw.w = 0u;
              oacc = __builtin_amdgcn_mfma_f32_16x16x32_bf16(__builtin_bit_cast(bf16x8, aw), bv, oacc, 0, 0, 0); }
#pragma unroll
            for (int e = 0; e < 4; ++e) *(LAS float*)(L + OT + ((4 * g + e) * OS + vd) * 4) = oacc[e];
#pragma unroll
            for (int i = 0; i < 8; ++i) {
                const f32x4 dc = *(const LAS f32x4*)(L + DECS + (16 * i + 4 * g) * 4);
                const v4i16_t lo = trr(L + KT + (4 * g + q4) * TS + (16 * i + 4 * p4) * 2);
                const bf16x8 a = (bf16x8){lo[0], lo[1], lo[2], lo[3], 0, 0, 0, 0};
                sacc[i] = __builtin_amdgcn_mfma_f32_16x16x32_bf16(a, bv, sacc[i] * dc, 0, 0, 0);
            }
#pragma unroll
            for (int i = 0; i < 8; ++i)
#pragma unroll
                for (int e = 0; e < 4; ++e) *(LAS float*)(L + ST + (16 * i + 4 * g + e) * SS + vd * 4) = sacc[i][e];
        }
        __syncthreads();
        if (tid < 64) {
            const f32x4 n0 = *(const f32x4*)(hgn + ec), n1 = *(const f32x4*)(hgn + ec + 4), n2 = *(const f32x4*)(hgn + ec + 8), n3 = *(const f32x4*)(hgn + ec + 12);
            f32x4 x[4]; float ss = 0.f;
#pragma unroll
            for (int k = 0; k < 4; ++k) { x[k] = *(const LAS f32x4*)(L + OT + (et * OS + ec + 4 * k) * 4); ss += mk::dot4(x[k]); }
            ss += __shfl_xor(ss, 1); ss += __shfl_xor(ss, 2); ss += __shfl_xor(ss, 4);
            const float rs = rsqrtf(ss * (1.f / 128.f) + EPS);
            const f32x4 y0 = x[0] * rs * n0 * (f32x4){mk::bflo(g0.x), mk::bfhi(g0.x), mk::bflo(g0.y), mk::bfhi(g0.y)}, y1 = x[1] * rs * n1 * (f32x4){mk::bflo(g0.z), mk::bfhi(g0.z), mk::bflo(g0.w), mk::bfhi(g0.w)};
            const f32x4 y2 = x[2] * rs * n2 * (f32x4){mk::bflo(g1.x), mk::bfhi(g1.x), mk::bflo(g1.y), mk::bfhi(g1.y)}, y3 = x[3] * rs * n3 * (f32x4){mk::bflo(g1.z), mk::bfhi(g1.z), mk::bflo(g1.w), mk::bfhi(g1.w)};
            { bf16_t* op = AOR + (m0 + et) * 1024 + 512 + h * 128 + ec; *(u32x4*)op = mk::pack8(y0, y1); *(u32x4*)(op + 8) = mk::pack8(y2, y3); }
        }
        { float* so = Sout + (size_t)id * 16384;
#pragma unroll
          for (int q = 0; q < 8; ++q) { const int cid = tid + 512 * q, row = cid >> 5, c4 = cid & 31; __builtin_nontemporal_store(*(const LAS f32x4*)(L + ST + row * SS + c4 * 16), (f32x4*)(so + (size_t)cid * 4)); } }
        __syncthreads();
    }
}
}
struct Args { const float* in[24]; float* out; unsigned char* ws; int ph_lo, ph_hi, li, pad; };
__global__ void __launch_bounds__(NWAVES * 64, 2) mega(Args args) {
    extern __shared__ __attribute__((aligned(16))) unsigned char lds[];
    LAS unsigned char* L = (LAS unsigned char*)lds;
    volatile LAS unsigned* MISC = (volatile LAS unsigned*)(L + MISC_OFF);
    const int tid = threadIdx.x, lane = tid & 63, wave = __builtin_amdgcn_readfirstlane(tid >> 6);
    const int G = gridDim.x; const int bx = blockIdx.x; const int vcu = (G % 8 == 0) ? (bx % 8) * (G / 8) + bx / 8 : bx;
    unsigned char* ws = args.ws;
    gu32* ctl = (gu32*)(ws + WS_CTL);
    for (int u = tid; u < (LDS_BYTES - LDSCTL_OFF) / 4; u += NWAVES * 64) ((LAS unsigned*)(L + LDSCTL_OFF))[u] = 0u;
    __syncthreads();
    const int lo = args.ph_lo, hi = args.ph_hi;
    XcdBarrier bar; bar.bar = (unsigned*)(ctl + CW_BAR) + args.li * XCD_BAR_WORDS; bar.x = 0; bar.st = nullptr;
    if (hi - lo > 1) bar = xcd_barrier_post((unsigned*)(ctl + CW_BAR) + args.li * XCD_BAR_WORDS, MISC + 8);
#define IN(k) (lo <= (k) && (k) < hi)
#define SEAM(k) do { if (IN(k) && IN((k) + 1)) xcd_barrier_bg(bar, [&]() { BG_WORK(k); }); } while (0)
#define BG_RUN(lo_, hi_, SET_) do { const int st_ = G * (NWAVES - 1); int j_ = (lo_) + vcu * (NWAVES - 1) + wave - 1; mk::WI w_, wn_; f32x4 r_[8], rn_[8]; \
        if (j_ < (hi_)) { SET_(w_, j_); mk::wi_load(w_, r_, lane); } \
        for (; j_ < (hi_); j_ += st_) { const bool hn_ = j_ + st_ < (hi_); if (hn_) { SET_(wn_, j_ + st_); mk::wi_load(wn_, rn_, lane); } mk::wi_proc(w_, r_, scr, lane); \
            if (hn_) { w_ = wn_; _Pragma("unroll") for (int i_ = 0; i_ < 8; ++i_) r_[i_] = rn_[i_]; } } } while (0)
#define BG_SET0(w, j) do { if ((j) < 1408) mk::wi_set(w, 0, args.in[8], nullptr, D, DFF, W2, 32, nullptr, (j)); else mk::wi_set(w, 2, args.in[10], nullptr, INW, D, WIN, 152, args.in[9], (j) - 1408); } while (0)
#define BG_SET1(w, j) do { if ((j) < 256) mk::wi_set(w, 0, args.in[17], nullptr, D, 1024, WUA, 32, nullptr, (j)); else if ((j) < 512) mk::wi_set(w, 0, args.in[18], nullptr, D, 1024, WUA + 512, 32, nullptr, (j) - 256); \
        else if ((j) < 1024) mk::wi_set(w, 0, args.in[19], nullptr, D, D, WOUT, 32, nullptr, (j) - 512); else mk::wi_set(w, 2, args.in[10], nullptr, INW, D, WIN, 152, args.in[9], (j) - 1024 + 1216); } while (0)
#define BG_SET2(w, j) mk::wi_set(w, 1, args.in[21], args.in[22], DFF, D, W13, 176, args.in[20], (j))
#define BG_SET4(w, j) mk::wi_set(w, 0, args.in[23], nullptr, D, DFF, W2, 32, nullptr, (j))
#define BG_COPY(lo_, hi_) do { for (int c_ = (lo_) + vcu * (NWAVES - 1) + wave - 1; c_ < (hi_); c_ += G * (NWAVES - 1)) { f32x4 v_[8]; \
        _Pragma("unroll") for (int i_ = 0; i_ < 8; ++i_) { const int u_ = c_ * 512 + i_ * 64 + lane, ten_ = u_ / (128 * 3840), rem_ = u_ % (128 * 3840), bd_ = rem_ / 3840, q_ = rem_ % 3840; \
            v_[i_] = __builtin_nontemporal_load((const f32x4*)(args.in[2 + ten_] + (size_t)bd_ * 16384 + 1024) + q_); } \
        _Pragma("unroll") for (int i_ = 0; i_ < 8; ++i_) { const int u_ = c_ * 512 + i_ * 64 + lane, ten_ = u_ / (128 * 3840), rem_ = u_ % (128 * 3840), bd_ = rem_ / 3840, q_ = rem_ % 3840; \
            __builtin_nontemporal_store(v_[i_], (f32x4*)(args.out + (ten_ ? O_SWV : O_SWK) + (size_t)bd_ * 16384) + q_); } } } while (0)
#define BG_WORK(k) do { \
        if ((k) == 0) BG_RUN(0, 1408 + 1216, BG_SET0); \
        else if ((k) == 1) BG_RUN(0, 1024 + 1216, BG_SET1); \
        else if ((k) == 2) BG_RUN(0, 1792, BG_SET2); \
        else if ((k) == 3) BG_RUN(1792, 2816, BG_SET2); \
        else if ((k) == 4) BG_RUN(0, 1408, BG_SET4); \
        else if ((k) == 5) BG_COPY(0, 1792); \
        else if ((k) == 6) BG_COPY(1792, 1920); \
    } while (0)
    const float* xp = args.in[0]; const float* xs = args.in[1];
    pg8::bf16_t* W13 = (pg8::bf16_t*)(ws + WS_W13); pg8::bf16_t* W2 = (pg8::bf16_t*)(ws + WS_W2); pg8::bf16_t* WIN = (pg8::bf16_t*)(ws + WS_WIN);
    pg8::bf16_t* WUA = (pg8::bf16_t*)(ws + WS_WUA); pg8::bf16_t* WUR = (pg8::bf16_t*)(ws + WS_WUR); pg8::bf16_t* WOUT = (pg8::bf16_t*)(ws + WS_WOUT);
    float* RSTD1 = (float*)(ws + WS_RSTD1); float* SSQ1 = (float*)(ws + WS_SSQ1); float* SSQ2 = (float*)(ws + WS_SSQ2);
    pg8::bf16_t* AB = (pg8::bf16_t*)(ws + WS_AB); pg8::bf16_t* HID = (pg8::bf16_t*)(ws + WS_HID);
    pg8::bf16_t* Qb = (pg8::bf16_t*)(ws + WS_Q); pg8::bf16_t* KVb = (pg8::bf16_t*)(ws + WS_KV); pg8::bf16_t* QRb = (pg8::bf16_t*)(ws + WS_QR); const unsigned short* LOGF = (const unsigned short*)(ws + WS_LOGF);
    pg8::bf16_t* MRG = (pg8::bf16_t*)(ws + WS_MRG); pg8::bf16_t* IRb = (pg8::bf16_t*)(ws + WS_IR); pg8::bf16_t* GRb = (pg8::bf16_t*)(ws + WS_GR);
    pg8::bf16_t* SGA = (pg8::bf16_t*)(ws + WS_SGA); pg8::bf16_t* SGR = (pg8::bf16_t*)(ws + WS_SGR); pg8::bf16_t* AOR = (pg8::bf16_t*)(ws + WS_AOR);
    const bool tail_first = ((bx >> 3) & 1) != 0;
    LAS float* scr = (LAS float*)(L + RING_OFF + wave * 16384);
    const int gw = vcu * NWAVES + wave, NGW = G * NWAVES;

    if (IN(0)) {
        constexpr int NIT = 176 * 16;
#define WI_DEC0(w, it_) mk::wi_set(w, 1, args.in[6], args.in[7], DFF, D, W13, 176, args.in[5], (it_))
        { mk::WI wc, wn; f32x4 rc[8], rn[8]; int it = gw;
          if (it < NIT) { WI_DEC0(wc, it); mk::wi_load(wc, rc, lane); }
          for (; it < NIT; it += NGW) {
              const bool hn = it + NGW < NIT;
              if (hn) { WI_DEC0(wn, it + NGW); mk::wi_load(wn, rn, lane); }
              mk::wi_proc(wc, rc, scr, lane);
              if (hn) { wc = wn;
#pragma unroll
                  for (int i = 0; i < 8; ++i) rc[i] = rn[i]; }
          } }
#undef WI_DEC0
        for (int m0 = gw; m0 < M; m0 += 4 * NGW) {
            f32x4 v[4][4];
#pragma unroll
            for (int q = 0; q < 4; ++q) { const int m = m0 + q * NGW; if (m < M) { const float* xr = m < MP ? xp + (size_t)m * D : xs + (size_t)(m - MP) * D; const GAS f32x4* p = (const GAS f32x4*)xr + lane;
#pragma unroll
                for (int j = 0; j < 4; ++j) v[q][j] = p[64 * j]; } }
#pragma unroll
            for (int q = 0; q < 4; ++q) { const int m = m0 + q * NGW; if (m < M) { float ss = 0.f;
#pragma unroll
                for (int j = 0; j < 4; ++j) ss += mk::dot4(v[q][j]);
                ss = mk::wave_sum(ss);
                if (lane == 0) RSTD1[m] = rsqrtf(ss * (1.f / 1024.f) + EPS);
                GAS unsigned long long* o8 = (GAS unsigned long long*)(AB + (size_t)m * D) + lane;
#pragma unroll
                for (int j = 0; j < 4; ++j) o8[64 * j] = (unsigned long long)pk2(v[q][j][0], v[q][j][1]) | ((unsigned long long)pk2(v[q][j][2], v[q][j][3]) << 32); } }
        }
        VM_WAIT(); __syncthreads();
    }
    SEAM(0);
    if (IN(1)) {
        pg8::Gemm g{AB, W13, M, 2 * DFF, D}; pg8::StaticOrder S; S.init(M, 2 * DFF, G, bx);
        mk::EpiSwiglu<false> E{HID, RSTD1, L + mk::RTAB_OFF};
        mk::build_rstd_table<false>(L, S, RSTD1, tid);
        pg8::gemm_phase<mk::EpiSwiglu<false>, pg8::StaticOrder, true, true>(L + RING_OFF, g, S, E);
    }
    SEAM(1);
    if (IN(2)) {
        pg8::Gemm g{HID, W2, MP, D, DFF}; pg8::StaticOrder S; S.init(MP, D, G, bx);
        mk::EpiResidB<false> E{AB, nullptr, SSQ1, 0.5f};
if (tail_first) mk::gemm_tail(L + RING_OFF, HID, W2, DFF, MP, 16, 16, vcu, G, E, tid, lane, wave);
        pg8::gemm_phase<mk::EpiResidB<false>, pg8::StaticOrder, true, true>(L + RING_OFF, g, S, E);
        if (!tail_first) mk::gemm_tail(L + RING_OFF, HID, W2, DFF, MP, 16, 16, vcu, G, E, tid, lane, wave);
    }
    SEAM(2);
    if (IN(3)) {
        pg8::Gemm g{AB, WIN, M, INW, D}; mk::ProjOrder S; S.init(G, bx);
        mk::EpiProj E{SSQ1, ws, args.out, args.in[11], args.in[12], args.in[15], L + mk::RTAB_OFF};
        mk::build_rstd_table<true>(L, S, SSQ1, tid);
        pg8::gemm_phase<mk::EpiProj, mk::ProjOrder, true, true>(L + RING_OFF, g, S, E);
        mk::EpiProjTail ET{SSQ1, SGA};
        mk::gemm_tail(L + RING_OFF, AB, WIN + (size_t)2816 * D, D, MP, 16, 12, vcu, G, ET, tid, lane, wave);
    }
    SEAM(3);
    pg8::bf16_t* US = (pg8::bf16_t*)args.out;
    float* DEC = (float*)(ws + WS_DEC);
    if (IN(4)) {
        for (int t = vcu; t < 512; t += G) {
            if (t < 256) at::attn_prompt_task(L, Qb, AOR, KVb, args.in[14], args.in[13], t >> 6, (t >> 1) & 31, t & 1, tid, lane, wave);
            else at::attn_sample_task(L, Qb, AOR, KVb, args.in[2], args.in[3], args.in[14], args.in[13], (t - 256) >> 1, t & 1, tid, lane, wave);
        }
        hg::HaPre HP; if (vcu < 256) hg::ha_issue(HP, LOGF, IRb, 4 * vcu, tid);
        hg::ha_phase(L, HP, LOGF, IRb, US, DEC, vcu, G, tid, lane, wave);
        VM_WAIT(); __syncthreads();
    }
    SEAM(4);
    if (IN(5)) {
        for (int idx = bx * (NWAVES * 64) + tid; idx < 131072; idx += G * NWAVES * 64) hg::hb_scan((unsigned*)US, DEC, args.out + O_PST, idx);
        VM_WAIT(); __syncthreads();
    }
    SEAM(5);
    if (IN(6)) {
        hg::hc_phase_prompt(L, LOGF, QRb, AOR, IRb, GRb, args.in[16], US, vcu, G, tid, lane, wave);
        hg::HcPreS PS; if (vcu < 512) hg::hc_issue_sample(PS, LOGF, QRb, IRb, args.in[4], vcu, tid);
        hg::hc_phase_sample(L, LOGF, QRb, AOR, IRb, GRb, args.in[16], args.in[4], args.out + O_SST, PS, vcu, G, tid, lane, wave);
        VM_WAIT(); __syncthreads();
    }
    SEAM(6);
    if (IN(7)) {
        { pg8::Gemm g{AOR, WUA, MP, D, D}; pg8::StaticOrder S; S.init(MP, D, G, bx); mk::EpiUpR E{MRG, (const unsigned char*)SGA, (const unsigned char*)SGR};
if (tail_first) mk::gemm_tail(L + RING_OFF, AOR, WUA, D, MP, 16, 16, vcu, G, E, tid, lane, wave);
        pg8::gemm_phase<mk::EpiUpR, pg8::StaticOrder, true, true>(L + RING_OFF, g, S, E);
        if (!tail_first) mk::gemm_tail(L + RING_OFF, AOR, WUA, D, MP, 16, 16, vcu, G, E, tid, lane, wave); }
    }
    SEAM(7);
    if (IN(8)) {
        pg8::Gemm g{MRG, WOUT, MP, D, D}; pg8::StaticOrder S; S.init(MP, D, G, bx);
        mk::EpiResidB<false> E{AB, nullptr, SSQ2, 1.0f};
if (tail_first) mk::gemm_tail(L + RING_OFF, MRG, WOUT, D, MP, 16, 16, vcu, G, E, tid, lane, wave);
        pg8::gemm_phase<mk::EpiResidB<false>, pg8::StaticOrder, true, true>(L + RING_OFF, g, S, E);
        if (!tail_first) mk::gemm_tail(L + RING_OFF, MRG, WOUT, D, MP, 16, 16, vcu, G, E, tid, lane, wave);
    }
    SEAM(8);
    if (IN(9)) {
        pg8::Gemm g{AB, W13, M, 2 * DFF, D}; pg8::StaticOrder S; S.init(M, 2 * DFF, G, bx);
        mk::EpiSwiglu<true> E{HID, SSQ2, L + mk::RTAB_OFF};
        mk::build_rstd_table<true>(L, S, SSQ2, tid);
        pg8::gemm_phase<mk::EpiSwiglu<true>, pg8::StaticOrder, true, true>(L + RING_OFF, g, S, E);
    }
    SEAM(9);
    if (IN(10)) {
        pg8::Gemm g{HID, W2, MP, D, DFF}; pg8::StaticOrder S; S.init(MP, D, G, bx);
        mk::EpiResidB<true> E{AB, args.out, nullptr, 0.5f};
if (tail_first) mk::gemm_tail(L + RING_OFF, HID, W2, DFF, MP, 16, 16, vcu, G, E, tid, lane, wave);
        pg8::gemm_phase<mk::EpiResidB<true>, pg8::StaticOrder, true, true>(L + RING_OFF, g, S, E);
        if (!tail_first) mk::gemm_tail(L + RING_OFF, HID, W2, DFF, MP, 16, 16, vcu, G, E, tid, lane, wave);
    }
#undef IN
#undef SEAM
}

extern "C" void kernel_launch(void* const* d_in, const int* in_sizes, int n_in, void* d_out, int out_size, void* d_ws, size_t ws_size, hipStream_t stream) {
    static int grid = 0;
    if (grid == 0) {
        int dev = 0, cus = 0;
        if (hipGetDevice(&dev) != hipSuccess || hipDeviceGetAttribute(&cus, hipDeviceAttributeMultiprocessorCount, dev) != hipSuccess) { fprintf(stderr, "kernel_launch: device query failed\n"); grid = -1; return; }
        if (hipFuncSetAttribute((const void*)mega, hipFuncAttributeMaxDynamicSharedMemorySize, LDS_BYTES) != hipSuccess) { fprintf(stderr, "kernel_launch: hipFuncSetAttribute failed\n"); grid = -1; return; }
        if (ws_size < WS_END) { fprintf(stderr, "kernel_launch: workspace too small: %zu < %zu\n", ws_size, (size_t)WS_END); grid = -1; return; }
        grid = cus;
    }
    if (grid < 0) return;
    (void)hipMemsetAsync((char*)d_ws + WS_CTL + CW_BAR * 4, 0, 16384, stream);
    Args a{};
    for (int i = 0; i < 24; ++i) a.in[i] = (const float*)d_in[i];
    a.out = (float*)d_out; a.ws = (unsigned char*)d_ws;
    unsigned char* ws = (unsigned char*)d_ws; float* out = (float*)d_out;
    int nl = 0;
    auto launch = [&](int lo, int hi) { a.ph_lo = lo; a.ph_hi = hi; a.li = nl++; hipLaunchKernelGGL(mega, dim3(grid), dim3(NWAVES * 64), LDS_BYTES, stream, a); };
    launch(0, 11);
}
```

```cpp
#include <hip/hip_runtime.h>
#include <cstdio>
#include <cstdint>
namespace pg8 {
#define PG8_LAS __attribute__((address_space(3)))
typedef unsigned short bf16_t;
typedef short bf16x8 __attribute__((ext_vector_type(8)));
typedef float f32x4 __attribute__((ext_vector_type(4)));
typedef unsigned u32x4 __attribute__((ext_vector_type(4)));
constexpr int BM = 256, BK = 64, HALF = 128, HTB = HALF * BK * 2  , STAGE_BYTES = 8 * HTB, NXCD = 8, WGM = 8;

__host__ __device__ __forceinline__ int lds_byte(int r, int c) { const int st = (r >> 4) * 2 + (c >> 5), rr = r & 15, cc = c & 31, ob = rr * 64 + cc * 2; return st * 1024 + (ob ^ (((ob >> 9) & 1) << 5)); }
__host__ __device__ __forceinline__ void stage_rc(int b, int& R, int& C) { const int st = b / 1024, sb = b % 1024, swz = sb ^ (((sb >> 9) & 1) << 5); R = (st >> 1) * 16 + swz / 64; C = (st & 1) * 32 + (swz % 64) / 2; }
__host__ __device__ __forceinline__ int perm32(int rho) { const int n = rho >> 4, i = rho & 15; return 8 * (i >> 2) + 4 * n + (i & 3); }

struct Unit { int pm, pn, idx; };
struct Gemm { const bf16_t* A; const bf16_t* Bt; int M, N, K; };

struct StaticOrder {
    int nM, nN, nwg, G, c;
    __host__ __device__ void init(int M, int N, int G_, int c_) { nM = M / BM; nN = N / BM; nwg = nM * nN; G = G_; c = c_; }
    __host__ __device__ bool next(int i, Unit& u) const {
        const long L = (long)i * G + c; if (L >= nwg) return false;
        int wgid = (int)L; { const int q = nwg / NXCD, r = nwg % NXCD, xcd = wgid % NXCD, off = wgid / NXCD; wgid = (xcd < r ? xcd * (q + 1) : r * (q + 1) + (xcd - r) * q) + off; }
        const int nig = WGM * nN, gid = wgid / nig, fm = gid * WGM, gsz = (nM - fm) < WGM ? (nM - fm) : WGM;
        u.pm = fm + ((wgid % nig) % gsz); u.pn = (wgid % nig) / gsz; u.idx = i; return true;
    }
    __device__ __forceinline__ void a_ready(const Unit&) const {}
    __device__ __forceinline__ void done(const Unit&) const {}
};

typedef float f32x2_cv __attribute__((ext_vector_type(2))); typedef __bf16 bf16x2_cv __attribute__((ext_vector_type(2)));
__device__ __forceinline__ unsigned cvt_pk_bf16(float lo, float hi) { const f32x2_cv v = {lo, hi}; const bf16x2_cv b = __builtin_convertvector(v, bf16x2_cv); return __builtin_bit_cast(unsigned, b); }
typedef float f32x2 __attribute__((ext_vector_type(2)));
template <class Epi, class Sched, bool ALIGN_EPI = false, bool SP2 = false>
__device__ __forceinline__ void gemm_phase(PG8_LAS unsigned char* lds, const Gemm g, const Sched& S, const Epi& E) {
    const int tid = threadIdx.x, wid = __builtin_amdgcn_readfirstlane(tid >> 6), lane = tid & 63, wr = wid >> 2, wc = wid & 3, fr = lane & 15, fq = lane >> 4;
    constexpr bool KS = Epi::MIDT > 0;
    const int K = g.K, nt = KS ? Epi::MIDT : K / BK;
    unsigned voffA[2], voffB[2];
#pragma unroll
    for (int i = 0; i < 2; ++i) { int R, C; stage_rc(tid * 16 + i * 8192, R, C); const int Rb = Epi::PERM ? ((R & ~31) + perm32(R & 31)) : R;
        voffA[i] = (unsigned)(R * K + C) * 2u; voffB[i] = (unsigned)(Rb * K + C) * 2u; }
    const size_t kstep = (size_t)(BK * 2);
    const size_t hstep = (size_t)HALF * K * 2;
    const size_t tstep = 2 * hstep;
    const unsigned ldsw = (unsigned)wid * 1024u;
    const int aoff = lds_byte(wr * 64 + fr, fq * 8), boff = lds_byte(wc * 32 + fr, fq * 8);
#define PG8_SA(b, h) (((b) * 2 + (h)) * HTB)
#define PG8_SB(b, h) ((4 + (b) * 2 + (h)) * HTB)
#define PG8_STAGE(bufoff, gbase, voff) do { _Pragma("unroll") for (int _i = 0; _i < 2; ++_i) \
        __builtin_amdgcn_global_load_lds((const unsigned*)((const char*)(gbase) + (voff)[_i]), (PG8_LAS unsigned*)(lds + (bufoff) + ldsw + _i * 8192), 16, 0, 0); } while (0)
#define PG8_LDA(dst, b, h) do { _Pragma("unroll") for (int m = 0; m < 4; ++m) _Pragma("unroll") for (int k = 0; k < 2; ++k) dst[m][k] = *(const PG8_LAS bf16x8*)(lds + PG8_SA(b, h) + aoff + m * 2048 + k * 1024); } while (0)
#define PG8_LDB(dst, b, h) do { _Pragma("unroll") for (int n = 0; n < 2; ++n) _Pragma("unroll") for (int k = 0; k < 2; ++k) dst[n][k] = *(const PG8_LAS bf16x8*)(lds + PG8_SB(b, h) + boff + n * 2048 + k * 1024); } while (0)
#define PG8_MMA(ai, bj, At, Bt) do { __builtin_amdgcn_s_setprio(1); _Pragma("unroll") for (int m = 0; m < 4; ++m) _Pragma("unroll") for (int n = 0; n < 2; ++n) _Pragma("unroll") for (int k = 0; k < 2; ++k) \
        acc[ai][bj][m][n] = __builtin_amdgcn_mfma_f32_16x16x32_bf16(Bt[n][k], At[m][k], acc[ai][bj][m][n], 0, 0, 0); __builtin_amdgcn_s_setprio(0); } while (0)
#define PG8_WAIT_V(n) asm volatile("s_waitcnt vmcnt(" #n ")" ::: "memory")
#define PG8_WAIT_V8R(t_) do { if constexpr (Epi::EPI_VM == 8) asm volatile("s_waitcnt vmcnt(16)\n\ts_cmp_eq_u32 %0, 0\n\ts_cbranch_scc1 1f\n\ts_waitcnt vmcnt(8)\n1:" :: "s"(t_) : "scc", "memory"); \
        else if constexpr (Epi::EPI_VM == 16) asm volatile("s_waitcnt vmcnt(24)\n\ts_cmp_eq_u32 %0, 0\n\ts_cbranch_scc1 1f\n\ts_waitcnt vmcnt(8)\n1:" :: "s"(t_) : "scc", "memory"); \
        else { static_assert(Epi::EPI_VM == 0, "EPI_VM: 0, 8 or 16"); PG8_WAIT_V(8); } } while (0)
#define PG8_WAIT_L(n) asm volatile("s_waitcnt lgkmcnt(" #n ")" ::: "memory")
#define PG8_BAR __builtin_amdgcn_s_barrier()
#define PG8_SCHED __builtin_amdgcn_sched_barrier(0)
    Unit cur, nxt; int ui = 0;
    if (!S.next(0, cur)) return;
    f32x4 acc[2][2][4][2];
    u32x4 ipre[Epi::INIT ? 16 : 1];
    if constexpr (Epi::INIT) E.init_issue(ipre, cur, wr, wc, fr, fq);
    else {
#pragma unroll
    for (int a = 0; a < 2; ++a)
#pragma unroll
        for (int b = 0; b < 2; ++b)
#pragma unroll
            for (int m = 0; m < 4; ++m)
#pragma unroll
                for (int n = 0; n < 2; ++n) acc[a][b][m][n] = (f32x4){0.f, 0.f, 0.f, 0.f};
    }
    bf16x8 At[4][2], B0[2][2], B1[2][2];
    const char* cA = (const char*)g.A + (size_t)cur.pm * tstep; const char* cB = (const char*)g.Bt + (size_t)cur.pn * tstep;
    S.a_ready(cur);
    if constexpr (SP2) {
        PG8_STAGE(PG8_SB(0, 0), cB, voffB); PG8_STAGE(PG8_SB(0, 1), cB + hstep, voffB); PG8_STAGE(PG8_SA(0, 0), cA, voffA); PG8_STAGE(PG8_SA(0, 1), cA + hstep, voffA);
        if (wr == 1) PG8_BAR;
        PG8_WAIT_V(2); PG8_BAR;
        PG8_STAGE(PG8_SB(1, 0), cB + kstep, voffB); PG8_STAGE(PG8_SA(1, 0), cA + kstep, voffA); PG8_STAGE(PG8_SB(1, 1), cB + hstep + kstep, voffB);
        if constexpr (Epi::EPI_VM > 0) PG8_WAIT_V(0); else PG8_WAIT_V(6);
        PG8_BAR;
    } else {
        PG8_STAGE(PG8_SB(0, 0), cB, voffB); PG8_STAGE(PG8_SA(0, 0), cA, voffA); PG8_STAGE(PG8_SB(0, 1), cB + hstep, voffB); PG8_STAGE(PG8_SA(0, 1), cA + hstep, voffA);
        if (wr == 1) PG8_BAR;
        PG8_WAIT_V(4); PG8_BAR;
        PG8_STAGE(PG8_SB(1, 0), cB + kstep, voffB); PG8_STAGE(PG8_SA(1, 0), cA + kstep, voffA); PG8_STAGE(PG8_SB(1, 1), cB + hstep + kstep, voffB);
        PG8_WAIT_V(6); PG8_BAR;
    }
    if constexpr (Epi::INIT) E.init_finish(acc, ipre);
    for (;;) {
        const bool has_next = KS ? S.next((ui + 1) >> 1, nxt) : S.next(ui + 1, nxt);
        const size_t nko = (KS && ((ui + 1) & 1)) ? (size_t)nt * kstep : (size_t)0;
        const char* nA = has_next ? (const char*)g.A + (size_t)nxt.pm * tstep + nko : cA; const char* nB = has_next ? (const char*)g.Bt + (size_t)nxt.pn * tstep + nko : cB;
        for (int t = 0; t < nt; t += 2) {
            const bool last = (t == nt - 2);
            const char* a1 = cA + (size_t)(t + 1) * kstep;
            const char* a2 = last ? nA : cA + (size_t)(t + 2) * kstep; const char* b2 = last ? nB : cB + (size_t)(t + 2) * kstep;
            const char* a3 = a2 + kstep; const char* b3 = b2 + kstep;
            if (last && has_next) S.a_ready(nxt);
            if constexpr (SP2) {
            PG8_LDB(B0, 0, 0); PG8_LDB(B1, 0, 1); PG8_SCHED; PG8_LDA(At, 0, 0); PG8_STAGE(PG8_SA(1, 1), a1 + hstep, voffA);
            PG8_WAIT_V8R(t); PG8_WAIT_L(0); PG8_BAR; PG8_MMA(0, 0, At, B0); PG8_MMA(0, 1, At, B1); PG8_BAR; PG8_SCHED;
            PG8_LDA(At, 0, 1); PG8_STAGE(PG8_SB(0, 0), b2, voffB); PG8_STAGE(PG8_SB(0, 1), b2 + hstep, voffB); PG8_STAGE(PG8_SA(0, 0), a2, voffA);
            PG8_WAIT_V8R(t); PG8_WAIT_L(0); PG8_BAR; PG8_MMA(1, 0, At, B0); PG8_MMA(1, 1, At, B1); PG8_BAR; PG8_SCHED;
            PG8_LDB(B0, 1, 0); PG8_LDB(B1, 1, 1); PG8_SCHED; PG8_LDA(At, 1, 0); PG8_STAGE(PG8_SA(0, 1), a2 + hstep, voffA);
            PG8_WAIT_V(8); PG8_WAIT_L(0); PG8_BAR; PG8_MMA(0, 0, At, B0); PG8_MMA(0, 1, At, B1); PG8_BAR; PG8_SCHED;
            PG8_LDA(At, 1, 1); PG8_STAGE(PG8_SB(1, 0), b3, voffB); PG8_STAGE(PG8_SB(1, 1), b3 + hstep, voffB); PG8_STAGE(PG8_SA(1, 0), a3, voffA);
            PG8_WAIT_V(8); PG8_WAIT_L(0); PG8_BAR; PG8_MMA(1, 0, At, B0); PG8_MMA(1, 1, At, B1); PG8_BAR; PG8_SCHED;
            } else {
            PG8_LDB(B0, 0, 0); PG8_SCHED; PG8_LDA(At, 0, 0); PG8_STAGE(PG8_SA(1, 1), a1 + hstep, voffA);
            PG8_WAIT_L(8); PG8_BAR; PG8_WAIT_L(0); PG8_MMA(0, 0, At, B0); PG8_BAR; PG8_SCHED;
            PG8_LDB(B1, 0, 1); PG8_STAGE(PG8_SB(0, 0), b2, voffB);
            PG8_BAR; PG8_WAIT_L(0); PG8_MMA(0, 1, At, B1); PG8_BAR;
            PG8_LDA(At, 0, 1); PG8_STAGE(PG8_SA(0, 0), a2, voffA);
            PG8_BAR; PG8_WAIT_L(0); PG8_MMA(1, 0, At, B0); PG8_BAR; PG8_SCHED;
            PG8_STAGE(PG8_SB(0, 1), b2 + hstep, voffB);
            PG8_WAIT_V(6); PG8_BAR; PG8_MMA(1, 1, At, B1); PG8_BAR;
            PG8_LDB(B0, 1, 0); PG8_SCHED; PG8_LDA(At, 1, 0); PG8_STAGE(PG8_SA(0, 1), a2 + hstep, voffA);
            PG8_WAIT_L(8); PG8_BAR; PG8_WAIT_L(0); PG8_MMA(0, 0, At, B0); PG8_BAR; PG8_SCHED;
            PG8_LDB(B1, 1, 1); PG8_STAGE(PG8_SB(1, 0), b3, voffB);
            PG8_BAR; PG8_WAIT_L(0); PG8_MMA(0, 1, At, B1); PG8_BAR;
            PG8_LDA(At, 1, 1); PG8_STAGE(PG8_SA(1, 0), a3, voffA);
            PG8_BAR; PG8_WAIT_L(0); PG8_MMA(1, 0, At, B0); PG8_BAR; PG8_SCHED;
            PG8_STAGE(PG8_SB(1, 1), b3 + hstep, voffB);
            PG8_WAIT_V(6); PG8_BAR; PG8_MMA(1, 1, At, B1); PG8_BAR;
            }
        }
        if constexpr (ALIGN_EPI) { if (wr == 0) PG8_BAR; }
        if constexpr (KS) { if (ui & 1) { E(acc, cur, wr, wc, fr, fq); S.done(cur); } else E.mid(acc, cur, wr, wc, fr, fq); }
        else if constexpr (!Epi::AFTER_DRAIN) { E(acc, cur, wr, wc, fr, fq); S.done(cur); }
        if (!has_next) break;
        if constexpr (Epi::INIT) { E.init_issue(ipre, nxt, wr, wc, fr, fq); E.init_finish(acc, ipre); }
        else if (!KS || (ui & 1)) {
#pragma unroll
        for (int a = 0; a < 2; ++a)
#pragma unroll
            for (int b = 0; b < 2; ++b)
#pragma unroll
                for (int m = 0; m < 4; ++m)
#pragma unroll
                    for (int n = 0; n < 2; ++n) acc[a][b][m][n] = (f32x4){0.f, 0.f, 0.f, 0.f};
        }
        cur = nxt; cA = nA; cB = nB; ++ui;
        if constexpr (ALIGN_EPI) { if (wr == 1) PG8_BAR; }
    }
    PG8_WAIT_V(0);
    if constexpr (!ALIGN_EPI) { if (wr == 0) PG8_BAR; }
    PG8_BAR;
    if constexpr (Epi::AFTER_DRAIN) { E.fused(acc, cur, wr, wc, fr, fq, lds, wid, lane); S.done(cur); }
#undef PG8_SA
#undef PG8_SB
#undef PG8_STAGE
#undef PG8_LDA
#undef PG8_LDB
#undef PG8_MMA
#undef PG8_WAIT_V
#undef PG8_WAIT_L
#undef PG8_WAIT_V8R
#undef PG8_BAR
#undef PG8_SCHED
}
}
#define GAS __attribute__((address_space(1)))
#define LAS __attribute__((address_space(3)))
typedef unsigned short bf16;
typedef unsigned v4u __attribute__((ext_vector_type(4)));
typedef float f32x4 __attribute__((ext_vector_type(4)));
typedef short bf16x8 __attribute__((ext_vector_type(8)));
typedef GAS unsigned gu32;
typedef GAS unsigned long long gu64;
#define RLX_AGENT __ATOMIC_RELAXED, __HIP_MEMORY_SCOPE_AGENT
#define LDS_WAIT() asm volatile("s_waitcnt lgkmcnt(0)" ::: "memory")
#define VM_WAIT() asm volatile("s_waitcnt vmcnt(0)" ::: "memory")
__device__ __forceinline__ unsigned long long rt() { return __builtin_amdgcn_s_memrealtime(); }
__device__ __forceinline__ unsigned f2bf(float f) { unsigned u = __builtin_bit_cast(unsigned, f); return (u + 0x7fffu + ((u >> 16) & 1u)) >> 16; }
__device__ __forceinline__ unsigned pk2(float lo, float hi) { return f2bf(lo) | (f2bf(hi) << 16); }
#define XB_TMO      128
#define XB_XCNT(j)  (256  + 64 * (j))
#define XB_XSUB(j)  (1280 + 64 * (j))
#define XB_XGEN(j)  (2304 + 64 * (j))
#define XB_TOP      3328
#define XB_TOPGEN   3392
#define XCD_BAR_WORDS 3456
#define XB_SPIN_CAP (1u << 18)

__device__ __forceinline__ unsigned xb_ld(unsigned* p)              { return __hip_atomic_load(p, __ATOMIC_RELAXED, __HIP_MEMORY_SCOPE_AGENT); }
__device__ __forceinline__ unsigned xb_add(unsigned* p, unsigned v) { return __hip_atomic_fetch_add(p, v, __ATOMIC_RELAXED, __HIP_MEMORY_SCOPE_AGENT); }
__device__ __forceinline__ unsigned xb_xcc_id() { return (unsigned)__builtin_amdgcn_s_getreg((3 << 11) | 20) & 0xFu; }
#define XB_SPIN(cond, bar) do { unsigned _sp = 0; while (cond) { __builtin_amdgcn_s_sleep(1); \
    if ((++_sp & 255u) == 0u) { if (xb_ld(&(bar)[XB_TMO])) break; if (_sp > XB_SPIN_CAP) { atomicAdd(&(bar)[XB_TMO], 1u); break; } } } } while (0)

struct XcdBarrier {
    unsigned* bar; unsigned x;
    volatile LAS unsigned* st;
};

__device__ __forceinline__ XcdBarrier xcd_barrier_post(unsigned* bar, volatile LAS unsigned* st) {
    XcdBarrier b; b.bar = bar; b.x = xb_xcc_id(); b.st = st;
    if (threadIdx.x == 0) (void)xb_add(&bar[XB_XCNT(b.x)], 1u);
    return b;
}
__device__ __forceinline__ void xcd_barrier_complete(unsigned* bar, unsigned x, unsigned& nloc, unsigned& nx) {
    const unsigned G = gridDim.x * gridDim.y * gridDim.z;
    unsigned sum, cnt, mine, sp = 0u;
    for (;;) {
        sum = 0u; cnt = 0u; mine = 0u;
#pragma unroll
        for (unsigned j = 0; j < 16; ++j) { const unsigned c = xb_ld(&bar[XB_XCNT(j)]); sum += c; cnt += (c > 0u) ? 1u : 0u; mine = (j == x) ? c : mine; }
        if (sum == G) break;
        __builtin_amdgcn_s_sleep(1);
        if ((++sp & 255u) == 0u) { if (xb_ld(&bar[XB_TMO])) break; if (sp > XB_SPIN_CAP) { atomicAdd(&bar[XB_TMO], 1u); break; } }
    }
    nloc = mine > 0u ? mine : 1u; nx = cnt > 0u ? cnt : 1u;
}

__device__ __forceinline__ void xcd_barrier(const XcdBarrier& b) {
    asm volatile("s_waitcnt vmcnt(0)" ::: "memory");
    __syncthreads();
    if (threadIdx.x == 0) {
        unsigned* bar = b.bar;
        __builtin_amdgcn_s_waitcnt(0);
        unsigned nloc = b.st[0], nx = b.st[1];
        if (nloc == 0u) { xcd_barrier_complete(bar, b.x, nloc, nx); b.st[0] = nloc; b.st[1] = nx; }
        const unsigned old = xb_add(&bar[XB_XSUB(b.x)], 1u);
        const unsigned gen = old / nloc;
        if (old + 1u == (gen + 1u) * nloc) {
            __builtin_amdgcn_fence(__ATOMIC_RELEASE, "agent");
            asm volatile("s_waitcnt vmcnt(0)" ::: "memory");
            const unsigned og = xb_add(&bar[XB_TOP], 1u);
            const unsigned tg = og / nx;
            if (og + 1u == (tg + 1u) * nx) xb_add(&bar[XB_TOPGEN], 1u);
            else XB_SPIN(xb_ld(&bar[XB_TOPGEN]) == tg, bar);
            __builtin_amdgcn_fence(__ATOMIC_ACQUIRE, "agent");
            xb_add(&bar[XB_XGEN(b.x)], 1u);
            asm volatile("s_waitcnt vmcnt(0)" ::: "memory");
        } else {
            XB_SPIN(xb_ld(&bar[XB_XGEN(b.x)]) == gen, bar);
            __builtin_amdgcn_fence(__ATOMIC_ACQUIRE, "agent");
            asm volatile("s_waitcnt vmcnt(0)" ::: "memory");
        }
    }
    __syncthreads();
}

template <class BG> __device__ __forceinline__ void xcd_barrier_bg(const XcdBarrier& b, const BG& bg) {
    asm volatile("s_waitcnt vmcnt(0)" ::: "memory");
    __syncthreads();
    if (threadIdx.x == 0) {
        unsigned* bar = b.bar;
        __builtin_amdgcn_s_waitcnt(0);
        unsigned nloc = b.st[0], nx = b.st[1];
        if (nloc == 0u) { xcd_barrier_complete(bar, b.x, nloc, nx); b.st[0] = nloc; b.st[1] = nx; }
        const unsigned old = xb_add(&bar[XB_XSUB(b.x)], 1u);
        const unsigned gen = old / nloc;
        if (old + 1u == (gen + 1u) * nloc) {
            __builtin_amdgcn_fence(__ATOMIC_RELEASE, "agent");
            asm volatile("s_waitcnt vmcnt(0)" ::: "memory");
            const unsigned og = xb_add(&bar[XB_TOP], 1u);
            const unsigned tg = og / nx;
            if (og + 1u == (tg + 1u) * nx) xb_add(&bar[XB_TOPGEN], 1u);
            else XB_SPIN(xb_ld(&bar[XB_TOPGEN]) == tg, bar);
            __builtin_amdgcn_fence(__ATOMIC_ACQUIRE, "agent");
            xb_add(&bar[XB_XGEN(b.x)], 1u);
            asm volatile("s_waitcnt vmcnt(0)" ::: "memory");
        } else {
            XB_SPIN(xb_ld(&bar[XB_XGEN(b.x)]) == gen, bar);
            __builtin_amdgcn_fence(__ATOMIC_ACQUIRE, "agent");
            asm volatile("s_waitcnt vmcnt(0)" ::: "memory");
        }
    } else if (threadIdx.x >= 64) bg();
    __syncthreads();
}

constexpr int D = 1024, MP = 16384, MS = 1024, M = MP + MS, DFF = 2816, INW = 4864;
constexpr float EPS = 1e-6f;
constexpr size_t O_YS = (size_t)MP * D, O_PWK = O_YS + (size_t)MS * D, O_PWV = O_PWK + 65536, O_PST = O_PWV + 65536, O_SWK = O_PST + 262144, O_SWV = O_SWK + 2097152, O_SST = O_SWV + 2097152;
constexpr size_t MiB = 1u << 20, HMiB = 1u << 19;
constexpr size_t WS_CTL = 0, CTL_ZERO_BYTES = 1 * MiB;
constexpr size_t WS_W13 = 1 * MiB, WS_W2 = 12 * MiB, WS_WIN = 17 * MiB + HMiB, WS_WUA = 27 * MiB, WS_WUR = 28 * MiB, WS_WOUT = 29 * MiB;
constexpr size_t WS_DEC = 31 * MiB, WS_RSTD1 = 31 * MiB + HMiB, WS_SSQ1 = 32 * MiB, WS_SSQ2 = 34 * MiB;
constexpr size_t WS_AB = 36 * MiB, WS_BIG = 70 * MiB;
constexpr size_t WS_HID = WS_BIG, WS_Q = WS_BIG, WS_KV = WS_BIG + 17 * MiB, WS_QR = WS_KV + 8 * MiB + HMiB, WS_LOGF = WS_QR + 17 * MiB, WS_MRG = WS_LOGF, WS_IR = WS_LOGF + 34 * MiB,
                 WS_GR = WS_IR + 17 * MiB, WS_SGA = WS_GR + 17 * MiB, WS_SGR = WS_SGA + 17 * MiB, WS_AOR = WS_SGR + 17 * MiB, WS_END = WS_AOR + 34 * MiB;
static_assert(WS_END <= 256 * MiB && WS_HID + (size_t)M * DFF * 2 <= WS_END, "ws map");
constexpr int CW_BAR = 4096;
constexpr int RING_OFF = 0, RING_BYTES = 131072, LDSCTL_OFF = 139264, MISC_OFF = LDSCTL_OFF + 320, LDS_BYTES = 147456;
constexpr int NWAVES = 8;

namespace mk {
using pg8::f32x4; using pg8::u32x4; using pg8::Unit; using pg8::bf16_t; using pg8::cvt_pk_bf16;
typedef unsigned u32x2 __attribute__((ext_vector_type(2)));
__device__ __forceinline__ float fsigmoid(float x) { return __builtin_amdgcn_rcpf(1.f + __expf(-x)); }
__device__ __forceinline__ float fsilu(float x) { return x * fsigmoid(x); }
__device__ __forceinline__ float bflo(unsigned w) { return __uint_as_float(w << 16); }
__device__ __forceinline__ float bfhi(unsigned w) { return __uint_as_float(w & 0xffff0000u); }
__device__ __forceinline__ float bf2f(bf16_t h) { return __uint_as_float((unsigned)h << 16); }
__device__ __forceinline__ u32x4 pack8(const f32x4 a, const f32x4 b) { u32x4 w; w.x = cvt_pk_bf16(a[0], a[1]); w.y = cvt_pk_bf16(a[2], a[3]); w.z = cvt_pk_bf16(b[0], b[1]); w.w = cvt_pk_bf16(b[2], b[3]); return w; }
__device__ __forceinline__ float dot4(const f32x4 a) { return (a[0] * a[0] + a[1] * a[1]) + (a[2] * a[2] + a[3] * a[3]); }
__device__ __forceinline__ unsigned q16(float s) { return (unsigned)(s * 65535.f + 0.5f); }
__device__ __forceinline__ unsigned q8(float s) { return (unsigned)(s * 255.f + 0.5f); }
__device__ __forceinline__ unsigned pack4q8(const f32x4 s) { return q8(s[0]) | (q8(s[1]) << 8) | (q8(s[2]) << 16) | (q8(s[3]) << 24); }
__device__ __forceinline__ f32x4 unpack4q8(unsigned w) { return (f32x4){(float)(w & 0xffu), (float)((w >> 8) & 0xffu), (float)((w >> 16) & 0xffu), (float)(w >> 24)} * (1.f / 255.f); }
__device__ __forceinline__ float row_rstd16(const float* ssqp, int r) {
    const f32x4* p = (const f32x4*)(ssqp + (size_t)r * 16); const f32x4 a = p[0], b = p[1], c = p[2], d = p[3]; const f32x4 s = (a + b) + (c + d);
    return rsqrtf(((s[0] + s[1]) + (s[2] + s[3])) * (1.f / 1024.f) + EPS);
}

constexpr int RTAB_OFF = LDSCTL_OFF + 1024;
template <bool FROM_SSQ, class Sched> __device__ __forceinline__ void build_rstd_table(LAS unsigned char* L, const Sched& S, const float* src, int tid) {
    Unit u;
    for (int i = 0; i < 6 && S.next(i, u); ++i) if (tid < 256) *(LAS float*)(L + RTAB_OFF + (i * 256 + tid) * 4) = FROM_SSQ ? row_rstd16(src, u.pm * 256 + tid) : src[u.pm * 256 + tid];
    __syncthreads();
}
template <bool FROM_SSQ> struct EpiSwiglu {
    static constexpr bool PERM = true, AFTER_DRAIN = false, INIT = false; static constexpr int MIDT = 0, EPI_VM = 8;
    bf16_t* H; const float* rs; LAS unsigned char* tab;
    __device__ __forceinline__ void operator()(const f32x4 (&acc)[2][2][4][2], const Unit& u, int wr, int wc, int fr, int fq) const {
        const int row0 = u.pm * 256 + wr * 64 + fr, col0 = u.pn * 128 + wc * 32 + 8 * fq;
#pragma unroll
        for (int ai = 0; ai < 2; ++ai)
#pragma unroll
            for (int m = 0; m < 4; ++m) {
                const int r = row0 + ai * 128 + m * 16;
                const float s = u.idx < 6 ? *(const LAS float*)(tab + (u.idx * 256 + (r & 255)) * 4) : (FROM_SSQ ? row_rstd16(rs, r) : rs[r]);
                f32x4 h0, h1;
#pragma unroll
                for (int e = 0; e < 4; ++e) { h0[e] = fsilu(acc[ai][0][m][0][e] * s) * (acc[ai][1][m][0][e] * s); h1[e] = fsilu(acc[ai][0][m][1][e] * s) * (acc[ai][1][m][1][e] * s); }
                *(u32x4*)(H + (size_t)r * DFF + col0) = pack8(h0, h1);
            }
    }
};
template <bool WRITE_B> struct EpiResid {
    static constexpr bool PERM = false, AFTER_DRAIN = false, INIT = false; static constexpr int MIDT = 0, EPI_VM = 0;
    const float* xp; const float* xs; float* Hout; bf16_t* HB; float* ssqp; float scale; int base_is_x;
    __device__ __forceinline__ void operator()(const f32x4 (&acc)[2][2][4][2], const Unit& u, int wr, int wc, int fr, int fq) const {
        const int row0 = u.pm * 256 + wr * 64 + fr, col0 = u.pn * 256 + wc * 32 + 4 * fq;
        f32x4 pre[3][4];
#define ER_BASE(g_) (base_is_x ? (row0 + ((g_) >> 2) * 128 + ((g_) & 3) * 16 < MP ? xp + (size_t)(row0 + ((g_) >> 2) * 128 + ((g_) & 3) * 16) * D : xs + (size_t)(row0 + ((g_) >> 2) * 128 + ((g_) & 3) * 16 - MP) * D) : Hout + (size_t)(row0 + ((g_) >> 2) * 128 + ((g_) & 3) * 16) * D)
#define ER_LOAD(g_) do { const float* bp_ = ER_BASE(g_); _Pragma("unroll") for (int q_ = 0; q_ < 4; ++q_) pre[(g_) % 3][q_] = *(const f32x4*)(bp_ + col0 + (q_ >> 1) * 128 + (q_ & 1) * 16); } while (0)
        ER_LOAD(0); ER_LOAD(1);
#pragma unroll
        for (int g = 0; g < 8; ++g) {
            if (g + 2 < 8) ER_LOAD(g + 2);
            const int ai = g >> 2, m = g & 3, r = row0 + ai * 128 + m * 16;
            float* op = Hout + (size_t)r * D; float ss = 0.f;
#pragma unroll
            for (int q = 0; q < 4; ++q) {
                const int bj = q >> 1, n = q & 1, c = col0 + bj * 128 + n * 16; const f32x4 o = pre[g % 3][q] + acc[ai][bj][m][n] * scale;
                if (WRITE_B) *(f32x4*)(op + c) = o; else __builtin_nontemporal_store(o, (f32x4*)(op + c));
                if (WRITE_B) { ss += dot4(o); u32x2 w; w.x = cvt_pk_bf16(o[0], o[1]); w.y = cvt_pk_bf16(o[2], o[3]); *(u32x2*)(HB + (size_t)r * D + c) = w; }
            }
            if (WRITE_B) { ss += __shfl_xor(ss, 16); ss += __shfl_xor(ss, 32); if (fq == 0) ssqp[(size_t)r * 16 + u.pn * 4 + wc] = ss; }
            __builtin_amdgcn_sched_barrier(0);
        }
#undef ER_LOAD
#undef ER_BASE
    }
    __device__ __forceinline__ void tail(const f32x4 (&acc)[4], int r, int c0, int fq) const {
        const float* bp = base_is_x ? (r < MP ? xp + (size_t)r * D : xs + (size_t)(r - MP) * D) : Hout + (size_t)r * D;
        float* op = Hout + (size_t)r * D; float ss = 0.f;
#pragma unroll
        for (int n = 0; n < 4; ++n) {
            const int c = c0 + 16 * n + 4 * fq; const f32x4 b = *(const f32x4*)(bp + c); const f32x4 o = b + acc[n] * scale; if (WRITE_B) *(f32x4*)(op + c) = o; else __builtin_nontemporal_store(o, (f32x4*)(op + c));
            if (WRITE_B) { ss += dot4(o); u32x2 w; w.x = cvt_pk_bf16(o[0], o[1]); w.y = cvt_pk_bf16(o[2], o[3]); *(u32x2*)(HB + (size_t)r * D + c) = w; }
        }
        if (WRITE_B) { ss += __shfl_xor(ss, 16); ss += __shfl_xor(ss, 32); if (fq == 0) ssqp[(size_t)r * 16 + (c0 >> 6)] = ss; }
    }
};
template <bool FINAL> struct EpiResidB {
    static constexpr bool PERM = true, AFTER_DRAIN = false, INIT = true; static constexpr int MIDT = 0, EPI_VM = 0;
    bf16_t* HB; float* Y; float* ssqp; float scale;
    __device__ __forceinline__ void init_issue(u32x4 (&pre)[16], const Unit& u, int wr, int wc, int fr, int fq) const {
        const int row0 = u.pm * 256 + wr * 64 + fr, col0 = u.pn * 256 + wc * 32 + 8 * fq;
#pragma unroll
        for (int g = 0; g < 8; ++g)
#pragma unroll
            for (int bj = 0; bj < 2; ++bj) pre[2 * g + bj] = *(const u32x4*)(HB + (size_t)(row0 + (g >> 2) * 128 + (g & 3) * 16) * D + col0 + 128 * bj);
    }
    __device__ __forceinline__ void init_finish(f32x4 (&acc)[2][2][4][2], const u32x4 (&pre)[16]) const {
        const float inv = 1.f / scale;
#pragma unroll
        for (int g = 0; g < 8; ++g)
#pragma unroll
            for (int bj = 0; bj < 2; ++bj) { const u32x4 b = pre[2 * g + bj];
                acc[g >> 2][bj][g & 3][0] = (f32x4){bflo(b.x), bfhi(b.x), bflo(b.y), bfhi(b.y)} * inv; acc[g >> 2][bj][g & 3][1] = (f32x4){bflo(b.z), bfhi(b.z), bflo(b.w), bfhi(b.w)} * inv; }
    }
    __device__ __forceinline__ void operator()(const f32x4 (&acc)[2][2][4][2], const Unit& u, int wr, int wc, int fr, int fq) const {
        const int row0 = u.pm * 256 + wr * 64 + fr, col0 = u.pn * 256 + wc * 32 + 8 * fq;
#pragma unroll
        for (int g = 0; g < 8; ++g) {
            const int ai = g >> 2, m = g & 3, r = row0 + ai * 128 + m * 16; float ss = 0.f;
#pragma unroll
            for (int bj = 0; bj < 2; ++bj) {
                const f32x4 o0 = acc[ai][bj][m][0] * scale, o1 = acc[ai][bj][m][1] * scale;
                if (FINAL) { float* yp = Y + (size_t)r * D + col0 + 128 * bj; __builtin_nontemporal_store(o0, (f32x4*)yp); __builtin_nontemporal_store(o1, (f32x4*)(yp + 4)); }
                else { ss += dot4(o0) + dot4(o1); *(u32x4*)(HB + (size_t)r * D + col0 + 128 * bj) = pack8(o0, o1); }
            }
            if (!FINAL) { ss += __shfl_xor(ss, 16); ss += __shfl_xor(ss, 32); if (fq == 0) ssqp[(size_t)r * 16 + u.pn * 4 + wc] = ss; }
        }
    }
    __device__ __forceinline__ void tail(const f32x4 (&acc)[4], int r, int c0, int fq) const {
        bf16_t* bp = HB + (size_t)r * D + c0 + 4 * fq; float ss = 0.f; u32x2 b[4];
#pragma unroll
        for (int n = 0; n < 4; ++n) b[n] = *(const u32x2*)(bp + 16 * n);
#pragma unroll
        for (int n = 0; n < 4; ++n) {
            const f32x4 o = (f32x4){bflo(b[n].x), bfhi(b[n].x), bflo(b[n].y), bfhi(b[n].y)} + acc[n] * scale;
            if (FINAL) __builtin_nontemporal_store(o, (f32x4*)(Y + (size_t)r * D + c0 + 16 * n + 4 * fq));
            else { ss += dot4(o); u32x2 w; w.x = cvt_pk_bf16(o[0], o[1]); w.y = cvt_pk_bf16(o[2], o[3]); *(u32x2*)(bp + 16 * n) = w; }
        }
        if (!FINAL) { ss += __shfl_xor(ss, 16); ss += __shfl_xor(ss, 32); if (fq == 0) ssqp[(size_t)r * 16 + (c0 >> 6)] = ss; }
    }
};
struct EpiProj {
    static constexpr bool PERM = true, AFTER_DRAIN = false, INIT = false; static constexpr int MIDT = 0, EPI_VM = 16;
    const float* ssqp; unsigned char* ws; float* out; const float *qn, *kn, *lbl; LAS unsigned char* tab;
    __device__ __forceinline__ void operator()(const f32x4 (&acc)[2][2][4][2], const Unit& u, int wr, int wc, int fr, int fq) const {
        const int pn = u.pn, row0 = u.pm * 256 + wr * 64 + fr, pc = wc * 32 + 8 * fq;
        bf16_t* const Q = (bf16_t*)(ws + WS_Q); bf16_t* const KV = (bf16_t*)(ws + WS_KV); unsigned short* const LOGF = (unsigned short*)(ws + WS_LOGF);
        if (pn < 3) {
            const bool isv = (pn == 2 && wc >= 2);
            const float* gp = (pn < 2) ? qn : kn;
            f32x4 gn[2][2];
#pragma unroll
            for (int bj = 0; bj < 2; ++bj)
#pragma unroll
                for (int n = 0; n < 2; ++n) gn[bj][n] = isv ? (f32x4){1.f, 1.f, 1.f, 1.f} : *(const f32x4*)(gp + 32 * bj + 8 * fq + 4 * n);
#pragma unroll
            for (int ai = 0; ai < 2; ++ai)
#pragma unroll
                for (int m = 0; m < 4; ++m) {
                    const int r = row0 + ai * 128 + m * 16; const float s = u.idx < 6 ? *(const LAS float*)(tab + (u.idx * 256 + (r & 255)) * 4) : row_rstd16(ssqp, r);
                    f32x4 v[2][2]; float ss = 0.f;
#pragma unroll
                    for (int bj = 0; bj < 2; ++bj)
#pragma unroll
                        for (int n = 0; n < 2; ++n) { v[bj][n] = acc[ai][bj][m][n] * s; ss += dot4(v[bj][n]); }
                    ss += __shfl_xor(ss, 16); ss += __shfl_xor(ss, 32);
                    const float nr = isv ? 1.f : rsqrtf(ss * (1.f / 64.f) + EPS);
#pragma unroll
                    for (int bj = 0; bj < 2; ++bj)
#pragma unroll
                        for (int n = 0; n < 2; ++n) v[bj][n] = v[bj][n] * nr * gn[bj][n];
                    bf16_t* dst = (pn < 2) ? Q + (size_t)r * 512 + (4 * pn + wc) * 64 + 8 * fq : KV + (size_t)r * 256 + wc * 64 + 8 * fq;
#pragma unroll
                    for (int bj = 0; bj < 2; ++bj) *(u32x4*)(dst + 32 * bj) = pack8(v[bj][0], v[bj][1]);
                    if (pn == 2) {
                        float* o = nullptr; const int kvh = wc & 1;
                        if (r < MP) { const int t = r & 4095; if (t >= 3968) o = out + (wc < 2 ? O_PWK : O_PWV) + ((size_t)((r >> 12) * 128 + (t - 3968)) * 2 + kvh) * 64; }
                        else { const int rr = r - MP; o = out + (wc < 2 ? O_SWK : O_SWV) + ((size_t)((rr >> 3) * 128 + 120 + (rr & 7)) * 2 + kvh) * 64; }
                        if (o) {
#pragma unroll
                            for (int bj = 0; bj < 2; ++bj)
#pragma unroll
                                for (int n = 0; n < 2; ++n) *(f32x4*)(o + 32 * bj + 8 * fq + 4 * n) = v[bj][n];
                        }
                    }
                }
        } else if (pn >= 5 && pn < 7) {
            const int tc = (pn - 5) * 256 + pc;
            f32x4 lb[2][2];
#pragma unroll
            for (int bj = 0; bj < 2; ++bj)
#pragma unroll
                for (int n = 0; n < 2; ++n) { const f32x4 l0 = *(const f32x4*)(lbl + tc + 128 * bj + 4 * n), l1 = *(const f32x4*)(lbl + 512 + tc + 128 * bj + 4 * n);
#pragma unroll
                    for (int e = 0; e < 4; ++e) lb[bj][n][e] = 1.f / (1.f + __expf(l1[e] - l0[e])); }
#pragma unroll
            for (int ai = 0; ai < 2; ++ai)
#pragma unroll
                for (int m = 0; m < 4; ++m) {
                    const int r = row0 + ai * 128 + m * 16; const float s = u.idx < 6 ? *(const LAS float*)(tab + (u.idx * 256 + (r & 255)) * 4) : row_rstd16(ssqp, r);
#pragma unroll
                    for (int bj = 0; bj < 2; ++bj)
#pragma unroll
                        for (int n = 0; n < 2; ++n) { f32x4 lf;
#pragma unroll
                            for (int e = 0; e < 4; ++e) { const float f = lb[bj][n][e] + (1.f - lb[bj][n][e]) * fsigmoid(acc[ai][bj][m][n][e] * s); lf[e] = f; }
                            u32x2 w; w.x = q16(lf[0]) | (q16(lf[1]) << 16); w.y = q16(lf[2]) | (q16(lf[3]) << 16);
                            *(u32x2*)(LOGF + (size_t)r * 512 + tc + 128 * bj + 4 * n) = w; }
                }
        } else {
            int act, ld, tc; size_t boff;
            if (pn < 5) { act = 1; boff = WS_QR; ld = 512; tc = (pn - 3) * 256 + pc; }
            else if (pn < 9) { act = 0; boff = WS_IR; ld = 512; tc = (pn - 7) * 256 + pc; }
            else if (pn < 11) { act = 1; boff = WS_GR; ld = 512; tc = (pn - 9) * 256 + pc; }
            else if (pn < 15) { act = 2; boff = WS_SGA; ld = 1024; tc = (pn - 11) * 256 + pc; }
            else { act = 2; boff = WS_SGR; ld = 1024; tc = (pn - 15) * 256 + pc; }
            bf16_t* const base = (bf16_t*)(ws + boff);
#pragma unroll
            for (int ai = 0; ai < 2; ++ai)
#pragma unroll
                for (int m = 0; m < 4; ++m) {
                    const int r = row0 + ai * 128 + m * 16; const float s = u.idx < 6 ? *(const LAS float*)(tab + (u.idx * 256 + (r & 255)) * 4) : row_rstd16(ssqp, r);
#pragma unroll
                    for (int bj = 0; bj < 2; ++bj) { f32x4 a, b;
#pragma unroll
                        for (int e = 0; e < 4; ++e) { const float x0 = acc[ai][bj][m][0][e] * s, x1 = acc[ai][bj][m][1][e] * s;
                            a[e] = act == 0 ? x0 : (act == 1 ? fsilu(x0) : fsigmoid(x0)); b[e] = act == 0 ? x1 : (act == 1 ? fsilu(x1) : fsigmoid(x1)); }
                        if (act == 2) { u32x2 w; w.x = pack4q8(a); w.y = pack4q8(b); *(u32x2*)((unsigned char*)base + (size_t)r * ld + tc + 128 * bj) = w; }
                        else *(u32x4*)(base + (size_t)r * ld + tc + 128 * bj) = pack8(a, b); }
                }
        }
    }
};
struct ProjOrder {
    pg8::StaticOrder P; int G, c;
    __device__ void init(int G_, int c_) { P.init(MP, INW, G_, c_); G = G_; c = c_; }
    __device__ bool next(int i, Unit& u) const {
        if (P.next(i, u)) return true;
        const long L = (long)i * G + c - 1216; if (L >= 64) return false;
        const int q = (int)L & 15; u.pm = 64 + ((int)L >> 4); u.pn = q < 11 ? q : q + 3; u.idx = i; return true;
    }
    __device__ __forceinline__ void a_ready(const Unit&) const {}
    __device__ __forceinline__ void done(const Unit&) const {}
};
struct EpiProjTail {
    static constexpr int MIDT = 0, EPI_VM = 0;
    const float* ssqp; bf16_t* SGA;
    __device__ __forceinline__ void tail(const f32x4 (&acc)[4], int r, int c0, int fq) const {
        const float s = row_rstd16(ssqp, r);
#pragma unroll
        for (int n = 0; n < 4; ++n) { f32x4 a;
#pragma unroll
            for (int e = 0; e < 4; ++e) a[e] = fsigmoid(acc[n][e] * s);
            *(unsigned*)((unsigned char*)SGA + (size_t)r * 1024 + c0 + 16 * n + 4 * fq) = pack4q8(a); }
    }
};
template <int PASS> struct EpiUp {
    static constexpr bool PERM = true, AFTER_DRAIN = false, INIT = false; static constexpr int MIDT = 0, EPI_VM = 0;
    bf16_t* MRG; const bf16_t* G;
    __device__ __forceinline__ void operator()(const f32x4 (&acc)[2][2][4][2], const Unit& u, int wr, int wc, int fr, int fq) const {
        const int row0 = u.pm * 256 + wr * 64 + fr, c0 = u.pn * 256 + wc * 32 + 8 * fq;
#pragma unroll
        for (int ai = 0; ai < 2; ++ai)
#pragma unroll
            for (int m = 0; m < 4; ++m) {
                const int r = row0 + ai * 128 + m * 16;
#pragma unroll
                for (int bj = 0; bj < 2; ++bj) {
                    const size_t off = (size_t)r * 1024 + c0 + 128 * bj; const u32x2 g = *(const u32x2*)((const unsigned char*)G + off); const f32x4 ga = unpack4q8(g.x), gb = unpack4q8(g.y);
                    f32x4 a = acc[ai][bj][m][0], b = acc[ai][bj][m][1];
                    a = a * ga; b = b * gb;
                    if (PASS == 1) { const u32x4 p = *(const u32x4*)(MRG + off);
                        a[0] += bflo(p.x); a[1] += bfhi(p.x); a[2] += bflo(p.y); a[3] += bfhi(p.y); b[0] += bflo(p.z); b[1] += bfhi(p.z); b[2] += bflo(p.w); b[3] += bfhi(p.w); }
                    *(u32x4*)(MRG + off) = pack8(a, b);
                }
            }
    }
    __device__ __forceinline__ void tail(const f32x4 (&acc)[4], int r, int c0, int fq) const {
#pragma unroll
        for (int n = 0; n < 4; ++n) {
            const size_t off = (size_t)r * 1024 + c0 + 16 * n + 4 * fq; const f32x4 gq = unpack4q8(*(const unsigned*)((const unsigned char*)G + off));
            f32x4 a = acc[n] * gq;
            if (PASS == 1) { const u32x2 p = *(const u32x2*)(MRG + off); a[0] += bflo(p.x); a[1] += bfhi(p.x); a[2] += bflo(p.y); a[3] += bfhi(p.y); }
            u32x2 w; w.x = cvt_pk_bf16(a[0], a[1]); w.y = cvt_pk_bf16(a[2], a[3]); *(u32x2*)(MRG + off) = w;
        }
    }
};
struct EpiUpR {
    static constexpr bool PERM = true, AFTER_DRAIN = false, INIT = false; static constexpr int MIDT = 8, EPI_VM = 0;
    static constexpr float EPSQ = 1e-18f;
    bf16_t* MRG; const unsigned char* GA; const unsigned char* GR;
    static __device__ __forceinline__ f32x4 q4(unsigned w) { return (f32x4){(float)(w & 0xffu), (float)((w >> 8) & 0xffu), (float)((w >> 16) & 0xffu), (float)(w >> 24)}; }
    static __device__ __forceinline__ f32x4 ratio4(unsigned wa, unsigned wr_) { const f32x4 a = q4(wa), r = q4(wr_);
        return (f32x4){a[0] * __builtin_amdgcn_rcpf(fmaxf(r[0], EPSQ)), a[1] * __builtin_amdgcn_rcpf(fmaxf(r[1], EPSQ)), a[2] * __builtin_amdgcn_rcpf(fmaxf(r[2], EPSQ)), a[3] * __builtin_amdgcn_rcpf(fmaxf(r[3], EPSQ))}; }
    static __device__ __forceinline__ f32x4 gate4(unsigned wr_) { const f32x4 r = q4(wr_); return (f32x4){fmaxf(r[0], EPSQ), fmaxf(r[1], EPSQ), fmaxf(r[2], EPSQ), fmaxf(r[3], EPSQ)} * (1.f / 255.f); }
    __device__ __forceinline__ void mid(f32x4 (&acc)[2][2][4][2], const Unit& u, int wr, int wc, int fr, int fq) const {
        const int row0 = u.pm * 256 + wr * 64 + fr, c0 = u.pn * 256 + wc * 32 + 8 * fq;
#pragma unroll
        for (int ai = 0; ai < 2; ++ai)
#pragma unroll
            for (int m = 0; m < 4; ++m) {
                const int r = row0 + ai * 128 + m * 16;
#pragma unroll
                for (int bj = 0; bj < 2; ++bj) {
                    const size_t off = (size_t)r * 1024 + c0 + 128 * bj; const u32x2 ga = *(const u32x2*)(GA + off), gr = *(const u32x2*)(GR + off);
                    acc[ai][bj][m][0] = acc[ai][bj][m][0] * ratio4(ga.x, gr.x); acc[ai][bj][m][1] = acc[ai][bj][m][1] * ratio4(ga.y, gr.y);
                }
                if (m == 1 || m == 3) __builtin_amdgcn_sched_barrier(0);
            }
    }
    __device__ __forceinline__ void operator()(const f32x4 (&acc)[2][2][4][2], const Unit& u, int wr, int wc, int fr, int fq) const {
        const int row0 = u.pm * 256 + wr * 64 + fr, c0 = u.pn * 256 + wc * 32 + 8 * fq;
#pragma unroll
        for (int ai = 0; ai < 2; ++ai)
#pragma unroll
            for (int m = 0; m < 4; ++m) {
                const int r = row0 + ai * 128 + m * 16;
#pragma unroll
                for (int bj = 0; bj < 2; ++bj) {
                    const size_t off = (size_t)r * 1024 + c0 + 128 * bj; const u32x2 gr = *(const u32x2*)(GR + off);
                    *(u32x4*)(MRG + off) = pack8(acc[ai][bj][m][0] * gate4(gr.x), acc[ai][bj][m][1] * gate4(gr.y));
                }
            }
    }
    __device__ __forceinline__ void mid_tail(f32x4 (&acc)[4], int r, int c0, int fq) const {
#pragma unroll
        for (int n = 0; n < 4; ++n) { const size_t off = (size_t)r * 1024 + c0 + 16 * n + 4 * fq; acc[n] = acc[n] * ratio4(*(const unsigned*)(GA + off), *(const unsigned*)(GR + off)); }
    }
    __device__ __forceinline__ void tail(const f32x4 (&acc)[4], int r, int c0, int fq) const {
#pragma unroll
        for (int n = 0; n < 4; ++n) { const size_t off = (size_t)r * 1024 + c0 + 16 * n + 4 * fq; const f32x4 a = acc[n] * gate4(*(const unsigned*)(GR + off));
            u32x2 w; w.x = cvt_pk_bf16(a[0], a[1]); w.y = cvt_pk_bf16(a[2], a[3]); *(u32x2*)(MRG + off) = w; }
    }
};
template <class Epi> __device__ __forceinline__ void gemm_tail(LAS unsigned char* L, const bf16_t* A, const bf16_t* Bt, int K, int row_base, int ntr, int ntc, int v, int G, const Epi& E, int tid, int lane, int wave) {
    constexpr int RS = 528, OPB = 64 * RS, BUF = 2 * OPB, XCH = 0;
    static_assert(2 * BUF <= LDSCTL_OFF, "tail buffers must stay below the LDS control words");
    const int fr = lane & 15, fq = lane >> 4, rw = wave & 3, kh = wave >> 2, nc = K / 256;
    const int lrow = tid >> 5, lch = tid & 31;
    for (int tt = v; tt < ntr * ntc; tt += G) {
        int tr = tt / ntc, tc = tt % ntc;
        if (ntr == 16 && ntc == 16 && G == 256) { const int x = tt >> 5, q = tt & 31; tr = (x >> 1) * 4 + (q >> 3); tc = (x & 1) * 8 + (q & 7); }
        const int r0 = row_base + 64 * tr, c0 = 64 * tc;
        const bf16_t* Ag = A + (size_t)(r0 + lrow) * K + 8 * lch; const bf16_t* Bg = Bt + (size_t)(c0 + lrow) * K + 8 * lch; const size_t h16 = (size_t)16 * K;
        u32x4 ra0[4], rb0[4], ra1[4], rb1[4], ra2[4], rb2[4];
#define TL_LOAD(ra, rb, c) do { _Pragma("unroll") for (int j_ = 0; j_ < 4; ++j_) { ra[j_] = *(const u32x4*)(Ag + j_ * h16 + 256 * (c)); rb[j_] = *(const u32x4*)(Bg + j_ * h16 + 256 * (c)); } } while (0)
#define TL_WRITE(ra, rb, b) do { LAS unsigned char* p_ = L + (b) * BUF + lrow * RS + lch * 16; _Pragma("unroll") for (int j_ = 0; j_ < 4; ++j_) { *(LAS u32x4*)(p_ + j_ * 16 * RS) = ra[j_]; *(LAS u32x4*)(p_ + OPB + j_ * 16 * RS) = rb[j_]; } } while (0)
#define TL_COMP(b) do { _Pragma("unroll") for (int i_ = 0; i_ < 4; ++i_) { const int ko_ = (32 * (4 * kh + i_) + 8 * fq) * 2; \
            const pg8::bf16x8 a_ = *(const LAS pg8::bf16x8*)(L + (b) * BUF + (16 * rw + fr) * RS + ko_); \
            _Pragma("unroll") for (int n = 0; n < 4; ++n) { const pg8::bf16x8 b_ = *(const LAS pg8::bf16x8*)(L + (b) * BUF + OPB + (16 * n + fr) * RS + ko_); acc[n] = __builtin_amdgcn_mfma_f32_16x16x32_bf16(b_, a_, acc[n], 0, 0, 0); } } } while (0)
#define TL_STEP(ra, rb, rna, rnb, b, cc) do { if ((cc) < nc) { if ((cc) + 1 < nc) TL_WRITE(rna, rnb, (b) ^ 1); if constexpr (Epi::MIDT > 0) { if ((cc) == Epi::MIDT / 4) E.mid_tail(acc, r0 + 16 * rw + fr, c0, fq); } TL_COMP(b); if ((cc) + 3 < nc) TL_LOAD(ra, rb, (cc) + 3); __syncthreads(); } } while (0)
        f32x4 acc[4];
#pragma unroll
        for (int n = 0; n < 4; ++n) acc[n] = (f32x4){0.f, 0.f, 0.f, 0.f};
        TL_LOAD(ra0, rb0, 0); if (1 < nc) TL_LOAD(ra1, rb1, 1); if (2 < nc) TL_LOAD(ra2, rb2, 2);
        TL_WRITE(ra0, rb0, 0); __syncthreads();
#pragma unroll 1
        for (int c = 0; c < nc; c += 6) { TL_STEP(ra0, rb0, ra1, rb1, 0, c); TL_STEP(ra1, rb1, ra2, rb2, 1, c + 1); TL_STEP(ra2, rb2, ra0, rb0, 0, c + 2); TL_STEP(ra0, rb0, ra1, rb1, 1, c + 3); TL_STEP(ra1, rb1, ra2, rb2, 0, c + 4); TL_STEP(ra2, rb2, ra0, rb0, 1, c + 5); }
#undef TL_STEP
#undef TL_LOAD
#undef TL_WRITE
#undef TL_COMP
        if (kh == 1) {
#pragma unroll
            for (int n = 0; n < 4; ++n) *(LAS f32x4*)(L + XCH + ((rw * 4 + n) * 64 + lane) * 16) = acc[n];
        }
        __syncthreads();
        if (kh == 0) {
#pragma unroll
            for (int n = 0; n < 4; ++n) acc[n] += *(const LAS f32x4*)(L + XCH + ((rw * 4 + n) * 64 + lane) * 16);
            E.tail(acc, r0 + 16 * rw + fr, c0, fq);
        }
        __syncthreads();
    }
}
__device__ __forceinline__ float wave_sum(float v) {
#pragma unroll
    for (int o = 1; o < 64; o <<= 1) v += __shfl_xor(v, o);
    return v;
}
struct WI { const float* W; const float* gain; bf16_t* WT; int ldw, K, dr, sc, k0; };
__device__ __forceinline__ void wi_set(WI& w, int kind, const float* W, const float* W2, int ldw, int K, bf16_t* WT, int nrg, const float* gain, int it) {
    const int kb = it / nrg, rg = it % nrg, p0 = rg * 32; int sc = p0; const float* Ws = W;
    if (kind == 1) { if ((p0 & 255) >> 7) Ws = W2; sc = 128 * (p0 >> 8) + (p0 & 127); }
    else if (kind == 2) { const int tile = p0 >> 8; if (tile < 3) sc = 256 * tile + 64 * ((p0 & 127) >> 5) + 32 * ((p0 & 255) >> 7); }
    w.W = Ws; w.gain = gain; w.WT = WT; w.ldw = ldw; w.K = K; w.dr = p0; w.sc = sc; w.k0 = 64 * kb;
}
__device__ __forceinline__ void wi_load(const WI& w, f32x4 (&r)[8], int lane) {
    const int lr = lane >> 3, lc4 = (lane & 7) * 4;
#pragma unroll
    for (int i = 0; i < 8; ++i) r[i] = __builtin_nontemporal_load((const GAS f32x4*)(w.W + (size_t)(w.k0 + 8 * i + lr) * w.ldw + w.sc + lc4));
}
__device__ __forceinline__ void wi_proc(const WI& w, const f32x4 (&r)[8], LAS float* scr, int lane) {
    const int lr = lane >> 3, lc4 = (lane & 7) * 4;
#pragma unroll
    for (int i = 0; i < 8; ++i) { const int kk = 8 * i + lr; const float gsc = w.gain ? w.gain[w.k0 + kk] : 1.f;
        scr[kk * 33 + lc4 + 0] = r[i][0] * gsc; scr[kk * 33 + lc4 + 1] = r[i][1] * gsc; scr[kk * 33 + lc4 + 2] = r[i][2] * gsc; scr[kk * 33 + lc4 + 3] = r[i][3] * gsc; }
    LDS_WAIT(); asm volatile("" ::: "memory");
    const int c = lane & 7;
#pragma unroll
    for (int j = 0; j < 4; ++j) { const int n = (lane >> 3) + 8 * j; const LAS float* s = scr + (8 * c) * 33 + n;
        v4u o; o.x = pk2(s[0 * 33], s[1 * 33]); o.y = pk2(s[2 * 33], s[3 * 33]); o.z = pk2(s[4 * 33], s[5 * 33]); o.w = pk2(s[6 * 33], s[7 * 33]);
        *(GAS v4u*)(w.WT + (size_t)(w.dr + n) * w.K + w.k0 + 8 * c) = o; }
    LDS_WAIT(); asm volatile("" ::: "memory");
}
}


namespace at {
using pg8::bf16_t; using pg8::bf16x8; using pg8::u32x4; using pg8::cvt_pk_bf16;
typedef float f32x16 __attribute__((ext_vector_type(16)));
typedef short v4i16_t __attribute__((ext_vector_type(4)));
typedef unsigned u32x2 __attribute__((ext_vector_type(2)));
constexpr int KS_OFF = 0, VS_OFF = 46080, LUT_OFF = 87040, KROW = 144;
__device__ const unsigned char T5LUT[129] = {0, 1, 2, 3, 4, 5, 6, 7, 8, 9, 10, 11, 12, 13, 14, 15, 16, 16, 16, 17, 17, 18, 18, 18, 19, 19, 19, 20, 20, 20, 20, 21, 21, 21, 21, 22, 22, 22, 22, 22, 23, 23, 23, 23, 23, 23, 24, 24, 24, 24, 24, 24, 25, 25, 25, 25, 25, 25, 25, 26, 26, 26, 26, 26, 26, 26, 26, 27, 27, 27, 27, 27, 27, 27, 27, 27, 27, 28, 28, 28, 28, 28, 28, 28, 28, 28, 28, 29, 29, 29, 29, 29, 29, 29, 29, 29, 29, 29, 29, 30, 30, 30, 30, 30, 30, 30, 30, 30, 30, 30, 30, 30, 30, 31, 31, 31, 31, 31, 31, 31, 31, 31, 31, 31, 31, 31, 31, 31, 31};
__device__ __forceinline__ v4i16_t trr(LAS const unsigned char* p) { return __builtin_amdgcn_ds_read_tr16_b64_v4i16((LAS v4i16_t*)p); }
__device__ __forceinline__ void attn_wave(const bf16x8 (&qf)[4], LAS const unsigned char* Kt, LAS const unsigned char* Vt, int vdh, LAS const float* lut, float sink, int iq, int jmin, int kb0, int lane, f32x16 (&o)[2]) {
    const int ql = lane & 31, h = lane >> 5;
    f32x16 acc[5];
#pragma unroll
    for (int kb = 0; kb < 5; ++kb) {
        acc[kb] = (f32x16){};
        LAS const unsigned char* kp = Kt + (32 * (kb0 + kb) + ql) * KROW + 16 * h;
#pragma unroll
        for (int ds = 0; ds < 4; ++ds) { const bf16x8 a = *(LAS const bf16x8*)(kp + 32 * ds); acc[kb] = __builtin_amdgcn_mfma_f32_32x32x16_bf16(a, qf[ds], acc[kb], 0, 0, 0); }
    }
    const int base = iq + 128 - 4 * h - 32 * kb0, dmax0 = iq + 128 - jmin; const unsigned dmax = (unsigned)(dmax0 < 128 ? dmax0 : 128);
    const float sink2 = sink * 1.4426950408889634f; float mx = sink2;
#pragma unroll
    for (int kb = 0; kb < 5; ++kb)
#pragma unroll
        for (int r = 0; r < 16; ++r) {
            const int dist = base - (32 * kb + (r & 3) + 8 * (r >> 2));
            const float s = ((unsigned)dist <= dmax) ? __builtin_fmaf(acc[kb][r], 0.125f * 1.4426950408889634f, lut[dist]) : -INFINITY;
            acc[kb][r] = s; mx = fmaxf(mx, s);
        }
    mx = fmaxf(mx, __shfl_xor(mx, 32));
    float l = 0.f;
#pragma unroll
    for (int kb = 0; kb < 5; ++kb)
#pragma unroll
        for (int r = 0; r < 16; ++r) { const float p = __builtin_amdgcn_exp2f(acc[kb][r] - mx); acc[kb][r] = p; l += p; }
    l += __shfl_xor(l, 32);
    l += __builtin_amdgcn_exp2f(sink2 - mx);
    const float inv = 1.f / l;
    o[0] = (f32x16){}; o[1] = (f32x16){};
    const int g16 = (lane >> 4) & 1, q4 = (lane & 15) >> 2, p4 = lane & 3;
#pragma unroll
    for (int kb = 0; kb < 5; ++kb)
#pragma unroll
        for (int s2 = 0; s2 < 2; ++s2) {
            u32x4 pw; pw.x = cvt_pk_bf16(acc[kb][8 * s2 + 0], acc[kb][8 * s2 + 1]); pw.y = cvt_pk_bf16(acc[kb][8 * s2 + 2], acc[kb][8 * s2 + 3]);
            pw.z = cvt_pk_bf16(acc[kb][8 * s2 + 4], acc[kb][8 * s2 + 5]); pw.w = cvt_pk_bf16(acc[kb][8 * s2 + 6], acc[kb][8 * s2 + 7]);
            const bf16x8 pf = __builtin_bit_cast(bf16x8, pw);
            const int key = 32 * (kb0 + kb) + 16 * s2 + 4 * h + q4;
#pragma unroll
            for (int db = 0; db < 2; ++db) {
                LAS const unsigned char* vp = Vt + db * vdh + key * 64 + (16 * g16 + 4 * p4) * 2;
                const v4i16_t lo = trr(vp), hi = trr(vp + 8 * 64);
                const bf16x8 a = (bf16x8){lo[0], lo[1], lo[2], lo[3], hi[0], hi[1], hi[2], hi[3]};
                o[db] = __builtin_amdgcn_mfma_f32_32x32x16_bf16(a, pf, o[db], 0, 0, 0);
            }
        }
#pragma unroll
    for (int db = 0; db < 2; ++db)
#pragma unroll
        for (int r = 0; r < 16; ++r) o[db][r] *= inv;
}
__device__ __forceinline__ void attn_store(bf16_t* dst, const f32x16 (&o)[2], int h) {
#pragma unroll
    for (int db = 0; db < 2; ++db)
#pragma unroll
        for (int rg = 0; rg < 4; ++rg) { u32x2 w; w.x = cvt_pk_bf16(o[db][4 * rg + 0], o[db][4 * rg + 1]); w.y = cvt_pk_bf16(o[db][4 * rg + 2], o[db][4 * rg + 3]);
            *(u32x2*)(dst + 32 * db + 8 * rg + 4 * h) = w; }
}
__device__ __forceinline__ void attn_prompt_task(LAS unsigned char* L, const bf16_t* Q, bf16_t* AOR, const bf16_t* KV, const float* table, const float* sinks, int b, int n, int kvh, int tid, int lane, int wave) {
    const int m0 = b * 4096 + 128 * n;
    for (int c = tid; c < 2048; c += 512) {
        const int j = c >> 3, ch = c & 7; u32x4 kx = (u32x4){0u, 0u, 0u, 0u}, vx = kx;
        if (n > 0 || j >= 128) { const bf16_t* src = KV + (size_t)(m0 - 128 + j) * 256 + kvh * 64 + 8 * ch; kx = *(const u32x4*)src; vx = *(const u32x4*)(src + 128); }
        *(LAS u32x4*)(L + KS_OFF + j * KROW + 16 * ch) = kx;
        *(LAS u32x4*)(L + VS_OFF + (ch >> 2) * 16384 + j * 64 + (ch & 3) * 16) = vx;
    }
    for (int e = tid; e < 4 * 129; e += 512) { const int hl = e / 129, d = e % 129; ((LAS float*)(L + LUT_OFF))[hl * 132 + d] = table[T5LUT[d] * 8 + 4 * kvh + hl] * 1.4426950408889634f; }
    __syncthreads();
    const int ql = lane & 31, h = lane >> 5, hl = wave & 3, head = 4 * kvh + hl;
    const float sink = sinks[head];
#pragma unroll 1
    for (int rep = 0; rep < 2; ++rep) {
        const int qb = (wave >> 2) + 2 * rep, iq = 32 * qb + ql;
        const bf16_t* qp = Q + (size_t)(m0 + iq) * 512 + head * 64;
        bf16x8 qf[4];
#pragma unroll
        for (int ds = 0; ds < 4; ++ds) qf[ds] = *(const bf16x8*)(qp + 16 * ds + 8 * h);
        f32x16 o[2];
        attn_wave(qf, L + KS_OFF, L + VS_OFF, 16384, (LAS const float*)(L + LUT_OFF) + hl * 132, sink, iq, n == 0 ? 128 : 0, qb, lane, o);
        attn_store(AOR + (size_t)(m0 + iq) * 1024 + head * 64, o, h);
    }
    __syncthreads();
}
__device__ __forceinline__ void attn_sample_task(LAS unsigned char* L, const bf16_t* Q, bf16_t* AOR, const bf16_t* KV, const float* wk, const float* wv, const float* table, const float* sinks, int bd, int kvh, int tid, int lane, int wave) {
    for (int c = tid; c < 1280; c += 512) {
        const int j = c >> 3, ch = c & 7; u32x4 kx = (u32x4){0u, 0u, 0u, 0u}, vx = kx;
        if (j < 128) {
            const size_t so = ((size_t)(bd * 128 + j) * 2 + kvh) * 64 + 8 * ch;
            const f32x4 k0 = *(const f32x4*)(wk + so), k1 = *(const f32x4*)(wk + so + 4), v0 = *(const f32x4*)(wv + so), v1 = *(const f32x4*)(wv + so + 4);
            kx = mk::pack8(k0, k1); vx = mk::pack8(v0, v1);
        } else if (j < 136) { const bf16_t* src = KV + (size_t)(MP + bd * 8 + (j - 128)) * 256 + kvh * 64 + 8 * ch; kx = *(const u32x4*)src; vx = *(const u32x4*)(src + 128); }
        *(LAS u32x4*)(L + KS_OFF + j * KROW + 16 * ch) = kx;
        *(LAS u32x4*)(L + VS_OFF + (ch >> 2) * 10240 + j * 64 + (ch & 3) * 16) = vx;
    }
    for (int e = tid; e < 4 * 129; e += 512) { const int hl = e / 129, d = e % 129; ((LAS float*)(L + LUT_OFF))[hl * 132 + d] = table[T5LUT[d] * 8 + 4 * kvh + hl] * 1.4426950408889634f; }
    __syncthreads();
    if (wave == 0) {
        const int ql = lane & 31, h = lane >> 5, hl = ql >> 3, iq = ql & 7, head = 4 * kvh + hl;
        const bf16_t* qp = Q + (size_t)(MP + bd * 8 + iq) * 512 + head * 64;
        bf16x8 qf[4];
#pragma unroll
        for (int ds = 0; ds < 4; ++ds) qf[ds] = *(const bf16x8*)(qp + 16 * ds + 8 * h);
        f32x16 o[2];
        attn_wave(qf, L + KS_OFF, L + VS_OFF, 10240, (LAS const float*)(L + LUT_OFF) + hl * 132, sinks[head], iq, 0, 0, lane, o);
        attn_store(AOR + (size_t)(MP + bd * 8 + iq) * 1024 + head * 64, o, h);
    }
    __syncthreads();
}
}

namespace hg {
using pg8::bf16_t; using pg8::bf16x8; using pg8::f32x4; using pg8::u32x4; using pg8::cvt_pk_bf16;
typedef short v4i16_t __attribute__((ext_vector_type(4)));
typedef unsigned u32x2 __attribute__((ext_vector_type(2)));
__device__ __forceinline__ v4i16_t trr(LAS const unsigned char* p) { return __builtin_amdgcn_ds_read_tr16_b64_v4i16((LAS v4i16_t*)p); }
constexpr int TS = 288;
constexpr float FQ = 1.f / 65535.f;
struct HaPre { unsigned short lf[16]; u32x4 vch[2]; };
__device__ __forceinline__ void ha_issue(HaPre& P, const unsigned short* LOGF, const bf16_t* IR, int task, int tid) {
    const int bh = task >> 6, c = task & 63, h = bh & 3; const size_t m0 = (size_t)(bh >> 2) * 4096 + 64 * c; const int kd = tid & 127, seg = tid >> 7;
#pragma unroll
    for (int i = 0; i < 16; ++i) P.lf[i] = LOGF[(m0 + 16 * seg + i) * 512 + h * 128 + kd];
#pragma unroll
    for (int q = 0; q < 2; ++q) { const int cid = tid + 512 * q, t = cid >> 4, ch = cid & 15; P.vch[q] = *(const u32x4*)(IR + (m0 + t) * 512 + h * 128 + 8 * ch); }
}
__device__ __forceinline__ void ha_phase(LAS unsigned char* L, HaPre& P, const unsigned short* LOGF, const bf16_t* IR, bf16_t* US, float* DEC, int v, int G, int tid, int lane, int wave) {
    constexpr int KT = 0, VT = 64 * TS, SEG = 2 * 64 * TS, DCS = SEG + 2048;
#pragma unroll 1
    for (int grp = v; grp < 256; grp += G) {
        const int kd = tid & 127, seg = tid >> 7, g = lane >> 4, q4 = (lane & 15) >> 2, p4 = lane & 3;
        f32x4 acc[8];
#pragma unroll
        for (int i = 0; i < 8; ++i) acc[i] = (f32x4){0.f, 0.f, 0.f, 0.f};
        float dg = 1.f;
#pragma unroll 1
        for (int cc = 0; cc < 4; ++cc) {
            float lf[16]; float run = 1.f;
#pragma unroll
            for (int i = 0; i < 16; ++i) { lf[i] = (float)P.lf[i] * FQ; run *= lf[i]; }
            ((LAS float*)(L + SEG))[seg * 128 + kd] = run;
#pragma unroll
            for (int q = 0; q < 2; ++q) { const int cid = tid + 512 * q, t = cid >> 4, ch = cid & 15; *(LAS u32x4*)(L + VT + t * TS + ch * 16) = P.vch[q]; }
            const int nxt = cc < 3 ? 4 * grp + cc + 1 : 4 * (grp + G);
            if (nxt < 1024) ha_issue(P, LOGF, IR, nxt, tid);
            __syncthreads();
            {
                const LAS float* sg = (const LAS float*)(L + SEG);
                const float s0 = sg[kd], s1 = sg[128 + kd], s2 = sg[256 + kd], s3 = sg[384 + kd];
                float suf = seg == 3 ? 1.f : (seg == 2 ? s3 : (seg == 1 ? s2 * s3 : s1 * (s2 * s3)));
#pragma unroll
                for (int i = 15; i >= 0; --i) { const float kt = (1.f - lf[i]) * suf; suf *= lf[i]; *(LAS bf16_t*)(L + KT + (16 * seg + i) * TS + kd * 2) = (bf16_t)cvt_pk_bf16(kt, 0.f); }
                const float dcv = (s0 * s1) * (s2 * s3); dg *= dcv;
                if (seg == 0) ((LAS float*)(L + DCS))[kd] = dcv;
            }
            __syncthreads();
            {
                bf16x8 bv[2];
#pragma unroll
                for (int ks = 0; ks < 2; ++ks) { LAS const unsigned char* vp = L + VT + (32 * ks + 4 * g + q4) * TS + (16 * wave + 4 * p4) * 2; const v4i16_t lo = trr(vp), hi = trr(vp + 16 * TS);
                    bv[ks] = (bf16x8){lo[0], lo[1], lo[2], lo[3], hi[0], hi[1], hi[2], hi[3]}; }
#pragma unroll
                for (int i = 0; i < 8; ++i) {
                    const f32x4 dc = *(const LAS f32x4*)(L + DCS + (16 * i + 4 * g) * 4);
                    acc[i] = acc[i] * dc;
#pragma unroll
                    for (int ks = 0; ks < 2; ++ks) { LAS const unsigned char* kp = L + KT + (32 * ks + 4 * g + q4) * TS + (16 * i + 4 * p4) * 2; const v4i16_t lo = trr(kp), hi = trr(kp + 16 * TS);
                        const bf16x8 a = (bf16x8){lo[0], lo[1], lo[2], lo[3], hi[0], hi[1], hi[2], hi[3]};
                        acc[i] = __builtin_amdgcn_mfma_f32_16x16x32_bf16(a, bv[ks], acc[i], 0, 0, 0); }
                }
            }
            __syncthreads();
        }
        const size_t ub = ((size_t)grp * 128 + 16 * wave + (lane & 15)) * 128 + 4 * g;
#pragma unroll
        for (int i = 0; i < 8; ++i) { u32x2 w; w.x = cvt_pk_bf16(acc[i][0], acc[i][1]); w.y = cvt_pk_bf16(acc[i][2], acc[i][3]); *(u32x2*)(US + ub + 16 * i) = w; }
        if (seg == 0) DEC[(size_t)grp * 128 + kd] = dg;
    }
}
__device__ __forceinline__ void hb_scan(unsigned* US32, const float* DEC, float* out_pst, int idx) {
    const int bh = idx >> 13, pair = idx & 8191, vd = pair >> 6, kd0 = (pair & 63) * 2;
    float s0 = 0.f, s1 = 0.f;
    unsigned* up = US32 + (size_t)bh * 16 * 8192 + pair; const float* dp = DEC + (size_t)bh * 16 * 128 + kd0;
#pragma unroll 1
    for (int c0 = 0; c0 < 16; c0 += 8) {
        unsigned w[8]; float d0[8], d1[8];
#pragma unroll
        for (int i = 0; i < 8; ++i) { w[i] = up[(size_t)(c0 + i) * 8192]; const float2 dd = *(const float2*)(dp + (c0 + i) * 128); d0[i] = dd.x; d1[i] = dd.y; }
#pragma unroll
        for (int i = 0; i < 8; ++i) { up[(size_t)(c0 + i) * 8192] = cvt_pk_bf16(s0, s1); s0 = d0[i] * s0 + mk::bflo(w[i]); s1 = d1[i] * s1 + mk::bfhi(w[i]); }
    }
    out_pst[((size_t)bh * 128 + kd0) * 128 + vd] = s0; out_pst[((size_t)bh * 128 + kd0 + 1) * 128 + vd] = s1;
}
struct HcPre { u32x2 lfc[4]; u32x4 qc[2], vch[2]; u32x2 st[8]; };
__device__ __forceinline__ void hc_issue_prompt(HcPre& P, const unsigned short* LOGF, const bf16_t* QR, const bf16_t* IR, const bf16_t* US, int task, bool st, int tid, int lane, int wave) {
    const int bh = task >> 6, c = task & 63, h = bh & 3; const size_t m0 = (size_t)(bh >> 2) * 4096 + 64 * c;
#pragma unroll
    for (int q = 0; q < 4; ++q) { const int cid = tid + 512 * q, t = cid >> 5, c4 = cid & 31; P.lfc[q] = *(const u32x2*)(LOGF + (m0 + t) * 512 + h * 128 + 4 * c4); }
#pragma unroll
    for (int q = 0; q < 2; ++q) { const int cid = tid + 512 * q, t = cid >> 4, ch = cid & 15; const size_t off = (m0 + t) * 512 + h * 128 + 8 * ch; P.qc[q] = *(const u32x4*)(QR + off); P.vch[q] = *(const u32x4*)(IR + off); }
    if (st) {
        const bf16_t* USt = US + (size_t)(task >> 2) * 16384; const int g = lane >> 4, vd = 16 * wave + (lane & 15);
#pragma unroll
        for (int i = 0; i < 8; ++i) P.st[i] = *(const u32x2*)(USt + (size_t)vd * 128 + 16 * i + 4 * g);
    }
}
__device__ __forceinline__ void hc_phase_prompt(LAS unsigned char* L, const unsigned short* LOGF, const bf16_t* QR, bf16_t* AOR, const bf16_t* IR, const bf16_t* GR, const float* hgn, const bf16_t* US, int v, int G, int tid, int lane, int wave) {
    constexpr int QH = 0, KH = 17408, KT = 34816, VT = 53248, AT = 71680, DECS = 73728, OT = 75776, QT = 109568, QS = 272, OS = 132, LFT = OT, LS = 528;
    const int g = lane >> 4, lc = lane & 15, q4 = lc >> 2, p4 = lane & 3, vd = 16 * wave + lc;
    const int et = tid >> 3, ec = (tid & 7) * 16;
    const f32x4 n0 = *(const f32x4*)(hgn + ec), n1 = *(const f32x4*)(hgn + ec + 4), n2 = *(const f32x4*)(hgn + ec + 8), n3 = *(const f32x4*)(hgn + ec + 12);
    HcPre P;
    if (v < 256) hc_issue_prompt(P, LOGF, QR, IR, US, 4 * v, true, tid, lane, wave);
    f32x4 sacc[8];
#pragma unroll
    for (int i = 0; i < 8; ++i) sacc[i] = (f32x4){0.f, 0.f, 0.f, 0.f};
#pragma unroll 1
    for (int grp = v; grp < 256; grp += G)
#pragma unroll 1
    for (int cc = 0; cc < 4; ++cc) {
        const int task = 4 * grp + cc;
        const int bh = task >> 6, c = task & 63, h = bh & 3; const size_t m0 = (size_t)(bh >> 2) * 4096 + 64 * c;
        if (cc == 0) {
#pragma unroll
            for (int i = 0; i < 8; ++i) sacc[i] = (f32x4){mk::bflo(P.st[i].x), mk::bfhi(P.st[i].x), mk::bflo(P.st[i].y), mk::bfhi(P.st[i].y)};
        }
#pragma unroll
        for (int q = 0; q < 4; ++q) { const int cid = tid + 512 * q, t = cid >> 5, c4 = cid & 31; const u32x2 w = P.lfc[q];
            *(LAS f32x4*)(L + LFT + t * LS + c4 * 16) = (f32x4){(float)(w.x & 0xffffu), (float)(w.x >> 16), (float)(w.y & 0xffffu), (float)(w.y >> 16)} * FQ; }
#pragma unroll
        for (int q = 0; q < 2; ++q) { const int cid = tid + 512 * q, t = cid >> 4, ch = cid & 15; *(LAS u32x4*)(L + QT + t * QS + ch * 16) = P.qc[q]; *(LAS u32x4*)(L + VT + t * TS + ch * 16) = P.vch[q]; }
        const size_t eoff = (m0 + et) * 512 + h * 128 + ec;
        const u32x4 g0 = *(const u32x4*)(GR + eoff), g1 = *(const u32x4*)(GR + eoff + 8);
        { const int nxt = cc < 3 ? task + 1 : 4 * (grp + G); if (nxt < 1024) hc_issue_prompt(P, LOGF, QR, IR, US, nxt, cc == 3, tid, lane, wave); }
        __syncthreads();
        {
            const int kd = tid & 127, sub = tid >> 7; float lf[16], pp[16]; float p = 1.f;
#pragma unroll
            for (int t = 0; t < 16; ++t) { lf[t] = *(const LAS float*)(L + LFT + (16 * sub + t) * LS + kd * 4); p *= lf[t]; pp[t] = p; }
            float suf = 1.f;
#pragma unroll
            for (int t = 15; t >= 0; --t) {
                const float kk = 1.f - lf[t]; const int ro = 16 * sub + t; const float qv = mk::bf2f(*(const LAS bf16_t*)(L + QT + ro * QS + kd * 2));
                *(LAS bf16_t*)(L + QH + ro * QS + kd * 2) = (bf16_t)cvt_pk_bf16(qv * pp[t], 0.f);
                *(LAS bf16_t*)(L + KH + ro * QS + kd * 2) = (bf16_t)cvt_pk_bf16(kk * __builtin_amdgcn_rcpf(fmaxf(pp[t], 1e-30f)), 0.f);
                *(LAS bf16_t*)(L + KT + ro * TS + kd * 2) = (bf16_t)cvt_pk_bf16(kk * suf, 0.f);
                suf *= lf[t];
            }
            *(LAS float*)(L + DECS + (sub * 128 + kd) * 4) = p;
        }
        __syncthreads();
        if (wave < 4) {
            f32x4 acc = (f32x4){0.f, 0.f, 0.f, 0.f};
#pragma unroll
            for (int ks = 0; ks < 4; ++ks) { const bf16x8 a = *(const LAS bf16x8*)(L + QH + (16 * wave + lc) * QS + (32 * ks + 8 * g) * 2), b = *(const LAS bf16x8*)(L + KH + (16 * wave + lc) * QS + (32 * ks + 8 * g) * 2);
                acc = __builtin_amdgcn_mfma_f32_16x16x32_bf16(a, b, acc, 0, 0, 0); }
#pragma unroll
            for (int e = 0; e < 4; ++e) { const int t = 4 * g + e; *(LAS bf16_t*)(L + AT + wave * 512 + t * 32 + lc * 2) = (bf16_t)cvt_pk_bf16(lc <= t ? acc[e] : 0.f, 0.f); }
        }
        __syncthreads();
#pragma unroll 1
        for (int sb = 0; sb < 4; ++sb) {
            f32x4 oacc = (f32x4){0.f, 0.f, 0.f, 0.f};
#pragma unroll
            for (int ks = 0; ks < 4; ++ks) {
                u32x4 bw; bw.x = cvt_pk_bf16(sacc[2 * ks][0], sacc[2 * ks][1]); bw.y = cvt_pk_bf16(sacc[2 * ks][2], sacc[2 * ks][3]); bw.z = cvt_pk_bf16(sacc[2 * ks + 1][0], sacc[2 * ks + 1][1]); bw.w = cvt_pk_bf16(sacc[2 * ks + 1][2], sacc[2 * ks + 1][3]);
                const u32x2 a0 = *(const LAS u32x2*)(L + QH + (16 * sb + lc) * QS + (32 * ks + 4 * g) * 2), a1 = *(const LAS u32x2*)(L + QH + (16 * sb + lc) * QS + (32 * ks + 16 + 4 * g) * 2);
                u32x4 aw; aw.x = a0.x; aw.y = a0.y; aw.z = a1.x; aw.w = a1.y;
                oacc = __builtin_amdgcn_mfma_f32_16x16x32_bf16(__builtin_bit_cast(bf16x8, aw), __builtin_bit_cast(bf16x8, bw), oacc, 0, 0, 0);
            }
            bf16x8 bv;
            { const v4i16_t lo = trr(L + VT + (16 * sb + 4 * g + q4) * TS + (16 * wave + 4 * p4) * 2); bv = (bf16x8){lo[0], lo[1], lo[2], lo[3], 0, 0, 0, 0}; }
            { const u32x2 a0 = *(const LAS u32x2*)(L + AT + sb * 512 + lc * 32 + 8 * g); u32x4 aw; aw.x = a0.x; aw.y = a0.y; aw.z = 0u; aw.w = 0u;
              oacc = __builtin_amdgcn_mfma_f32_16x16x32_bf16(__builtin_bit_cast(bf16x8, aw), bv, oacc, 0, 0, 0); }
#pragma unroll
            for (int e = 0; e < 4; ++e) *(LAS float*)(L + OT + ((16 * sb + 4 * g + e) * OS + vd) * 4) = oacc[e];
            if (sb < 3 || cc < 3) {
#pragma unroll
                for (int i = 0; i < 8; ++i) {
                    const f32x4 dc = *(const LAS f32x4*)(L + DECS + (sb * 128 + 16 * i + 4 * g) * 4);
                    const v4i16_t lo = trr(L + KT + (16 * sb + 4 * g + q4) * TS + (16 * i + 4 * p4) * 2);
                    const bf16x8 a = (bf16x8){lo[0], lo[1], lo[2], lo[3], 0, 0, 0, 0};
                    sacc[i] = __builtin_amdgcn_mfma_f32_16x16x32_bf16(a, bv, sacc[i] * dc, 0, 0, 0);
                }
            }
        }
        __syncthreads();
        {
            f32x4 x[4]; float ss = 0.f;
#pragma unroll
            for (int k = 0; k < 4; ++k) { x[k] = *(const LAS f32x4*)(L + OT + (et * OS + ec + 4 * k) * 4); ss += mk::dot4(x[k]); }
            ss += __shfl_xor(ss, 1); ss += __shfl_xor(ss, 2); ss += __shfl_xor(ss, 4);
            const float rs = rsqrtf(ss * (1.f / 128.f) + EPS);
            const f32x4 y0 = x[0] * rs * n0 * (f32x4){mk::bflo(g0.x), mk::bfhi(g0.x), mk::bflo(g0.y), mk::bfhi(g0.y)}, y1 = x[1] * rs * n1 * (f32x4){mk::bflo(g0.z), mk::bfhi(g0.z), mk::bflo(g0.w), mk::bfhi(g0.w)};
            const f32x4 y2 = x[2] * rs * n2 * (f32x4){mk::bflo(g1.x), mk::bfhi(g1.x), mk::bflo(g1.y), mk::bfhi(g1.y)}, y3 = x[3] * rs * n3 * (f32x4){mk::bflo(g1.z), mk::bfhi(g1.z), mk::bflo(g1.w), mk::bfhi(g1.w)};
            { bf16_t* op = AOR + (m0 + et) * 1024 + 512 + h * 128 + ec; *(u32x4*)op = mk::pack8(y0, y1); *(u32x4*)(op + 8) = mk::pack8(y2, y3); }
        }
        __syncthreads();
    }
}

struct HcPreS { f32x4 sreg[8]; unsigned short lf[8]; unsigned short qv[8]; u32x4 vch; };
__device__ __forceinline__ void hc_issue_sample(HcPreS& P, const unsigned short* LOGF, const bf16_t* QR, const bf16_t* IR, const float* S0, int id, int tid) {
    const int bd = id >> 2, h = id & 3; const size_t m0 = (size_t)MP + bd * 8; const float* s0 = S0 + (size_t)id * 16384;
#pragma unroll
    for (int q = 0; q < 8; ++q) { const int cid = tid + 512 * q; P.sreg[q] = __builtin_nontemporal_load((const f32x4*)(s0 + (size_t)cid * 4)); }
    if (tid < 128) {
#pragma unroll
        for (int t = 0; t < 8; ++t) { const size_t off = (m0 + t) * 512 + h * 128 + tid; P.lf[t] = LOGF[off]; P.qv[t] = QR[off]; }
        P.vch = *(const u32x4*)(IR + (m0 + (tid >> 4)) * 512 + h * 128 + 8 * (tid & 15));
    }
}
__device__ __forceinline__ void hc_phase_sample(LAS unsigned char* L, const unsigned short* LOGF, const bf16_t* QR, bf16_t* AOR, const bf16_t* IR, const bf16_t* GR, const float* hgn, const float* S0, float* Sout, HcPreS& P, int v, int G, int tid, int lane, int wave) {
    constexpr int QH = 0, KH = 4352, KT = 8704, VT = 13312, AT = 17920, DECS = 18432, OT = 18944, ST = 27392, QS = 272, OS = 132, SS = 528;
    const int g = lane >> 4, lc = lane & 15, q4 = lc >> 2, p4 = lane & 3, vd = 16 * wave + lc;
    const int et = tid >> 3, ec = (tid & 7) * 16;
#pragma unroll 1
    for (int id = v; id < 512; id += G) {
        const int bd = id >> 2, h = id & 3; const size_t m0 = (size_t)MP + bd * 8;
#pragma unroll
        for (int q = 0; q < 8; ++q) { const int cid = tid + 512 * q, row = cid >> 5, c4 = cid & 31; *(LAS f32x4*)(L + ST + row * SS + c4 * 16) = P.sreg[q]; }
        if (tid < 128) {
            const int kd = tid; float pp[8], lfs[8]; float p = 1.f;
#pragma unroll
            for (int t = 0; t < 8; ++t) { lfs[t] = (float)P.lf[t] * FQ; p *= lfs[t]; pp[t] = p; }
            float suf = 1.f;
#pragma unroll
            for (int t = 7; t >= 0; --t) {
                const float kk = 1.f - lfs[t];
                *(LAS bf16_t*)(L + QH + t * QS + kd * 2) = (bf16_t)cvt_pk_bf16(mk::bf2f(P.qv[t]) * pp[t], 0.f);
                *(LAS bf16_t*)(L + KH + t * QS + kd * 2) = (bf16_t)cvt_pk_bf16(kk * __builtin_amdgcn_rcpf(fmaxf(pp[t], 1e-30f)), 0.f);
                *(LAS bf16_t*)(L + KT + t * TS + kd * 2) = (bf16_t)cvt_pk_bf16(kk * suf, 0.f);
                suf *= lfs[t];
            }
#pragma unroll
            for (int t = 8; t < 16; ++t) { *(LAS bf16_t*)(L + QH + t * QS + kd * 2) = 0; *(LAS bf16_t*)(L + KH + t * QS + kd * 2) = 0; *(LAS bf16_t*)(L + KT + t * TS + kd * 2) = 0; }
            *(LAS float*)(L + DECS + kd * 4) = p;
            *(LAS u32x4*)(L + VT + (tid >> 4) * TS + (tid & 15) * 16) = P.vch;
        } else if (tid < 256) { const int c = tid - 128; *(LAS u32x4*)(L + VT + (8 + (c >> 4)) * TS + (c & 15) * 16) = (u32x4){0u, 0u, 0u, 0u}; }
        const size_t eoff = (m0 + et) * 512 + h * 128 + ec; u32x4 g0 = (u32x4){0u, 0u, 0u, 0u}, g1 = g0;
        if (tid < 64) { g0 = *(const u32x4*)(GR + eoff); g1 = *(const u32x4*)(GR + eoff + 8); }
        if (id + G < 512) hc_issue_sample(P, LOGF, QR, IR, S0, id + G, tid);
        __syncthreads();
        f32x4 sacc[8];
#pragma unroll
        for (int i = 0; i < 8; ++i)
#pragma unroll
            for (int e = 0; e < 4; ++e) sacc[i][e] = *(const LAS float*)(L + ST + (16 * i + 4 * g + e) * SS + vd * 4);
        if (wave == 0) {
            f32x4 acc = (f32x4){0.f, 0.f, 0.f, 0.f};
#pragma unroll
            for (int ks = 0; ks < 4; ++ks) { const bf16x8 a = *(const LAS bf16x8*)(L + QH + lc * QS + (32 * ks + 8 * g) * 2), b = *(const LAS bf16x8*)(L + KH + lc * QS + (32 * ks + 8 * g) * 2);
                acc = __builtin_amdgcn_mfma_f32_16x16x32_bf16(a, b, acc, 0, 0, 0); }
#pragma unroll
            for (int e = 0; e < 4; ++e) { const int t = 4 * g + e; *(LAS bf16_t*)(L + AT + t * 32 + lc * 2) = (bf16_t)cvt_pk_bf16(lc <= t ? acc[e] : 0.f, 0.f); }
        }
        __syncthreads();
        {
            f32x4 oacc = (f32x4){0.f, 0.f, 0.f, 0.f};
#pragma unroll
            for (int ks = 0; ks < 4; ++ks) {
                u32x4 bw; bw.x = cvt_pk_bf16(sacc[2 * ks][0], sacc[2 * ks][1]); bw.y = cvt_pk_bf16(sacc[2 * ks][2], sacc[2 * ks][3]); bw.z = cvt_pk_bf16(sacc[2 * ks + 1][0], sacc[2 * ks + 1][1]); bw.w = cvt_pk_bf16(sacc[2 * ks + 1][2], sacc[2 * ks + 1][3]);
                const u32x2 a0 = *(const LAS u32x2*)(L + QH + lc * QS + (32 * ks + 4 * g) * 2), a1 = *(const LAS u32x2*)(L + QH + lc * QS + (32 * ks + 16 + 4 * g) * 2);
                u32x4 aw; aw.x = a0.x; aw.y = a0.y; aw.z = a1.x; aw.w = a1.y;
                oacc = __builtin_amdgcn_mfma_f32_16x16x32_bf16(__builtin_bit_cast(bf16x8, aw), __builtin_bit_cast(bf16x8, bw), oacc, 0, 0, 0);
            }
            bf16x8 bv;
            { const v4i16_t lo = trr(L + VT + (4 * g + q4) * TS + (16 * wave + 4 * p4) * 2); bv = (bf16x8){lo[0], lo[1], lo[2], lo[3], 0, 0, 0, 0}; }
            { const u32x2 a0 = *(const LAS u32x2*)(L + AT + lc * 32 + 8 * g); u32x4 aw; aw.x = a0.x; aw.y = a0.y; aw.z = 0u; aw.w = 0u;
              oacc = __builtin_amdgcn_mfma_f32_16x16x32_bf16(__builtin_bit_cast(bf16x8, aw), bv, oacc, 0, 0, 0); }
#pragma unroll
            for (int e = 0; e < 4; ++e) *(LAS float*)(L + OT + ((4 * g + e) * OS + vd) * 4) = oacc[e];
#pragma unroll
            for (int i = 0; i < 8; ++i) {
                const f32x4 dc = *(const LAS f32x4*)(L + DECS + (16 * i + 4 * g) * 4);
                const v4i16_t lo = trr(L + KT + (4 * g + q4) * TS + (16 * i + 4 * p4) * 2);
                const bf16x8 a = (bf16x8){lo[0], lo[1], lo[2], lo[3], 0, 0, 0, 0};
                sacc[i] = __builtin_amdgcn_mfma_f32_16x16x32_bf16(a, bv, sacc[i] * dc, 0, 0, 0);
            }
#pragma unroll
            for (int i = 0; i < 8; ++i)
#pragma unroll
                for (int e = 0; e < 4; ++e) *(LAS float*)(L + ST + (16 * i + 4 * g + e) * SS + vd * 4) = sacc[i][e];
        }
        __syncthreads();
        if (tid < 64) {
            const f32x4 n0 = *(const f32x4*)(hgn + ec), n1 = *(const f32x4*)(hgn + ec + 4), n2 = *(const f32x4*)(hgn + ec + 8), n3 = *(const f32x4*)(hgn + ec + 12);
            f32x4 x[4]; float ss = 0.f;
#pragma unroll
            for (int k = 0; k < 4; ++k) { x[k] = *(const LAS f32x4*)(L + OT + (et * OS + ec + 4 * k) * 4); ss += mk::dot4(x[k]); }
            ss += __shfl_xor(ss, 1); ss += __shfl_xor(ss, 2); ss += __shfl_xor(ss, 4);
            const float rs = rsqrtf(ss * (1.f / 128.f) + EPS);
            const f32x4 y0 = x[0] * rs * n0 * (f32x4){mk::bflo(g0.x), mk::bfhi(g0.x), mk::bflo(g0.y), mk::bfhi(g0.y)}, y1 = x[1] * rs * n1 * (f32x4){mk::bflo(g0.z), mk::bfhi(g0.z), mk::bflo(g0.w), mk::bfhi(g0.w)};
            const f32x4 y2 = x[2] * rs * n2 * (f32x4){mk::bflo(g1.x), mk::bfhi(g1.x), mk::bflo(g1.y), mk::bfhi(g1.y)}, y3 = x[3] * rs * n3 * (f32x4){mk::bflo(g1.z), mk::bfhi(g1.z), mk::bflo(g1.w), mk::bfhi(g1.w)};
            { bf16_t* op = AOR + (m0 + et) * 1024 + 512 + h * 128 + ec; *(u32x4*)op = mk::pack8(y0, y1); *(u32x4*)(op + 8) = mk::pack8(y2, y3); }
        }
        { float* so = Sout + (size_t)id * 16384;
#pragma unroll
          for (int q = 0; q < 8; ++q) { const int cid = tid + 512 * q, row = cid >> 5, c4 = cid & 31; __builtin_nontemporal_store(*(const LAS f32x4*)(L + ST + row * SS + c4 * 16), (f32x4*)(so + (size_t)cid * 4)); } }
        __syncthreads();
    }
}
}
struct Args { const float* in[24]; float* out; unsigned char* ws; int ph_lo, ph_hi, li, pad; };
__global__ void __launch_bounds__(NWAVES * 64, 2) mega(Args args) {
    extern __shared__ __attribute__((aligned(16))) unsigned char lds[];
    LAS unsigned char* L = (LAS unsigned char*)lds;
    volatile LAS unsigned* MISC = (volatile LAS unsigned*)(L + MISC_OFF);
    const int tid = threadIdx.x, lane = tid & 63, wave = __builtin_amdgcn_readfirstlane(tid >> 6);
    const int G = gridDim.x; const int bx = blockIdx.x; const int vcu = (G % 8 == 0) ? (bx % 8) * (G / 8) + bx / 8 : bx;
    unsigned char* ws = args.ws;
    gu32* ctl = (gu32*)(ws + WS_CTL);
    for (int u = tid; u < (LDS_BYTES - LDSCTL_OFF) / 4; u += NWAVES * 64) ((LAS unsigned*)(L + LDSCTL_OFF))[u] = 0u;
    __syncthreads();
    const int lo = args.ph_lo, hi = args.ph_hi;
    XcdBarrier bar; bar.bar = (unsigned*)(ctl + CW_BAR) + args.li * XCD_BAR_WORDS; bar.x = 0; bar.st = nullptr;
    if (hi - lo > 1) bar = xcd_barrier_post((unsigned*)(ctl + CW_BAR) + args.li * XCD_BAR_WORDS, MISC + 8);
#define IN(k) (lo <= (k) && (k) < hi)
#define SEAM(k) do { if (IN(k) && IN((k) + 1)) xcd_barrier_bg(bar, [&]() { BG_WORK(k); }); } while (0)
#define BG_RUN(lo_, hi_, SET_) do { const int st_ = G * (NWAVES - 1); int j_ = (lo_) + vcu * (NWAVES - 1) + wave - 1; mk::WI w_, wn_; f32x4 r_[8], rn_[8]; \
        if (j_ < (hi_)) { SET_(w_, j_); mk::wi_load(w_, r_, lane); } \
        for (; j_ < (hi_); j_ += st_) { const bool hn_ = j_ + st_ < (hi_); if (hn_) { SET_(wn_, j_ + st_); mk::wi_load(wn_, rn_, lane); } mk::wi_proc(w_, r_, scr, lane); \
            if (hn_) { w_ = wn_; _Pragma("unroll") for (int i_ = 0; i_ < 8; ++i_) r_[i_] = rn_[i_]; } } } while (0)
#define BG_SET0(w, j) do { if ((j) < 1408) mk::wi_set(w, 0, args.in[8], nullptr, D, DFF, W2, 32, nullptr, (j)); else mk::wi_set(w, 2, args.in[10], nullptr, INW, D, WIN, 152, args.in[9], (j) - 1408); } while (0)
#define BG_SET1(w, j) do { if ((j) < 256) mk::wi_set(w, 0, args.in[17], nullptr, D, 1024, WUA, 32, nullptr, (j)); else if ((j) < 512) mk::wi_set(w, 0, args.in[18], nullptr, D, 1024, WUA + 512, 32, nullptr, (j) - 256); \
        else if ((j) < 1024) mk::wi_set(w, 0, args.in[19], nullptr, D, D, WOUT, 32, nullptr, (j) - 512); else mk::wi_set(w, 2, args.in[10], nullptr, INW, D, WIN, 152, args.in[9], (j) - 1024 + 1216); } while (0)
#define BG_SET2(w, j) mk::wi_set(w, 1, args.in[21], args.in[22], DFF, D, W13, 176, args.in[20], (j))
#define BG_SET4(w, j) mk::wi_set(w, 0, args.in[23], nullptr, D, DFF, W2, 32, nullptr, (j))
#define BG_COPY(lo_, hi_) do { for (int c_ = (lo_) + vcu * (NWAVES - 1) + wave - 1; c_ < (hi_); c_ += G * (NWAVES - 1)) { f32x4 v_[8]; \
        _Pragma("unroll") for (int i_ = 0; i_ < 8; ++i_) { const int u_ = c_ * 512 + i_ * 64 + lane, ten_ = u_ / (128 * 3840), rem_ = u_ % (128 * 3840), bd_ = rem_ / 3840, q_ = rem_ % 3840; \
            v_[i_] = __builtin_nontemporal_load((const f32x4*)(args.in[2 + ten_] + (size_t)bd_ * 16384 + 1024) + q_); } \
        _Pragma("unroll") for (int i_ = 0; i_ < 8; ++i_) { const int u_ = c_ * 512 + i_ * 64 + lane, ten_ = u_ / (128 * 3840), rem_ = u_ % (128 * 3840), bd_ = rem_ / 3840, q_ = rem_ % 3840; \
            __builtin_nontemporal_store(v_[i_], (f32x4*)(args.out + (ten_ ? O_SWV : O_SWK) + (size_t)bd_ * 16384) + q_); } } } while (0)
#define BG_WORK(k) do { \
        if ((k) == 0) BG_RUN(0, 1408 + 1216, BG_SET0); \
        else if ((k) == 1) BG_RUN(0, 1024 + 1216, BG_SET1); \
        else if ((k) == 2) BG_RUN(0, 1792, BG_SET2); \
        else if ((k) == 3) BG_RUN(1792, 2816, BG_SET2); \
        else if ((k) == 4) BG_RUN(0, 1408, BG_SET4); \
        else if ((k) == 5) BG_COPY(0, 1792); \
        else if ((k) == 6) BG_COPY(1792, 1920); \
    } while (0)
    const float* xp = args.in[0]; const float* xs = args.in[1];
    pg8::bf16_t* W13 = (pg8::bf16_t*)(ws + WS_W13); pg8::bf16_t* W2 = (pg8::bf16_t*)(ws + WS_W2); pg8::bf16_t* WIN = (pg8::bf16_t*)(ws + WS_WIN);
    pg8::bf16_t* WUA = (pg8::bf16_t*)(ws + WS_WUA); pg8::bf16_t* WUR = (pg8::bf16_t*)(ws + WS_WUR); pg8::bf16_t* WOUT = (pg8::bf16_t*)(ws + WS_WOUT);
    float* RSTD1 = (float*)(ws + WS_RSTD1); float* SSQ1 = (float*)(ws + WS_SSQ1); float* SSQ2 = (float*)(ws + WS_SSQ2);
    pg8::bf16_t* AB = (pg8::bf16_t*)(ws + WS_AB); pg8::bf16_t* HID = (pg8::bf16_t*)(ws + WS_HID);
    pg8::bf16_t* Qb = (pg8::bf16_t*)(ws + WS_Q); pg8::bf16_t* KVb = (pg8::bf16_t*)(ws + WS_KV); pg8::bf16_t* QRb = (pg8::bf16_t*)(ws + WS_QR); const unsigned short* LOGF = (const unsigned short*)(ws + WS_LOGF);
    pg8::bf16_t* MRG = (pg8::bf16_t*)(ws + WS_MRG); pg8::bf16_t* IRb = (pg8::bf16_t*)(ws + WS_IR); pg8::bf16_t* GRb = (pg8::bf16_t*)(ws + WS_GR);
    pg8::bf16_t* SGA = (pg8::bf16_t*)(ws + WS_SGA); pg8::bf16_t* SGR = (pg8::bf16_t*)(ws + WS_SGR); pg8::bf16_t* AOR = (pg8::bf16_t*)(ws + WS_AOR);
    const bool tail_first = ((bx >> 3) & 1) != 0;
    LAS float* scr = (LAS float*)(L + RING_OFF + wave * 16384);
    const int gw = vcu * NWAVES + wave, NGW = G * NWAVES;

    if (IN(0)) {
        constexpr int NIT = 176 * 16;
#define WI_DEC0(w, it_) mk::wi_set(w, 1, args.in[6], args.in[7], DFF, D, W13, 176, args.in[5], (it_))
        { mk::WI wc, wn; f32x4 rc[8], rn[8]; int it = gw;
          if (it < NIT) { WI_DEC0(wc, it); mk::wi_load(wc, rc, lane); }
          for (; it < NIT; it += NGW) {
              const bool hn = it + NGW < NIT;
              if (hn) { WI_DEC0(wn, it + NGW); mk::wi_load(wn, rn, lane); }
              mk::wi_proc(wc, rc, scr, lane);
              if (hn) { wc = wn;
#pragma unroll
                  for (int i = 0; i < 8; ++i) rc[i] = rn[i]; }
          } }
#undef WI_DEC0
        for (int m0 = gw; m0 < M; m0 += 4 * NGW) {
            f32x4 v[4][4];
#pragma unroll
            for (int q = 0; q < 4; ++q) { const int m = m0 + q * NGW; if (m < M) { const float* xr = m < MP ? xp + (size_t)m * D : xs + (size_t)(m - MP) * D; const GAS f32x4* p = (const GAS f32x4*)xr + lane;
#pragma unroll
                for (int j = 0; j < 4; ++j) v[q][j] = p[64 * j]; } }
#pragma unroll
            for (int q = 0; q < 4; ++q) { const int m = m0 + q * NGW; if (m < M) { float ss = 0.f;
#pragma unroll
                for (int j = 0; j < 4; ++j) ss += mk::dot4(v[q][j]);
                ss = mk::wave_sum(ss);
                if (lane == 0) RSTD1[m] = rsqrtf(ss * (1.f / 1024.f) + EPS);
                GAS unsigned long long* o8 = (GAS unsigned long long*)(AB + (size_t)m * D) + lane;
#pragma unroll
                for (int j = 0; j < 4; ++j) o8[64 * j] = (unsigned long long)pk2(v[q][j][0], v[q][j][1]) | ((unsigned long long)pk2(v[q][j][2], v[q][j][3]) << 32); } }
        }
        VM_WAIT(); __syncthreads();
    }
    SEAM(0);
    if (IN(1)) {
        pg8::Gemm g{AB, W13, M, 2 * DFF, D}; pg8::StaticOrder S; S.init(M, 2 * DFF, G, bx);
        mk::EpiSwiglu<false> E{HID, RSTD1, L + mk::RTAB_OFF};
        mk::build_rstd_table<false>(L, S, RSTD1, tid);
        pg8::gemm_phase<mk::EpiSwiglu<false>, pg8::StaticOrder, true, true>(L + RING_OFF, g, S, E);
    }
    SEAM(1);
    if (IN(2)) {
        pg8::Gemm g{HID, W2, MP, D, DFF}; pg8::StaticOrder S; S.init(MP, D, G, bx);
        mk::EpiResidB<false> E{AB, nullptr, SSQ1, 0.5f};
if (tail_first) mk::gemm_tail(L + RING_OFF, HID, W2, DFF, MP, 16, 16, vcu, G, E, tid, lane, wave);
        pg8::gemm_phase<mk::EpiResidB<false>, pg8::StaticOrder, true, true>(L + RING_OFF, g, S, E);
        if (!tail_first) mk::gemm_tail(L + RING_OFF, HID, W2, DFF, MP, 16, 16, vcu, G, E, tid, lane, wave);
    }
    SEAM(2);
    if (IN(3)) {
        pg8::Gemm g{AB, WIN, M, INW, D}; mk::ProjOrder S; S.init(G, bx);
        mk::EpiProj E{SSQ1, ws, args.out, args.in[11], args.in[12], args.in[15], L + mk::RTAB_OFF};
        mk::build_rstd_table<true>(L, S, SSQ1, tid);
        pg8::gemm_phase<mk::EpiProj, mk::ProjOrder, true, true>(L + RING_OFF, g, S, E);
        mk::EpiProjTail ET{SSQ1, SGA};
        mk::gemm_tail(L + RING_OFF, AB, WIN + (size_t)2816 * D, D, MP, 16, 12, vcu, G, ET, tid, lane, wave);
    }
    SEAM(3);
    pg8::bf16_t* US = (pg8::bf16_t*)args.out;
    float* DEC = (float*)(ws + WS_DEC);
    if (IN(4)) {
        for (int t = vcu; t < 512; t += G) {
            if (t < 256) at::attn_prompt_task(L, Qb, AOR, KVb, args.in[14], args.in[13], t >> 6, (t >> 1) & 31, t & 1, tid, lane, wave);
            else at::attn_sample_task(L, Qb, AOR, KVb, args.in[2], args.in[3], args.in[14], args.in[13], (t - 256) >> 1, t & 1, tid, lane, wave);
        }
        hg::HaPre HP; if (vcu < 256) hg::ha_issue(HP, LOGF, IRb, 4 * vcu, tid);
        hg::ha_phase(L, HP, LOGF, IRb, US, DEC, vcu, G, tid, lane, wave);
        VM_WAIT(); __syncthreads();
    }
    SEAM(4);
    if (IN(5)) {
        for (int idx = bx * (NWAVES * 64) + tid; idx < 131072; idx += G * NWAVES * 64) hg::hb_scan((unsigned*)US, DEC, args.out + O_PST, idx);
        VM_WAIT(); __syncthreads();
    }
    SEAM(5);
    if (IN(6)) {
        hg::hc_phase_prompt(L, LOGF, QRb, AOR, IRb, GRb, args.in[16], US, vcu, G, tid, lane, wave);
        hg::HcPreS PS; if (vcu < 512) hg::hc_issue_sample(PS, LOGF, QRb, IRb, args.in[4], vcu, tid);
        hg::hc_phase_sample(L, LOGF, QRb, AOR, IRb, GRb, args.in[16], args.in[4], args.out + O_SST, PS, vcu, G, tid, lane, wave);
        VM_WAIT(); __syncthreads();
    }
    SEAM(6);
    if (IN(7)) {
        { pg8::Gemm g{AOR, WUA, MP, D, D}; pg8::StaticOrder S; S.init(MP, D, G, bx); mk::EpiUpR E{MRG, (const unsigned char*)SGA, (const unsigned char*)SGR};
if (tail_first) mk::gemm_tail(L + RING_OFF, AOR, WUA, D, MP, 16, 16, vcu, G, E, tid, lane, wave);
        pg8::gemm_phase<mk::EpiUpR, pg8::StaticOrder, true, true>(L + RING_OFF, g, S, E);
        if (!tail_first) mk::gemm_tail(L + RING_OFF, AOR, WUA, D, MP, 16, 16, vcu, G, E, tid, lane, wave); }
    }
    SEAM(7);
    if (IN(8)) {
        pg8::Gemm g{MRG, WOUT, MP, D, D}; pg8::StaticOrder S; S.init(MP, D, G, bx);
        mk::EpiResidB<false> E{AB, nullptr, SSQ2, 1.0f};
if (tail_first) mk::gemm_tail(L + RING_OFF, MRG, WOUT, D, MP, 16, 16, vcu, G, E, tid, lane, wave);
        pg8::gemm_phase<mk::EpiResidB<false>, pg8::StaticOrder, true, true>(L + RING_OFF, g, S, E);
        if (!tail_first) mk::gemm_tail(L + RING_OFF, MRG, WOUT, D, MP, 16, 16, vcu, G, E, tid, lane, wave);
    }
    SEAM(8);
    if (IN(9)) {
        pg8::Gemm g{AB, W13, M, 2 * DFF, D}; pg8::StaticOrder S; S.init(M, 2 * DFF, G, bx);
        mk::EpiSwiglu<true> E{HID, SSQ2, L + mk::RTAB_OFF};
        mk::build_rstd_table<true>(L, S, SSQ2, tid);
        pg8::gemm_phase<mk::EpiSwiglu<true>, pg8::StaticOrder, true, true>(L + RING_OFF, g, S, E);
    }
    SEAM(9);
    if (IN(10)) {
        pg8::Gemm g{HID, W2, MP, D, DFF}; pg8::StaticOrder S; S.init(MP, D, G, bx);
        mk::EpiResidB<true> E{AB, args.out, nullptr, 0.5f};
if (tail_first) mk::gemm_tail(L + RING_OFF, HID, W2, DFF, MP, 16, 16, vcu, G, E, tid, lane, wave);
        pg8::gemm_phase<mk::EpiResidB<true>, pg8::StaticOrder, true, true>(L + RING_OFF, g, S, E);
        if (!tail_first) mk::gemm_tail(L + RING_OFF, HID, W2, DFF, MP, 16, 16, vcu, G, E, tid, lane, wave);
    }
#undef IN
#undef SEAM
}

extern "C" void kernel_launch(void* const* d_in, const int* in_sizes, int n_in, void* d_out, int out_size, void* d_ws, size_t ws_size, hipStream_t stream) {
    static int grid = 0;
    if (grid == 0) {
        int dev = 0, cus = 0;
        if (hipGetDevice(&dev) != hipSuccess || hipDeviceGetAttribute(&cus, hipDeviceAttributeMultiprocessorCount, dev) != hipSuccess) { fprintf(stderr, "kernel_launch: device query failed\n"); grid = -1; return; }
        if (hipFuncSetAttribute((const void*)mega, hipFuncAttributeMaxDynamicSharedMemorySize, LDS_BYTES) != hipSuccess) { fprintf(stderr, "kernel_launch: hipFuncSetAttribute failed\n"); grid = -1; return; }
        if (ws_size < WS_END) { fprintf(stderr, "kernel_launch: workspace too small: %zu < %zu\n", ws_size, (size_t)WS_END); grid = -1; return; }
        grid = cus;
    }
    if (grid < 0) return;
    (void)hipMemsetAsync((char*)d_ws + WS_CTL + CW_BAR * 4, 0, 16384, stream);
    Args a{};
    for (int i = 0; i < 24; ++i) a.in[i] = (const float*)d_in[i];
    a.out = (float*)d_out; a.ws = (unsigned char*)d_ws;
    unsigned char* ws = (unsigned char*)d_ws; float* out = (float*)d_out;
    int nl = 0;
    auto launch = [&](int lo, int hi) { a.ph_lo = lo; a.ph_hi = hi; a.li = nl++; hipLaunchKernelGGL(mega, dim3(grid), dim3(NWAVES * 64), LDS_BYTES, stream, a); };
    launch(0, 11);
}
```

```cpp
#include <hip/hip_runtime.h>
#include <cstdio>
#include <cstdint>
namespace pg8 {
#define PG8_LAS __attribute__((address_space(3)))
typedef unsigned short bf16_t;
typedef short bf16x8 __attribute__((ext_vector_type(8)));
typedef float f32x4 __attribute__((ext_vector_type(4)));
typedef unsigned u32x4 __attribute__((ext_vector_type(4)));
constexpr int BM = 256, BK = 64, HALF = 128, HTB = HALF * BK * 2  , STAGE_BYTES = 8 * HTB, NXCD = 8, WGM = 8;

__host__ __device__ __forceinline__ int lds_byte(int r, int c) { const int st = (r >> 4) * 2 + (c >> 5), rr = r & 15, cc = c & 31, ob = rr * 64 + cc * 2; return st * 1024 + (ob ^ (((ob >> 9) & 1) << 5)); }
__host__ __device__ __forceinline__ void stage_rc(int b, int& R, int& C) { const int st = b / 1024, sb = b % 1024, swz = sb ^ (((sb >> 9) & 1) << 5); R = (st >> 1) * 16 + swz / 64; C = (st & 1) * 32 + (swz % 64) / 2; }
__host__ __device__ __forceinline__ int perm32(int rho) { const int n = rho >> 4, i = rho & 15; return 8 * (i >> 2) + 4 * n + (i & 3); }

struct Unit { int pm, pn, idx; };
struct Gemm { const bf16_t* A; const bf16_t* Bt; int M, N, K; };

struct StaticOrder {
    int nM, nN, nwg, G, c;
    __host__ __device__ void init(int M, int N, int G_, int c_) { nM = M / BM; nN = N / BM; nwg = nM * nN; G = G_; c = c_; }
    __host__ __device__ bool next(int i, Unit& u) const {
        const long L = (long)i * G + c; if (L >= nwg) return false;
        int wgid = (int)L; { const int q = nwg / NXCD, r = nwg % NXCD, xcd = wgid % NXCD, off = wgid / NXCD; wgid = (xcd < r ? xcd * (q + 1) : r * (q + 1) + (xcd - r) * q) + off; }
        const int nig = WGM * nN, gid = wgid / nig, fm = gid * WGM, gsz = (nM - fm) < WGM ? (nM - fm) : WGM;
        u.pm = fm + ((wgid % nig) % gsz); u.pn = (wgid % nig) / gsz; u.idx = i; return true;
    }
    __device__ __forceinline__ void a_ready(const Unit&) const {}
    __device__ __forceinline__ void done(const Unit&) const {}
};

typedef float f32x2_cv __attribute__((ext_vector_type(2))); typedef __bf16 bf16x2_cv __attribute__((ext_vector_type(2)));
__device__ __forceinline__ unsigned cvt_pk_bf16(float lo, float hi) { const f32x2_cv v = {lo, hi}; const bf16x2_cv b = __builtin_convertvector(v, bf16x2_cv); return __builtin_bit_cast(unsigned, b); }
typedef float f32x2 __attribute__((ext_vector_type(2)));
template <class Epi, class Sched, bool ALIGN_EPI = false, bool SP2 = false>
__device__ __forceinline__ void gemm_phase(PG8_LAS unsigned char* lds, const Gemm g, const Sched& S, const Epi& E) {
    const int tid = threadIdx.x, wid = __builtin_amdgcn_readfirstlane(tid >> 6), lane = tid & 63, wr = wid >> 2, wc = wid & 3, fr = lane & 15, fq = lane >> 4;
    constexpr bool KS = Epi::MIDT > 0;
    const int K = g.K, nt = KS ? Epi::MIDT : K / BK;
    unsigned voffA[2], voffB[2];
#pragma unroll
    for (int i = 0; i < 2; ++i) { int R, C; stage_rc(tid * 16 + i * 8192, R, C); const int Rb = Epi::PERM ? ((R & ~31) + perm32(R & 31)) : R;
        voffA[i] = (unsigned)(R * K + C) * 2u; voffB[i] = (unsigned)(Rb * K + C) * 2u; }
    const size_t kstep = (size_t)(BK * 2);
    const size_t hstep = (size_t)HALF * K * 2;
    const size_t tstep = 2 * hstep;
    const unsigned ldsw = (unsigned)wid * 1024u;
    const int aoff = lds_byte(wr * 64 + fr, fq * 8), boff = lds_byte(wc * 32 + fr, fq * 8);
#define PG8_SA(b, h) (((b) * 2 + (h)) * HTB)
#define PG8_SB(b, h) ((4 + (b) * 2 + (h)) * HTB)
#define PG8_STAGE(bufoff, gbase, voff) do { _Pragma("unroll") for (int _i = 0; _i < 2; ++_i) \
        __builtin_amdgcn_global_load_lds((const unsigned*)((const char*)(gbase) + (voff)[_i]), (PG8_LAS unsigned*)(lds + (bufoff) + ldsw + _i * 8192), 16, 0, 0); } while (0)
#define PG8_LDA(dst, b, h) do { _Pragma("unroll") for (int m = 0; m < 4; ++m) _Pragma("unroll") for (int k = 0; k < 2; ++k) dst[m][k] = *(const PG8_LAS bf16x8*)(lds + PG8_SA(b, h) + aoff + m * 2048 + k * 1024); } while (0)
#define PG8_LDB(dst, b, h) do { _Pragma("unroll") for (int n = 0; n < 2; ++n) _Pragma("unroll") for (int k = 0; k < 2; ++k) dst[n][k] = *(const PG8_LAS bf16x8*)(lds + PG8_SB(b, h) + boff + n * 2048 + k * 1024); } while (0)
#define PG8_MMA(ai, bj, At, Bt) do { __builtin_amdgcn_s_setprio(1); _Pragma("unroll") for (int m = 0; m < 4; ++m) _Pragma("unroll") for (int n = 0; n < 2; ++n) _Pragma("unroll") for (int k = 0; k < 2; ++k) \
        acc[ai][bj][m][n] = __builtin_amdgcn_mfma_f32_16x16x32_bf16(Bt[n][k], At[m][k], acc[ai][bj][m][n], 0, 0, 0); __builtin_amdgcn_s_setprio(0); } while (0)
#define PG8_WAIT_V(n) asm volatile("s_waitcnt vmcnt(" #n ")" ::: "memory")
#define PG8_WAIT_V8R(t_) do { if constexpr (Epi::EPI_VM == 8) asm volatile("s_waitcnt vmcnt(16)\n\ts_cmp_eq_u32 %0, 0\n\ts_cbranch_scc1 1f\n\ts_waitcnt vmcnt(8)\n1:" :: "s"(t_) : "scc", "memory"); \
        else if constexpr (Epi::EPI_VM == 16) asm volatile("s_waitcnt vmcnt(24)\n\ts_cmp_eq_u32 %0, 0\n\ts_cbranch_scc1 1f\n\ts_waitcnt vmcnt(8)\n1:" :: "s"(t_) : "scc", "memory"); \
        else { static_assert(Epi::EPI_VM == 0, "EPI_VM: 0, 8 or 16"); PG8_WAIT_V(8); } } while (0)
#define PG8_WAIT_L(n) asm volatile("s_waitcnt lgkmcnt(" #n ")" ::: "memory")
#define PG8_BAR __builtin_amdgcn_s_barrier()
#define PG8_SCHED __builtin_amdgcn_sched_barrier(0)
    Unit cur, nxt; int ui = 0;
    if (!S.next(0, cur)) return;
    f32x4 acc[2][2][4][2];
    u32x4 ipre[Epi::INIT ? 16 : 1];
    if constexpr (Epi::INIT) E.init_issue(ipre, cur, wr, wc, fr, fq);
    else {
#pragma unroll
    for (int a = 0; a < 2; ++a)
#pragma unroll
        for (int b = 0; b < 2; ++b)
#pragma unroll
            for (int m = 0; m < 4; ++m)
#pragma unroll
                for (int n = 0; n < 2; ++n) acc[a][b][m][n] = (f32x4){0.f, 0.f, 0.f, 0.f};
    }
    bf16x8 At[4][2], B0[2][2], B1[2][2];
    const char* cA = (const char*)g.A + (size_t)cur.pm * tstep; const char* cB = (const char*)g.Bt + (size_t)cur.pn * tstep;
    S.a_ready(cur);
    if constexpr (SP2) {
        PG8_STAGE(PG8_SB(0, 0), cB, voffB); PG8_STAGE(PG8_SB(0, 1), cB + hstep, voffB); PG8_STAGE(PG8_SA(0, 0), cA, voffA); PG8_STAGE(PG8_SA(0, 1), cA + hstep, voffA);
        if (wr == 1) PG8_BAR;
        PG8_WAIT_V(2); PG8_BAR;
        PG8_STAGE(PG8_SB(1, 0), cB + kstep, voffB); PG8_STAGE(PG8_SA(1, 0), cA + kstep, voffA); PG8_STAGE(PG8_SB(1, 1), cB + hstep + kstep, voffB);
        if constexpr (Epi::EPI_VM > 0) PG8_WAIT_V(0); else PG8_WAIT_V(6);
        PG8_BAR;
    } else {
        PG8_STAGE(PG8_SB(0, 0), cB, voffB); PG8_STAGE(PG8_SA(0, 0), cA, voffA); PG8_STAGE(PG8_SB(0, 1), cB + hstep, voffB); PG8_STAGE(PG8_SA(0, 1), cA + hstep, voffA);
        if (wr == 1) PG8_BAR;
        PG8_WAIT_V(4); PG8_BAR;
        PG8_STAGE(PG8_SB(1, 0), cB + kstep, voffB); PG8_STAGE(PG8_SA(1, 0), cA + kstep, voffA); PG8_STAGE(PG8_SB(1, 1), cB + hstep + kstep, voffB);
        PG8_WAIT_V(6); PG8_BAR;
    }
    if constexpr (Epi::INIT) E.init_finish(acc, ipre);
    for (;;) {
        const bool has_next = KS ? S.next((ui + 1) >> 1, nxt) : S.next(ui + 1, nxt);
        const size_t nko = (KS && ((ui + 1) & 1)) ? (size_t)nt * kstep : (size_t)0;
        const char* nA = has_next ? (const char*)g.A + (size_t)nxt.pm * tstep + nko : cA; const char* nB = has_next ? (const char*)g.Bt + (size_t)nxt.pn * tstep + nko : cB;
        for (int t = 0; t < nt; t += 2) {
            const bool last = (t == nt - 2);
            const char* a1 = cA + (size_t)(t + 1) * kstep;
            const char* a2 = last ? nA : cA + (size_t)(t + 2) * kstep; const char* b2 = last ? nB : cB + (size_t)(t + 2) * kstep;
            const char* a3 = a2 + kstep; const char* b3 = b2 + kstep;
            if (last && has_next) S.a_ready(nxt);
            if constexpr (SP2) {
            PG8_LDB(B0, 0, 0); PG8_LDB(B1, 0, 1); PG8_SCHED; PG8_LDA(At, 0, 0); PG8_STAGE(PG8_SA(1, 1), a1 + hstep, voffA);
            PG8_WAIT_V8R(t); PG8_WAIT_L(0); PG8_BAR; PG8_MMA(0, 0, At, B0); PG8_MMA(0, 1, At, B1); PG8_BAR; PG8_SCHED;
            PG8_LDA(At, 0, 1); PG8_STAGE(PG8_SB(0, 0), b2, voffB); PG8_STAGE(PG8_SB(0, 1), b2 + hstep, voffB); PG8_STAGE(PG8_SA(0, 0), a2, voffA);
            PG8_WAIT_V8R(t); PG8_WAIT_L(0); PG8_BAR; PG8_MMA(1, 0, At, B0); PG8_MMA(1, 1, At, B1); PG8_BAR; PG8_SCHED;
            PG8_LDB(B0, 1, 0); PG8_LDB(B1, 1, 1); PG8_SCHED; PG8_LDA(At, 1, 0); PG8_STAGE(PG8_SA(0, 1), a2 + hstep, voffA);
            PG8_WAIT_V(8); PG8_WAIT_L(0); PG8_BAR; PG8_MMA(0, 0, At, B0); PG8_MMA(0, 1, At, B1); PG8_BAR; PG8_SCHED;
            PG8_LDA(At, 1, 1); PG8_STAGE(PG8_SB(1, 0), b3, voffB); PG8_STAGE(PG8_SB(1, 1), b3 + hstep, voffB); PG8_STAGE(PG8_SA(1, 0), a3, voffA);
            PG8_WAIT_V(8); PG8_WAIT_L(0); PG8_BAR; PG8_MMA(1, 0, At, B0); PG8_MMA(1, 1, At, B1); PG8_BAR; PG8_SCHED;
            } else {
            PG8_LDB(B0, 0, 0); PG8_SCHED; PG8_LDA(At, 0, 0); PG8_STAGE(PG8_SA(1, 1), a1 + hstep, voffA);
            PG8_WAIT_L(8); PG8_BAR; PG8_WAIT_L(0); PG8_MMA(0, 0, At, B0); PG8_BAR; PG8_SCHED;
            PG8_LDB(B1, 0, 1); PG8_STAGE(PG8_SB(0, 0), b2, voffB);
            PG8_BAR; PG8_WAIT_L(0); PG8_MMA(0, 1, At, B1); PG8_BAR;
            PG8_LDA(At, 0, 1); PG8_STAGE(PG8_SA(0, 0), a2, voffA);
            PG8_BAR; PG8_WAIT_L(0); PG8_MMA(1, 0, At, B0); PG8_BAR; PG8_SCHED;
            PG8_STAGE(PG8_SB(0, 1), b2 + hstep, voffB);
            PG8_WAIT_V(6); PG8_BAR; PG8_MMA(1, 1, At, B1); PG8_BAR;
            PG8_LDB(B0, 1, 0); PG8_SCHED; PG8_LDA(At, 1, 0); PG8_STAGE(PG8_SA(0, 1), a2 + hstep, voffA);
            PG8_WAIT_L(8); PG8_BAR; PG8_WAIT_L(0); PG8_MMA(0, 0, At, B0); PG8_BAR; PG8_SCHED;
            PG8_LDB(B1, 1, 1); PG8_STAGE(PG8_SB(1, 0), b3, voffB);
            PG8_BAR; PG8_WAIT_L(0); PG8_MMA(0, 1, At, B1); PG8_BAR;
            PG8_LDA(At, 1, 1); PG8_STAGE(PG8_SA(1, 0), a3, voffA);
            PG8_BAR; PG8_WAIT_L(0); PG8_MMA(1, 0, At, B0); PG8_BAR; PG8_SCHED;
            PG8_STAGE(PG8_SB(1, 1), b3 + hstep, voffB);
            PG8_WAIT_V(6); PG8_BAR; PG8_MMA(1, 1, At, B1); PG8_BAR;
            }
        }
        if constexpr (ALIGN_EPI) { if (wr == 0) PG8_BAR; }
        if constexpr (KS) { if (ui & 1) { E(acc, cur, wr, wc, fr, fq); S.done(cur); } else E.mid(acc, cur, wr, wc, fr, fq); }
        else if constexpr (!Epi::AFTER_DRAIN) { E(acc, cur, wr, wc, fr, fq); S.done(cur); }
        if (!has_next) break;
        if constexpr (Epi::INIT) { E.init_issue(ipre, nxt, wr, wc, fr, fq); E.init_finish(acc, ipre); }
        else if (!KS || (ui & 1)) {
#pragma unroll
        for (int a = 0; a < 2; ++a)
#pragma unroll
            for (int b = 0; b < 2; ++b)
#pragma unroll
                for (int m = 0; m < 4; ++m)
#pragma unroll
                    for (int n = 0; n < 2; ++n) acc[a][b][m][n] = (f32x4){0.f, 0.f, 0.f, 0.f};
        }
        cur = nxt; cA = nA; cB = nB; ++ui;
        if constexpr (ALIGN_EPI) { if (wr == 1) PG8_BAR; }
    }
    PG8_WAIT_V(0);
    if constexpr (!ALIGN_EPI) { if (wr == 0) PG8_BAR; }
    PG8_BAR;
    if constexpr (Epi::AFTER_DRAIN) { E.fused(acc, cur, wr, wc, fr, fq, lds, wid, lane); S.done(cur); }
#undef PG8_SA
#undef PG8_SB
#undef PG8_STAGE
#undef PG8_LDA
#undef PG8_LDB
#undef PG8_MMA
#undef PG8_WAIT_V
#undef PG8_WAIT_L
#undef PG8_WAIT_V8R
#undef PG8_BAR
#undef PG8_SCHED
}
}
#define GAS __attribute__((address_space(1)))
#define LAS __attribute__((address_space(3)))
typedef unsigned short bf16;
typedef unsigned v4u __attribute__((ext_vector_type(4)));
typedef float f32x4 __attribute__((ext_vector_type(4)));
typedef short bf16x8 __attribute__((ext_vector_type(8)));
typedef GAS unsigned gu32;
typedef GAS unsigned long long gu64;
#define RLX_AGENT __ATOMIC_RELAXED, __HIP_MEMORY_SCOPE_AGENT
#define LDS_WAIT() asm volatile("s_waitcnt lgkmcnt(0)" ::: "memory")
#define VM_WAIT() asm volatile("s_waitcnt vmcnt(0)" ::: "memory")
__device__ __forceinline__ unsigned long long rt() { return __builtin_amdgcn_s_memrealtime(); }
__device__ __forceinline__ unsigned f2bf(float f) { unsigned u = __builtin_bit_cast(unsigned, f); return (u + 0x7fffu + ((u >> 16) & 1u)) >> 16; }
__device__ __forceinline__ unsigned pk2(float lo, float hi) { return f2bf(lo) | (f2bf(hi) << 16); }
#define XB_TMO      128
#define XB_XCNT(j)  (256  + 64 * (j))
#define XB_XSUB(j)  (1280 + 64 * (j))
#define XB_XGEN(j)  (2304 + 64 * (j))
#define XB_TOP      3328
#define XB_TOPGEN   3392
#define XCD_BAR_WORDS 3456
#define XB_SPIN_CAP (1u << 18)

__device__ __forceinline__ unsigned xb_ld(unsigned* p)              { return __hip_atomic_load(p, __ATOMIC_RELAXED, __HIP_MEMORY_SCOPE_AGENT); }
__device__ __forceinline__ unsigned xb_add(unsigned* p, unsigned v) { return __hip_atomic_fetch_add(p, v, __ATOMIC_RELAXED, __HIP_MEMORY_SCOPE_AGENT); }
__device__ __forceinline__ unsigned xb_xcc_id() { return (unsigned)__builtin_amdgcn_s_getreg((3 << 11) | 20) & 0xFu; }
#define XB_SPIN(cond, bar) do { unsigned _sp = 0; while (cond) { __builtin_amdgcn_s_sleep(1); \
    if ((++_sp & 255u) == 0u) { if (xb_ld(&(bar)[XB_TMO])) break; if (_sp > XB_SPIN_CAP) { atomicAdd(&(bar)[XB_TMO], 1u); break; } } } } while (0)

struct XcdBarrier {
    unsigned* bar; unsigned x;
    volatile LAS unsigned* st;
};

__device__ __forceinline__ XcdBarrier xcd_barrier_post(unsigned* bar, volatile LAS unsigned* st) {
    XcdBarrier b; b.bar = bar; b.x = xb_xcc_id(); b.st = st;
    if (threadIdx.x == 0) (void)xb_add(&bar[XB_XCNT(b.x)], 1u);
    return b;
}
__device__ __forceinline__ void xcd_barrier_complete(unsigned* bar, unsigned x, unsigned& nloc, unsigned& nx) {
    const unsigned G = gridDim.x * gridDim.y * gridDim.z;
    unsigned sum, cnt, mine, sp = 0u;
    for (;;) {
        sum = 0u; cnt = 0u; mine = 0u;
#pragma unroll
        for (unsigned j = 0; j < 16; ++j) { const unsigned c = xb_ld(&bar[XB_XCNT(j)]); sum += c; cnt += (c > 0u) ? 1u : 0u; mine = (j == x) ? c : mine; }
        if (sum == G) break;
        __builtin_amdgcn_s_sleep(1);
        if ((++sp & 255u) == 0u) { if (xb_ld(&bar[XB_TMO])) break; if (sp > XB_SPIN_CAP) { atomicAdd(&bar[XB_TMO], 1u); break; } }
    }
    nloc = mine > 0u ? mine : 1u; nx = cnt > 0u ? cnt : 1u;
}

__device__ __forceinline__ void xcd_barrier(const XcdBarrier& b) {
    asm volatile("s_waitcnt vmcnt(0)" ::: "memory");
    __syncthreads();
    if (threadIdx.x == 0) {
        unsigned* bar = b.bar;
        __builtin_amdgcn_s_waitcnt(0);
        unsigned nloc = b.st[0], nx = b.st[1];
        if (nloc == 0u) { xcd_barrier_complete(bar, b.x, nloc, nx); b.st[0] = nloc; b.st[1] = nx; }
        const unsigned old = xb_add(&bar[XB_XSUB(b.x)], 1u);
        const unsigned gen = old / nloc;
        if (old + 1u == (gen + 1u) * nloc) {
            __builtin_amdgcn_fence(__ATOMIC_RELEASE, "agent");
            asm volatile("s_waitcnt vmcnt(0)" ::: "memory");
            const unsigned og = xb_add(&bar[XB_TOP], 1u);
            const unsigned tg = og / nx;
            if (og + 1u == (tg + 1u) * nx) xb_add(&bar[XB_TOPGEN], 1u);
            else XB_SPIN(xb_ld(&bar[XB_TOPGEN]) == tg, bar);
            __builtin_amdgcn_fence(__ATOMIC_ACQUIRE, "agent");
            xb_add(&bar[XB_XGEN(b.x)], 1u);
            asm volatile("s_waitcnt vmcnt(0)" ::: "memory");
        } else {
            XB_SPIN(xb_ld(&bar[XB_XGEN(b.x)]) == gen, bar);
            __builtin_amdgcn_fence(__ATOMIC_ACQUIRE, "agent");
            asm volatile("s_waitcnt vmcnt(0)" ::: "memory");
        }
    }
    __syncthreads();
}

template <class BG> __device__ __forceinline__ void xcd_barrier_bg(const XcdBarrier& b, const BG& bg) {
    asm volatile("s_waitcnt vmcnt(0)" ::: "memory");
    __syncthreads();
    if (threadIdx.x == 0) {
        unsigned* bar = b.bar;
        __builtin_amdgcn_s_waitcnt(0);
        unsigned nloc = b.st[0], nx = b.st[1];
        if (nloc == 0u) { xcd_barrier_complete(bar, b.x, nloc, nx); b.st[0] = nloc; b.st[1] = nx; }
        const unsigned old = xb_add(&bar[XB_XSUB(b.x)], 1u);
        const unsigned gen = old / nloc;
        if (old + 1u == (gen + 1u) * nloc) {
            __builtin_amdgcn_fence(__ATOMIC_RELEASE, "agent");
            asm volatile("s_waitcnt vmcnt(0)" ::: "memory");
            const unsigned og = xb_add(&bar[XB_TOP], 1u);
            const unsigned tg = og / nx;
            if (og + 1u == (tg + 1u) * nx) xb_add(&bar[XB_TOPGEN], 1u);
            else XB_SPIN(xb_ld(&bar[XB_TOPGEN]) == tg, bar);
            __builtin_amdgcn_fence(__ATOMIC_ACQUIRE, "agent");
            xb_add(&bar[XB_XGEN(b.x)], 1u);
            asm volatile("s_waitcnt vmcnt(0)" ::: "memory");
        } else {
            XB_SPIN(xb_ld(&bar[XB_XGEN(b.x)]) == gen, bar);
            __builtin_amdgcn_fence(__ATOMIC_ACQUIRE, "agent");
            asm volatile("s_waitcnt vmcnt(0)" ::: "memory");
        }
    } else if (threadIdx.x >= 64) bg();
    __syncthreads();
}

constexpr int D = 1024, MP = 16384, MS = 1024, M = MP + MS, DFF = 2816, INW = 4864;
constexpr float EPS = 1e-6f;
constexpr size_t O_YS = (size_t)MP * D, O_PWK = O_YS + (size_t)MS * D, O_PWV = O_PWK + 65536, O_PST = O_PWV + 65536, O_SWK = O_PST + 262144, O_SWV = O_SWK + 2097152, O_SST = O_SWV + 2097152;
constexpr size_t MiB = 1u << 20, HMiB = 1u << 19;
constexpr size_t WS_CTL = 0, CTL_ZERO_BYTES = 1 * MiB;
constexpr size_t WS_W13 = 1 * MiB, WS_W2 = 12 * MiB, WS_WIN = 17 * MiB + HMiB, WS_WUA = 27 * MiB, WS_WUR = 28 * MiB, WS_WOUT = 29 * MiB;
constexpr size_t WS_DEC = 31 * MiB, WS_RSTD1 = 31 * MiB + HMiB, WS_SSQ1 = 32 * MiB, WS_SSQ2 = 34 * MiB;
constexpr size_t WS_AB = 36 * MiB, WS_BIG = 70 * MiB;
constexpr size_t WS_HID = WS_BIG, WS_Q = WS_BIG, WS_KV = WS_BIG + 17 * MiB, WS_QR = WS_KV + 8 * MiB + HMiB, WS_LOGF = WS_QR + 17 * MiB, WS_MRG = WS_LOGF, WS_IR = WS_LOGF + 34 * MiB,
                 WS_GR = WS_IR + 17 * MiB, WS_SGA = WS_GR + 17 * MiB, WS_SGR = WS_SGA + 17 * MiB, WS_AOR = WS_SGR + 17 * MiB, WS_END = WS_AOR + 34 * MiB;
static_assert(WS_END <= 256 * MiB && WS_HID + (size_t)M * DFF * 2 <= WS_END, "ws map");
constexpr int CW_BAR = 4096;
constexpr int RING_OFF = 0, RING_BYTES = 131072, LDSCTL_OFF = 139264, MISC_OFF = LDSCTL_OFF + 320, LDS_BYTES = 147456;
constexpr int NWAVES = 8;

namespace mk {
using pg8::f32x4; using pg8::u32x4; using pg8::Unit; using pg8::bf16_t; using pg8::cvt_pk_bf16;
typedef unsigned u32x2 __attribute__((ext_vector_type(2)));
__device__ __forceinline__ float fsigmoid(float x) { return __builtin_amdgcn_rcpf(1.f + __expf(-x)); }
__device__ __forceinline__ float fsilu(float x) { return x * fsigmoid(x); }
__device__ __forceinline__ float bflo(unsigned w) { return __uint_as_float(w << 16); }
__device__ __forceinline__ float bfhi(unsigned w) { return __uint_as_float(w & 0xffff0000u); }
__device__ __forceinline__ float bf2f(bf16_t h) { return __uint_as_float((unsigned)h << 16); }
__device__ __forceinline__ u32x4 pack8(const f32x4 a, const f32x4 b) { u32x4 w; w.x = cvt_pk_bf16(a[0], a[1]); w.y = cvt_pk_bf16(a[2], a[3]); w.z = cvt_pk_bf16(b[0], b[1]); w.w = cvt_pk_bf16(b[2], b[3]); return w; }
__device__ __forceinline__ float dot4(const f32x4 a) { return (a[0] * a[0] + a[1] * a[1]) + (a[2] * a[2] + a[3] * a[3]); }
__device__ __forceinline__ unsigned q16(float s) { return (unsigned)(s * 65535.f + 0.5f); }
__device__ __forceinline__ unsigned q8(float s) { return (unsigned)(s * 255.f + 0.5f); }
__device__ __forceinline__ unsigned pack4q8(const f32x4 s) { return q8(s[0]) | (q8(s[1]) << 8) | (q8(s[2]) << 16) | (q8(s[3]) << 24); }
__device__ __forceinline__ f32x4 unpack4q8(unsigned w) { return (f32x4){(float)(w & 0xffu), (float)((w >> 8) & 0xffu), (float)((w >> 16) & 0xffu), (float)(w >> 24)} * (1.f / 255.f); }
__device__ __forceinline__ float row_rstd16(const float* ssqp, int r) {
    const f32x4* p = (const f32x4*)(ssqp + (size_t)r * 16); const f32x4 a = p[0], b = p[1], c = p[2], d = p[3]; const f32x4 s = (a + b) + (c + d);
    return rsqrtf(((s[0] + s[1]) + (s[2] + s[3])) * (1.f / 1024.f) + EPS);
}

constexpr int RTAB_OFF = LDSCTL_OFF + 1024;
template <bool FROM_SSQ, class Sched> __device__ __forceinline__ void build_rstd_table(LAS unsigned char* L, const Sched& S, const float* src, int tid) {
    Unit u;
    for (int i = 0; i < 6 && S.next(i, u); ++i) if (tid < 256) *(LAS float*)(L + RTAB_OFF + (i * 256 + tid) * 4) = FROM_SSQ ? row_rstd16(src, u.pm * 256 + tid) : src[u.pm * 256 + tid];
    __syncthreads();
}
template <bool FROM_SSQ> struct EpiSwiglu {
    static constexpr bool PERM = true, AFTER_DRAIN = false, INIT = false; static constexpr int MIDT = 0, EPI_VM = 8;
    bf16_t* H; const float* rs; LAS unsigned char* tab;
    __device__ __forceinline__ void operator()(const f32x4 (&acc)[2][2][4][2], const Unit& u, int wr, int wc, int fr, int fq) const {
        const int row0 = u.pm * 256 + wr * 64 + fr, col0 = u.pn * 128 + wc * 32 + 8 * fq;
#pragma unroll
        for (int ai = 0; ai < 2; ++ai)
#pragma unroll
            for (int m = 0; m < 4; ++m) {
                const int r = row0 + ai * 128 + m * 16;
                const float s = u.idx < 6 ? *(const LAS float*)(tab + (u.idx * 256 + (r & 255)) * 4) : (FROM_SSQ ? row_rstd16(rs, r) : rs[r]);
                f32x4 h0, h1;
#pragma unroll
                for (int e = 0; e < 4; ++e) { h0[e] = fsilu(acc[ai][0][m][0][e] * s) * (acc[ai][1][m][0][e] * s); h1[e] = fsilu(acc[ai][0][m][1][e] * s) * (acc[ai][1][m][1][e] * s); }
                *(u32x4*)(H + (size_t)r * DFF + col0) = pack8(h0, h1);
            }
    }
};
template <bool WRITE_B> struct EpiResid {
    static constexpr bool PERM = false, AFTER_DRAIN = false, INIT = false; static constexpr int MIDT = 0, EPI_VM = 0;
    const float* xp; const float* xs; float* Hout; bf16_t* HB; float* ssqp; float scale; int base_is_x;
    __device__ __forceinline__ void operator()(const f32x4 (&acc)[2][2][4][2], const Unit& u, int wr, int wc, int fr, int fq) const {
        const int row0 = u.pm * 256 + wr * 64 + fr, col0 = u.pn * 256 + wc * 32 + 4 * fq;
        f32x4 pre[3][4];
#define ER_BASE(g_) (base_is_x ? (row0 + ((g_) >> 2) * 128 + ((g_) & 3) * 16 < MP ? xp + (size_t)(row0 + ((g_) >> 2) * 128 + ((g_) & 3) * 16) * D : xs + (size_t)(row0 + ((g_) >> 2) * 128 + ((g_) & 3) * 16 - MP) * D) : Hout + (size_t)(row0 + ((g_) >> 2) * 128 + ((g_) & 3) * 16) * D)
#define ER_LOAD(g_) do { const float* bp_ = ER_BASE(g_); _Pragma("unroll") for (int q_ = 0; q_ < 4; ++q_) pre[(g_) % 3][q_] = *(const f32x4*)(bp_ + col0 + (q_ >> 1) * 128 + (q_ & 1) * 16); } while (0)
        ER_LOAD(0); ER_LOAD(1);
#pragma unroll
        for (int g = 0; g < 8; ++g) {
            if (g + 2 < 8) ER_LOAD(g + 2);
            const int ai = g >> 2, m = g & 3, r = row0 + ai * 128 + m * 16;
            float* op = Hout + (size_t)r * D; float ss = 0.f;
#pragma unroll
            for (int q = 0; q < 4; ++q) {
                const int bj = q >> 1, n = q & 1, c = col0 + bj * 128 + n * 16; const f32x4 o = pre[g % 3][q] + acc[ai][bj][m][n] * scale;
                if (WRITE_B) *(f32x4*)(op + c) = o; else __builtin_nontemporal_store(o, (f32x4*)(op + c));
                if (WRITE_B) { ss += dot4(o); u32x2 w; w.x = cvt_pk_bf16(o[0], o[1]); w.y = cvt_pk_bf16(o[2], o[3]); *(u32x2*)(HB + (size_t)r * D + c) = w; }
            }
            if (WRITE_B) { ss += __shfl_xor(ss, 16); ss += __shfl_xor(ss, 32); if (fq == 0) ssqp[(size_t)r * 16 + u.pn * 4 + wc] = ss; }
            __builtin_amdgcn_sched_barrier(0);
        }
#undef ER_LOAD
#undef ER_BASE
    }
    __device__ __forceinline__ void tail(const f32x4 (&acc)[4], int r, int c0, int fq) const {
        const float* bp = base_is_x ? (r < MP ? xp + (size_t)r * D : xs + (size_t)(r - MP) * D) : Hout + (size_t)r * D;
        float* op = Hout + (size_t)r * D; float ss = 0.f;
#pragma unroll
        for (int n = 0; n < 4; ++n) {
            const int c = c0 + 16 * n + 4 * fq; const f32x4 b = *(const f32x4*)(bp + c); const f32x4 o = b + acc[n] * scale; if (WRITE_B) *(f32x4*)(op + c) = o; else __builtin_nontemporal_store(o, (f32x4*)(op + c));
            if (WRITE_B) { ss += dot4(o); u32x2 w; w.x = cvt_pk_bf16(o[0], o[1]); w.y = cvt_pk_bf16(o[2], o[3]); *(u32x2*)(HB + (size_t)r * D + c) = w; }
        }
        if (WRITE_B) { ss += __shfl_xor(ss, 16); ss += __shfl_xor(ss, 32); if (fq == 0) ssqp[(size_t)r * 16 + (c0 >> 6)] = ss; }
    }
};
template <bool FINAL> struct EpiResidB {
    static constexpr bool PERM = true, AFTER_DRAIN = false, INIT = true; static constexpr int MIDT = 0, EPI_VM = 0;
    bf16_t* HB; float* Y; float* ssqp; float scale;
    __device__ __forceinline__ void init_issue(u32x4 (&pre)[16], const Unit& u, int wr, int wc, int fr, int fq) const {
        const int row0 = u.pm * 256 + wr * 64 + fr, col0 = u.pn * 256 + wc * 32 + 8 * fq;
#pragma unroll
        for (int g = 0; g < 8; ++g)
#pragma unroll
            for (int bj = 0; bj < 2; ++bj) pre[2 * g + bj] = *(const u32x4*)(HB + (size_t)(row0 + (g >> 2) * 128 + (g & 3) * 16) * D + col0 + 128 * bj);
    }
    __device__ __forceinline__ void init_finish(f32x4 (&acc)[2][2][4][2], const u32x4 (&pre)[16]) const {
        const float inv = 1.f / scale;
#pragma unroll
        for (int g = 0; g < 8; ++g)
#pragma unroll
            for (int bj = 0; bj < 2; ++bj) { const u32x4 b = pre[2 * g + bj];
                acc[g >> 2][bj][g & 3][0] = (f32x4){bflo(b.x), bfhi(b.x), bflo(b.y), bfhi(b.y)} * inv; acc[g >> 2][bj][g & 3][1] = (f32x4){bflo(b.z), bfhi(b.z), bflo(b.w), bfhi(b.w)} * inv; }
    }
    __device__ __forceinline__ void operator()(const f32x4 (&acc)[2][2][4][2], const Unit& u, int wr, int wc, int fr, int fq) const {
        const int row0 = u.pm * 256 + wr * 64 + fr, col0 = u.pn * 256 + wc * 32 + 8 * fq;
#pragma unroll
        for (int g = 0; g < 8; ++g) {
            const int ai = g >> 2, m = g & 3, r = row0 + ai * 128 + m * 16; float ss = 0.f;
#pragma unroll
            for (int bj = 0; bj < 2; ++bj) {
                const f32x4 o0 = acc[ai][bj][m][0] * scale, o1 = acc[ai][bj][m][1] * scale;
                if (FINAL) { float* yp = Y + (size_t)r * D + col0 + 128 * bj; __builtin_nontemporal_store(o0, (f32x4*)yp); __builtin_nontemporal_store(o1, (f32x4*)(yp + 4)); }
                else { ss += dot4(o0) + dot4(o1); *(u32x4*)(HB + (size_t)r * D + col0 + 128 * bj) = pack8(o0, o1); }
            }
            if (!FINAL) { ss += __shfl_xor(ss, 16); ss += __shfl_xor(ss, 32); if (fq == 0) ssqp[(size_t)r * 16 + u.pn * 4 + wc] = ss; }
        }
    }
    __device__ __forceinline__ void tail(const f32x4 (&acc)[4], int r, int c0, int fq) const {
        bf16_t* bp = HB + (size_t)r * D + c0 + 4 * fq; float ss = 0.f; u32x2 b[4];
#pragma unroll
        for (int n = 0; n < 4; ++n) b[n] = *(const u32x2*)(bp + 16 * n);
#pragma unroll
        for (int n = 0; n < 4; ++n) {
            const f32x4 o = (f32x4){bflo(b[n].x), bfhi(b[n].x), bflo(b[n].y), bfhi(b[n].y)} + acc[n] * scale;
            if (FINAL) __builtin_nontemporal_store(o, (f32x4*)(Y + (size_t)r * D + c0 + 16 * n + 4 * fq));
            else { ss += dot4(o); u32x2 w; w.x = cvt_pk_bf16(o[0], o[1]); w.y = cvt_pk_bf16(o[2], o[3]); *(u32x2*)(bp + 16 * n) = w; }
        }
        if (!FINAL) { ss += __shfl_xor(ss, 16); ss += __shfl_xor(ss, 32); if (fq == 0) ssqp[(size_t)r * 16 + (c0 >> 6)] = ss; }
    }
};
struct EpiProj {
    static constexpr bool PERM = true, AFTER_DRAIN = false, INIT = false; static constexpr int MIDT = 0, EPI_VM = 16;
    const float* ssqp; unsigned char* ws; float* out; const float *qn, *kn, *lbl; LAS unsigned char* tab;
    __device__ __forceinline__ void operator()(const f32x4 (&acc)[2][2][4][2], const Unit& u, int wr, int wc, int fr, int fq) const {
        const int pn = u.pn, row0 = u.pm * 256 + wr * 64 + fr, pc = wc * 32 + 8 * fq;
        bf16_t* const Q = (bf16_t*)(ws + WS_Q); bf16_t* const KV = (bf16_t*)(ws + WS_KV); unsigned short* const LOGF = (unsigned short*)(ws + WS_LOGF);
        if (pn < 3) {
            const bool isv = (pn == 2 && wc >= 2);
            const float* gp = (pn < 2) ? qn : kn;
            f32x4 gn[2][2];
#pragma unroll
            for (int bj = 0; bj < 2; ++bj)
#pragma unroll
                for (int n = 0; n < 2; ++n) gn[bj][n] = isv ? (f32x4){1.f, 1.f, 1.f, 1.f} : *(const f32x4*)(gp + 32 * bj + 8 * fq + 4 * n);
#pragma unroll
            for (int ai = 0; ai < 2; ++ai)
#pragma unroll
                for (int m = 0; m < 4; ++m) {
                    const int r = row0 + ai * 128 + m * 16; const float s = u.idx < 6 ? *(const LAS float*)(tab + (u.idx * 256 + (r & 255)) * 4) : row_rstd16(ssqp, r);
                    f32x4 v[2][2]; float ss = 0.f;
#pragma unroll
                    for (int bj = 0; bj < 2; ++bj)
#pragma unroll
                        for (int n = 0; n < 2; ++n) { v[bj][n] = acc[ai][bj][m][n] * s; ss += dot4(v[bj][n]); }
                    ss += __shfl_xor(ss, 16); ss += __shfl_xor(ss, 32);
                    const float nr = isv ? 1.f : rsqrtf(ss * (1.f / 64.f) + EPS);
#pragma unroll
                    for (int bj = 0; bj < 2; ++bj)
#pragma unroll
                        for (int n = 0; n < 2; ++n) v[bj][n] = v[bj][n] * nr * gn[bj][n];
                    bf16_t* dst = (pn < 2) ? Q + (size_t)r * 512 + (4 * pn + wc) * 64 + 8 * fq : KV + (size_t)r * 256 + wc * 64 + 8 * fq;
#pragma unroll
                    for (int bj = 0; bj < 2; ++bj) *(u32x4*)(dst + 32 * bj) = pack8(v[bj][0], v[bj][1]);
                    if (pn == 2) {
                        float* o = nullptr; const int kvh = wc & 1;
                        if (r < MP) { const int t = r & 4095; if (t >= 3968) o = out + (wc < 2 ? O_PWK : O_PWV) + ((size_t)((r >> 12) * 128 + (t - 3968)) * 2 + kvh) * 64; }
                        else { const int rr = r - MP; o = out + (wc < 2 ? O_SWK : O_SWV) + ((size_t)((rr >> 3) * 128 + 120 + (rr & 7)) * 2 + kvh) * 64; }
                        if (o) {
#pragma unroll
                            for (int bj = 0; bj < 2; ++bj)
#pragma unroll
                                for (int n = 0; n < 2; ++n) *(f32x4*)(o + 32 * bj + 8 * fq + 4 * n) = v[bj][n];
                        }
                    }
                }
        } else if (pn >= 5 && pn < 7) {
            const int tc = (pn - 5) * 256 + pc;
            f32x4 lb[2][2];
#pragma unroll
            for (int bj = 0; bj < 2; ++bj)
#pragma unroll
                for (int n = 0; n < 2; ++n) { const f32x4 l0 = *(const f32x4*)(lbl + tc + 128 * bj + 4 * n), l1 = *(const f32x4*)(lbl + 512 + tc + 128 * bj + 4 * n);
#pragma unroll
                    for (int e = 0; e < 4; ++e) lb[bj][n][e] = 1.f / (1.f + __expf(l1[e] - l0[e])); }
#pragma unroll
            for (int ai = 0; ai < 2; ++ai)
#pragma unroll
                for (int m = 0; m < 4; ++m) {
                    const int r = row0 + ai * 128 + m * 16; const float s = u.idx < 6 ? *(const LAS float*)(tab + (u.idx * 256 + (r & 255)) * 4) : row_rstd16(ssqp, r);
#pragma unroll
                    for (int bj = 0; bj < 2; ++bj)
#pragma unroll
                        for (int n = 0; n < 2; ++n) { f32x4 lf;
#pragma unroll
                            for (int e = 0; e < 4; ++e) { const float f = lb[bj][n][e] + (1.f - lb[bj][n][e]) * fsigmoid(acc[ai][bj][m][n][e] * s); lf[e] = f; }
                            u32x2 w; w.x = q16(lf[0]) | (q16(lf[1]) << 16); w.y = q16(lf[2]) | (q16(lf[3]) << 16);
                            *(u32x2*)(LOGF + (size_t)r * 512 + tc + 128 * bj + 4 * n) = w; }
                }
        } else {
            int act, ld, tc; size_t boff;
            if (pn < 5) { act = 1; boff = WS_QR; ld = 512; tc = (pn - 3) * 256 + pc; }
            else if (pn < 9) { act = 0; boff = WS_IR; ld = 512; tc = (pn - 7) * 256 + pc; }
            else if (pn < 11) { act = 1; boff = WS_GR; ld = 512; tc = (pn - 9) * 256 + pc; }
            else if (pn < 15) { act = 2; boff = WS_SGA; ld = 1024; tc = (pn - 11) * 256 + pc; }
            else { act = 2; boff = WS_SGR; ld = 1024; tc = (pn - 15) * 256 + pc; }
            bf16_t* const base = (bf16_t*)(ws + boff);
#pragma unroll
            for (int ai = 0; ai < 2; ++ai)
#pragma unroll
                for (int m = 0; m < 4; ++m) {
                    const int r = row0 + ai * 128 + m * 16; const float s = u.idx < 6 ? *(const LAS float*)(tab + (u.idx * 256 + (r & 255)) * 4) : row_rstd16(ssqp, r);
#pragma unroll
                    for (int bj = 0; bj < 2; ++bj) { f32x4 a, b;
#pragma unroll
                        for (int e = 0; e < 4; ++e) { const float x0 = acc[ai][bj][m][0][e] * s, x1 = acc[ai][bj][m][1][e] * s;
                            a[e] = act == 0 ? x0 : (act == 1 ? fsilu(x0) : fsigmoid(x0)); b[e] = act == 0 ? x1 : (act == 1 ? fsilu(x1) : fsigmoid(x1)); }
                        if (act == 2) { u32x2 w; w.x = pack4q8(a); w.y = pack4q8(b); *(u32x2*)((unsigned char*)base + (size_t)r * ld + tc + 128 * bj) = w; }
                        else *(u32x4*)(base + (size_t)r * ld + tc + 128 * bj) = pack8(a, b); }
                }
        }
    }
};
struct ProjOrder {
    pg8::StaticOrder P; int G, c;
    __device__ void init(int G_, int c_) { P.init(MP, INW, G_, c_); G = G_; c = c_; }
    __device__ bool next(int i, Unit& u) const {
        if (P.next(i, u)) return true;
        const long L = (long)i * G + c - 1216; if (L >= 64) return false;
        const int q = (int)L & 15; u.pm = 64 + ((int)L >> 4); u.pn = q < 11 ? q : q + 3; u.idx = i; return true;
    }
    __device__ __forceinline__ void a_ready(const Unit&) const {}
    __device__ __forceinline__ void done(const Unit&) const {}
};
struct EpiProjTail {
    static constexpr int MIDT = 0, EPI_VM = 0;
    const float* ssqp; bf16_t* SGA;
    __device__ __forceinline__ void tail(const f32x4 (&acc)[4], int r, int c0, int fq) const {
        const float s = row_rstd16(ssqp, r);
#pragma unroll
        for (int n = 0; n < 4; ++n) { f32x4 a;
#pragma unroll
            for (int e = 0; e < 4; ++e) a[e] = fsigmoid(acc[n][e] * s);
            *(unsigned*)((unsigned char*)SGA + (size_t)r * 1024 + c0 + 16 * n + 4 * fq) = pack4q8(a); }
    }
};
template <int PASS> struct EpiUp {
    static constexpr bool PERM = true, AFTER_DRAIN = false, INIT = false; static constexpr int MIDT = 0, EPI_VM = 0;
    bf16_t* MRG; const bf16_t* G;
    __device__ __forceinline__ void operator()(const f32x4 (&acc)[2][2][4][2], const Unit& u, int wr, int wc, int fr, int fq) const {
        const int row0 = u.pm * 256 + wr * 64 + fr, c0 = u.pn * 256 + wc * 32 + 8 * fq;
#pragma unroll
        for (int ai = 0; ai < 2; ++ai)
#pragma unroll
            for (int m = 0; m < 4; ++m) {
                const int r = row0 + ai * 128 + m * 16;
#pragma unroll
                for (int bj = 0; bj < 2; ++bj) {
                    const size_t off = (size_t)r * 1024 + c0 + 128 * bj; const u32x2 g = *(const u32x2*)((const unsigned char*)G + off); const f32x4 ga = unpack4q8(g.x), gb = unpack4q8(g.y);
                    f32x4 a = acc[ai][bj][m][0], b = acc[ai][bj][m][1];
                    a = a * ga; b = b * gb;
                    if (PASS == 1) { const u32x4 p = *(const u32x4*)(MRG + off);
                        a[0] += bflo(p.x); a[1] += bfhi(p.x); a[2] += bflo(p.y); a[3] += bfhi(p.y); b[0] += bflo(p.z); b[1] += bfhi(p.z); b[2] += bflo(p.w); b[3] += bfhi(p.w); }
                    *(u32x4*)(MRG + off) = pack8(a, b);
                }
            }
    }
    __device__ __forceinline__ void tail(const f32x4 (&acc)[4], int r, int c0, int fq) const {
#pragma unroll
        for (int n = 0; n < 4; ++n) {
            const size_t off = (size_t)r * 1024 + c0 + 16 * n + 4 * fq; const f32x4 gq = unpack4q8(*(const unsigned*)((const unsigned char*)G + off));
            f32x4 a = acc[n] * gq;
            if (PASS == 1) { const u32x2 p = *(const u32x2*)(MRG + off); a[0] += bflo(p.x); a[1] += bfhi(p.x); a[2] += bflo(p.y); a[3] += bfhi(p.y); }
            u32x2 w; w.x = cvt_pk_bf16(a[0], a[1]); w.y = cvt_pk_bf16(a[2], a[3]); *(u32x2*)(MRG + off) = w;
        }
    }
};
struct EpiUpR {
    static constexpr bool PERM = true, AFTER_DRAIN = false, INIT = false; static constexpr int MIDT = 8, EPI_VM = 0;
    static constexpr float EPSQ = 1e-18f;
    bf16_t* MRG; const unsigned char* GA; const unsigned char* GR;
    static __device__ __forceinline__ f32x4 q4(unsigned w) { return (f32x4){(float)(w & 0xffu), (float)((w >> 8) & 0xffu), (float)((w >> 16) & 0xffu), (float)(w >> 24)}; }
    static __device__ __forceinline__ f32x4 ratio4(unsigned wa, unsigned wr_) { const f32x4 a = q4(wa), r = q4(wr_);
        return (f32x4){a[0] * __builtin_amdgcn_rcpf(fmaxf(r[0], EPSQ)), a[1] * __builtin_amdgcn_rcpf(fmaxf(r[1], EPSQ)), a[2] * __builtin_amdgcn_rcpf(fmaxf(r[2], EPSQ)), a[3] * __builtin_amdgcn_rcpf(fmaxf(r[3], EPSQ))}; }
    static __device__ __forceinline__ f32x4 gate4(unsigned wr_) { const f32x4 r = q4(wr_); return (f32x4){fmaxf(r[0], EPSQ), fmaxf(r[1], EPSQ), fmaxf(r[2], EPSQ), fmaxf(r[3], EPSQ)} * (1.f / 255.f); }
    __device__ __forceinline__ void mid(f32x4 (&acc)[2][2][4][2], const Unit& u, int wr, int wc, int fr, int fq) const {
        const int row0 = u.pm * 256 + wr * 64 + fr, c0 = u.pn * 256 + wc * 32 + 8 * fq;
#pragma unroll
        for (int ai = 0; ai < 2; ++ai)
#pragma unroll
            for (int m = 0; m < 4; ++m) {
                const int r = row0 + ai * 128 + m * 16;
#pragma unroll
                for (int bj = 0; bj < 2; ++bj) {
                    const size_t off = (size_t)r * 1024 + c0 + 128 * bj; const u32x2 ga = *(const u32x2*)(GA + off), gr = *(const u32x2*)(GR + off);
                    acc[ai][bj][m][0] = acc[ai][bj][m][0] * ratio4(ga.x, gr.x); acc[ai][bj][m][1] = acc[ai][bj][m][1] * ratio4(ga.y, gr.y);
                }
                if (m == 1 || m == 3) __builtin_amdgcn_sched_barrier(0);
            }
    }
    __device__ __forceinline__ void operator()(const f32x4 (&acc)[2][2][4][2], const Unit& u, int wr, int wc, int fr, int fq) const {
        const int row0 = u.pm * 256 + wr * 64 + fr, c0 = u.pn * 256 + wc * 32 + 8 * fq;
#pragma unroll
        for (int ai = 0; ai < 2; ++ai)
#pragma unroll
            for (int m = 0; m < 4; ++m) {
                const int r = row0 + ai * 128 + m * 16;
#pragma unroll
                for (int bj = 0; bj < 2; ++bj) {
                    const size_t off = (size_t)r * 1024 + c0 + 128 * bj; const u32x2 gr = *(const u32x2*)(GR + off);
                    *(u32x4*)(MRG + off) = pack8(acc[ai][bj][m][0] * gate4(gr.x), acc[ai][bj][m][1] * gate4(gr.y));
                }
            }
    }
    __device__ __forceinline__ void mid_tail(f32x4 (&acc)[4], int r, int c0, int fq) const {
#pragma unroll
        for (int n = 0; n < 4; ++n) { const size_t off = (size_t)r * 1024 + c0 + 16 * n + 4 * fq; acc[n] = acc[n] * ratio4(*(const unsigned*)(GA + off), *(const unsigned*)(GR + off)); }
    }
    __device__ __forceinline__ void tail(const f32x4 (&acc)[4], int r, int c0, int fq) const {
#pragma unroll
        for (int n = 0; n < 4; ++n) { const size_t off = (size_t)r * 1024 + c0 + 16 * n + 4 * fq; const f32x4 a = acc[n] * gate4(*(const unsigned*)(GR + off));
            u32x2 w; w.x = cvt_pk_bf16(a[0], a[1]); w.y = cvt_pk_bf16(a[2], a[3]); *(u32x2*)(MRG + off) = w; }
    }
};
template <class Epi> __device__ __forceinline__ void gemm_tail(LAS unsigned char* L, const bf16_t* A, const bf16_t* Bt, int K, int row_base, int ntr, int ntc, int v, int G, const Epi& E, int tid, int lane, int wave) {
    constexpr int RS = 528, OPB = 64 * RS, BUF = 2 * OPB, XCH = 0;
    static_assert(2 * BUF <= LDSCTL_OFF, "tail buffers must stay below the LDS control words");
    const int fr = lane & 15, fq = lane >> 4, rw = wave & 3, kh = wave >> 2, nc = K / 256;
    const int lrow = tid >> 5, lch = tid & 31;
    for (int tt = v; tt < ntr * ntc; tt += G) {
        int tr = tt / ntc, tc = tt % ntc;
        if (ntr == 16 && ntc == 16 && G == 256) { const int x = tt >> 5, q = tt & 31; tr = (x >> 1) * 4 + (q >> 3); tc = (x & 1) * 8 + (q & 7); }
        const int r0 = row_base + 64 * tr, c0 = 64 * tc;
        const bf16_t* Ag = A + (size_t)(r0 + lrow) * K + 8 * lch; const bf16_t* Bg = Bt + (size_t)(c0 + lrow) * K + 8 * lch; const size_t h16 = (size_t)16 * K;
        u32x4 ra0[4], rb0[4], ra1[4], rb1[4], ra2[4], rb2[4];
#define TL_LOAD(ra, rb, c) do { _Pragma("unroll") for (int j_ = 0; j_ < 4; ++j_) { ra[j_] = *(const u32x4*)(Ag + j_ * h16 + 256 * (c)); rb[j_] = *(const u32x4*)(Bg + j_ * h16 + 256 * (c)); } } while (0)
#define TL_WRITE(ra, rb, b) do { LAS unsigned char* p_ = L + (b) * BUF + lrow * RS + lch * 16; _Pragma("unroll") for (int j_ = 0; j_ < 4; ++j_) { *(LAS u32x4*)(p_ + j_ * 16 * RS) = ra[j_]; *(LAS u32x4*)(p_ + OPB + j_ * 16 * RS) = rb[j_]; } } while (0)
#define TL_COMP(b) do { _Pragma("unroll") for (int i_ = 0; i_ < 4; ++i_) { const int ko_ = (32 * (4 * kh + i_) + 8 * fq) * 2; \
            const pg8::bf16x8 a_ = *(const LAS pg8::bf16x8*)(L + (b) * BUF + (16 * rw + fr) * RS + ko_); \
            _Pragma("unroll") for (int n = 0; n < 4; ++n) { const pg8::bf16x8 b_ = *(const LAS pg8::bf16x8*)(L + (b) * BUF + OPB + (16 * n + fr) * RS + ko_); acc[n] = __builtin_amdgcn_mfma_f32_16x16x32_bf16(b_, a_, acc[n], 0, 0, 0); } } } while (0)
#define TL_STEP(ra, rb, rna, rnb, b, cc) do { if ((cc) < nc) { if ((cc) + 1 < nc) TL_WRITE(rna, rnb, (b) ^ 1); if constexpr (Epi::MIDT > 0) { if ((cc) == Epi::MIDT / 4) E.mid_tail(acc, r0 + 16 * rw + fr, c0, fq); } TL_COMP(b); if ((cc) + 3 < nc) TL_LOAD(ra, rb, (cc) + 3); __syncthreads(); } } while (0)
        f32x4 acc[4];
#pragma unroll
        for (int n = 0; n < 4; ++n) acc[n] = (f32x4){0.f, 0.f, 0.f, 0.f};
        TL_LOAD(ra0, rb0, 0); if (1 < nc) TL_LOAD(ra1, rb1, 1); if (2 < nc) TL_LOAD(ra2, rb2, 2);
        TL_WRITE(ra0, rb0, 0); __syncthreads();
#pragma unroll 1
        for (int c = 0; c < nc; c += 6) { TL_STEP(ra0, rb0, ra1, rb1, 0, c); TL_STEP(ra1, rb1, ra2, rb2, 1, c + 1); TL_STEP(ra2, rb2, ra0, rb0, 0, c + 2); TL_STEP(ra0, rb0, ra1, rb1, 1, c + 3); TL_STEP(ra1, rb1, ra2, rb2, 0, c + 4); TL_STEP(ra2, rb2, ra0, rb0, 1, c + 5); }
#undef TL_STEP
#undef TL_LOAD
#undef TL_WRITE
#undef TL_COMP
        if (kh == 1) {
#pragma unroll
            for (int n = 0; n < 4; ++n) *(LAS f32x4*)(L + XCH + ((rw * 4 + n) * 64 + lane) * 16) = acc[n];
        }
        __syncthreads();
        if (kh == 0) {
#pragma unroll
            for (int n = 0; n < 4; ++n) acc[n] += *(const LAS f32x4*)(L + XCH + ((rw * 4 + n) * 64 + lane) * 16);
            E.tail(acc, r0 + 16 * rw + fr, c0, fq);
        }
        __syncthreads();
    }
}
__device__ __forceinline__ float wave_sum(float v) {
#pragma unroll
    for (int o = 1; o < 64; o <<= 1) v += __shfl_xor(v, o);
    return v;
}
struct WI { const float* W; const float* gain; bf16_t* WT; int ldw, K, dr, sc, k0; };
__device__ __forceinline__ void wi_set(WI& w, int kind, const float* W, const float* W2, int ldw, int K, bf16_t* WT, int nrg, const float* gain, int it) {
    const int kb = it / nrg, rg = it % nrg, p0 = rg * 32; int sc = p0; const float* Ws = W;
    if (kind == 1) { if ((p0 & 255) >> 7) Ws = W2; sc = 128 * (p0 >> 8) + (p0 & 127); }
    else if (kind == 2) { const int tile = p0 >> 8; if (tile < 3) sc = 256 * tile + 64 * ((p0 & 127) >> 5) + 32 * ((p0 & 255) >> 7); }
    w.W = Ws; w.gain = gain; w.WT = WT; w.ldw = ldw; w.K = K; w.dr = p0; w.sc = sc; w.k0 = 64 * kb;
}
__device__ __forceinline__ void wi_load(const WI& w, f32x4 (&r)[8], int lane) {
    const int lr = lane >> 3, lc4 = (lane & 7) * 4;
#pragma unroll
    for (int i = 0; i < 8; ++i) r[i] = __builtin_nontemporal_load((const GAS f32x4*)(w.W + (size_t)(w.k0 + 8 * i + lr) * w.ldw + w.sc + lc4));
}
__device__ __forceinline__ void wi_proc(const WI& w, const f32x4 (&r)[8], LAS float* scr, int lane) {
    const int lr = lane >> 3, lc4 = (lane & 7) * 4;
#pragma unroll
    for (int i = 0; i < 8; ++i) { const int kk = 8 * i + lr; const float gsc = w.gain ? w.gain[w.k0 + kk] : 1.f;
        scr[kk * 33 + lc4 + 0] = r[i][0] * gsc; scr[kk * 33 + lc4 + 1] = r[i][1] * gsc; scr[kk * 33 + lc4 + 2] = r[i][2] * gsc; scr[kk * 33 + lc4 + 3] = r[i][3] * gsc; }
    LDS_WAIT(); asm volatile("" ::: "memory");
    const int c = lane & 7;
#pragma unroll
    for (int j = 0; j < 4; ++j) { const int n = (lane >> 3) + 8 * j; const LAS float* s = scr + (8 * c) * 33 + n;
        v4u o; o.x = pk2(s[0 * 33], s[1 * 33]); o.y = pk2(s[2 * 33], s[3 * 33]); o.z = pk2(s[4 * 33], s[5 * 33]); o.w = pk2(s[6 * 33], s[7 * 33]);
        *(GAS v4u*)(w.WT + (size_t)(w.dr + n) * w.K + w.k0 + 8 * c) = o; }
    LDS_WAIT(); asm volatile("" ::: "memory");
}
}


namespace at {
using pg8::bf16_t; using pg8::bf16x8; using pg8::u32x4; using pg8::cvt_pk_bf16;
typedef float f32x16 __attribute__((ext_vector_type(16)));
typedef short v4i16_t __attribute__((ext_vector_type(4)));
typedef unsigned u32x2 __attribute__((ext_vector_type(2)));
constexpr int KS_OFF = 0, VS_OFF = 46080, LUT_OFF = 87040, KROW = 144;
__device__ const unsigned char T5LUT[129] = {0, 1, 2, 3, 4, 5, 6, 7, 8, 9, 10, 11, 12, 13, 14, 15, 16, 16, 16, 17, 17, 18, 18, 18, 19, 19, 19, 20, 20, 20, 20, 21, 21, 21, 21, 22, 22, 22, 22, 22, 23, 23, 23, 23, 23, 23, 24, 24, 24, 24, 24, 24, 25, 25, 25, 25, 25, 25, 25, 26, 26, 26, 26, 26, 26, 26, 26, 27, 27, 27, 27, 27, 27, 27, 27, 27, 27, 28, 28, 28, 28, 28, 28, 28, 28, 28, 28, 29, 29, 29, 29, 29, 29, 29, 29, 29, 29, 29, 29, 30, 30, 30, 30, 30, 30, 30, 30, 30, 30, 30, 30, 30, 30, 31, 31, 31, 31, 31, 31, 31, 31, 31, 31, 31, 31, 31, 31, 31, 31};
__device__ __forceinline__ v4i16_t trr(LAS const unsigned char* p) { return __builtin_amdgcn_ds_read_tr16_b64_v4i16((LAS v4i16_t*)p); }
__device__ __forceinline__ void attn_wave(const bf16x8 (&qf)[4], LAS const unsigned char* Kt, LAS const unsigned char* Vt, int vdh, LAS const float* lut, float sink, int iq, int jmin, int kb0, int lane, f32x16 (&o)[2]) {
    const int ql = lane & 31, h = lane >> 5;
    f32x16 acc[5];
#pragma unroll
    for (int kb = 0; kb < 5; ++kb) {
        acc[kb] = (f32x16){};
        LAS const unsigned char* kp = Kt + (32 * (kb0 + kb) + ql) * KROW + 16 * h;
#pragma unroll
        for (int ds = 0; ds < 4; ++ds) { const bf16x8 a = *(LAS const bf16x8*)(kp + 32 * ds); acc[kb] = __builtin_amdgcn_mfma_f32_32x32x16_bf16(a, qf[ds], acc[kb], 0, 0, 0); }
    }
    const int base = iq + 128 - 4 * h - 32 * kb0, dmax0 = iq + 128 - jmin; const unsigned dmax = (unsigned)(dmax0 < 128 ? dmax0 : 128);
    const float sink2 = sink * 1.4426950408889634f; float mx = sink2;
#pragma unroll
    for (int kb = 0; kb < 5; ++kb)
#pragma unroll
        for (int r = 0; r < 16; ++r) {
            const int dist = base - (32 * kb + (r & 3) + 8 * (r >> 2));
            const float s = ((unsigned)dist <= dmax) ? __builtin_fmaf(acc[kb][r], 0.125f * 1.4426950408889634f, lut[dist]) : -INFINITY;
            acc[kb][r] = s; mx = fmaxf(mx, s);
        }
    mx = fmaxf(mx, __shfl_xor(mx, 32));
    float l = 0.f;
#pragma unroll
    for (int kb = 0; kb < 5; ++kb)
#pragma unroll
        for (int r = 0; r < 16; ++r) { const float p = __builtin_amdgcn_exp2f(acc[kb][r] - mx); acc[kb][r] = p; l += p; }
    l += __shfl_xor(l, 32);
    l += __builtin_amdgcn_exp2f(sink2 - mx);
    const float inv = 1.f / l;
    o[0] = (f32x16){}; o[1] = (f32x16){};
    const int g16 = (lane >> 4) & 1, q4 = (lane & 15) >> 2, p4 = lane & 3;
#pragma unroll
    for (int kb = 0; kb < 5; ++kb)
#pragma unroll
        for (int s2 = 0; s2 < 2; ++s2) {
            u32x4 pw; pw.x = cvt_pk_bf16(acc[kb][8 * s2 + 0], acc[kb][8 * s2 + 1]); pw.y = cvt_pk_bf16(acc[kb][8 * s2 + 2], acc[kb][8 * s2 + 3]);
            pw.z = cvt_pk_bf16(acc[kb][8 * s2 + 4], acc[kb][8 * s2 + 5]); pw.w = cvt_pk_bf16(acc[kb][8 * s2 + 6], acc[kb][8 * s2 + 7]);
            const bf16x8 pf = __builtin_bit_cast(bf16x8, pw);
            const int key = 32 * (kb0 + kb) + 16 * s2 + 4 * h + q4;
#pragma unroll
            for (int db = 0; db < 2; ++db) {
                LAS const unsigned char* vp = Vt + db * vdh + key * 64 + (16 * g16 + 4 * p4) * 2;
                const v4i16_t lo = trr(vp), hi = trr(vp + 8 * 64);
                const bf16x8 a = (bf16x8){lo[0], lo[1], lo[2], lo[3], hi[0], hi[1], hi[2], hi[3]};
                o[db] = __builtin_amdgcn_mfma_f32_32x32x16_bf16(a, pf, o[db], 0, 0, 0);
            }
        }
#pragma unroll
    for (int db = 0; db < 2; ++db)
#pragma unroll
        for (int r = 0; r < 16; ++r) o[db][r] *= inv;
}
__device__ __forceinline__ void attn_store(bf16_t* dst, const f32x16 (&o)[2], int h) {
#pragma unroll
    for (int db = 0; db < 2; ++db)
#pragma unroll
        for (int rg = 0; rg < 4; ++rg) { u32x2 w; w.x = cvt_pk_bf16(o[db][4 * rg + 0], o[db][4 * rg + 1]); w.y = cvt_pk_bf16(o[db][4 * rg + 2], o[db][4 * rg + 3]);
            *(u32x2*)(dst + 32 * db + 8 * rg + 4 * h) = w; }
}
__device__ __forceinline__ void attn_prompt_task(LAS unsigned char* L, const bf16_t* Q, bf16_t* AOR, const bf16_t* KV, const float* table, const float* sinks, int b, int n, int kvh, int tid, int lane, int wave) {
    const int m0 = b * 4096 + 128 * n;
    for (int c = tid; c < 2048; c += 512) {
        const int j = c >> 3, ch = c & 7; u32x4 kx = (u32x4){0u, 0u, 0u, 0u}, vx = kx;
        if (n > 0 || j >= 128) { const bf16_t* src = KV + (size_t)(m0 - 128 + j) * 256 + kvh * 64 + 8 * ch; kx = *(const u32x4*)src; vx = *(const u32x4*)(src + 128); }
        *(LAS u32x4*)(L + KS_OFF + j * KROW + 16 * ch) = kx;
        *(LAS u32x4*)(L + VS_OFF + (ch >> 2) * 16384 + j * 64 + (ch & 3) * 16) = vx;
    }
    for (int e = tid; e < 4 * 129; e += 512) { const int hl = e / 129, d = e % 129; ((LAS float*)(L + LUT_OFF))[hl * 132 + d] = table[T5LUT[d] * 8 + 4 * kvh + hl] * 1.4426950408889634f; }
    __syncthreads();
    const int ql = lane & 31, h = lane >> 5, hl = wave & 3, head = 4 * kvh + hl;
    const float sink = sinks[head];
#pragma unroll 1
    for (int rep = 0; rep < 2; ++rep) {
        const int qb = (wave >> 2) + 2 * rep, iq = 32 * qb + ql;
        const bf16_t* qp = Q + (size_t)(m0 + iq) * 512 + head * 64;
        bf16x8 qf[4];
#pragma unroll
        for (int ds = 0; ds < 4; ++ds) qf[ds] = *(const bf16x8*)(qp + 16 * ds + 8 * h);
        f32x16 o[2];
        attn_wave(qf, L + KS_OFF, L + VS_OFF, 16384, (LAS const float*)(L + LUT_OFF) + hl * 132, sink, iq, n == 0 ? 128 : 0, qb, lane, o);
        attn_store(AOR + (size_t)(m0 + iq) * 1024 + head * 64, o, h);
    }
    __syncthreads();
}
__device__ __forceinline__ void attn_sample_task(LAS unsigned char* L, const bf16_t* Q, bf16_t* AOR, const bf16_t* KV, const float* wk, const float* wv, const float* table, const float* sinks, int bd, int kvh, int tid, int lane, int wave) {
    for (int c = tid; c < 1280; c += 512) {
        const int j = c >> 3, ch = c & 7; u32x4 kx = (u32x4){0u, 0u, 0u, 0u}, vx = kx;
        if (j < 128) {
            const size_t so = ((size_t)(bd * 128 + j) * 2 + kvh) * 64 + 8 * ch;
            const f32x4 k0 = *(const f32x4*)(wk + so), k1 = *(const f32x4*)(wk + so + 4), v0 = *(const f32x4*)(wv + so), v1 = *(const f32x4*)(wv + so + 4);
            kx = mk::pack8(k0, k1); vx = mk::pack8(v0, v1);
        } else if (j < 136) { const bf16_t* src = KV + (size_t)(MP + bd * 8 + (j - 128)) * 256 + kvh * 64 + 8 * ch; kx = *(const u32x4*)src; vx = *(const u32x4*)(src + 128); }
        *(LAS u32x4*)(L + KS_OFF + j * KROW + 16 * ch) = kx;
        *(LAS u32x4*)(L + VS_OFF + (ch >> 2) * 10240 + j * 64 + (ch & 3) * 16) = vx;
    }
    for (int e = tid; e < 4 * 129; e += 512) { const int hl = e / 129, d = e % 129; ((LAS float*)(L + LUT_OFF))[hl * 132 + d] = table[T5LUT[d] * 8 + 4 * kvh + hl] * 1.4426950408889634f; }
    __syncthreads();
    if (wave == 0) {
        const int ql = lane & 31, h = lane >> 5, hl = ql >> 3, iq = ql & 7, head = 4 * kvh + hl;
        const bf16_t* qp = Q + (size_t)(MP + bd * 8 + iq) * 512 + head * 64;
        bf16x8 qf[4];
#pragma unroll
        for (int ds = 0; ds < 4; ++ds) qf[ds] = *(const bf16x8*)(qp + 16 * ds + 8 * h);
        f32x16 o[2];
        attn_wave(qf, L + KS_OFF, L + VS_OFF, 10240, (LAS const float*)(L + LUT_OFF) + hl * 132, sinks[head], iq, 0, 0, lane, o);
        attn_store(AOR + (size_t)(MP + bd * 8 + iq) * 1024 + head * 64, o, h);
    }
    __syncthreads();
}
}

namespace hg {
using pg8::bf16_t; using pg8::bf16x8; using pg8::f32x4; using pg8::u32x4; using pg8::cvt_pk_bf16;
typedef short v4i16_t __attribute__((ext_vector_type(4)));
typedef unsigned u32x2 __attribute__((ext_vector_type(2)));
__device__ __forceinline__ v4i16_t trr(LAS const unsigned char* p) { return __builtin_amdgcn_ds_read_tr16_b64_v4i16((LAS v4i16_t*)p); }
constexpr int TS = 288;
constexpr float FQ = 1.f / 65535.f;
struct HaPre { unsigned short lf[16]; u32x4 vch[2]; };
__device__ __forceinline__ void ha_issue(HaPre& P, const unsigned short* LOGF, const bf16_t* IR, int task, int tid) {
    const int bh = task >> 6, c = task & 63, h = bh & 3; const size_t m0 = (size_t)(bh >> 2) * 4096 + 64 * c; const int kd = tid & 127, seg = tid >> 7;
#pragma unroll
    for (int i = 0; i < 16; ++i) P.lf[i] = LOGF[(m0 + 16 * seg + i) * 512 + h * 128 + kd];
#pragma unroll
    for (int q = 0; q < 2; ++q) { const int cid = tid + 512 * q, t = cid >> 4, ch = cid & 15; P.vch[q] = *(const u32x4*)(IR + (m0 + t) * 512 + h * 128 + 8 * ch); }
}
__device__ __forceinline__ void ha_phase(LAS unsigned char* L, HaPre& P, const unsigned short* LOGF, const bf16_t* IR, bf16_t* US, float* DEC, int v, int G, int tid, int lane, int wave) {
    constexpr int KT = 0, VT = 64 * TS, SEG = 2 * 64 * TS, DCS = SEG + 2048;
#pragma unroll 1
    for (int grp = v; grp < 256; grp += G) {
        const int kd = tid & 127, seg = tid >> 7, g = lane >> 4, q4 = (lane & 15) >> 2, p4 = lane & 3;
        f32x4 acc[8];
#pragma unroll
        for (int i = 0; i < 8; ++i) acc[i] = (f32x4){0.f, 0.f, 0.f, 0.f};
        float dg = 1.f;
#pragma unroll 1
        for (int cc = 0; cc < 4; ++cc) {
            float lf[16]; float run = 1.f;
#pragma unroll
            for (int i = 0; i < 16; ++i) { lf[i] = (float)P.lf[i] * FQ; run *= lf[i]; }
            ((LAS float*)(L + SEG))[seg * 128 + kd] = run;
#pragma unroll
            for (int q = 0; q < 2; ++q) { const int cid = tid + 512 * q, t = cid >> 4, ch = cid & 15; *(LAS u32x4*)(L + VT + t * TS + ch * 16) = P.vch[q]; }
            const int nxt = cc < 3 ? 4 * grp + cc + 1 : 4 * (grp + G);
            if (nxt < 1024) ha_issue(P, LOGF, IR, nxt, tid);
            __syncthreads();
            {
                const LAS float* sg = (const LAS float*)(L + SEG);
                const float s0 = sg[kd], s1 = sg[128 + kd], s2 = sg[256 + kd], s3 = sg[384 + kd];
                float suf = seg == 3 ? 1.f : (seg == 2 ? s3 : (seg == 1 ? s2 * s3 : s1 * (s2 * s3)));
#pragma unroll
                for (int i = 15; i >= 0; --i) { const float kt = (1.f - lf[i]) * suf; suf *= lf[i]; *(LAS bf16_t*)(L + KT + (16 * seg + i) * TS + kd * 2) = (bf16_t)cvt_pk_bf16(kt, 0.f); }
                const float dcv = (s0 * s1) * (s2 * s3); dg *= dcv;
                if (seg == 0) ((LAS float*)(L + DCS))[kd] = dcv;
            }
            __syncthreads();
            {
                bf16x8 bv[2];
#pragma unroll
                for (int ks = 0; ks < 2; ++ks) { LAS const unsigned char* vp = L + VT + (32 * ks + 4 * g + q4) * TS + (16 * wave + 4 * p4) * 2; const v4i16_t lo = trr(vp), hi = trr(vp + 16 * TS);
                    bv[ks] = (bf16x8){lo[0], lo[1], lo[2], lo[3], hi[0], hi[1], hi[2], hi[3]}; }
#pragma unroll
                for (int i = 0; i < 8; ++i) {
                    const f32x4 dc = *(const LAS f32x4*)(L + DCS + (16 * i + 4 * g) * 4);
                    acc[i] = acc[i] * dc;
#pragma unroll
                    for (int ks = 0; ks < 2; ++ks) { LAS const unsigned char* kp = L + KT + (32 * ks + 4 * g + q4) * TS + (16 * i + 4 * p4) * 2; const v4i16_t lo = trr(kp), hi = trr(kp + 16 * TS);
                        const bf16x8 a = (bf16x8){lo[0], lo[1], lo[2], lo[3], hi[0], hi[1], hi[2], hi[3]};
                        acc[i] = __builtin_amdgcn_mfma_f32_16x16x32_bf16(a, bv[ks], acc[i], 0, 0, 0); }
                }
            }
            __syncthreads();
        }
        const size_t ub = ((size_t)grp * 128 + 16 * wave + (lane & 15)) * 128 + 4 * g;
#pragma unroll
        for (int i = 0; i < 8; ++i) { u32x2 w; w.x = cvt_pk_bf16(acc[i][0], acc[i][1]); w.y = cvt_pk_bf16(acc[i][2], acc[i][3]); *(u32x2*)(US + ub + 16 * i) = w; }
        if (seg == 0) DEC[(size_t)grp * 128 + kd] = dg;
    }
}
__device__ __forceinline__ void hb_scan(unsigned* US32, const float* DEC, float* out_pst, int idx) {
    const int bh = idx >> 13, pair = idx & 8191, vd = pair >> 6, kd0 = (pair & 63) * 2;
    float s0 = 0.f, s1 = 0.f;
    unsigned* up = US32 + (size_t)bh * 16 * 8192 + pair; const float* dp = DEC + (size_t)bh * 16 * 128 + kd0;
#pragma unroll 1
    for (int c0 = 0; c0 < 16; c0 += 8) {
        unsigned w[8]; float d0[8], d1[8];
#pragma unroll
        for (int i = 0; i < 8; ++i) { w[i] = up[(size_t)(c0 + i) * 8192]; const float2 dd = *(const float2*)(dp + (c0 + i) * 128); d0[i] = dd.x; d1[i] = dd.y; }
#pragma unroll
        for (int i = 0; i < 8; ++i) { up[(size_t)(c0 + i) * 8192] = cvt_pk_bf16(s0, s1); s0 = d0[i] * s0 + mk::bflo(w[i]); s1 = d1[i] * s1 + mk::bfhi(w[i]); }
    }
    out_pst[((size_t)bh * 128 + kd0) * 128 + vd] = s0; out_pst[((size_t)bh * 128 + kd0 + 1) * 128 + vd] = s1;
}
struct HcPre { u32x2 lfc[4]; u32x4 qc[2], vch[2]; u32x2 st[8]; };
__device__ __forceinline__ void hc_issue_prompt(HcPre& P, const unsigned short* LOGF, const bf16_t* QR, const bf16_t* IR, const bf16_t* US, int task, bool st, int tid, int lane, int wave) {
    const int bh = task >> 6, c = task & 63, h = bh & 3; const size_t m0 = (size_t)(bh >> 2) * 4096 + 64 * c;
#pragma unroll
    for (int q = 0; q < 4; ++q) { const int cid = tid + 512 * q, t = cid >> 5, c4 = cid & 31; P.lfc[q] = *(const u32x2*)(LOGF + (m0 + t) * 512 + h * 128 + 4 * c4); }
#pragma unroll
    for (int q = 0; q < 2; ++q) { const int cid = tid + 512 * q, t = cid >> 4, ch = cid & 15; const size_t off = (m0 + t) * 512 + h * 128 + 8 * ch; P.qc[q] = *(const u32x4*)(QR + off); P.vch[q] = *(const u32x4*)(IR + off); }
    if (st) {
        const bf16_t* USt = US + (size_t)(task >> 2) * 16384; const int g = lane >> 4, vd = 16 * wave + (lane & 15);
#pragma unroll
        for (int i = 0; i < 8; ++i) P.st[i] = *(const u32x2*)(USt + (size_t)vd * 128 + 16 * i + 4 * g);
    }
}
__device__ __forceinline__ void hc_phase_prompt(LAS unsigned char* L, const unsigned short* LOGF, const bf16_t* QR, bf16_t* AOR, const bf16_t* IR, const bf16_t* GR, const float* hgn, const bf16_t* US, int v, int G, int tid, int lane, int wave) {
    constexpr int QH = 0, KH = 17408, KT = 34816, VT = 53248, AT = 71680, DECS = 73728, OT = 75776, QT = 109568, QS = 272, OS = 132, LFT = OT, LS = 528;
    const int g = lane >> 4, lc = lane & 15, q4 = lc >> 2, p4 = lane & 3, vd = 16 * wave + lc;
    const int et = tid >> 3, ec = (tid & 7) * 16;
    const f32x4 n0 = *(const f32x4*)(hgn + ec), n1 = *(const f32x4*)(hgn + ec + 4), n2 = *(const f32x4*)(hgn + ec + 8), n3 = *(const f32x4*)(hgn + ec + 12);
    HcPre P;
    if (v < 256) hc_issue_prompt(P, LOGF, QR, IR, US, 4 * v, true, tid, lane, wave);
    f32x4 sacc[8];
#pragma unroll
    for (int i = 0; i < 8; ++i) sacc[i] = (f32x4){0.f, 0.f, 0.f, 0.f};
#pragma unroll 1
    for (int grp = v; grp < 256; grp += G)
#pragma unroll 1
    for (int cc = 0; cc < 4; ++cc) {
        const int task = 4 * grp + cc;
        const int bh = task >> 6, c = task & 63, h = bh & 3; const size_t m0 = (size_t)(bh >> 2) * 4096 + 64 * c;
        if (cc == 0) {
#pragma unroll
            for (int i = 0; i < 8; ++i) sacc[i] = (f32x4){mk::bflo(P.st[i].x), mk::bfhi(P.st[i].x), mk::bflo(P.st[i].y), mk::bfhi(P.st[i].y)};
        }
#pragma unroll
        for (int q = 0; q < 4; ++q) { const int cid = tid + 512 * q, t = cid >> 5, c4 = cid & 31; const u32x2 w = P.lfc[q];
            *(LAS f32x4*)(L + LFT + t * LS + c4 * 16) = (f32x4){(float)(w.x & 0xffffu), (float)(w.x >> 16), (float)(w.y & 0xffffu), (float)(w.y >> 16)} * FQ; }
#pragma unroll
        for (int q = 0; q < 2; ++q) { const int cid = tid + 512 * q, t = cid >> 4, ch = cid & 15; *(LAS u32x4*)(L + QT + t * QS + ch * 16) = P.qc[q]; *(LAS u32x4*)(L + VT + t * TS + ch * 16) = P.vch[q]; }
        const size_t eoff = (m0 + et) * 512 + h * 128 + ec;
        const u32x4 g0 = *(const u32x4*)(GR + eoff), g1 = *(const u32x4*)(GR + eoff + 8);
        { const int nxt = cc < 3 ? task + 1 : 4 * (grp + G); if (nxt < 1024) hc_issue_prompt(P, LOGF, QR, IR, US, nxt, cc == 3, tid, lane, wave); }
        __syncthreads();
        {
            const int kd = tid & 127, sub = tid >> 7; float lf[16], pp[16]; float p = 1.f;
#pragma unroll
            for (int t = 0; t < 16; ++t) { lf[t] = *(const LAS float*)(L + LFT + (16 * sub + t) * LS + kd * 4); p *= lf[t]; pp[t] = p; }
            float suf = 1.f;
#pragma unroll
            for (int t = 15; t >= 0; --t) {
                const float kk = 1.f - lf[t]; const int ro = 16 * sub + t; const float qv = mk::bf2f(*(const LAS bf16_t*)(L + QT + ro * QS + kd * 2));
                *(LAS bf16_t*)(L + QH + ro * QS + kd * 2) = (bf16_t)cvt_pk_bf16(qv * pp[t], 0.f);
                *(LAS bf16_t*)(L + KH + ro * QS + kd * 2) = (bf16_t)cvt_pk_bf16(kk * __builtin_amdgcn_rcpf(fmaxf(pp[t], 1e-30f)), 0.f);
                *(LAS bf16_t*)(L + KT + ro * TS + kd * 2) = (bf16_t)cvt_pk_bf16(kk * suf, 0.f);
                suf *= lf[t];
            }
            *(LAS float*)(L + DECS + (sub * 128 + kd) * 4) = p;
        }
        __syncthreads();
        if (wave < 4) {
            f32x4 acc = (f32x4){0.f, 0.f, 0.f, 0.f};
#pragma unroll
            for (int ks = 0; ks < 4; ++ks) { const bf16x8 a = *(const LAS bf16x8*)(L + QH + (16 * wave + lc) * QS + (32 * ks + 8 * g) * 2), b = *(const LAS bf16x8*)(L + KH + (16 * wave + lc) * QS + (32 * ks + 8 * g) * 2);
                acc = __builtin_amdgcn_mfma_f32_16x16x32_bf16(a, b, acc, 0, 0, 0); }
#pragma unroll
            for (int e = 0; e < 4; ++e) { const int t = 4 * g + e; *(LAS bf16_t*)(L + AT + wave * 512 + t * 32 + lc * 2) = (bf16_t)cvt_pk_bf16(lc <= t ? acc[e] : 0.f, 0.f); }
        }
        __syncthreads();
#pragma unroll 1
        for (int sb = 0; sb < 4; ++sb) {
            f32x4 oacc = (f32x4){0.f, 0.f, 0.f, 0.f};
#pragma unroll
            for (int ks = 0; ks < 4; ++ks) {
                u32x4 bw; bw.x = cvt_pk_bf16(sacc[2 * ks][0], sacc[2 * ks][1]); bw.y = cvt_pk_bf16(sacc[2 * ks][2], sacc[2 * ks][3]); bw.z = cvt_pk_bf16(sacc[2 * ks + 1][0], sacc[2 * ks + 1][1]); bw.w = cvt_pk_bf16(sacc[2 * ks + 1][2], sacc[2 * ks + 1][3]);
                const u32x2 a0 = *(const LAS u32x2*)(L + QH + (16 * sb + lc) * QS + (32 * ks + 4 * g) * 2), a1 = *(const LAS u32x2*)(L + QH + (16 * sb + lc) * QS + (32 * ks + 16 + 4 * g) * 2);
                u32x4 aw; aw.x = a0.x; aw.y = a0.y; aw.z = a1.x; aw.w = a1.y;
                oacc = __builtin_amdgcn_mfma_f32_16x16x32_bf16(__builtin_bit_cast(bf16x8, aw), __builtin_bit_cast(bf16x8, bw), oacc, 0, 0, 0);
            }
            bf16x8 bv;
            { const v4i16_t lo = trr(L + VT + (16 * sb + 4 * g + q4) * TS + (16 * wave + 4 * p4) * 2); bv = (bf16x8){lo[0], lo[1], lo[2], lo[3], 0, 0, 0, 0}; }
            { const u32x2 a0 = *(const LAS u32x2*)(L + AT + sb * 512 + lc * 32 + 8 * g); u32x4 aw; aw.x = a0.x; aw.y = a0.y; aw.z = 0u; aw.w = 0u;
              oacc = __builtin_amdgcn_mfma_f32_16x16x32_bf16(__builtin_bit_cast(bf16x8, aw), bv, oacc, 0, 0, 0); }
#pragma unroll
            for (int e = 0; e < 4; ++e) *(LAS float*)(L + OT + ((16 * sb + 4 * g + e) * OS + vd) * 4) = oacc[e];
            if (sb < 3 || cc < 3) {
#pragma unroll
                for (int i = 0; i < 8; ++i) {
                    const f32x4 dc = *(const LAS f32x4*)(L + DECS + (sb * 128 + 16 * i + 4 * g) * 4);
                    const v4i16_t lo = trr(L + KT + (16 * sb + 4 * g + q4) * TS + (16 * i + 4 * p4) * 2);
                    const bf16x8 a = (bf16x8){lo[0], lo[1], lo[2], lo[3], 0, 0, 0, 0};
                    sacc[i] = __builtin_amdgcn_mfma_f32_16x16x32_bf16(a, bv, sacc[i] * dc, 0, 0, 0);
                }
            }
        }
        __syncthreads();
        {
            f32x4 x[4]; float ss = 0.f;
#pragma unroll
            for (int k = 0; k < 4; ++k) { x[k] = *(const LAS f32x4*)(L + OT + (et * OS + ec + 4 * k) * 4); ss += mk::dot4(x[k]); }
            ss += __shfl_xor(ss, 1); ss += __shfl_xor(ss, 2); ss += __shfl_xor(ss, 4);
            const float rs = rsqrtf(ss * (1.f / 128.f) + EPS);
            const f32x4 y0 = x[0] * rs * n0 * (f32x4){mk::bflo(g0.x), mk::bfhi(g0.x), mk::bflo(g0.y), mk::bfhi(g0.y)}, y1 = x[1] * rs * n1 * (f32x4){mk::bflo(g0.z), mk::bfhi(g0.z), mk::bflo(g0.w), mk::bfhi(g0.w)};
            const f32x4 y2 = x[2] * rs * n2 * (f32x4){mk::bflo(g1.x), mk::bfhi(g1.x), mk::bflo(g1.y), mk::bfhi(g1.y)}, y3 = x[3] * rs * n3 * (f32x4){mk::bflo(g1.z), mk::bfhi(g1.z), mk::bflo(g1.w), mk::bfhi(g1.w)};
            { bf16_t* op = AOR + (m0 + et) * 1024 + 512 + h * 128 + ec; *(u32x4*)op = mk::pack8(y0, y1); *(u32x4*)(op + 8) = mk::pack8(y2, y3); }
        }
        __syncthreads();
    }
}

struct HcPreS { f32x4 sreg[8]; unsigned short lf[8]; unsigned short qv[8]; u32x4 vch; };
__device__ __forceinline__ void hc_issue_sample(HcPreS& P, const unsigned short* LOGF, const bf16_t* QR, const bf16_t* IR, const float* S0, int id, int tid) {
    const int bd = id >> 2, h = id & 3; const size_t m0 = (size_t)MP + bd * 8; const float* s0 = S0 + (size_t)id * 16384;
#pragma unroll
    for (int q = 0; q < 8; ++q) { const int cid = tid + 512 * q; P.sreg[q] = __builtin_nontemporal_load((const f32x4*)(s0 + (size_t)cid * 4)); }
    if (tid < 128) {
#pragma unroll
        for (int t = 0; t < 8; ++t) { const size_t off = (m0 + t) * 512 + h * 128 + tid; P.lf[t] = LOGF[off]; P.qv[t] = QR[off]; }
        P.vch = *(const u32x4*)(IR + (m0 + (tid >> 4)) * 512 + h * 128 + 8 * (tid & 15));
    }
}
__device__ __forceinline__ void hc_phase_sample(LAS unsigned char* L, const unsigned short* LOGF, const bf16_t* QR, bf16_t* AOR, const bf16_t* IR, const bf16_t* GR, const float* hgn, const float* S0, float* Sout, HcPreS& P, int v, int G, int tid, int lane, int wave) {
    constexpr int QH = 0, KH = 4352, KT = 8704, VT = 13312, AT = 17920, DECS = 18432, OT = 18944, ST = 27392, QS = 272, OS = 132, SS = 528;
    const int g = lane >> 4, lc = lane & 15, q4 = lc >> 2, p4 = lane & 3, vd = 16 * wave + lc;
    const int et = tid >> 3, ec = (tid & 7) * 16;
#pragma unroll 1
    for (int id = v; id < 512; id += G) {
        const int bd = id >> 2, h = id & 3; const size_t m0 = (size_t)MP + bd * 8;
#pragma unroll
        for (int q = 0; q < 8; ++q) { const int cid = tid + 512 * q, row = cid >> 5, c4 = cid & 31; *(LAS f32x4*)(L + ST + row * SS + c4 * 16) = P.sreg[q]; }
        if (tid < 128) {
            const int kd = tid; float pp[8], lfs[8]; float p = 1.f;
#pragma unroll
            for (int t = 0; t < 8; ++t) { lfs[t] = (float)P.lf[t] * FQ; p *= lfs[t]; pp[t] = p; }
            float suf = 1.f;
#pragma unroll
            for (int t = 7; t >= 0; --t) {
                const float kk = 1.f - lfs[t];
                *(LAS bf16_t*)(L + QH + t * QS + kd * 2) = (bf16_t)cvt_pk_bf16(mk::bf2f(P.qv[t]) * pp[t], 0.f);
                *(LAS bf16_t*)(L + KH + t * QS + kd * 2) = (bf16_t)cvt_pk_bf16(kk * __builtin_amdgcn_rcpf(fmaxf(pp[t], 1e-30f)), 0.f);
                *(LAS bf16_t*)(L + KT + t * TS + kd * 2) = (bf16_t)cvt_pk_bf16(kk * suf, 0.f);
                suf *= lfs[t];
            }
#pragma unroll
            for (int t = 8; t < 16; ++t) { *(LAS bf16_t*)(L + QH + t * QS + kd * 2) = 0; *(LAS bf16_t*)(L + KH + t * QS + kd * 2) = 0; *(LAS bf16_t*)(L + KT + t * TS + kd * 2) = 0; }
            *(LAS float*)(L + DECS + kd * 4) = p;
            *(LAS u32x4*)(L + VT + (tid >> 4) * TS + (tid & 15) * 16) = P.vch;
        } else if (tid < 256) { const int c = tid - 128; *(LAS u32x4*)(L + VT + (8 + (c >> 4)) * TS + (c & 15) * 16) = (u32x4){0u, 0u, 0u, 0u}; }
        const size_t eoff = (m0 + et) * 512 + h * 128 + ec; u32x4 g0 = (u32x4){0u, 0u, 0u, 0u}, g1 = g0;
        if (tid < 64) { g0 = *(const u32x4*)(GR + eoff); g1 = *(const u32x4*)(GR + eoff + 8); }
        if (id + G < 512) hc_issue_sample(P, LOGF, QR, IR, S0, id + G, tid);
        __syncthreads();
        f32x4 sacc[8];
#pragma unroll
        for (int i = 0; i < 8; ++i)
#pragma unroll
            for (int e = 0; e < 4; ++e) sacc[i][e] = *(const LAS float*)(L + ST + (16 * i + 4 * g + e) * SS + vd * 4);
        if (wave == 0) {
            f32x4 acc = (f32x4){0.f, 0.f, 0.f, 0.f};
#pragma unroll
            for (int ks = 0; ks < 4; ++ks) { const bf16x8 a = *(const LAS bf16x8*)(L + QH + lc * QS + (32 * ks + 8 * g) * 2), b = *(const LAS bf16x8*)(L + KH + lc * QS + (32 * ks + 8 * g) * 2);
                acc = __builtin_amdgcn_mfma_f32_16x16x32_bf16(a, b, acc, 0, 0, 0); }
#pragma unroll
            for (int e = 0; e < 4; ++e) { const int t = 4 * g + e; *(LAS bf16_t*)(L + AT + t * 32 + lc * 2) = (bf16_t)cvt_pk_bf16(lc <= t ? acc[e] : 0.f, 0.f); }
        }
        __syncthreads();
        {
            f32x4 oacc = (f32x4){0.f, 0.f, 0.f, 0.f};
#pragma unroll
            for (int ks = 0; ks < 4; ++ks) {
                u32x4 bw; bw.x = cvt_pk_bf16(sacc[2 * ks][0], sacc[2 * ks][1]); bw.y = cvt_pk_bf16(sacc[2 * ks][2], sacc[2 * ks][3]); bw.z = cvt_pk_bf16(sacc[2 * ks + 1][0], sacc[2 * ks + 1][1]); bw.w = cvt_pk_bf16(sacc[2 * ks + 1][2], sacc[2 * ks + 1][3]);
                const u32x2 a0 = *(const LAS u32x2*)(L + QH + lc * QS + (32 * ks + 4 * g) * 2), a1 = *(const LAS u32x2*)(L + QH + lc * QS + (32 * ks + 16 + 4 * g) * 2);
                u32x4 aw; aw.x = a0.x; aw.y = a0.y; aw.z = a1.x; aw.w = a1.y;
                oacc = __builtin_amdgcn_mfma_f32_16x16x32_bf16(__builtin_bit_cast(bf16x8, aw), __builtin_bit_cast(bf16x8, bw), oacc, 0, 0, 0);
            }
            bf16x8 bv;
            { const v4i16_t lo = trr(L + VT + (4 * g + q4) * TS + (16 * wave + 4 * p4) * 2); bv = (bf16x8){lo[0], lo[1], lo[2], lo[3], 0, 0, 0, 0}; }
            { const u32x2 a0 = *(const LAS u32x2*)(L + AT + lc * 32 + 8 * g); u32x4 aw; aw.x = a0.x; aw.y = a0.y; aw.z = 0u; aw.w = 0u;
              oacc = __builtin_amdgcn_mfma_f32_16x16x32_bf16(__builtin_bit_cast(bf16x8, aw), bv, oacc, 0, 0, 0); }
#pragma unroll
            for (int e = 0; e < 4; ++e) *(LAS float*)(L + OT + ((4 * g + e) * OS + vd) * 4) = oacc[e];
#pragma unroll
            for (int i = 0; i < 8; ++i) {
                const f32x4 dc = *(const LAS f32x4*)(L + DECS + (16 * i + 4 * g) * 4);
                const v4i16_t lo = trr(L + KT + (4 * g + q4) * TS + (16 * i + 4 * p4) * 2);
                const bf16x8 a = (bf16x8){lo[0], lo[1], lo[2], lo[3], 0, 0, 0, 0};
                sacc[i] = __builtin_amdgcn_mfma_f32_16x16x32_bf16(a, bv, sacc[i] * dc, 0, 0, 0);
            }
#pragma unroll
            for (int i = 0; i < 8; ++i)
#pragma unroll
                for (int e = 0; e < 4; ++e) *(LAS float*)(L + ST + (16 * i + 4 * g + e) * SS + vd * 4) = sacc[i][e];
        }
        __syncthreads();
        if (tid < 64) {
            const f32x4 n0 = *(const f32x4*)(hgn + ec), n1 = *(const f32x4*)(hgn + ec + 4), n2 = *(const f32x4*)(hgn + ec + 8), n3 = *(const f32x4*)(hgn + ec + 12);
            f32x4 x[4]; float ss = 0.f;
#pragma unroll
            for (int k = 0; k < 4; ++k) { x[k] = *(const LAS f32x4*)(L + OT + (et * OS + ec + 4 * k) * 4); ss += mk::dot4(x[k]); }
            ss += __shfl_xor(ss, 1); ss += __shfl_xor(ss, 2); ss += __shfl_xor(ss, 4);
            const float rs = rsqrtf(ss * (1.f / 128.f) + EPS);
            const f32x4 y0 = x[0] * rs * n0 * (f32x4){mk::bflo(g0.x), mk::bfhi(g0.x), mk::bflo(g0.y), mk::bfhi(g0.y)}, y1 = x[1] * rs * n1 * (f32x4){mk::bflo(g0.z), mk::bfhi(g0.z), mk::bflo(g0.w), mk::bfhi(g0.w)};
            const f32x4 y2 = x[2] * rs * n2 * (f32x4){mk::bflo(g1.x), mk::bfhi(g1.x), mk::bflo(g1.y), mk::bfhi(g1.y)}, y3 = x[3] * rs * n3 * (f32x4){mk::bflo(g1.z), mk::bfhi(g1.z), mk::bflo(g1.w), mk::bfhi(g1.w)};
            { bf16_t* op = AOR + (m0 + et) * 1024 + 512 + h * 128 + ec; *(u32x4*)op = mk::pack8(y0, y1); *(u32x4*)(op + 8) = mk::pack8(y2, y3); }
        }
        { float* so = Sout + (size_t)id * 16384;
#pragma unroll
          for (int q = 0; q < 8; ++q) { const int cid = tid + 512 * q, row = cid >> 5, c4 = cid & 31; __builtin_nontemporal_store(*(const LAS f32x4*)(L + ST + row * SS + c4 * 16), (f32x4*)(so + (size_t)cid * 4)); } }
        __syncthreads();
    }
}
}
struct Args { const float* in[24]; float* out; unsigned char* ws; int ph_lo, ph_hi, li, pad; };
__global__ void __launch_bounds__(NWAVES * 64, 2) mega(Args args) {
    extern __shared__ __attribute__((aligned(16))) unsigned char lds[];
    LAS unsigned char* L = (LAS unsigned char*)lds;
    volatile LAS unsigned* MISC = (volatile LAS unsigned*)(L + MISC_OFF);
    const int tid = threadIdx.x, lane = tid & 63, wave = __builtin_amdgcn_readfirstlane(tid >> 6);
    const int G = gridDim.x; const int bx = blockIdx.x; const int vcu = (G % 8 == 0) ? (bx % 8) * (G / 8) + bx / 8 : bx;
    unsigned char* ws = args.ws;
    gu32* ctl = (gu32*)(ws + WS_CTL);
    for (int u = tid; u < (LDS_BYTES - LDSCTL_OFF) / 4; u += NWAVES * 64) ((LAS unsigned*)(L + LDSCTL_OFF))[u] = 0u;
    __syncthreads();
    const int lo = args.ph_lo, hi = args.ph_hi;
    XcdBarrier bar; bar.bar = (unsigned*)(ctl + CW_BAR) + args.li * XCD_BAR_WORDS; bar.x = 0; bar.st = nullptr;
    if (hi - lo > 1) bar = xcd_barrier_post((unsigned*)(ctl + CW_BAR) + args.li * XCD_BAR_WORDS, MISC + 8);
#define IN(k) (lo <= (k) && (k) < hi)
#define SEAM(k) do { if (IN(k) && IN((k) + 1)) xcd_barrier_bg(bar, [&]() { BG_WORK(k); }); } while (0)
#define BG_RUN(lo_, hi_, SET_) do { const int st_ = G * (NWAVES - 1); int j_ = (lo_) + vcu * (NWAVES - 1) + wave - 1; mk::WI w_, wn_; f32x4 r_[8], rn_[8]; \
        if (j_ < (hi_)) { SET_(w_, j_); mk::wi_load(w_, r_, lane); } \
        for (; j_ < (hi_); j_ += st_) { const bool hn_ = j_ + st_ < (hi_); if (hn_) { SET_(wn_, j_ + st_); mk::wi_load(wn_, rn_, lane); } mk::wi_proc(w_, r_, scr, lane); \
            if (hn_) { w_ = wn_; _Pragma("unroll") for (int i_ = 0; i_ < 8; ++i_) r_[i_] = rn_[i_]; } } } while (0)
#define BG_SET0(w, j) do { if ((j) < 1408) mk::wi_set(w, 0, args.in[8], nullptr, D, DFF, W2, 32, nullptr, (j)); else mk::wi_set(w, 2, args.in[10], nullptr, INW, D, WIN, 152, args.in[9], (j) - 1408); } while (0)
#define BG_SET1(w, j) do { if ((j) < 256) mk::wi_set(w, 0, args.in[17], nullptr, D, 1024, WUA, 32, nullptr, (j)); else if ((j) < 512) mk::wi_set(w, 0, args.in[18], nullptr, D, 1024, WUA + 512, 32, nullptr, (j) - 256); \
        else if ((j) < 1024) mk::wi_set(w, 0, args.in[19], nullptr, D, D, WOUT, 32, nullptr, (j) - 512); else mk::wi_set(w, 2, args.in[10], nullptr, INW, D, WIN, 152, args.in[9], (j) - 1024 + 1216); } while (0)
#define BG_SET2(w, j) mk::wi_set(w, 1, args.in[21], args.in[22], DFF, D, W13, 176, args.in[20], (j))
#define BG_SET4(w, j) mk::wi_set(w, 0, args.in[23], nullptr, D, DFF, W2, 32, nullptr, (j))
#define BG_COPY(lo_, hi_) do { for (int c_ = (lo_) + vcu * (NWAVES - 1) + wave - 1; c_ < (hi_); c_ += G * (NWAVES - 1)) { f32x4 v_[8]; \
        _Pragma("unroll") for (int i_ = 0; i_ < 8; ++i_) { const int u_ = c_ * 512 + i_ * 64 + lane, ten_ = u_ / (128 * 3840), rem_ = u_ % (128 * 3840), bd_ = rem_ / 3840, q_ = rem_ % 3840; \
            v_[i_] = __builtin_nontemporal_load((const f32x4*)(args.in[2 + ten_] + (size_t)bd_ * 16384 + 1024) + q_); } \
        _Pragma("unroll") for (int i_ = 0; i_ < 8; ++i_) { const int u_ = c_ * 512 + i_ * 64 + lane, ten_ = u_ / (128 * 3840), rem_ = u_ % (128 * 3840), bd_ = rem_ / 3840, q_ = rem_ % 3840; \
            __builtin_nontemporal_store(v_[i_], (f32x4*)(args.out + (ten_ ? O_SWV : O_SWK) + (size_t)bd_ * 16384) + q_); } } } while (0)
#define BG_WORK(k) do { \
        if ((k) == 0) BG_RUN(0, 1408 + 1216, BG_SET0); \
        else if ((k) == 1) BG_RUN(0, 1024 + 1216, BG_SET1); \
        else if ((k) == 2) BG_RUN(0, 1792, BG_SET2); \
        else if ((k) == 3) BG_RUN(1792, 2816, BG_SET2); \
        else if ((k) == 4) BG_RUN(0, 1408, BG_SET4); \
        else if ((k) == 5) BG_COPY(0, 1792); \
        else if ((k) == 6) BG_COPY(1792, 1920); \
    } while (0)
    const float* xp = args.in[0]; const float* xs = args.in[1];
    pg8::bf16_t* W13 = (pg8::bf16_t*)(ws + WS_W13); pg8::bf16_t* W2 = (pg8::bf16_t*)(ws + WS_W2); pg8::bf16_t* WIN = (pg8::bf16_t*)(ws + WS_WIN);
    pg8::bf16_t* WUA = (pg8::bf16_t*)(ws + WS_WUA); pg8::bf16_t* WUR = (pg8::bf16_t*)(ws + WS_WUR); pg8::bf16_t* WOUT = (pg8::bf16_t*)(ws + WS_WOUT);
    float* RSTD1 = (float*)(ws + WS_RSTD1); float* SSQ1 = (float*)(ws + WS_SSQ1); float* SSQ2 = (float*)(ws + WS_SSQ2);
    pg8::bf16_t* AB = (pg8::bf16_t*)(ws + WS_AB); pg8::bf16_t* HID = (pg8::bf16_t*)(ws + WS_HID);
    pg8::bf16_t* Qb = (pg8::bf16_t*)(ws + WS_Q); pg8::bf16_t* KVb = (pg8::bf16_t*)(ws + WS_KV); pg8::bf16_t* QRb = (pg8::bf16_t*)(ws + WS_QR); const unsigned short* LOGF = (const unsigned short*)(ws + WS_LOGF);
    pg8::bf16_t* MRG = (pg8::bf16_t*)(ws + WS_MRG); pg8::bf16_t* IRb = (pg8::bf16_t*)(ws + WS_IR); pg8::bf16_t* GRb = (pg8::bf16_t*)(ws + WS_GR);
    pg8::bf16_t* SGA = (pg8::bf16_t*)(ws + WS_SGA); pg8::bf16_t* SGR = (pg8::bf16_t*)(ws + WS_SGR); pg8::bf16_t* AOR = (pg8::bf16_t*)(ws + WS_AOR);
    const bool tail_first = ((bx >> 3) & 1) != 0;
    LAS float* scr = (LAS float*)(L + RING_OFF + wave * 16384);
    const int gw = vcu * NWAVES + wave, NGW = G * NWAVES;

    if (IN(0)) {
        constexpr int NIT = 176 * 16;
#define WI_DEC0(w, it_) mk::wi_set(w, 1, args.in[6], args.in[7], DFF, D, W13, 176, args.in[5], (it_))
        { mk::WI wc, wn; f32x4 rc[8], rn[8]; int it = gw;
          if (it < NIT) { WI_DEC0(wc, it); mk::wi_load(wc, rc, lane); }
          for (; it < NIT; it += NGW) {
              const bool hn = it + NGW < NIT;
              if (hn) { WI_DEC0(wn, it + NGW); mk::wi_load(wn, rn, lane); }
              mk::wi_proc(wc, rc, scr, lane);
              if (hn) { wc = wn;
#pragma unroll
                  for (int i = 0; i < 8; ++i) rc[i] = rn[i]; }
          } }
#undef WI_DEC0
#define X_ISSUE(v, m0_) do { _Pragma("unroll") for (int q = 0; q < 4; ++q) { const int m = (m0_) + q * NGW; if (m < M) { const float* xr = m < MP ? xp + (size_t)m * D : xs + (size_t)(m - MP) * D; const GAS f32x4* p = (const GAS f32x4*)xr + lane; \
            _Pragma("unroll") for (int j = 0; j < 4; ++j) v[q][j] = __builtin_nontemporal_load(p + 64 * j); } } } while (0)
        { f32x4 v[4][4], vn[4][4]; int m0 = gw;
          if (m0 < M) X_ISSUE(v, m0);
          for (; m0 < M; m0 += 4 * NGW) {
            const bool hn = m0 + 4 * NGW < M;
            if (hn) X_ISSUE(vn, m0 + 4 * NGW);
#pragma unroll
            for (int q = 0; q < 4; ++q) { const int m = m0 + q * NGW; if (m < M) { float ss = 0.f;
#pragma unroll
                for (int j = 0; j < 4; ++j) ss += mk::dot4(v[q][j]);
                ss = mk::wave_sum(ss);
                if (lane == 0) RSTD1[m] = rsqrtf(ss * (1.f / 1024.f) + EPS);
                GAS unsigned long long* o8 = (GAS unsigned long long*)(AB + (size_t)m * D) + lane;
#pragma unroll
                for (int j = 0; j < 4; ++j) o8[64 * j] = (unsigned long long)pk2(v[q][j][0], v[q][j][1]) | ((unsigned long long)pk2(v[q][j][2], v[q][j][3]) << 32); } }
            if (hn) {
#pragma unroll
                for (int q = 0; q < 4; ++q)
#pragma unroll
                    for (int j = 0; j < 4; ++j) v[q][j] = vn[q][j]; }
          } }
#undef X_ISSUE
        VM_WAIT(); __syncthreads();
    }
    SEAM(0);
    if (IN(1)) {
        pg8::Gemm g{AB, W13, M, 2 * DFF, D}; pg8::StaticOrder S; S.init(M, 2 * DFF, G, bx);
        mk::EpiSwiglu<false> E{HID, RSTD1, L + mk::RTAB_OFF};
        mk::build_rstd_table<false>(L, S, RSTD1, tid);
        pg8::gemm_phase<mk::EpiSwiglu<false>, pg8::StaticOrder, true, true>(L + RING_OFF, g, S, E);
    }
    SEAM(1);
    if (IN(2)) {
        pg8::Gemm g{HID, W2, MP, D, DFF}; pg8::StaticOrder S; S.init(MP, D, G, bx);
        mk::EpiResidB<false> E{AB, nullptr, SSQ1, 0.5f};
if (tail_first) mk::gemm_tail(L + RING_OFF, HID, W2, DFF, MP, 16, 16, vcu, G, E, tid, lane, wave);
        pg8::gemm_phase<mk::EpiResidB<false>, pg8::StaticOrder, true, true>(L + RING_OFF, g, S, E);
        if (!tail_first) mk::gemm_tail(L + RING_OFF, HID, W2, DFF, MP, 16, 16, vcu, G, E, tid, lane, wave);
    }
    SEAM(2);
    if (IN(3)) {
        pg8::Gemm g{AB, WIN, M, INW, D}; mk::ProjOrder S; S.init(G, bx);
        mk::EpiProj E{SSQ1, ws, args.out, args.in[11], args.in[12], args.in[15], L + mk::RTAB_OFF};
        mk::build_rstd_table<true>(L, S, SSQ1, tid);
        pg8::gemm_phase<mk::EpiProj, mk::ProjOrder, true, true>(L + RING_OFF, g, S, E);
        mk::EpiProjTail ET{SSQ1, SGA};
        mk::gemm_tail(L + RING_OFF, AB, WIN + (size_t)2816 * D, D, MP, 16, 12, vcu, G, ET, tid, lane, wave);
    }
    SEAM(3);
    pg8::bf16_t* US = (pg8::bf16_t*)args.out;
    float* DEC = (float*)(ws + WS_DEC);
    if (IN(4)) {
        for (int t = vcu; t < 512; t += G) {
            if (t < 256) at::attn_prompt_task(L, Qb, AOR, KVb, args.in[14], args.in[13], t >> 6, (t >> 1) & 31, t & 1, tid, lane, wave);
            else at::attn_sample_task(L, Qb, AOR, KVb, args.in[2], args.in[3], args.in[14], args.in[13], (t - 256) >> 1, t & 1, tid, lane, wave);
        }
        hg::HaPre HP; if (vcu < 256) hg::ha_issue(HP, LOGF, IRb, 4 * vcu, tid);
        hg::ha_phase(L, HP, LOGF, IRb, US, DEC, vcu, G, tid, lane, wave);
        VM_WAIT(); __syncthreads();
    }
    SEAM(4);
    if (IN(5)) {
        for (int idx = bx * (NWAVES * 64) + tid; idx < 131072; idx += G * NWAVES * 64) hg::hb_scan((unsigned*)US, DEC, args.out + O_PST, idx);
        VM_WAIT(); __syncthreads();
    }
    SEAM(5);
    if (IN(6)) {
        hg::hc_phase_prompt(L, LOGF, QRb, AOR, IRb, GRb, args.in[16], US, vcu, G, tid, lane, wave);
        hg::HcPreS PS; if (vcu < 512) hg::hc_issue_sample(PS, LOGF, QRb, IRb, args.in[4], vcu, tid);
        hg::hc_phase_sample(L, LOGF, QRb, AOR, IRb, GRb, args.in[16], args.in[4], args.out + O_SST, PS, vcu, G, tid, lane, wave);
        VM_WAIT(); __syncthreads();
    }
    SEAM(6);
    if (IN(7)) {
        { pg8::Gemm g{AOR, WUA, MP, D, D}; pg8::StaticOrder S; S.init(MP, D, G, bx); mk::EpiUpR E{MRG, (const unsigned char*)SGA, (const unsigned char*)SGR};
if (tail_first) mk::gemm_tail(L + RING_OFF, AOR, WUA, D, MP, 16, 16, vcu, G, E, tid, lane, wave);
        pg8::gemm_phase<mk::EpiUpR, pg8::StaticOrder, true, true>(L + RING_OFF, g, S, E);
        if (!tail_first) mk::gemm_tail(L + RING_OFF, AOR, WUA, D, MP, 16, 16, vcu, G, E, tid, lane, wave); }
    }
    SEAM(7);
    if (IN(8)) {
        pg8::Gemm g{MRG, WOUT, MP, D, D}; pg8::StaticOrder S; S.init(MP, D, G, bx);
        mk::EpiResidB<false> E{AB, nullptr, SSQ2, 1.0f};
if (tail_first) mk::gemm_tail(L + RING_OFF, MRG, WOUT, D, MP, 16, 16, vcu, G, E, tid, lane, wave);
        pg8::gemm_phase<mk::EpiResidB<false>, pg8::StaticOrder, true, true>(L + RING_OFF, g, S, E);
        if (!tail_first) mk::gemm_tail(L + RING_OFF, MRG, WOUT, D, MP, 16, 16, vcu, G, E, tid, lane, wave);
    }
    SEAM(8);
    if (IN(9)) {
        pg8::Gemm g{AB, W13, M, 2 * DFF, D}; pg8::StaticOrder S; S.init(M, 2 * DFF, G, bx);
        mk::EpiSwiglu<true> E{HID, SSQ2, L + mk::RTAB_OFF};
        mk::build_rstd_table<true>(L, S, SSQ2, tid);
        pg8::gemm_phase<mk::EpiSwiglu<true>, pg8::StaticOrder, true, true>(L + RING_OFF, g, S, E);
    }
    SEAM(9);
    if (IN(10)) {
        pg8::Gemm g{HID, W2, MP, D, DFF}; pg8::StaticOrder S; S.init(MP, D, G, bx);
        mk::EpiResidB<true> E{AB, args.out, nullptr, 0.5f};
if (tail_first) mk::gemm_tail(L + RING_OFF, HID, W2, DFF, MP, 16, 16, vcu, G, E, tid, lane, wave);
        pg8::gemm_phase<mk::EpiResidB<true>, pg8::StaticOrder, true, true>(L + RING_OFF, g, S, E);
        if (!tail_first) mk::gemm_tail(L + RING_OFF, HID, W2, DFF, MP, 16, 16, vcu, G, E, tid, lane, wave);
    }
#undef IN
#undef SEAM
}

extern "C" void kernel_launch(void* const* d_in, const int* in_sizes, int n_in, void* d_out, int out_size, void* d_ws, size_t ws_size, hipStream_t stream) {
    static int grid = 0;
    if (grid == 0) {
        int dev = 0, cus = 0;
        if (hipGetDevice(&dev) != hipSuccess || hipDeviceGetAttribute(&cus, hipDeviceAttributeMultiprocessorCount, dev) != hipSuccess) { fprintf(stderr, "kernel_launch: device query failed\n"); grid = -1; return; }
        if (hipFuncSetAttribute((const void*)mega, hipFuncAttributeMaxDynamicSharedMemorySize, LDS_BYTES) != hipSuccess) { fprintf(stderr, "kernel_launch: hipFuncSetAttribute failed\n"); grid = -1; return; }
        if (ws_size < WS_END) { fprintf(stderr, "kernel_launch: workspace too small: %zu < %zu\n", ws_size, (size_t)WS_END); grid = -1; return; }
        grid = cus;
    }
    if (grid < 0) return;
    (void)hipMemsetAsync((char*)d_ws + WS_CTL + CW_BAR * 4, 0, 16384, stream);
    Args a{};
    for (int i = 0; i < 24; ++i) a.in[i] = (const float*)d_in[i];
    a.out = (float*)d_out; a.ws = (unsigned char*)d_ws;
    unsigned char* ws = (unsigned char*)d_ws; float* out = (float*)d_out;
    int nl = 0;
    auto launch = [&](int lo, int hi) { a.ph_lo = lo; a.ph_hi = hi; a.li = nl++; hipLaunchKernelGGL(mega, dim3(grid), dim3(NWAVES * 64), LDS_BYTES, stream, a); };
    launch(0, 11);
}
```

```cpp
#include <hip/hip_runtime.h>
#include <cstdio>
#include <cstdint>
namespace pg8 {
#define PG8_LAS __attribute__((address_space(3)))
typedef unsigned short bf16_t;
typedef short bf16x8 __attribute__((ext_vector_type(8)));
typedef float f32x4 __attribute__((ext_vector_type(4)));
typedef unsigned u32x4 __attribute__((ext_vector_type(4)));
constexpr int BM = 256, BK = 64, HALF = 128, HTB = HALF * BK * 2  , STAGE_BYTES = 8 * HTB, NXCD = 8, WGM = 8;

__host__ __device__ __forceinline__ int lds_byte(int r, int c) { const int st = (r >> 4) * 2 + (c >> 5), rr = r & 15, cc = c & 31, ob = rr * 64 + cc * 2; return st * 1024 + (ob ^ (((ob >> 9) & 1) << 5)); }
__host__ __device__ __forceinline__ void stage_rc(int b, int& R, int& C) { const int st = b / 1024, sb = b % 1024, swz = sb ^ (((sb >> 9) & 1) << 5); R = (st >> 1) * 16 + swz / 64; C = (st & 1) * 32 + (swz % 64) / 2; }
__host__ __device__ __forceinline__ int perm32(int rho) { const int n = rho >> 4, i = rho & 15; return 8 * (i >> 2) + 4 * n + (i & 3); }

struct Unit { int pm, pn, idx; };
struct Gemm { const bf16_t* A; const bf16_t* Bt; int M, N, K; };

struct StaticOrder {
    int nM, nN, nwg, G, c;
    __host__ __device__ void init(int M, int N, int G_, int c_) { nM = M / BM; nN = N / BM; nwg = nM * nN; G = G_; c = c_; }
    __host__ __device__ bool next(int i, Unit& u) const {
        const long L = (long)i * G + c; if (L >= nwg) return false;
        int wgid = (int)L; { const int q = nwg / NXCD, r = nwg % NXCD, xcd = wgid % NXCD, off = wgid / NXCD; wgid = (xcd < r ? xcd * (q + 1) : r * (q + 1) + (xcd - r) * q) + off; }
        const int nig = WGM * nN, gid = wgid / nig, fm = gid * WGM, gsz = (nM - fm) < WGM ? (nM - fm) : WGM;
        u.pm = fm + ((wgid % nig) % gsz); u.pn = (wgid % nig) / gsz; u.idx = i; return true;
    }
    __device__ __forceinline__ void a_ready(const Unit&) const {}
    __device__ __forceinline__ void done(const Unit&) const {}
};

typedef float f32x2_cv __attribute__((ext_vector_type(2))); typedef __bf16 bf16x2_cv __attribute__((ext_vector_type(2)));
__device__ __forceinline__ unsigned cvt_pk_bf16(float lo, float hi) { const f32x2_cv v = {lo, hi}; const bf16x2_cv b = __builtin_convertvector(v, bf16x2_cv); return __builtin_bit_cast(unsigned, b); }
typedef float f32x2 __attribute__((ext_vector_type(2)));
template <class Epi, class Sched, bool ALIGN_EPI = false, bool SP2 = false>
__device__ __forceinline__ void gemm_phase(PG8_LAS unsigned char* lds, const Gemm g, const Sched& S, const Epi& E) {
    const int tid = threadIdx.x, wid = __builtin_amdgcn_readfirstlane(tid >> 6), lane = tid & 63, wr = wid >> 2, wc = wid & 3, fr = lane & 15, fq = lane >> 4;
    constexpr bool KS = Epi::MIDT > 0;
    const int K = g.K, nt = KS ? Epi::MIDT : K / BK;
    unsigned voffA[2], voffB[2];
#pragma unroll
    for (int i = 0; i < 2; ++i) { int R, C; stage_rc(tid * 16 + i * 8192, R, C); const int Rb = Epi::PERM ? ((R & ~31) + perm32(R & 31)) : R;
        voffA[i] = (unsigned)(R * K + C) * 2u; voffB[i] = (unsigned)(Rb * K + C) * 2u; }
    const size_t kstep = (size_t)(BK * 2);
    const size_t hstep = (size_t)HALF * K * 2;
    const size_t tstep = 2 * hstep;
    const unsigned ldsw = (unsigned)wid * 1024u;
    const int aoff = lds_byte(wr * 64 + fr, fq * 8), boff = lds_byte(wc * 32 + fr, fq * 8);
#define PG8_SA(b, h) (((b) * 2 + (h)) * HTB)
#define PG8_SB(b, h) ((4 + (b) * 2 + (h)) * HTB)
#define PG8_STAGE(bufoff, gbase, voff) do { _Pragma("unroll") for (int _i = 0; _i < 2; ++_i) \
        __builtin_amdgcn_global_load_lds((const unsigned*)((const char*)(gbase) + (voff)[_i]), (PG8_LAS unsigned*)(lds + (bufoff) + ldsw + _i * 8192), 16, 0, 0); } while (0)
#define PG8_LDA(dst, b, h) do { _Pragma("unroll") for (int m = 0; m < 4; ++m) _Pragma("unroll") for (int k = 0; k < 2; ++k) dst[m][k] = *(const PG8_LAS bf16x8*)(lds + PG8_SA(b, h) + aoff + m * 2048 + k * 1024); } while (0)
#define PG8_LDB(dst, b, h) do { _Pragma("unroll") for (int n = 0; n < 2; ++n) _Pragma("unroll") for (int k = 0; k < 2; ++k) dst[n][k] = *(const PG8_LAS bf16x8*)(lds + PG8_SB(b, h) + boff + n * 2048 + k * 1024); } while (0)
#define PG8_MMA(ai, bj, At, Bt) do { __builtin_amdgcn_s_setprio(1); _Pragma("unroll") for (int m = 0; m < 4; ++m) _Pragma("unroll") for (int n = 0; n < 2; ++n) _Pragma("unroll") for (int k = 0; k < 2; ++k) \
        acc[ai][bj][m][n] = __builtin_amdgcn_mfma_f32_16x16x32_bf16(Bt[n][k], At[m][k], acc[ai][bj][m][n], 0, 0, 0); __builtin_amdgcn_s_setprio(0); } while (0)
#define PG8_WAIT_V(n) asm volatile("s_waitcnt vmcnt(" #n ")" ::: "memory")
#define PG8_WAIT_V8R(t_) do { if constexpr (Epi::EPI_VM == 8) asm volatile("s_waitcnt vmcnt(16)\n\ts_cmp_eq_u32 %0, 0\n\ts_cbranch_scc1 1f\n\ts_waitcnt vmcnt(8)\n1:" :: "s"(t_) : "scc", "memory"); \
        else if constexpr (Epi::EPI_VM == 16) asm volatile("s_waitcnt vmcnt(24)\n\ts_cmp_eq_u32 %0, 0\n\ts_cbranch_scc1 1f\n\ts_waitcnt vmcnt(8)\n1:" :: "s"(t_) : "scc", "memory"); \
        else { static_assert(Epi::EPI_VM == 0, "EPI_VM: 0, 8 or 16"); PG8_WAIT_V(8); } } while (0)
#define PG8_WAIT_L(n) asm volatile("s_waitcnt lgkmcnt(" #n ")" ::: "memory")
#define PG8_BAR __builtin_amdgcn_s_barrier()
#define PG8_SCHED __builtin_amdgcn_sched_barrier(0)
    Unit cur, nxt; int ui = 0;
    if (!S.next(0, cur)) return;
    f32x4 acc[2][2][4][2];
    u32x4 ipre[Epi::INIT ? 16 : 1];
    if constexpr (Epi::INIT) E.init_issue(ipre, cur, wr, wc, fr, fq);
    else {
#pragma unroll
    for (int a = 0; a < 2; ++a)
#pragma unroll
        for (int b = 0; b < 2; ++b)
#pragma unroll
            for (int m = 0; m < 4; ++m)
#pragma unroll
                for (int n = 0; n < 2; ++n) acc[a][b][m][n] = (f32x4){0.f, 0.f, 0.f, 0.f};
    }
    bf16x8 At[4][2], B0[2][2], B1[2][2];
    const char* cA = (const char*)g.A + (size_t)cur.pm * tstep; const char* cB = (const char*)g.Bt + (size_t)cur.pn * tstep;
    S.a_ready(cur);
    if constexpr (SP2) {
        PG8_STAGE(PG8_SB(0, 0), cB, voffB); PG8_STAGE(PG8_SB(0, 1), cB + hstep, voffB); PG8_STAGE(PG8_SA(0, 0), cA, voffA); PG8_STAGE(PG8_SA(0, 1), cA + hstep, voffA);
        if (wr == 1) PG8_BAR;
        PG8_WAIT_V(2); PG8_BAR;
        PG8_STAGE(PG8_SB(1, 0), cB + kstep, voffB); PG8_STAGE(PG8_SA(1, 0), cA + kstep, voffA); PG8_STAGE(PG8_SB(1, 1), cB + hstep + kstep, voffB);
        if constexpr (Epi::EPI_VM > 0) PG8_WAIT_V(0); else PG8_WAIT_V(6);
        PG8_BAR;
    } else {
        PG8_STAGE(PG8_SB(0, 0), cB, voffB); PG8_STAGE(PG8_SA(0, 0), cA, voffA); PG8_STAGE(PG8_SB(0, 1), cB + hstep, voffB); PG8_STAGE(PG8_SA(0, 1), cA + hstep, voffA);
        if (wr == 1) PG8_BAR;
        PG8_WAIT_V(4); PG8_BAR;
        PG8_STAGE(PG8_SB(1, 0), cB + kstep, voffB); PG8_STAGE(PG8_SA(1, 0), cA + kstep, voffA); PG8_STAGE(PG8_SB(1, 1), cB + hstep + kstep, voffB);
        PG8_WAIT_V(6); PG8_BAR;
    }
    if constexpr (Epi::INIT) E.init_finish(acc, ipre);
    for (;;) {
        const bool has_next = KS ? S.next((ui + 1) >> 1, nxt) : S.next(ui + 1, nxt);
        const size_t nko = (KS && ((ui + 1) & 1)) ? (size_t)nt * kstep : (size_t)0;
        const char* nA = has_next ? (const char*)g.A + (size_t)nxt.pm * tstep + nko : cA; const char* nB = has_next ? (const char*)g.Bt + (size_t)nxt.pn * tstep + nko : cB;
        for (int t = 0; t < nt; t += 2) {
            const bool last = (t == nt - 2);
            const char* a1 = cA + (size_t)(t + 1) * kstep;
            const char* a2 = last ? nA : cA + (size_t)(t + 2) * kstep; const char* b2 = last ? nB : cB + (size_t)(t + 2) * kstep;
            const char* a3 = a2 + kstep; const char* b3 = b2 + kstep;
            if (last && has_next) S.a_ready(nxt);
            if constexpr (SP2) {
            PG8_LDB(B0, 0, 0); PG8_LDB(B1, 0, 1); PG8_SCHED; PG8_LDA(At, 0, 0); PG8_STAGE(PG8_SA(1, 1), a1 + hstep, voffA);
            PG8_WAIT_V8R(t); PG8_WAIT_L(0); PG8_BAR; PG8_MMA(0, 0, At, B0); PG8_MMA(0, 1, At, B1); PG8_BAR; PG8_SCHED;
            PG8_LDA(At, 0, 1); PG8_STAGE(PG8_SB(0, 0), b2, voffB); PG8_STAGE(PG8_SB(0, 1), b2 + hstep, voffB); PG8_STAGE(PG8_SA(0, 0), a2, voffA);
            PG8_WAIT_V8R(t); PG8_WAIT_L(0); PG8_BAR; PG8_MMA(1, 0, At, B0); PG8_MMA(1, 1, At, B1); PG8_BAR; PG8_SCHED;
            PG8_LDB(B0, 1, 0); PG8_LDB(B1, 1, 1); PG8_SCHED; PG8_LDA(At, 1, 0); PG8_STAGE(PG8_SA(0, 1), a2 + hstep, voffA);
            PG8_WAIT_V(8); PG8_WAIT_L(0); PG8_BAR; PG8_MMA(0, 0, At, B0); PG8_MMA(0, 1, At, B1); PG8_BAR; PG8_SCHED;
            PG8_LDA(At, 1, 1); PG8_STAGE(PG8_SB(1, 0), b3, voffB); PG8_STAGE(PG8_SB(1, 1), b3 + hstep, voffB); PG8_STAGE(PG8_SA(1, 0), a3, voffA);
            PG8_WAIT_V(8); PG8_WAIT_L(0); PG8_BAR; PG8_MMA(1, 0, At, B0); PG8_MMA(1, 1, At, B1); PG8_BAR; PG8_SCHED;
            } else {
            PG8_LDB(B0, 0, 0); PG8_SCHED; PG8_LDA(At, 0, 0); PG8_STAGE(PG8_SA(1, 1), a1 + hstep, voffA);
            PG8_WAIT_L(8); PG8_BAR; PG8_WAIT_L(0); PG8_MMA(0, 0, At, B0); PG8_BAR; PG8_SCHED;
            PG8_LDB(B1, 0, 1); PG8_STAGE(PG8_SB(0, 0), b2, voffB);
            PG8_BAR; PG8_WAIT_L(0); PG8_MMA(0, 1, At, B1); PG8_BAR;
            PG8_LDA(At, 0, 1); PG8_STAGE(PG8_SA(0, 0), a2, voffA);
            PG8_BAR; PG8_WAIT_L(0); PG8_MMA(1, 0, At, B0); PG8_BAR; PG8_SCHED;
            PG8_STAGE(PG8_SB(0, 1), b2 + hstep, voffB);
            PG8_WAIT_V(6); PG8_BAR; PG8_MMA(1, 1, At, B1); PG8_BAR;
            PG8_LDB(B0, 1, 0); PG8_SCHED; PG8_LDA(At, 1, 0); PG8_STAGE(PG8_SA(0, 1), a2 + hstep, voffA);
            PG8_WAIT_L(8); PG8_BAR; PG8_WAIT_L(0); PG8_MMA(0, 0, At, B0); PG8_BAR; PG8_SCHED;
            PG8_LDB(B1, 1, 1); PG8_STAGE(PG8_SB(1, 0), b3, voffB);
            PG8_BAR; PG8_WAIT_L(0); PG8_MMA(0, 1, At, B1); PG8_BAR;
            PG8_LDA(At, 1, 1); PG8_STAGE(PG8_SA(1, 0), a3, voffA);
            PG8_BAR; PG8_WAIT_L(0); PG8_MMA(1, 0, At, B0); PG8_BAR; PG8_SCHED;
            PG8_STAGE(PG8_SB(1, 1), b3 + hstep, voffB);
            PG8_WAIT_V(6); PG8_BAR; PG8_MMA(1, 1, At, B1); PG8_BAR;
            }
        }
        if constexpr (ALIGN_EPI) { if (wr == 0) PG8_BAR; }
        if constexpr (KS) { if (ui & 1) { E(acc, cur, wr, wc, fr, fq); S.done(cur); } else E.mid(acc, cur, wr, wc, fr, fq); }
        else if constexpr (!Epi::AFTER_DRAIN) { E(acc, cur, wr, wc, fr, fq); S.done(cur); }
        if (!has_next) break;
        if constexpr (Epi::INIT) { E.init_issue(ipre, nxt, wr, wc, fr, fq); E.init_finish(acc, ipre); }
        else if (!KS || (ui & 1)) {
#pragma unroll
        for (int a = 0; a < 2; ++a)
#pragma unroll
            for (int b = 0; b < 2; ++b)
#pragma unroll
                for (int m = 0; m < 4; ++m)
#pragma unroll
                    for (int n = 0; n < 2; ++n) acc[a][b][m][n] = (f32x4){0.f, 0.f, 0.f, 0.f};
        }
        cur = nxt; cA = nA; cB = nB; ++ui;
        if constexpr (ALIGN_EPI) { if (wr == 1) PG8_BAR; }
    }
    PG8_WAIT_V(0);
    if constexpr (!ALIGN_EPI) { if (wr == 0) PG8_BAR; }
    PG8_BAR;
    if constexpr (Epi::AFTER_DRAIN) { E.fused(acc, cur, wr, wc, fr, fq, lds, wid, lane); S.done(cur); }
#undef PG8_SA
#undef PG8_SB
#undef PG8_STAGE
#undef PG8_LDA
#undef PG8_LDB
#undef PG8_MMA
#undef PG8_WAIT_V
#undef PG8_WAIT_L
#undef PG8_WAIT_V8R
#undef PG8_BAR
#undef PG8_SCHED
}
}
#define GAS __attribute__((address_space(1)))
#define LAS __attribute__((address_space(3)))
typedef unsigned short bf16;
typedef unsigned v4u __attribute__((ext_vector_type(4)));
typedef float f32x4 __attribute__((ext_vector_type(4)));
typedef short bf16x8 __attribute__((ext_vector_type(8)));
typedef GAS unsigned gu32;
typedef GAS unsigned long long gu64;
#define RLX_AGENT __ATOMIC_RELAXED, __HIP_MEMORY_SCOPE_AGENT
#define LDS_WAIT() asm volatile("s_waitcnt lgkmcnt(0)" ::: "memory")
#define VM_WAIT() asm volatile("s_waitcnt vmcnt(0)" ::: "memory")
__device__ __forceinline__ unsigned long long rt() { return __builtin_amdgcn_s_memrealtime(); }
__device__ __forceinline__ unsigned f2bf(float f) { unsigned u = __builtin_bit_cast(unsigned, f); return (u + 0x7fffu + ((u >> 16) & 1u)) >> 16; }
__device__ __forceinline__ unsigned pk2(float lo, float hi) { return f2bf(lo) | (f2bf(hi) << 16); }
#define XB_TMO      128
#define XB_XCNT(j)  (256  + 64 * (j))
#define XB_XSUB(j)  (1280 + 64 * (j))
#define XB_XGEN(j)  (2304 + 64 * (j))
#define XB_TOP      3328
#define XB_TOPGEN   3392
#define XCD_BAR_WORDS 3456
#define XB_SPIN_CAP (1u << 18)

__device__ __forceinline__ unsigned xb_ld(unsigned* p)              { return __hip_atomic_load(p, __ATOMIC_RELAXED, __HIP_MEMORY_SCOPE_AGENT); }
__device__ __forceinline__ unsigned xb_add(unsigned* p, unsigned v) { return __hip_atomic_fetch_add(p, v, __ATOMIC_RELAXED, __HIP_MEMORY_SCOPE_AGENT); }
__device__ __forceinline__ unsigned xb_xcc_id() { return (unsigned)__builtin_amdgcn_s_getreg((3 << 11) | 20) & 0xFu; }
#define XB_SPIN(cond, bar) do { unsigned _sp = 0; while (cond) { __builtin_amdgcn_s_sleep(1); \
    if ((++_sp & 255u) == 0u) { if (xb_ld(&(bar)[XB_TMO])) break; if (_sp > XB_SPIN_CAP) { atomicAdd(&(bar)[XB_TMO], 1u); break; } } } } while (0)

struct XcdBarrier {
    unsigned* bar; unsigned x;
    volatile LAS unsigned* st;
};

__device__ __forceinline__ XcdBarrier xcd_barrier_post(unsigned* bar, volatile LAS unsigned* st) {
    XcdBarrier b; b.bar = bar; b.x = xb_xcc_id(); b.st = st;
    if (threadIdx.x == 0) (void)xb_add(&bar[XB_XCNT(b.x)], 1u);
    return b;
}
__device__ __forceinline__ void xcd_barrier_complete(unsigned* bar, unsigned x, unsigned& nloc, unsigned& nx) {
    const unsigned G = gridDim.x * gridDim.y * gridDim.z;
    unsigned sum, cnt, mine, sp = 0u;
    for (;;) {
        sum = 0u; cnt = 0u; mine = 0u;
#pragma unroll
        for (unsigned j = 0; j < 16; ++j) { const unsigned c = xb_ld(&bar[XB_XCNT(j)]); sum += c; cnt += (c > 0u) ? 1u : 0u; mine = (j == x) ? c : mine; }
        if (sum == G) break;
        __builtin_amdgcn_s_sleep(1);
        if ((++sp & 255u) == 0u) { if (xb_ld(&bar[XB_TMO])) break; if (sp > XB_SPIN_CAP) { atomicAdd(&bar[XB_TMO], 1u); break; } }
    }
    nloc = mine > 0u ? mine : 1u; nx = cnt > 0u ? cnt : 1u;
}

__device__ __forceinline__ void xcd_barrier(const XcdBarrier& b) {
    asm volatile("s_waitcnt vmcnt(0)" ::: "memory");
    __syncthreads();
    if (threadIdx.x == 0) {
        unsigned* bar = b.bar;
        __builtin_amdgcn_s_waitcnt(0);
        unsigned nloc = b.st[0], nx = b.st[1];
        if (nloc == 0u) { xcd_barrier_complete(bar, b.x, nloc, nx); b.st[0] = nloc; b.st[1] = nx; }
        const unsigned old = xb_add(&bar[XB_XSUB(b.x)], 1u);
        const unsigned gen = old / nloc;
        if (old + 1u == (gen + 1u) * nloc) {
            __builtin_amdgcn_fence(__ATOMIC_RELEASE, "agent");
            asm volatile("s_waitcnt vmcnt(0)" ::: "memory");
            const unsigned og = xb_add(&bar[XB_TOP], 1u);
            const unsigned tg = og / nx;
            if (og + 1u == (tg + 1u) * nx) xb_add(&bar[XB_TOPGEN], 1u);
            else XB_SPIN(xb_ld(&bar[XB_TOPGEN]) == tg, bar);
            __builtin_amdgcn_fence(__ATOMIC_ACQUIRE, "agent");
            xb_add(&bar[XB_XGEN(b.x)], 1u);
            asm volatile("s_waitcnt vmcnt(0)" ::: "memory");
        } else {
            XB_SPIN(xb_ld(&bar[XB_XGEN(b.x)]) == gen, bar);
            __builtin_amdgcn_fence(__ATOMIC_ACQUIRE, "agent");
            asm volatile("s_waitcnt vmcnt(0)" ::: "memory");
        }
    }
    __syncthreads();
}

template <class BG> __device__ __forceinline__ void xcd_barrier_bg(const XcdBarrier& b, const BG& bg) {
    asm volatile("s_waitcnt vmcnt(0)" ::: "memory");
    __syncthreads();
    if (threadIdx.x == 0) {
        unsigned* bar = b.bar;
        __builtin_amdgcn_s_waitcnt(0);
        unsigned nloc = b.st[0], nx = b.st[1];
        if (nloc == 0u) { xcd_barrier_complete(bar, b.x, nloc, nx); b.st[0] = nloc; b.st[1] = nx; }
        const unsigned old = xb_add(&bar[XB_XSUB(b.x)], 1u);
        const unsigned gen = old / nloc;
        if (old + 1u == (gen + 1u) * nloc) {
            __builtin_amdgcn_fence(__ATOMIC_RELEASE, "agent");
            asm volatile("s_waitcnt vmcnt(0)" ::: "memory");
            const unsigned og = xb_add(&bar[XB_TOP], 1u);
            const unsigned tg = og / nx;
            if (og + 1u == (tg + 1u) * nx) xb_add(&bar[XB_TOPGEN], 1u);
            else XB_SPIN(xb_ld(&bar[XB_TOPGEN]) == tg, bar);
            __builtin_amdgcn_fence(__ATOMIC_ACQUIRE, "agent");
            xb_add(&bar[XB_XGEN(b.x)], 1u);
            asm volatile("s_waitcnt vmcnt(0)" ::: "memory");
        } else {
            XB_SPIN(xb_ld(&bar[XB_XGEN(b.x)]) == gen, bar);
            __builtin_amdgcn_fence(__ATOMIC_ACQUIRE, "agent");
            asm volatile("s_waitcnt vmcnt(0)" ::: "memory");
        }
    } else if (threadIdx.x >= 64) bg();
    __syncthreads();
}

constexpr int D = 1024, MP = 16384, MS = 1024, M = MP + MS, DFF = 2816, INW = 4864;
constexpr float EPS = 1e-6f;
constexpr size_t O_YS = (size_t)MP * D, O_PWK = O_YS + (size_t)MS * D, O_PWV = O_PWK + 65536, O_PST = O_PWV + 65536, O_SWK = O_PST + 262144, O_SWV = O_SWK + 2097152, O_SST = O_SWV + 2097152;
constexpr size_t MiB = 1u << 20, HMiB = 1u << 19;
constexpr size_t WS_CTL = 0, CTL_ZERO_BYTES = 1 * MiB;
constexpr size_t WS_W13 = 1 * MiB, WS_W2 = 12 * MiB, WS_WIN = 17 * MiB + HMiB, WS_WUA = 27 * MiB, WS_WUR = 28 * MiB, WS_WOUT = 29 * MiB;
constexpr size_t WS_DEC = 31 * MiB, WS_RSTD1 = 31 * MiB + HMiB, WS_SSQ1 = 32 * MiB, WS_SSQ2 = 34 * MiB;
constexpr size_t WS_AB = 36 * MiB, WS_BIG = 70 * MiB;
constexpr size_t WS_HID = WS_BIG, WS_Q = WS_BIG, WS_KV = WS_BIG + 17 * MiB, WS_QR = WS_KV + 8 * MiB + HMiB, WS_LOGF = WS_QR + 17 * MiB, WS_MRG = WS_LOGF, WS_IR = WS_LOGF + 34 * MiB,
                 WS_GR = WS_IR + 17 * MiB, WS_SGA = WS_GR + 17 * MiB, WS_SGR = WS_SGA + 17 * MiB, WS_AOR = WS_SGR + 17 * MiB, WS_END = WS_AOR + 34 * MiB;
static_assert(WS_END <= 256 * MiB && WS_HID + (size_t)M * DFF * 2 <= WS_END, "ws map");
constexpr int CW_BAR = 4096;
constexpr int RING_OFF = 0, RING_BYTES = 131072, LDSCTL_OFF = 139264, MISC_OFF = LDSCTL_OFF + 320, LDS_BYTES = 147456;
constexpr int NWAVES = 8;

namespace mk {
using pg8::f32x4; using pg8::u32x4; using pg8::Unit; using pg8::bf16_t; using pg8::cvt_pk_bf16;
typedef unsigned u32x2 __attribute__((ext_vector_type(2)));
__device__ __forceinline__ float fsigmoid(float x) { return __builtin_amdgcn_rcpf(1.f + __expf(-x)); }
__device__ __forceinline__ float fsilu(float x) { return x * fsigmoid(x); }
__device__ __forceinline__ float bflo(unsigned w) { return __uint_as_float(w << 16); }
__device__ __forceinline__ float bfhi(unsigned w) { return __uint_as_float(w & 0xffff0000u); }
__device__ __forceinline__ float bf2f(bf16_t h) { return __uint_as_float((unsigned)h << 16); }
__device__ __forceinline__ u32x4 pack8(const f32x4 a, const f32x4 b) { u32x4 w; w.x = cvt_pk_bf16(a[0], a[1]); w.y = cvt_pk_bf16(a[2], a[3]); w.z = cvt_pk_bf16(b[0], b[1]); w.w = cvt_pk_bf16(b[2], b[3]); return w; }
__device__ __forceinline__ float dot4(const f32x4 a) { return (a[0] * a[0] + a[1] * a[1]) + (a[2] * a[2] + a[3] * a[3]); }
__device__ __forceinline__ unsigned q16(float s) { return (unsigned)(s * 65535.f + 0.5f); }
__device__ __forceinline__ unsigned q8(float s) { return (unsigned)(s * 255.f + 0.5f); }
__device__ __forceinline__ unsigned pack4q8(const f32x4 s) { return q8(s[0]) | (q8(s[1]) << 8) | (q8(s[2]) << 16) | (q8(s[3]) << 24); }
__device__ __forceinline__ f32x4 unpack4q8(unsigned w) { return (f32x4){(float)(w & 0xffu), (float)((w >> 8) & 0xffu), (float)((w >> 16) & 0xffu), (float)(w >> 24)} * (1.f / 255.f); }
__device__ __forceinline__ float row_rstd16(const float* ssqp, int r) {
    const f32x4* p = (const f32x4*)(ssqp + (size_t)r * 16); const f32x4 a = p[0], b = p[1], c = p[2], d = p[3]; const f32x4 s = (a + b) + (c + d);
    return rsqrtf(((s[0] + s[1]) + (s[2] + s[3])) * (1.f / 1024.f) + EPS);
}

constexpr int RTAB_OFF = LDSCTL_OFF + 1024;
template <bool FROM_SSQ, class Sched> __device__ __forceinline__ void build_rstd_table(LAS unsigned char* L, const Sched& S, const float* src, int tid) {
    Unit u;
    for (int i = 0; i < 6 && S.next(i, u); ++i) if (tid < 256) *(LAS float*)(L + RTAB_OFF + (i * 256 + tid) * 4) = FROM_SSQ ? row_rstd16(src, u.pm * 256 + tid) : src[u.pm * 256 + tid];
    __syncthreads();
}
template <bool FROM_SSQ> struct EpiSwiglu {
    static constexpr bool PERM = true, AFTER_DRAIN = false, INIT = false; static constexpr int MIDT = 0, EPI_VM = 8;
    bf16_t* H; const float* rs; LAS unsigned char* tab;
    __device__ __forceinline__ void operator()(const f32x4 (&acc)[2][2][4][2], const Unit& u, int wr, int wc, int fr, int fq) const {
        const int row0 = u.pm * 256 + wr * 64 + fr, col0 = u.pn * 128 + wc * 32 + 8 * fq;
#pragma unroll
        for (int ai = 0; ai < 2; ++ai)
#pragma unroll
            for (int m = 0; m < 4; ++m) {
                const int r = row0 + ai * 128 + m * 16;
                const float s = u.idx < 6 ? *(const LAS float*)(tab + (u.idx * 256 + (r & 255)) * 4) : (FROM_SSQ ? row_rstd16(rs, r) : rs[r]);
                f32x4 h0, h1;
#pragma unroll
                for (int e = 0; e < 4; ++e) { h0[e] = fsilu(acc[ai][0][m][0][e] * s) * (acc[ai][1][m][0][e] * s); h1[e] = fsilu(acc[ai][0][m][1][e] * s) * (acc[ai][1][m][1][e] * s); }
                *(u32x4*)(H + (size_t)r * DFF + col0) = pack8(h0, h1);
            }
    }
};
template <bool WRITE_B> struct EpiResid {
    static constexpr bool PERM = false, AFTER_DRAIN = false, INIT = false; static constexpr int MIDT = 0, EPI_VM = 0;
    const float* xp; const float* xs; float* Hout; bf16_t* HB; float* ssqp; float scale; int base_is_x;
    __device__ __forceinline__ void operator()(const f32x4 (&acc)[2][2][4][2], const Unit& u, int wr, int wc, int fr, int fq) const {
        const int row0 = u.pm * 256 + wr * 64 + fr, col0 = u.pn * 256 + wc * 32 + 4 * fq;
        f32x4 pre[3][4];
#define ER_BASE(g_) (base_is_x ? (row0 + ((g_) >> 2) * 128 + ((g_) & 3) * 16 < MP ? xp + (size_t)(row0 + ((g_) >> 2) * 128 + ((g_) & 3) * 16) * D : xs + (size_t)(row0 + ((g_) >> 2) * 128 + ((g_) & 3) * 16 - MP) * D) : Hout + (size_t)(row0 + ((g_) >> 2) * 128 + ((g_) & 3) * 16) * D)
#define ER_LOAD(g_) do { const float* bp_ = ER_BASE(g_); _Pragma("unroll") for (int q_ = 0; q_ < 4; ++q_) pre[(g_) % 3][q_] = *(const f32x4*)(bp_ + col0 + (q_ >> 1) * 128 + (q_ & 1) * 16); } while (0)
        ER_LOAD(0); ER_LOAD(1);
#pragma unroll
        for (int g = 0; g < 8; ++g) {
            if (g + 2 < 8) ER_LOAD(g + 2);
            const int ai = g >> 2, m = g & 3, r = row0 + ai * 128 + m * 16;
            float* op = Hout + (size_t)r * D; float ss = 0.f;
#pragma unroll
            for (int q = 0; q < 4; ++q) {
                const int bj = q >> 1, n = q & 1, c = col0 + bj * 128 + n * 16; const f32x4 o = pre[g % 3][q] + acc[ai][bj][m][n] * scale;
                if (WRITE_B) *(f32x4*)(op + c) = o; else __builtin_nontemporal_store(o, (f32x4*)(op + c));
                if (WRITE_B) { ss += dot4(o); u32x2 w; w.x = cvt_pk_bf16(o[0], o[1]); w.y = cvt_pk_bf16(o[2], o[3]); *(u32x2*)(HB + (size_t)r * D + c) = w; }
            }
            if (WRITE_B) { ss += __shfl_xor(ss, 16); ss += __shfl_xor(ss, 32); if (fq == 0) ssqp[(size_t)r * 16 + u.pn * 4 + wc] = ss; }
            __builtin_amdgcn_sched_barrier(0);
        }
#undef ER_LOAD
#undef ER_BASE
    }
    __device__ __forceinline__ void tail(const f32x4 (&acc)[4], int r, int c0, int fq) const {
        const float* bp = base_is_x ? (r < MP ? xp + (size_t)r * D : xs + (size_t)(r - MP) * D) : Hout + (size_t)r * D;
        float* op = Hout + (size_t)r * D; float ss = 0.f;
#pragma unroll
        for (int n = 0; n < 4; ++n) {
            const int c = c0 + 16 * n + 4 * fq; const f32x4 b = *(const f32x4*)(bp + c); const f32x4 o = b + acc[n] * scale; if (WRITE_B) *(f32x4*)(op + c) = o; else __builtin_nontemporal_store(o, (f32x4*)(op + c));
            if (WRITE_B) { ss += dot4(o); u32x2 w; w.x = cvt_pk_bf16(o[0], o[1]); w.y = cvt_pk_bf16(o[2], o[3]); *(u32x2*)(HB + (size_t)r * D + c) = w; }
        }
        if (WRITE_B) { ss += __shfl_xor(ss, 16); ss += __shfl_xor(ss, 32); if (fq == 0) ssqp[(size_t)r * 16 + (c0 >> 6)] = ss; }
    }
};
template <bool FINAL> struct EpiResidB {
    static constexpr bool PERM = true, AFTER_DRAIN = false, INIT = true; static constexpr int MIDT = 0, EPI_VM = 0;
    bf16_t* HB; float* Y; float* ssqp; float scale;
    __device__ __forceinline__ void init_issue(u32x4 (&pre)[16], const Unit& u, int wr, int wc, int fr, int fq) const {
        const int row0 = u.pm * 256 + wr * 64 + fr, col0 = u.pn * 256 + wc * 32 + 8 * fq;
#pragma unroll
        for (int g = 0; g < 8; ++g)
#pragma unroll
            for (int bj = 0; bj < 2; ++bj) pre[2 * g + bj] = *(const u32x4*)(HB + (size_t)(row0 + (g >> 2) * 128 + (g & 3) * 16) * D + col0 + 128 * bj);
    }
    __device__ __forceinline__ void init_finish(f32x4 (&acc)[2][2][4][2], const u32x4 (&pre)[16]) const {
        const float inv = 1.f / scale;
#pragma unroll
        for (int g = 0; g < 8; ++g)
#pragma unroll
            for (int bj = 0; bj < 2; ++bj) { const u32x4 b = pre[2 * g + bj];
                acc[g >> 2][bj][g & 3][0] = (f32x4){bflo(b.x), bfhi(b.x), bflo(b.y), bfhi(b.y)} * inv; acc[g >> 2][bj][g & 3][1] = (f32x4){bflo(b.z), bfhi(b.z), bflo(b.w), bfhi(b.w)} * inv; }
    }
    __device__ __forceinline__ void operator()(const f32x4 (&acc)[2][2][4][2], const Unit& u, int wr, int wc, int fr, int fq) const {
        const int row0 = u.pm * 256 + wr * 64 + fr, col0 = u.pn * 256 + wc * 32 + 8 * fq;
#pragma unroll
        for (int g = 0; g < 8; ++g) {
            const int ai = g >> 2, m = g & 3, r = row0 + ai * 128 + m * 16; float ss = 0.f;
#pragma unroll
            for (int bj = 0; bj < 2; ++bj) {
                const f32x4 o0 = acc[ai][bj][m][0] * scale, o1 = acc[ai][bj][m][1] * scale;
                if (FINAL) { float* yp = Y + (size_t)r * D + col0 + 128 * bj; __builtin_nontemporal_store(o0, (f32x4*)yp); __builtin_nontemporal_store(o1, (f32x4*)(yp + 4)); }
                else { ss += dot4(o0) + dot4(o1); *(u32x4*)(HB + (size_t)r * D + col0 + 128 * bj) = pack8(o0, o1); }
            }
            if (!FINAL) { ss += __shfl_xor(ss, 16); ss += __shfl_xor(ss, 32); if (fq == 0) ssqp[(size_t)r * 16 + u.pn * 4 + wc] = ss; }
        }
    }
    __device__ __forceinline__ void tail(const f32x4 (&acc)[4], int r, int c0, int fq) const {
        bf16_t* bp = HB + (size_t)r * D + c0 + 4 * fq; float ss = 0.f; u32x2 b[4];
#pragma unroll
        for (int n = 0; n < 4; ++n) b[n] = *(const u32x2*)(bp + 16 * n);
#pragma unroll
        for (int n = 0; n < 4; ++n) {
            const f32x4 o = (f32x4){bflo(b[n].x), bfhi(b[n].x), bflo(b[n].y), bfhi(b[n].y)} + acc[n] * scale;
            if (FINAL) __builtin_nontemporal_store(o, (f32x4*)(Y + (size_t)r * D + c0 + 16 * n + 4 * fq));
            else { ss += dot4(o); u32x2 w; w.x = cvt_pk_bf16(o[0], o[1]); w.y = cvt_pk_bf16(o[2], o[3]); *(u32x2*)(bp + 16 * n) = w; }
        }
        if (!FINAL) { ss += __shfl_xor(ss, 16); ss += __shfl_xor(ss, 32); if (fq == 0) ssqp[(size_t)r * 16 + (c0 >> 6)] = ss; }
    }
};
struct EpiProj {
    static constexpr bool PERM = true, AFTER_DRAIN = false, INIT = false; static constexpr int MIDT = 0, EPI_VM = 16;
    const float* ssqp; unsigned char* ws; float* out; const float *qn, *kn, *lbl; LAS unsigned char* tab;
    __device__ __forceinline__ void operator()(const f32x4 (&acc)[2][2][4][2], const Unit& u, int wr, int wc, int fr, int fq) const {
        const int pn = u.pn, row0 = u.pm * 256 + wr * 64 + fr, pc = wc * 32 + 8 * fq;
        bf16_t* const Q = (bf16_t*)(ws + WS_Q); bf16_t* const KV = (bf16_t*)(ws + WS_KV); unsigned short* const LOGF = (unsigned short*)(ws + WS_LOGF);
        if (pn < 3) {
            const bool isv = (pn == 2 && wc >= 2);
            const float* gp = (pn < 2) ? qn : kn;
            f32x4 gn[2][2];
#pragma unroll
            for (int bj = 0; bj < 2; ++bj)
#pragma unroll
                for (int n = 0; n < 2; ++n) gn[bj][n] = isv ? (f32x4){1.f, 1.f, 1.f, 1.f} : *(const f32x4*)(gp + 32 * bj + 8 * fq + 4 * n);
#pragma unroll
            for (int ai = 0; ai < 2; ++ai)
#pragma unroll
                for (int m = 0; m < 4; ++m) {
                    const int r = row0 + ai * 128 + m * 16; const float s = u.idx < 6 ? *(const LAS float*)(tab + (u.idx * 256 + (r & 255)) * 4) : row_rstd16(ssqp, r);
                    f32x4 v[2][2]; float ss = 0.f;
#pragma unroll
                    for (int bj = 0; bj < 2; ++bj)
#pragma unroll
                        for (int n = 0; n < 2; ++n) { v[bj][n] = acc[ai][bj][m][n] * s; ss += dot4(v[bj][n]); }
                    ss += __shfl_xor(ss, 16); ss += __shfl_xor(ss, 32);
                    const float nr = isv ? 1.f : rsqrtf(ss * (1.f / 64.f) + EPS);
#pragma unroll
                    for (int bj = 0; bj < 2; ++bj)
#pragma unroll
                        for (int n = 0; n < 2; ++n) v[bj][n] = v[bj][n] * nr * gn[bj][n];
                    bf16_t* dst = (pn < 2) ? Q + (size_t)r * 512 + (4 * pn + wc) * 64 + 8 * fq : KV + (size_t)r * 256 + wc * 64 + 8 * fq;
#pragma unroll
                    for (int bj = 0; bj < 2; ++bj) *(u32x4*)(dst + 32 * bj) = pack8(v[bj][0], v[bj][1]);
                    if (pn == 2) {
                        float* o = nullptr; const int kvh = wc & 1;
                        if (r < MP) { const int t = r & 4095; if (t >= 3968) o = out + (wc < 2 ? O_PWK : O_PWV) + ((size_t)((r >> 12) * 128 + (t - 3968)) * 2 + kvh) * 64; }
                        else { const int rr = r - MP; o = out + (wc < 2 ? O_SWK : O_SWV) + ((size_t)((rr >> 3) * 128 + 120 + (rr & 7)) * 2 + kvh) * 64; }
                        if (o) {
#pragma unroll
                            for (int bj = 0; bj < 2; ++bj)
#pragma unroll
                                for (int n = 0; n < 2; ++n) *(f32x4*)(o + 32 * bj + 8 * fq + 4 * n) = v[bj][n];
                        }
                    }
                }
        } else if (pn >= 5 && pn < 7) {
            const int tc = (pn - 5) * 256 + pc;
            f32x4 lb[2][2];
#pragma unroll
            for (int bj = 0; bj < 2; ++bj)
#pragma unroll
                for (int n = 0; n < 2; ++n) { const f32x4 l0 = *(const f32x4*)(lbl + tc + 128 * bj + 4 * n), l1 = *(const f32x4*)(lbl + 512 + tc + 128 * bj + 4 * n);
#pragma unroll
                    for (int e = 0; e < 4; ++e) lb[bj][n][e] = 1.f / (1.f + __expf(l1[e] - l0[e])); }
#pragma unroll
            for (int ai = 0; ai < 2; ++ai)
#pragma unroll
                for (int m = 0; m < 4; ++m) {
                    const int r = row0 + ai * 128 + m * 16; const float s = u.idx < 6 ? *(const LAS float*)(tab + (u.idx * 256 + (r & 255)) * 4) : row_rstd16(ssqp, r);
#pragma unroll
                    for (int bj = 0; bj < 2; ++bj)
#pragma unroll
                        for (int n = 0; n < 2; ++n) { f32x4 lf;
#pragma unroll
                            for (int e = 0; e < 4; ++e) { const float f = lb[bj][n][e] + (1.f - lb[bj][n][e]) * fsigmoid(acc[ai][bj][m][n][e] * s); lf[e] = f; }
                            u32x2 w; w.x = q16(lf[0]) | (q16(lf[1]) << 16); w.y = q16(lf[2]) | (q16(lf[3]) << 16);
                            *(u32x2*)(LOGF + (size_t)r * 512 + tc + 128 * bj + 4 * n) = w; }
                }
        } else {
            int act, ld, tc; size_t boff;
            if (pn < 5) { act = 1; boff = WS_QR; ld = 512; tc = (pn - 3) * 256 + pc; }
            else if (pn < 9) { act = 0; boff = WS_IR; ld = 512; tc = (pn - 7) * 256 + pc; }
            else if (pn < 11) { act = 1; boff = WS_GR; ld = 512; tc = (pn - 9) * 256 + pc; }
            else if (pn < 15) { act = 2; boff = WS_SGA; ld = 1024; tc = (pn - 11) * 256 + pc; }
            else { act = 2; boff = WS_SGR; ld = 1024; tc = (pn - 15) * 256 + pc; }
            bf16_t* const base = (bf16_t*)(ws + boff);
#pragma unroll
            for (int ai = 0; ai < 2; ++ai)
#pragma unroll
                for (int m = 0; m < 4; ++m) {
                    const int r = row0 + ai * 128 + m * 16; const float s = u.idx < 6 ? *(const LAS float*)(tab + (u.idx * 256 + (r & 255)) * 4) : row_rstd16(ssqp, r);
#pragma unroll
                    for (int bj = 0; bj < 2; ++bj) { f32x4 a, b;
#pragma unroll
                        for (int e = 0; e < 4; ++e) { const float x0 = acc[ai][bj][m][0][e] * s, x1 = acc[ai][bj][m][1][e] * s;
                            a[e] = act == 0 ? x0 : (act == 1 ? fsilu(x0) : fsigmoid(x0)); b[e] = act == 0 ? x1 : (act == 1 ? fsilu(x1) : fsigmoid(x1)); }
                        if (act == 2) { u32x2 w; w.x = pack4q8(a); w.y = pack4q8(b); *(u32x2*)((unsigned char*)base + (size_t)r * ld + tc + 128 * bj) = w; }
                        else *(u32x4*)(base + (size_t)r * ld + tc + 128 * bj) = pack8(a, b); }
                }
        }
    }
};
struct ProjOrder {
    pg8::StaticOrder P; int G, c;
    __device__ void init(int G_, int c_) { P.init(MP, INW, G_, c_); G = G_; c = c_; }
    __device__ bool next(int i, Unit& u) const {
        if (P.next(i, u)) return true;
        const long L = (long)i * G + c - 1216; if (L >= 64) return false;
        const int q = (int)L & 15; u.pm = 64 + ((int)L >> 4); u.pn = q < 11 ? q : q + 3; u.idx = i; return true;
    }
    __device__ __forceinline__ void a_ready(const Unit&) const {}
    __device__ __forceinline__ void done(const Unit&) const {}
};
struct EpiProjTail {
    static constexpr int MIDT = 0, EPI_VM = 0;
    const float* ssqp; bf16_t* SGA;
    __device__ __forceinline__ void tail(const f32x4 (&acc)[4], int r, int c0, int fq) const {
        const float s = row_rstd16(ssqp, r);
#pragma unroll
        for (int n = 0; n < 4; ++n) { f32x4 a;
#pragma unroll
            for (int e = 0; e < 4; ++e) a[e] = fsigmoid(acc[n][e] * s);
            *(unsigned*)((unsigned char*)SGA + (size_t)r * 1024 + c0 + 16 * n + 4 * fq) = pack4q8(a); }
    }
};
template <int PASS> struct EpiUp {
    static constexpr bool PERM = true, AFTER_DRAIN = false, INIT = false; static constexpr int MIDT = 0, EPI_VM = 0;
    bf16_t* MRG; const bf16_t* G;
    __device__ __forceinline__ void operator()(const f32x4 (&acc)[2][2][4][2], const Unit& u, int wr, int wc, int fr, int fq) const {
        const int row0 = u.pm * 256 + wr * 64 + fr, c0 = u.pn * 256 + wc * 32 + 8 * fq;
#pragma unroll
        for (int ai = 0; ai < 2; ++ai)
#pragma unroll
            for (int m = 0; m < 4; ++m) {
                const int r = row0 + ai * 128 + m * 16;
#pragma unroll
                for (int bj = 0; bj < 2; ++bj) {
                    const size_t off = (size_t)r * 1024 + c0 + 128 * bj; const u32x2 g = *(const u32x2*)((const unsigned char*)G + off); const f32x4 ga = unpack4q8(g.x), gb = unpack4q8(g.y);
                    f32x4 a = acc[ai][bj][m][0], b = acc[ai][bj][m][1];
                    a = a * ga; b = b * gb;
                    if (PASS == 1) { const u32x4 p = *(const u32x4*)(MRG + off);
                        a[0] += bflo(p.x); a[1] += bfhi(p.x); a[2] += bflo(p.y); a[3] += bfhi(p.y); b[0] += bflo(p.z); b[1] += bfhi(p.z); b[2] += bflo(p.w); b[3] += bfhi(p.w); }
                    *(u32x4*)(MRG + off) = pack8(a, b);
                }
            }
    }
    __device__ __forceinline__ void tail(const f32x4 (&acc)[4], int r, int c0, int fq) const {
#pragma unroll
        for (int n = 0; n < 4; ++n) {
            const size_t off = (size_t)r * 1024 + c0 + 16 * n + 4 * fq; const f32x4 gq = unpack4q8(*(const unsigned*)((const unsigned char*)G + off));
            f32x4 a = acc[n] * gq;
            if (PASS == 1) { const u32x2 p = *(const u32x2*)(MRG + off); a[0] += bflo(p.x); a[1] += bfhi(p.x); a[2] += bflo(p.y); a[3] += bfhi(p.y); }
            u32x2 w; w.x = cvt_pk_bf16(a[0], a[1]); w.y = cvt_pk_bf16(a[2], a[3]); *(u32x2*)(MRG + off) = w;
        }
    }
};
struct EpiUpR {
    static constexpr bool PERM = true, AFTER_DRAIN = false, INIT = false; static constexpr int MIDT = 8, EPI_VM = 0;
    static constexpr float EPSQ = 1e-18f;
    bf16_t* MRG; const unsigned char* GA; const unsigned char* GR;
    static __device__ __forceinline__ f32x4 q4(unsigned w) { return (f32x4){(float)(w & 0xffu), (float)((w >> 8) & 0xffu), (float)((w >> 16) & 0xffu), (float)(w >> 24)}; }
    static __device__ __forceinline__ f32x4 ratio4(unsigned wa, unsigned wr_) { const f32x4 a = q4(wa), r = q4(wr_);
        return (f32x4){a[0] * __builtin_amdgcn_rcpf(fmaxf(r[0], EPSQ)), a[1] * __builtin_amdgcn_rcpf(fmaxf(r[1], EPSQ)), a[2] * __builtin_amdgcn_rcpf(fmaxf(r[2], EPSQ)), a[3] * __builtin_amdgcn_rcpf(fmaxf(r[3], EPSQ))}; }
    static __device__ __forceinline__ f32x4 gate4(unsigned wr_) { const f32x4 r = q4(wr_); return (f32x4){fmaxf(r[0], EPSQ), fmaxf(r[1], EPSQ), fmaxf(r[2], EPSQ), fmaxf(r[3], EPSQ)} * (1.f / 255.f); }
    __device__ __forceinline__ void mid(f32x4 (&acc)[2][2][4][2], const Unit& u, int wr, int wc, int fr, int fq) const {
        const int row0 = u.pm * 256 + wr * 64 + fr, c0 = u.pn * 256 + wc * 32 + 8 * fq;
#pragma unroll
        for (int ai = 0; ai < 2; ++ai)
#pragma unroll
            for (int m = 0; m < 4; ++m) {
                const int r = row0 + ai * 128 + m * 16;
#pragma unroll
                for (int bj = 0; bj < 2; ++bj) {
                    const size_t off = (size_t)r * 1024 + c0 + 128 * bj; const u32x2 ga = *(const u32x2*)(GA + off), gr = *(const u32x2*)(GR + off);
                    acc[ai][bj][m][0] = acc[ai][bj][m][0] * ratio4(ga.x, gr.x); acc[ai][bj][m][1] = acc[ai][bj][m][1] * ratio4(ga.y, gr.y);
                }
                if (m == 1 || m == 3) __builtin_amdgcn_sched_barrier(0);
            }
    }
    __device__ __forceinline__ void operator()(const f32x4 (&acc)[2][2][4][2], const Unit& u, int wr, int wc, int fr, int fq) const {
        const int row0 = u.pm * 256 + wr * 64 + fr, c0 = u.pn * 256 + wc * 32 + 8 * fq;
#pragma unroll
        for (int ai = 0; ai < 2; ++ai)
#pragma unroll
            for (int m = 0; m < 4; ++m) {
                const int r = row0 + ai * 128 + m * 16;
#pragma unroll
                for (int bj = 0; bj < 2; ++bj) {
                    const size_t off = (size_t)r * 1024 + c0 + 128 * bj; const u32x2 gr = *(const u32x2*)(GR + off);
                    *(u32x4*)(MRG + off) = pack8(acc[ai][bj][m][0] * gate4(gr.x), acc[ai][bj][m][1] * gate4(gr.y));
                }
            }
    }
    __device__ __forceinline__ void mid_tail(f32x4 (&acc)[4], int r, int c0, int fq) const {
#pragma unroll
        for (int n = 0; n < 4; ++n) { const size_t off = (size_t)r * 1024 + c0 + 16 * n + 4 * fq; acc[n] = acc[n] * ratio4(*(const unsigned*)(GA + off), *(const unsigned*)(GR + off)); }
    }
    __device__ __forceinline__ void tail(const f32x4 (&acc)[4], int r, int c0, int fq) const {
#pragma unroll
        for (int n = 0; n < 4; ++n) { const size_t off = (size_t)r * 1024 + c0 + 16 * n + 4 * fq; const f32x4 a = acc[n] * gate4(*(const unsigned*)(GR + off));
            u32x2 w; w.x = cvt_pk_bf16(a[0], a[1]); w.y = cvt_pk_bf16(a[2], a[3]); *(u32x2*)(MRG + off) = w; }
    }
};
template <class Epi> __device__ __forceinline__ void gemm_tail(LAS unsigned char* L, const bf16_t* A, const bf16_t* Bt, int K, int row_base, int ntr, int ntc, int v, int G, const Epi& E, int tid, int lane, int wave) {
    constexpr int RS = 528, OPB = 64 * RS, BUF = 2 * OPB, XCH = 0;
    static_assert(2 * BUF <= LDSCTL_OFF, "tail buffers must stay below the LDS control words");
    const int fr = lane & 15, fq = lane >> 4, rw = wave & 3, kh = wave >> 2, nc = K / 256;
    const int lrow = tid >> 5, lch = tid & 31;
    for (int tt = v; tt < ntr * ntc; tt += G) {
        int tr = tt / ntc, tc = tt % ntc;
        if (ntr == 16 && ntc == 16 && G == 256) { const int x = tt >> 5, q = tt & 31; tr = (x >> 1) * 4 + (q >> 3); tc = (x & 1) * 8 + (q & 7); }
        const int r0 = row_base + 64 * tr, c0 = 64 * tc;
        const bf16_t* Ag = A + (size_t)(r0 + lrow) * K + 8 * lch; const bf16_t* Bg = Bt + (size_t)(c0 + lrow) * K + 8 * lch; const size_t h16 = (size_t)16 * K;
        u32x4 ra0[4], rb0[4], ra1[4], rb1[4], ra2[4], rb2[4];
#define TL_LOAD(ra, rb, c) do { _Pragma("unroll") for (int j_ = 0; j_ < 4; ++j_) { ra[j_] = *(const u32x4*)(Ag + j_ * h16 + 256 * (c)); rb[j_] = *(const u32x4*)(Bg + j_ * h16 + 256 * (c)); } } while (0)
#define TL_WRITE(ra, rb, b) do { LAS unsigned char* p_ = L + (b) * BUF + lrow * RS + lch * 16; _Pragma("unroll") for (int j_ = 0; j_ < 4; ++j_) { *(LAS u32x4*)(p_ + j_ * 16 * RS) = ra[j_]; *(LAS u32x4*)(p_ + OPB + j_ * 16 * RS) = rb[j_]; } } while (0)
#define TL_COMP(b) do { _Pragma("unroll") for (int i_ = 0; i_ < 4; ++i_) { const int ko_ = (32 * (4 * kh + i_) + 8 * fq) * 2; \
            const pg8::bf16x8 a_ = *(const LAS pg8::bf16x8*)(L + (b) * BUF + (16 * rw + fr) * RS + ko_); \
            _Pragma("unroll") for (int n = 0; n < 4; ++n) { const pg8::bf16x8 b_ = *(const LAS pg8::bf16x8*)(L + (b) * BUF + OPB + (16 * n + fr) * RS + ko_); acc[n] = __builtin_amdgcn_mfma_f32_16x16x32_bf16(b_, a_, acc[n], 0, 0, 0); } } } while (0)
#define TL_STEP(ra, rb, rna, rnb, b, cc) do { if ((cc) < nc) { if ((cc) + 1 < nc) TL_WRITE(rna, rnb, (b) ^ 1); if constexpr (Epi::MIDT > 0) { if ((cc) == Epi::MIDT / 4) E.mid_tail(acc, r0 + 16 * rw + fr, c0, fq); } TL_COMP(b); if ((cc) + 3 < nc) TL_LOAD(ra, rb, (cc) + 3); __syncthreads(); } } while (0)
        f32x4 acc[4];
#pragma unroll
        for (int n = 0; n < 4; ++n) acc[n] = (f32x4){0.f, 0.f, 0.f, 0.f};
        TL_LOAD(ra0, rb0, 0); if (1 < nc) TL_LOAD(ra1, rb1, 1); if (2 < nc) TL_LOAD(ra2, rb2, 2);
        TL_WRITE(ra0, rb0, 0); __syncthreads();
#pragma unroll 1
        for (int c = 0; c < nc; c += 6) { TL_STEP(ra0, rb0, ra1, rb1, 0, c); TL_STEP(ra1, rb1, ra2, rb2, 1, c + 1); TL_STEP(ra2, rb2, ra0, rb0, 0, c + 2); TL_STEP(ra0, rb0, ra1, rb1, 1, c + 3); TL_STEP(ra1, rb1, ra2, rb2, 0, c + 4); TL_STEP(ra2, rb2, ra0, rb0, 1, c + 5); }
#undef TL_STEP
#undef TL_LOAD
#undef TL_WRITE
#undef TL_COMP
        if (kh == 1) {
#pragma unroll
            for (int n = 0; n < 4; ++n) *(LAS f32x4*)(L + XCH + ((rw * 4 + n) * 64 + lane) * 16) = acc[n];
        }
        __syncthreads();
        if (kh == 0) {
#pragma unroll
            for (int n = 0; n < 4; ++n) acc[n] += *(const LAS f32x4*)(L + XCH + ((rw * 4 + n) * 64 + lane) * 16);
            E.tail(acc, r0 + 16 * rw + fr, c0, fq);
        }
        __syncthreads();
    }
}
__device__ __forceinline__ float wave_sum(float v) {
#pragma unroll
    for (int o = 1; o < 64; o <<= 1) v += __shfl_xor(v, o);
    return v;
}
struct WI { const float* W; const float* gain; bf16_t* WT; int ldw, K, dr, sc, k0; };
__device__ __forceinline__ void wi_set(WI& w, int kind, const float* W, const float* W2, int ldw, int K, bf16_t* WT, int nrg, const float* gain, int it) {
    const int kb = it / nrg, rg = it % nrg, p0 = rg * 32; int sc = p0; const float* Ws = W;
    if (kind == 1) { if ((p0 & 255) >> 7) Ws = W2; sc = 128 * (p0 >> 8) + (p0 & 127); }
    else if (kind == 2) { const int tile = p0 >> 8; if (tile < 3) sc = 256 * tile + 64 * ((p0 & 127) >> 5) + 32 * ((p0 & 255) >> 7); }
    w.W = Ws; w.gain = gain; w.WT = WT; w.ldw = ldw; w.K = K; w.dr = p0; w.sc = sc; w.k0 = 64 * kb;
}
__device__ __forceinline__ void wi_load(const WI& w, f32x4 (&r)[8], int lane) {
    const int lr = lane >> 3, lc4 = (lane & 7) * 4;
#pragma unroll
    for (int i = 0; i < 8; ++i) r[i] = __builtin_nontemporal_load((const GAS f32x4*)(w.W + (size_t)(w.k0 + 8 * i + lr) * w.ldw + w.sc + lc4));
}
__device__ __forceinline__ void wi_proc(const WI& w, const f32x4 (&r)[8], LAS float* scr, int lane) {
    const int lr = lane >> 3, lc4 = (lane & 7) * 4;
#pragma unroll
    for (int i = 0; i < 8; ++i) { const int kk = 8 * i + lr; const float gsc = w.gain ? w.gain[w.k0 + kk] : 1.f;
        scr[kk * 33 + lc4 + 0] = r[i][0] * gsc; scr[kk * 33 + lc4 + 1] = r[i][1] * gsc; scr[kk * 33 + lc4 + 2] = r[i][2] * gsc; scr[kk * 33 + lc4 + 3] = r[i][3] * gsc; }
    LDS_WAIT(); asm volatile("" ::: "memory");
    const int c = lane & 7;
#pragma unroll
    for (int j = 0; j < 4; ++j) { const int n = (lane >> 3) + 8 * j; const LAS float* s = scr + (8 * c) * 33 + n;
        v4u o; o.x = pk2(s[0 * 33], s[1 * 33]); o.y = pk2(s[2 * 33], s[3 * 33]); o.z = pk2(s[4 * 33], s[5 * 33]); o.w = pk2(s[6 * 33], s[7 * 33]);
        *(GAS v4u*)(w.WT + (size_t)(w.dr + n) * w.K + w.k0 + 8 * c) = o; }
    LDS_WAIT(); asm volatile("" ::: "memory");
}
}


namespace at {
using pg8::bf16_t; using pg8::bf16x8; using pg8::u32x4; using pg8::cvt_pk_bf16;
typedef float f32x16 __attribute__((ext_vector_type(16)));
typedef short v4i16_t __attribute__((ext_vector_type(4)));
typedef unsigned u32x2 __attribute__((ext_vector_type(2)));
constexpr int KS_OFF = 0, VS_OFF = 46080, LUT_OFF = 87040, KROW = 144;
__device__ const unsigned char T5LUT[129] = {0, 1, 2, 3, 4, 5, 6, 7, 8, 9, 10, 11, 12, 13, 14, 15, 16, 16, 16, 17, 17, 18, 18, 18, 19, 19, 19, 20, 20, 20, 20, 21, 21, 21, 21, 22, 22, 22, 22, 22, 23, 23, 23, 23, 23, 23, 24, 24, 24, 24, 24, 24, 25, 25, 25, 25, 25, 25, 25, 26, 26, 26, 26, 26, 26, 26, 26, 27, 27, 27, 27, 27, 27, 27, 27, 27, 27, 28, 28, 28, 28, 28, 28, 28, 28, 28, 28, 29, 29, 29, 29, 29, 29, 29, 29, 29, 29, 29, 29, 30, 30, 30, 30, 30, 30, 30, 30, 30, 30, 30, 30, 30, 30, 31, 31, 31, 31, 31, 31, 31, 31, 31, 31, 31, 31, 31, 31, 31, 31};
__device__ __forceinline__ v4i16_t trr(LAS const unsigned char* p) { return __builtin_amdgcn_ds_read_tr16_b64_v4i16((LAS v4i16_t*)p); }
__device__ __forceinline__ void attn_wave(const bf16x8 (&qf)[4], LAS const unsigned char* Kt, LAS const unsigned char* Vt, int vdh, LAS const float* lut, float sink, int iq, int jmin, int kb0, int lane, f32x16 (&o)[2]) {
    const int ql = lane & 31, h = lane >> 5;
    f32x16 acc[5];
#pragma unroll
    for (int kb = 0; kb < 5; ++kb) {
        acc[kb] = (f32x16){};
        LAS const unsigned char* kp = Kt + (32 * (kb0 + kb) + ql) * KROW + 16 * h;
#pragma unroll
        for (int ds = 0; ds < 4; ++ds) { const bf16x8 a = *(LAS const bf16x8*)(kp + 32 * ds); acc[kb] = __builtin_amdgcn_mfma_f32_32x32x16_bf16(a, qf[ds], acc[kb], 0, 0, 0); }
    }
    const int base = iq + 128 - 4 * h - 32 * kb0, dmax0 = iq + 128 - jmin; const unsigned dmax = (unsigned)(dmax0 < 128 ? dmax0 : 128);
    const float sink2 = sink * 1.4426950408889634f; float mx = sink2;
#pragma unroll
    for (int kb = 0; kb < 5; ++kb)
#pragma unroll
        for (int r = 0; r < 16; ++r) {
            const int dist = base - (32 * kb + (r & 3) + 8 * (r >> 2));
            const float s = ((unsigned)dist <= dmax) ? __builtin_fmaf(acc[kb][r], 0.125f * 1.4426950408889634f, lut[dist]) : -INFINITY;
            acc[kb][r] = s; mx = fmaxf(mx, s);
        }
    mx = fmaxf(mx, __shfl_xor(mx, 32));
    float l = 0.f;
#pragma unroll
    for (int kb = 0; kb < 5; ++kb)
#pragma unroll
        for (int r = 0; r < 16; ++r) { const float p = __builtin_amdgcn_exp2f(acc[kb][r] - mx); acc[kb][r] = p; l += p; }
    l += __shfl_xor(l, 32);
    l += __builtin_amdgcn_exp2f(sink2 - mx);
    const float inv = 1.f / l;
    o[0] = (f32x16){}; o[1] = (f32x16){};
    const int g16 = (lane >> 4) & 1, q4 = (lane & 15) >> 2, p4 = lane & 3;
#pragma unroll
    for (int kb = 0; kb < 5; ++kb)
#pragma unroll
        for (int s2 = 0; s2 < 2; ++s2) {
            u32x4 pw; pw.x = cvt_pk_bf16(acc[kb][8 * s2 + 0], acc[kb][8 * s2 + 1]); pw.y = cvt_pk_bf16(acc[kb][8 * s2 + 2], acc[kb][8 * s2 + 3]);
            pw.z = cvt_pk_bf16(acc[kb][8 * s2 + 4], acc[kb][8 * s2 + 5]); pw.w = cvt_pk_bf16(acc[kb][8 * s2 + 6], acc[kb][8 * s2 + 7]);
            const bf16x8 pf = __builtin_bit_cast(bf16x8, pw);
            const int key = 32 * (kb0 + kb) + 16 * s2 + 4 * h + q4;
#pragma unroll
            for (int db = 0; db < 2; ++db) {
                LAS const unsigned char* vp = Vt + db * vdh + key * 64 + (16 * g16 + 4 * p4) * 2;
                const v4i16_t lo = trr(vp), hi = trr(vp + 8 * 64);
                const bf16x8 a = (bf16x8){lo[0], lo[1], lo[2], lo[3], hi[0], hi[1], hi[2], hi[3]};
                o[db] = __builtin_amdgcn_mfma_f32_32x32x16_bf16(a, pf, o[db], 0, 0, 0);
            }
        }
#pragma unroll
    for (int db = 0; db < 2; ++db)
#pragma unroll
        for (int r = 0; r < 16; ++r) o[db][r] *= inv;
}
__device__ __forceinline__ void attn_store(bf16_t* dst, const f32x16 (&o)[2], int h) {
#pragma unroll
    for (int db = 0; db < 2; ++db)
#pragma unroll
        for (int rg = 0; rg < 4; ++rg) { u32x2 w; w.x = cvt_pk_bf16(o[db][4 * rg + 0], o[db][4 * rg + 1]); w.y = cvt_pk_bf16(o[db][4 * rg + 2], o[db][4 * rg + 3]);
            *(u32x2*)(dst + 32 * db + 8 * rg + 4 * h) = w; }
}
__device__ __forceinline__ void attn_prompt_task(LAS unsigned char* L, const bf16_t* Q, bf16_t* AOR, const bf16_t* KV, const float* table, const float* sinks, int b, int n, int kvh, int tid, int lane, int wave) {
    const int m0 = b * 4096 + 128 * n;
    for (int c = tid; c < 2048; c += 512) {
        const int j = c >> 3, ch = c & 7; u32x4 kx = (u32x4){0u, 0u, 0u, 0u}, vx = kx;
        if (n > 0 || j >= 128) { const bf16_t* src = KV + (size_t)(m0 - 128 + j) * 256 + kvh * 64 + 8 * ch; kx = *(const u32x4*)src; vx = *(const u32x4*)(src + 128); }
        *(LAS u32x4*)(L + KS_OFF + j * KROW + 16 * ch) = kx;
        *(LAS u32x4*)(L + VS_OFF + (ch >> 2) * 16384 + j * 64 + (ch & 3) * 16) = vx;
    }
    for (int e = tid; e < 4 * 129; e += 512) { const int hl = e / 129, d = e % 129; ((LAS float*)(L + LUT_OFF))[hl * 132 + d] = table[T5LUT[d] * 8 + 4 * kvh + hl] * 1.4426950408889634f; }
    __syncthreads();
    const int ql = lane & 31, h = lane >> 5, hl = wave & 3, head = 4 * kvh + hl;
    const float sink = sinks[head];
#pragma unroll 1
    for (int rep = 0; rep < 2; ++rep) {
        const int qb = (wave >> 2) + 2 * rep, iq = 32 * qb + ql;
        const bf16_t* qp = Q + (size_t)(m0 + iq) * 512 + head * 64;
        bf16x8 qf[4];
#pragma unroll
        for (int ds = 0; ds < 4; ++ds) qf[ds] = *(const bf16x8*)(qp + 16 * ds + 8 * h);
        f32x16 o[2];
        attn_wave(qf, L + KS_OFF, L + VS_OFF, 16384, (LAS const float*)(L + LUT_OFF) + hl * 132, sink, iq, n == 0 ? 128 : 0, qb, lane, o);
        attn_store(AOR + (size_t)(m0 + iq) * 1024 + head * 64, o, h);
    }
    __syncthreads();
}
__device__ __forceinline__ void attn_sample_task(LAS unsigned char* L, const bf16_t* Q, bf16_t* AOR, const bf16_t* KV, const float* wk, const float* wv, const float* table, const float* sinks, int bd, int kvh, int tid, int lane, int wave) {
    for (int c = tid; c < 1280; c += 512) {
        const int j = c >> 3, ch = c & 7; u32x4 kx = (u32x4){0u, 0u, 0u, 0u}, vx = kx;
        if (j < 128) {
            const size_t so = ((size_t)(bd * 128 + j) * 2 + kvh) * 64 + 8 * ch;
            const f32x4 k0 = *(const f32x4*)(wk + so), k1 = *(const f32x4*)(wk + so + 4), v0 = *(const f32x4*)(wv + so), v1 = *(const f32x4*)(wv + so + 4);
            kx = mk::pack8(k0, k1); vx = mk::pack8(v0, v1);
        } else if (j < 136) { const bf16_t* src = KV + (size_t)(MP + bd * 8 + (j - 128)) * 256 + kvh * 64 + 8 * ch; kx = *(const u32x4*)src; vx = *(const u32x4*)(src + 128); }
        *(LAS u32x4*)(L + KS_OFF + j * KROW + 16 * ch) = kx;
        *(LAS u32x4*)(L + VS_OFF + (ch >> 2) * 10240 + j * 64 + (ch & 3) * 16) = vx;
    }
    for (int e = tid; e < 4 * 129; e += 512) { const int hl = e / 129, d = e % 129; ((LAS float*)(L + LUT_OFF))[hl * 132 + d] = table[T5LUT[d] * 8 + 4 * kvh + hl] * 1.4426950408889634f; }
    __syncthreads();
    if (wave == 0) {
        const int ql = lane & 31, h = lane >> 5, hl = ql >> 3, iq = ql & 7, head = 4 * kvh + hl;
        const bf16_t* qp = Q + (size_t)(MP + bd * 8 + iq) * 512 + head * 64;
        bf16x8 qf[4];
#pragma unroll
        for (int ds = 0; ds < 4; ++ds) qf[ds] = *(const bf16x8*)(qp + 16 * ds + 8 * h);
        f32x16 o[2];
        attn_wave(qf, L + KS_OFF, L + VS_OFF, 10240, (LAS const float*)(L + LUT_OFF) + hl * 132, sinks[head], iq, 0, 0, lane, o);
        attn_store(AOR + (size_t)(MP + bd * 8 + iq) * 1024 + head * 64, o, h);
    }
    __syncthreads();
}
}

namespace hg {
using pg8::bf16_t; using pg8::bf16x8; using pg8::f32x4; using pg8::u32x4; using pg8::cvt_pk_bf16;
typedef short v4i16_t __attribute__((ext_vector_type(4)));
typedef unsigned u32x2 __attribute__((ext_vector_type(2)));
__device__ __forceinline__ v4i16_t trr(LAS const unsigned char* p) { return __builtin_amdgcn_ds_read_tr16_b64_v4i16((LAS v4i16_t*)p); }
constexpr int TS = 288;
constexpr float FQ = 1.f / 65535.f;
struct HaPre { unsigned short lf[16]; u32x4 vch[2]; };
__device__ __forceinline__ void ha_issue(HaPre& P, const unsigned short* LOGF, const bf16_t* IR, int task, int tid) {
    const int bh = task >> 6, c = task & 63, h = bh & 3; const size_t m0 = (size_t)(bh >> 2) * 4096 + 64 * c; const int kd = tid & 127, seg = tid >> 7;
#pragma unroll
    for (int i = 0; i < 16; ++i) P.lf[i] = LOGF[(m0 + 16 * seg + i) * 512 + h * 128 + kd];
#pragma unroll
    for (int q = 0; q < 2; ++q) { const int cid = tid + 512 * q, t = cid >> 4, ch = cid & 15; P.vch[q] = *(const u32x4*)(IR + (m0 + t) * 512 + h * 128 + 8 * ch); }
}
__device__ __forceinline__ void ha_phase(LAS unsigned char* L, HaPre& P, const unsigned short* LOGF, const bf16_t* IR, bf16_t* US, float* DEC, int v, int G, int tid, int lane, int wave) {
    constexpr int KT = 0, VT = 64 * TS, SEG = 2 * 64 * TS, DCS = SEG + 2048;
#pragma unroll 1
    for (int grp = v; grp < 256; grp += G) {
        const int kd = tid & 127, seg = tid >> 7, g = lane >> 4, q4 = (lane & 15) >> 2, p4 = lane & 3;
        f32x4 acc[8];
#pragma unroll
        for (int i = 0; i < 8; ++i) acc[i] = (f32x4){0.f, 0.f, 0.f, 0.f};
        float dg = 1.f;
#pragma unroll 1
        for (int cc = 0; cc < 4; ++cc) {
            float lf[16]; float run = 1.f;
#pragma unroll
            for (int i = 0; i < 16; ++i) { lf[i] = (float)P.lf[i] * FQ; run *= lf[i]; }
            ((LAS float*)(L + SEG))[seg * 128 + kd] = run;
#pragma unroll
            for (int q = 0; q < 2; ++q) { const int cid = tid + 512 * q, t = cid >> 4, ch = cid & 15; *(LAS u32x4*)(L + VT + t * TS + ch * 16) = P.vch[q]; }
            const int nxt = cc < 3 ? 4 * grp + cc + 1 : 4 * (grp + G);
            if (nxt < 1024) ha_issue(P, LOGF, IR, nxt, tid);
            __syncthreads();
            {
                const LAS float* sg = (const LAS float*)(L + SEG);
                const float s0 = sg[kd], s1 = sg[128 + kd], s2 = sg[256 + kd], s3 = sg[384 + kd];
                float suf = seg == 3 ? 1.f : (seg == 2 ? s3 : (seg == 1 ? s2 * s3 : s1 * (s2 * s3)));
#pragma unroll
                for (int i = 15; i >= 0; --i) { const float kt = (1.f - lf[i]) * suf; suf *= lf[i]; *(LAS bf16_t*)(L + KT + (16 * seg + i) * TS + kd * 2) = (bf16_t)cvt_pk_bf16(kt, 0.f); }
                const float dcv = (s0 * s1) * (s2 * s3); dg *= dcv;
                if (seg == 0) ((LAS float*)(L + DCS))[kd] = dcv;
            }
            __syncthreads();
            {
                bf16x8 bv[2];
#pragma unroll
                for (int ks = 0; ks < 2; ++ks) { LAS const unsigned char* vp = L + VT + (32 * ks + 4 * g + q4) * TS + (16 * wave + 4 * p4) * 2; const v4i16_t lo = trr(vp), hi = trr(vp + 16 * TS);
                    bv[ks] = (bf16x8){lo[0], lo[1], lo[2], lo[3], hi[0], hi[1], hi[2], hi[3]}; }
#pragma unroll
                for (int i = 0; i < 8; ++i) {
                    const f32x4 dc = *(const LAS f32x4*)(L + DCS + (16 * i + 4 * g) * 4);
                    acc[i] = acc[i] * dc;
#pragma unroll
                    for (int ks = 0; ks < 2; ++ks) { LAS const unsigned char* kp = L + KT + (32 * ks + 4 * g + q4) * TS + (16 * i + 4 * p4) * 2; const v4i16_t lo = trr(kp), hi = trr(kp + 16 * TS);
                        const bf16x8 a = (bf16x8){lo[0], lo[1], lo[2], lo[3], hi[0], hi[1], hi[2], hi[3]};
                        acc[i] = __builtin_amdgcn_mfma_f32_16x16x32_bf16(a, bv[ks], acc[i], 0, 0, 0); }
                }
            }
            __syncthreads();
        }
        const size_t ub = ((size_t)grp * 128 + 16 * wave + (lane & 15)) * 128 + 4 * g;
#pragma unroll
        for (int i = 0; i < 8; ++i) { u32x2 w; w.x = cvt_pk_bf16(acc[i][0], acc[i][1]); w.y = cvt_pk_bf16(acc[i][2], acc[i][3]); *(u32x2*)(US + ub + 16 * i) = w; }
        if (seg == 0) DEC[(size_t)grp * 128 + kd] = dg;
    }
}
__device__ __forceinline__ void hb_scan(unsigned* US32, const float* DEC, float* out_pst, int idx) {
    const int bh = idx >> 13, pair = idx & 8191, vd = pair >> 6, kd0 = (pair & 63) * 2;
    float s0 = 0.f, s1 = 0.f;
    unsigned* up = US32 + (size_t)bh * 16 * 8192 + pair; const float* dp = DEC + (size_t)bh * 16 * 128 + kd0;
#pragma unroll 1
    for (int c0 = 0; c0 < 16; c0 += 8) {
        unsigned w[8]; float d0[8], d1[8];
#pragma unroll
        for (int i = 0; i < 8; ++i) { w[i] = up[(size_t)(c0 + i) * 8192]; const float2 dd = *(const float2*)(dp + (c0 + i) * 128); d0[i] = dd.x; d1[i] = dd.y; }
#pragma unroll
        for (int i = 0; i < 8; ++i) { up[(size_t)(c0 + i) * 8192] = cvt_pk_bf16(s0, s1); s0 = d0[i] * s0 + mk::bflo(w[i]); s1 = d1[i] * s1 + mk::bfhi(w[i]); }
    }
    out_pst[((size_t)bh * 128 + kd0) * 128 + vd] = s0; out_pst[((size_t)bh * 128 + kd0 + 1) * 128 + vd] = s1;
}
struct HcPre { unsigned short lf[16], q[16]; u32x4 vch[2]; u32x2 st[8]; };
__device__ __forceinline__ float dpp_xor1(float x) { return __builtin_bit_cast(float, __builtin_amdgcn_mov_dpp(__builtin_bit_cast(int, x), 0xB1, 0xF, 0xF, true)); }
__device__ __forceinline__ void hc_issue_prompt(HcPre& P, const unsigned short* LOGF, const bf16_t* QR, const bf16_t* IR, const bf16_t* US, int task, bool st, int tid, int lane, int wave) {
    const int bh = task >> 6, c = task & 63, h = bh & 3; const size_t m0 = (size_t)(bh >> 2) * 4096 + 64 * c;
    { const int kd = tid & 127, sub = tid >> 7;
#pragma unroll
      for (int t = 0; t < 16; ++t) { const size_t off = (m0 + 16 * sub + t) * 512 + h * 128 + kd; P.lf[t] = LOGF[off]; P.q[t] = QR[off]; } }
#pragma unroll
    for (int q = 0; q < 2; ++q) { const int cid = tid + 512 * q, t = cid >> 4, ch = cid & 15; P.vch[q] = *(const u32x4*)(IR + (m0 + t) * 512 + h * 128 + 8 * ch); }
    if (st) {
        const bf16_t* USt = US + (size_t)(task >> 2) * 16384; const int g = lane >> 4, vd = 16 * wave + (lane & 15);
#pragma unroll
        for (int i = 0; i < 8; ++i) P.st[i] = *(const u32x2*)(USt + (size_t)vd * 128 + 16 * i + 4 * g);
    }
}
__device__ __forceinline__ void hc_phase_prompt(LAS unsigned char* L, const unsigned short* LOGF, const bf16_t* QR, bf16_t* AOR, const bf16_t* IR, const bf16_t* GR, const float* hgn, const bf16_t* US, int v, int G, int tid, int lane, int wave) {
    constexpr int QH = 0, KH = 17408, KT = 34816, VT = 53248, AT = 71680, DECS = 73728, OT = 75776, QS = 272, OS = 132;
    const int g = lane >> 4, lc = lane & 15, q4 = lc >> 2, p4 = lane & 3, vd = 16 * wave + lc;
    const int et = tid >> 3, ec = (tid & 7) * 16;
    const f32x4 n0 = *(const f32x4*)(hgn + ec), n1 = *(const f32x4*)(hgn + ec + 4), n2 = *(const f32x4*)(hgn + ec + 8), n3 = *(const f32x4*)(hgn + ec + 12);
    HcPre P;
    if (v < 256) hc_issue_prompt(P, LOGF, QR, IR, US, 4 * v, true, tid, lane, wave);
    f32x4 sacc[8];
#pragma unroll
    for (int i = 0; i < 8; ++i) sacc[i] = (f32x4){0.f, 0.f, 0.f, 0.f};
#pragma unroll 1
    for (int grp = v; grp < 256; grp += G)
#pragma unroll 1
    for (int cc = 0; cc < 4; ++cc) {
        const int task = 4 * grp + cc;
        const int bh = task >> 6, c = task & 63, h = bh & 3; const size_t m0 = (size_t)(bh >> 2) * 4096 + 64 * c;
        if (cc == 0) {
#pragma unroll
            for (int i = 0; i < 8; ++i) sacc[i] = (f32x4){mk::bflo(P.st[i].x), mk::bfhi(P.st[i].x), mk::bflo(P.st[i].y), mk::bfhi(P.st[i].y)};
        }
        float lf[16], qv[16];
#pragma unroll
        for (int t = 0; t < 16; ++t) { lf[t] = (float)P.lf[t] * FQ; qv[t] = mk::bf2f(P.q[t]); }
#pragma unroll
        for (int q = 0; q < 2; ++q) { const int cid = tid + 512 * q, t = cid >> 4, ch = cid & 15; *(LAS u32x4*)(L + VT + t * TS + ch * 16) = P.vch[q]; }
        const size_t eoff = (m0 + et) * 512 + h * 128 + ec;
        const u32x4 g0 = *(const u32x4*)(GR + eoff), g1 = *(const u32x4*)(GR + eoff + 8);
        { const int nxt = cc < 3 ? task + 1 : 4 * (grp + G); if (nxt < 1024) hc_issue_prompt(P, LOGF, QR, IR, US, nxt, cc == 3, tid, lane, wave); }
        {
            const int kd = tid & 127, sub = tid >> 7, odd = lane & 1, kde = kd & ~1; float pp[16]; float p = 1.f;
#pragma unroll
            for (int t = 0; t < 16; ++t) { p *= lf[t]; pp[t] = p; }
            float suf = 1.f;
#pragma unroll
            for (int t = 14; t >= 0; t -= 2) {
                const float kk1 = 1.f - lf[t + 1], kk0 = 1.f - lf[t];
                const float qh1 = qv[t + 1] * pp[t + 1], kh1 = kk1 * __builtin_amdgcn_rcpf(fmaxf(pp[t + 1], 1e-30f)), kt1 = kk1 * suf; suf *= lf[t + 1];
                const float qh0 = qv[t] * pp[t], kh0 = kk0 * __builtin_amdgcn_rcpf(fmaxf(pp[t], 1e-30f)), kt0 = kk0 * suf; suf *= lf[t];
                const int ro = 16 * sub + t + odd;
                const float rq = dpp_xor1(odd ? qh0 : qh1), rk = dpp_xor1(odd ? kh0 : kh1), rt = dpp_xor1(odd ? kt0 : kt1);
                *(LAS unsigned*)(L + QH + ro * QS + kde * 2) = odd ? cvt_pk_bf16(rq, qh1) : cvt_pk_bf16(qh0, rq);
                *(LAS unsigned*)(L + KH + ro * QS + kde * 2) = odd ? cvt_pk_bf16(rk, kh1) : cvt_pk_bf16(kh0, rk);
                *(LAS unsigned*)(L + KT + ro * TS + kde * 2) = odd ? cvt_pk_bf16(rt, kt1) : cvt_pk_bf16(kt0, rt);
            }
            *(LAS float*)(L + DECS + (sub * 128 + kd) * 4) = p;
        }
        __syncthreads();
        if (wave < 4) {
            f32x4 acc = (f32x4){0.f, 0.f, 0.f, 0.f};
#pragma unroll
            for (int ks = 0; ks < 4; ++ks) { const bf16x8 a = *(const LAS bf16x8*)(L + QH + (16 * wave + lc) * QS + (32 * ks + 8 * g) * 2), b = *(const LAS bf16x8*)(L + KH + (16 * wave + lc) * QS + (32 * ks + 8 * g) * 2);
                acc = __builtin_amdgcn_mfma_f32_16x16x32_bf16(a, b, acc, 0, 0, 0); }
#pragma unroll
            for (int e = 0; e < 4; ++e) { const int t = 4 * g + e; *(LAS bf16_t*)(L + AT + wave * 512 + t * 32 + lc * 2) = (bf16_t)cvt_pk_bf16(lc <= t ? acc[e] : 0.f, 0.f); }
        }
        __syncthreads();
#pragma unroll 1
        for (int sb = 0; sb < 4; ++sb) {
            f32x4 oacc = (f32x4){0.f, 0.f, 0.f, 0.f};
#pragma unroll
            for (int ks = 0; ks < 4; ++ks) {
                u32x4 bw; bw.x = cvt_pk_bf16(sacc[2 * ks][0], sacc[2 * ks][1]); bw.y = cvt_pk_bf16(sacc[2 * ks][2], sacc[2 * ks][3]); bw.z = cvt_pk_bf16(sacc[2 * ks + 1][0], sacc[2 * ks + 1][1]); bw.w = cvt_pk_bf16(sacc[2 * ks + 1][2], sacc[2 * ks + 1][3]);
                const u32x2 a0 = *(const LAS u32x2*)(L + QH + (16 * sb + lc) * QS + (32 * ks + 4 * g) * 2), a1 = *(const LAS u32x2*)(L + QH + (16 * sb + lc) * QS + (32 * ks + 16 + 4 * g) * 2);
                u32x4 aw; aw.x = a0.x; aw.y = a0.y; aw.z = a1.x; aw.w = a1.y;
                oacc = __builtin_amdgcn_mfma_f32_16x16x32_bf16(__builtin_bit_cast(bf16x8, aw), __builtin_bit_cast(bf16x8, bw), oacc, 0, 0, 0);
            }
            bf16x8 bv;
            { const v4i16_t lo = trr(L + VT + (16 * sb + 4 * g + q4) * TS + (16 * wave + 4 * p4) * 2); bv = (bf16x8){lo[0], lo[1], lo[2], lo[3], 0, 0, 0, 0}; }
            { const u32x2 a0 = *(const LAS u32x2*)(L + AT + sb * 512 + lc * 32 + 8 * g); u32x4 aw; aw.x = a0.x; aw.y = a0.y; aw.z = 0u; aw.w = 0u;
              oacc = __builtin_amdgcn_mfma_f32_16x16x32_bf16(__builtin_bit_cast(bf16x8, aw), bv, oacc, 0, 0, 0); }
#pragma unroll
            for (int e = 0; e < 4; ++e) *(LAS float*)(L + OT + ((16 * sb + 4 * g + e) * OS + vd) * 4) = oacc[e];
            if (sb < 3 || cc < 3) {
#pragma unroll
                for (int i = 0; i < 8; ++i) {
                    const f32x4 dc = *(const LAS f32x4*)(L + DECS + (sb * 128 + 16 * i + 4 * g) * 4);
                    const v4i16_t lo = trr(L + KT + (16 * sb + 4 * g + q4) * TS + (16 * i + 4 * p4) * 2);
                    const bf16x8 a = (bf16x8){lo[0], lo[1], lo[2], lo[3], 0, 0, 0, 0};
                    sacc[i] = __builtin_amdgcn_mfma_f32_16x16x32_bf16(a, bv, sacc[i] * dc, 0, 0, 0);
                }
            }
        }
        __syncthreads();
        {
            f32x4 x[4]; float ss = 0.f;
#pragma unroll
            for (int k = 0; k < 4; ++k) { x[k] = *(const LAS f32x4*)(L + OT + (et * OS + ec + 4 * k) * 4); ss += mk::dot4(x[k]); }
            ss += __shfl_xor(ss, 1); ss += __shfl_xor(ss, 2); ss += __shfl_xor(ss, 4);
            const float rs = rsqrtf(ss * (1.f / 128.f) + EPS);
            const f32x4 y0 = x[0] * rs * n0 * (f32x4){mk::bflo(g0.x), mk::bfhi(g0.x), mk::bflo(g0.y), mk::bfhi(g0.y)}, y1 = x[1] * rs * n1 * (f32x4){mk::bflo(g0.z), mk::bfhi(g0.z), mk::bflo(g0.w), mk::bfhi(g0.w)};
            const f32x4 y2 = x[2] * rs * n2 * (f32x4){mk::bflo(g1.x), mk::bfhi(g1.x), mk::bflo(g1.y), mk::bfhi(g1.y)}, y3 = x[3] * rs * n3 * (f32x4){mk::bflo(g1.z), mk::bfhi(g1.z), mk::bflo(g1.w), mk::bfhi(g1.w)};
            { bf16_t* op = AOR + (m0 + et) * 1024 + 512 + h * 128 + ec; *(u32x4*)op = mk::pack8(y0, y1); *(u32x4*)(op + 8) = mk::pack8(y2, y3); }
        }
    }
    __syncthreads();
}

struct HcPreS { f32x4 sreg[8]; unsigned short lf[8]; unsigned short qv[8]; u32x4 vch; };
__device__ __forceinline__ void hc_issue_sample(HcPreS& P, const unsigned short* LOGF, const bf16_t* QR, const bf16_t* IR, const float* S0, int id, int tid) {
    const int bd = id >> 2, h = id & 3; const size_t m0 = (size_t)MP + bd * 8; const float* s0 = S0 + (size_t)id * 16384;
#pragma unroll
    for (int q = 0; q < 8; ++q) { const int cid = tid + 512 * q; P.sreg[q] = __builtin_nontemporal_load((const f32x4*)(s0 + (size_t)cid * 4)); }
    if (tid < 128) {
#pragma unroll
        for (int t = 0; t < 8; ++t) { const size_t off = (m0 + t) * 512 + h * 128 + tid; P.lf[t] = LOGF[off]; P.qv[t] = QR[off]; }
        P.vch = *(const u32x4*)(IR + (m0 + (tid >> 4)) * 512 + h * 128 + 8 * (tid & 15));
    }
}
__device__ __forceinline__ void hc_phase_sample(LAS unsigned char* L, const unsigned short* LOGF, const bf16_t* QR, bf16_t* AOR, const bf16_t* IR, const bf16_t* GR, const float* hgn, const float* S0, float* Sout, HcPreS& P, int v, int G, int tid, int lane, int wave) {
    constexpr int QH = 0, KH = 4352, KT = 8704, VT = 13312, AT = 17920, DECS = 18432, OT = 18944, ST = 27392, QS = 272, OS = 132, SS = 528;
    const int g = lane >> 4, lc = lane & 15, q4 = lc >> 2, p4 = lane & 3, vd = 16 * wave + lc;
    const int et = tid >> 3, ec = (tid & 7) * 16;
#pragma unroll 1
    for (int id = v; id < 512; id += G) {
        const int bd = id >> 2, h = id & 3; const size_t m0 = (size_t)MP + bd * 8;
#pragma unroll
        for (int q = 0; q < 8; ++q) { const int cid = tid + 512 * q, row = cid >> 5, c4 = cid & 31; *(LAS f32x4*)(L + ST + row * SS + c4 * 16) = P.sreg[q]; }
        if (tid < 128) {
            const int kd = tid; float pp[8], lfs[8]; float p = 1.f;
#pragma unroll
            for (int t = 0; t < 8; ++t) { lfs[t] = (float)P.lf[t] * FQ; p *= lfs[t]; pp[t] = p; }
            float suf = 1.f;
#pragma unroll
            for (int t = 7; t >= 0; --t) {
                const float kk = 1.f - lfs[t];
                *(LAS bf16_t*)(L + QH + t * QS + kd * 2) = (bf16_t)cvt_pk_bf16(mk::bf2f(P.qv[t]) * pp[t], 0.f);
                *(LAS bf16_t*)(L + KH + t * QS + kd * 2) = (bf16_t)cvt_pk_bf16(kk * __builtin_amdgcn_rcpf(fmaxf(pp[t], 1e-30f)), 0.f);
                *(LAS bf16_t*)(L + KT + t * TS + kd * 2) = (bf16_t)cvt_pk_bf16(kk * suf, 0.f);
                suf *= lfs[t];
            }
#pragma unroll
            for (int t = 8; t < 16; ++t) { *(LAS bf16_t*)(L + QH + t * QS + kd * 2) = 0; *(LAS bf16_t*)(L + KH + t * QS + kd * 2) = 0; *(LAS bf16_t*)(L + KT + t * TS + kd * 2) = 0; }
            *(LAS float*)(L + DECS + kd * 4) = p;
            *(LAS u32x4*)(L + VT + (tid >> 4) * TS + (tid & 15) * 16) = P.vch;
        } else if (tid < 256) { const int c = tid - 128; *(LAS u32x4*)(L + VT + (8 + (c >> 4)) * TS + (c & 15) * 16) = (u32x4){0u, 0u, 0u, 0u}; }
        const size_t eoff = (m0 + et) * 512 + h * 128 + ec; u32x4 g0 = (u32x4){0u, 0u, 0u, 0u}, g1 = g0;
        if (tid < 64) { g0 = *(const u32x4*)(GR + eoff); g1 = *(const u32x4*)(GR + eoff + 8); }
        if (id + G < 512) hc_issue_sample(P, LOGF, QR, IR, S0, id + G, tid);
        __syncthreads();
        f32x4 sacc[8];
#pragma unroll
        for (int i = 0; i < 8; ++i)
#pragma unroll
            for (int e = 0; e < 4; ++e) sacc[i][e] = *(const LAS float*)(L + ST + (16 * i + 4 * g + e) * SS + vd * 4);
        if (wave == 0) {
            f32x4 acc = (f32x4){0.f, 0.f, 0.f, 0.f};
#pragma unroll
            for (int ks = 0; ks < 4; ++ks) { const bf16x8 a = *(const LAS bf16x8*)(L + QH + lc * QS + (32 * ks + 8 * g) * 2), b = *(const LAS bf16x8*)(L + KH + lc * QS + (32 * ks + 8 * g) * 2);
                acc = __builtin_amdgcn_mfma_f32_16x16x32_bf16(a, b, acc, 0, 0, 0); }
#pragma unroll
            for (int e = 0; e < 4; ++e) { const int t = 4 * g + e; *(LAS bf16_t*)(L + AT + t * 32 + lc * 2) = (bf16_t)cvt_pk_bf16(lc <= t ? acc[e] : 0.f, 0.f); }
        }
        __syncthreads();
        {
            f32x4 oacc = (f32x4){0.f, 0.f, 0.f, 0.f};
#pragma unroll
            for (int ks = 0; ks < 4; ++ks) {
                u32x4 bw; bw.x = cvt_pk_bf16(sacc[2 * ks][0], sacc[2 * ks][1]); bw.y = cvt_pk_bf16(sacc[2 * ks][2], sacc[2 * ks][3]); bw.z = cvt_pk_bf16(sacc[2 * ks + 1][0], sacc[2 * ks + 1][1]); bw.w = cvt_pk_bf16(sacc[2 * ks + 1][2], sacc[2 * ks + 1][3]);
                const u32x2 a0 = *(const LAS u32x2*)(L + QH + lc * QS + (32 * ks + 4 * g) * 2), a1 = *(const LAS u32x2*)(L + QH + lc * QS + (32 * ks + 16 + 4 * g) * 2);
                u32x4 aw; aw.x = a0.x; aw.y = a0.y; aw.z = a1.x; aw.w = a1.y;
                oacc = __builtin_amdgcn_mfma_f32_16x16x32_bf16(__builtin_bit_cast(bf16x8, aw), __builtin_bit_cast(bf16x8, bw), oacc, 0, 0, 0);
            }
            bf16x8 bv;
            { const v4i16_t lo = trr(L + VT + (4 * g + q4) * TS + (16 * wave + 4 * p4) * 2); bv = (bf16x8){lo[0], lo[1], lo[2], lo[3], 0, 0, 0, 0}; }
            { const u32x2 a0 = *(const LAS u32x2*)(L + AT + lc * 32 + 8 * g); u32x4 aw; aw.x = a0.x; aw.y = a0.y; aw.z = 0u; aw.w = 0u;
              oacc = __builtin_amdgcn_mfma_f32_16x16x32_bf16(__builtin_bit_cast(bf16x8, aw), bv, oacc, 0, 0, 0); }
#pragma unroll
            for (int e = 0; e < 4; ++e) *(LAS float*)(L + OT + ((4 * g + e) * OS + vd) * 4) = oacc[e];
#pragma unroll
            for (int i = 0; i < 8; ++i) {
                const f32x4 dc = *(const LAS f32x4*)(L + DECS + (16 * i + 4 * g) * 4);
                const v4i16_t lo = trr(L + KT + (4 * g + q4) * TS + (16 * i + 4 * p4) * 2);
                const bf16x8 a = (bf16x8){lo[0], lo[1], lo[2], lo[3], 0, 0, 0, 0};
                sacc[i] = __builtin_amdgcn_mfma_f32_16x16x32_bf16(a, bv, sacc[i] * dc, 0, 0, 0);
            }
#pragma unroll
            for (int i = 0; i < 8; ++i)
#pragma unroll
                for (int e = 0; e < 4; ++e) *(LAS float*)(L + ST + (16 * i + 4 * g + e) * SS + vd * 4) = sacc[i][e];
        }
        __syncthreads();
        if (tid < 64) {
            const f32x4 n0 = *(const f32x4*)(hgn + ec), n1 = *(const f32x4*)(hgn + ec + 4), n2 = *(const f32x4*)(hgn + ec + 8), n3 = *(const f32x4*)(hgn + ec + 12);
            f32x4 x[4]; float ss = 0.f;
#pragma unroll
            for (int k = 0; k < 4; ++k) { x[k] = *(const LAS f32x4*)(L + OT + (et * OS + ec + 4 * k) * 4); ss += mk::dot4(x[k]); }
            ss += __shfl_xor(ss, 1); ss += __shfl_xor(ss, 2); ss += __shfl_xor(ss, 4);
            const float rs = rsqrtf(ss * (1.f / 128.f) + EPS);
            const f32x4 y0 = x[0] * rs * n0 * (f32x4){mk::bflo(g0.x), mk::bfhi(g0.x), mk::bflo(g0.y), mk::bfhi(g0.y)}, y1 = x[1] * rs * n1 * (f32x4){mk::bflo(g0.z), mk::bfhi(g0.z), mk::bflo(g0.w), mk::bfhi(g0.w)};
            const f32x4 y2 = x[2] * rs * n2 * (f32x4){mk::bflo(g1.x), mk::bfhi(g1.x), mk::bflo(g1.y), mk::bfhi(g1.y)}, y3 = x[3] * rs * n3 * (f32x4){mk::bflo(g1.z), mk::bfhi(g1.z), mk::bflo(g1.w), mk::bfhi(g1.w)};
            { bf16_t* op = AOR + (m0 + et) * 1024 + 512 + h * 128 + ec; *(u32x4*)op = mk::pack8(y0, y1); *(u32x4*)(op + 8) = mk::pack8(y2, y3); }
        }
        { float* so = Sout + (size_t)id * 16384;
#pragma unroll
          for (int q = 0; q < 8; ++q) { const int cid = tid + 512 * q, row = cid >> 5, c4 = cid & 31; __builtin_nontemporal_store(*(const LAS f32x4*)(L + ST + row * SS + c4 * 16), (f32x4*)(so + (size_t)cid * 4)); } }
        __syncthreads();
    }
}
}
struct Args { const float* in[24]; float* out; unsigned char* ws; int ph_lo, ph_hi, li, pad; };
__global__ void __launch_bounds__(NWAVES * 64, 2) mega(Args args) {
    extern __shared__ __attribute__((aligned(16))) unsigned char lds[];
    LAS unsigned char* L = (LAS unsigned char*)lds;
    volatile LAS unsigned* MISC = (volatile LAS unsigned*)(L + MISC_OFF);
    const int tid = threadIdx.x, lane = tid & 63, wave = __builtin_amdgcn_readfirstlane(tid >> 6);
    const int G = gridDim.x; const int bx = blockIdx.x; const int vcu = (G % 8 == 0) ? (bx % 8) * (G / 8) + bx / 8 : bx;
    unsigned char* ws = args.ws;
    gu32* ctl = (gu32*)(ws + WS_CTL);
    for (int u = tid; u < (LDS_BYTES - LDSCTL_OFF) / 4; u += NWAVES * 64) ((LAS unsigned*)(L + LDSCTL_OFF))[u] = 0u;
    __syncthreads();
    const int lo = args.ph_lo, hi = args.ph_hi;
    XcdBarrier bar; bar.bar = (unsigned*)(ctl + CW_BAR) + args.li * XCD_BAR_WORDS; bar.x = 0; bar.st = nullptr;
    if (hi - lo > 1) bar = xcd_barrier_post((unsigned*)(ctl + CW_BAR) + args.li * XCD_BAR_WORDS, MISC + 8);
#define IN(k) (lo <= (k) && (k) < hi)
#define SEAM(k) do { if (IN(k) && IN((k) + 1)) xcd_barrier_bg(bar, [&]() { BG_WORK(k); }); } while (0)
#define BG_RUN(lo_, hi_, SET_) do { const int st_ = G * (NWAVES - 1); int j_ = (lo_) + vcu * (NWAVES - 1) + wave - 1; mk::WI w_, wn_; f32x4 r_[8], rn_[8]; \
        if (j_ < (hi_)) { SET_(w_, j_); mk::wi_load(w_, r_, lane); } \
        for (; j_ < (hi_); j_ += st_) { const bool hn_ = j_ + st_ < (hi_); if (hn_) { SET_(wn_, j_ + st_); mk::wi_load(wn_, rn_, lane); } mk::wi_proc(w_, r_, scr, lane); \
            if (hn_) { w_ = wn_; _Pragma("unroll") for (int i_ = 0; i_ < 8; ++i_) r_[i_] = rn_[i_]; } } } while (0)
#define BG_SET0(w, j) do { if ((j) < 1408) mk::wi_set(w, 0, args.in[8], nullptr, D, DFF, W2, 32, nullptr, (j)); else mk::wi_set(w, 2, args.in[10], nullptr, INW, D, WIN, 152, args.in[9], (j) - 1408); } while (0)
#define BG_SET1(w, j) do { if ((j) < 256) mk::wi_set(w, 0, args.in[17], nullptr, D, 1024, WUA, 32, nullptr, (j)); else if ((j) < 512) mk::wi_set(w, 0, args.in[18], nullptr, D, 1024, WUA + 512, 32, nullptr, (j) - 256); \
        else if ((j) < 1024) mk::wi_set(w, 0, args.in[19], nullptr, D, D, WOUT, 32, nullptr, (j) - 512); else mk::wi_set(w, 2, args.in[10], nullptr, INW, D, WIN, 152, args.in[9], (j) - 1024 + 1216); } while (0)
#define BG_SET2(w, j) mk::wi_set(w, 1, args.in[21], args.in[22], DFF, D, W13, 176, args.in[20], (j))
#define BG_SET4(w, j) mk::wi_set(w, 0, args.in[23], nullptr, D, DFF, W2, 32, nullptr, (j))
#define BG_COPY(lo_, hi_) do { for (int c_ = (lo_) + vcu * (NWAVES - 1) + wave - 1; c_ < (hi_); c_ += G * (NWAVES - 1)) { f32x4 v_[8]; \
        _Pragma("unroll") for (int i_ = 0; i_ < 8; ++i_) { const int u_ = c_ * 512 + i_ * 64 + lane, ten_ = u_ / (128 * 3840), rem_ = u_ % (128 * 3840), bd_ = rem_ / 3840, q_ = rem_ % 3840; \
            v_[i_] = __builtin_nontemporal_load((const f32x4*)(args.in[2 + ten_] + (size_t)bd_ * 16384 + 1024) + q_); } \
        _Pragma("unroll") for (int i_ = 0; i_ < 8; ++i_) { const int u_ = c_ * 512 + i_ * 64 + lane, ten_ = u_ / (128 * 3840), rem_ = u_ % (128 * 3840), bd_ = rem_ / 3840, q_ = rem_ % 3840; \
            __builtin_nontemporal_store(v_[i_], (f32x4*)(args.out + (ten_ ? O_SWV : O_SWK) + (size_t)bd_ * 16384) + q_); } } } while (0)
#define BG_WORK(k) do { \
        if ((k) == 0) BG_RUN(0, 1408 + 1216, BG_SET0); \
        else if ((k) == 1) BG_RUN(0, 1024 + 1216, BG_SET1); \
        else if ((k) == 2) BG_RUN(0, 1792, BG_SET2); \
        else if ((k) == 3) BG_RUN(1792, 2816, BG_SET2); \
        else if ((k) == 4) BG_RUN(0, 1408, BG_SET4); \
        else if ((k) == 5) BG_COPY(0, 1792); \
        else if ((k) == 6) BG_COPY(1792, 1920); \
    } while (0)
    const float* xp = args.in[0]; const float* xs = args.in[1];
    pg8::bf16_t* W13 = (pg8::bf16_t*)(ws + WS_W13); pg8::bf16_t* W2 = (pg8::bf16_t*)(ws + WS_W2); pg8::bf16_t* WIN = (pg8::bf16_t*)(ws + WS_WIN);
    pg8::bf16_t* WUA = (pg8::bf16_t*)(ws + WS_WUA); pg8::bf16_t* WUR = (pg8::bf16_t*)(ws + WS_WUR); pg8::bf16_t* WOUT = (pg8::bf16_t*)(ws + WS_WOUT);
    float* RSTD1 = (float*)(ws + WS_RSTD1); float* SSQ1 = (float*)(ws + WS_SSQ1); float* SSQ2 = (float*)(ws + WS_SSQ2);
    pg8::bf16_t* AB = (pg8::bf16_t*)(ws + WS_AB); pg8::bf16_t* HID = (pg8::bf16_t*)(ws + WS_HID);
    pg8::bf16_t* Qb = (pg8::bf16_t*)(ws + WS_Q); pg8::bf16_t* KVb = (pg8::bf16_t*)(ws + WS_KV); pg8::bf16_t* QRb = (pg8::bf16_t*)(ws + WS_QR); const unsigned short* LOGF = (const unsigned short*)(ws + WS_LOGF);
    pg8::bf16_t* MRG = (pg8::bf16_t*)(ws + WS_MRG); pg8::bf16_t* IRb = (pg8::bf16_t*)(ws + WS_IR); pg8::bf16_t* GRb = (pg8::bf16_t*)(ws + WS_GR);
    pg8::bf16_t* SGA = (pg8::bf16_t*)(ws + WS_SGA); pg8::bf16_t* SGR = (pg8::bf16_t*)(ws + WS_SGR); pg8::bf16_t* AOR = (pg8::bf16_t*)(ws + WS_AOR);
    const bool tail_first = ((bx >> 3) & 1) != 0;
    LAS float* scr = (LAS float*)(L + RING_OFF + wave * 16384);
    const int gw = vcu * NWAVES + wave, NGW = G * NWAVES;

    if (IN(0)) {
        constexpr int NIT = 176 * 16;
#define WI_DEC0(w, it_) mk::wi_set(w, 1, args.in[6], args.in[7], DFF, D, W13, 176, args.in[5], (it_))
        { mk::WI wc, wn; f32x4 rc[8], rn[8]; int it = gw;
          if (it < NIT) { WI_DEC0(wc, it); mk::wi_load(wc, rc, lane); }
          for (; it < NIT; it += NGW) {
              const bool hn = it + NGW < NIT;
              if (hn) { WI_DEC0(wn, it + NGW); mk::wi_load(wn, rn, lane); }
              mk::wi_proc(wc, rc, scr, lane);
              if (hn) { wc = wn;
#pragma unroll
                  for (int i = 0; i < 8; ++i) rc[i] = rn[i]; }
          } }
#undef WI_DEC0
#define X_ISSUE(v, m0_) do { _Pragma("unroll") for (int q = 0; q < 4; ++q) { const int m = (m0_) + q * NGW; if (m < M) { const float* xr = m < MP ? xp + (size_t)m * D : xs + (size_t)(m - MP) * D; const GAS f32x4* p = (const GAS f32x4*)xr + lane; \
            _Pragma("unroll") for (int j = 0; j < 4; ++j) v[q][j] = __builtin_nontemporal_load(p + 64 * j); } } } while (0)
        { f32x4 v[4][4], vn[4][4]; int m0 = gw;
          if (m0 < M) X_ISSUE(v, m0);
          for (; m0 < M; m0 += 4 * NGW) {
            const bool hn = m0 + 4 * NGW < M;
            if (hn) X_ISSUE(vn, m0 + 4 * NGW);
#pragma unroll
            for (int q = 0; q < 4; ++q) { const int m = m0 + q * NGW; if (m < M) { float ss = 0.f;
#pragma unroll
                for (int j = 0; j < 4; ++j) ss += mk::dot4(v[q][j]);
                ss = mk::wave_sum(ss);
                if (lane == 0) RSTD1[m] = rsqrtf(ss * (1.f / 1024.f) + EPS);
                GAS unsigned long long* o8 = (GAS unsigned long long*)(AB + (size_t)m * D) + lane;
#pragma unroll
                for (int j = 0; j < 4; ++j) o8[64 * j] = (unsigned long long)pk2(v[q][j][0], v[q][j][1]) | ((unsigned long long)pk2(v[q][j][2], v[q][j][3]) << 32); } }
            if (hn) {
#pragma unroll
                for (int q = 0; q < 4; ++q)
#pragma unroll
                    for (int j = 0; j < 4; ++j) v[q][j] = vn[q][j]; }
          } }
#undef X_ISSUE
        VM_WAIT(); __syncthreads();
    }
    SEAM(0);
    if (IN(1)) {
        pg8::Gemm g{AB, W13, M, 2 * DFF, D}; pg8::StaticOrder S; S.init(M, 2 * DFF, G, bx);
        mk::EpiSwiglu<false> E{HID, RSTD1, L + mk::RTAB_OFF};
        mk::build_rstd_table<false>(L, S, RSTD1, tid);
        pg8::gemm_phase<mk::EpiSwiglu<false>, pg8::StaticOrder, true, true>(L + RING_OFF, g, S, E);
    }
    SEAM(1);
    if (IN(2)) {
        pg8::Gemm g{HID, W2, MP, D, DFF}; pg8::StaticOrder S; S.init(MP, D, G, bx);
        mk::EpiResidB<false> E{AB, nullptr, SSQ1, 0.5f};
if (tail_first) mk::gemm_tail(L + RING_OFF, HID, W2, DFF, MP, 16, 16, vcu, G, E, tid, lane, wave);
        pg8::gemm_phase<mk::EpiResidB<false>, pg8::StaticOrder, true, true>(L + RING_OFF, g, S, E);
        if (!tail_first) mk::gemm_tail(L + RING_OFF, HID, W2, DFF, MP, 16, 16, vcu, G, E, tid, lane, wave);
    }
    SEAM(2);
    if (IN(3)) {
        pg8::Gemm g{AB, WIN, M, INW, D}; mk::ProjOrder S; S.init(G, bx);
        mk::EpiProj E{SSQ1, ws, args.out, args.in[11], args.in[12], args.in[15], L + mk::RTAB_OFF};
        mk::build_rstd_table<true>(L, S, SSQ1, tid);
        pg8::gemm_phase<mk::EpiProj, mk::ProjOrder, true, true>(L + RING_OFF, g, S, E);
        mk::EpiProjTail ET{SSQ1, SGA};
        mk::gemm_tail(L + RING_OFF, AB, WIN + (size_t)2816 * D, D, MP, 16, 12, vcu, G, ET, tid, lane, wave);
    }
    SEAM(3);
    pg8::bf16_t* US = (pg8::bf16_t*)args.out;
    float* DEC = (float*)(ws + WS_DEC);
    if (IN(4)) {
        for (int t = vcu; t < 512; t += G) {
            if (t < 256) at::attn_prompt_task(L, Qb, AOR, KVb, args.in[14], args.in[13], t >> 6, (t >> 1) & 31, t & 1, tid, lane, wave);
            else at::attn_sample_task(L, Qb, AOR, KVb, args.in[2], args.in[3], args.in[14], args.in[13], (t - 256) >> 1, t & 1, tid, lane, wave);
        }
        hg::HaPre HP; if (vcu < 256) hg::ha_issue(HP, LOGF, IRb, 4 * vcu, tid);
        hg::ha_phase(L, HP, LOGF, IRb, US, DEC, vcu, G, tid, lane, wave);
        VM_WAIT(); __syncthreads();
    }
    SEAM(4);
    if (IN(5)) {
        for (int idx = bx * (NWAVES * 64) + tid; idx < 131072; idx += G * NWAVES * 64) hg::hb_scan((unsigned*)US, DEC, args.out + O_PST, idx);
        VM_WAIT(); __syncthreads();
    }
    SEAM(5);
    if (IN(6)) {
        hg::hc_phase_prompt(L, LOGF, QRb, AOR, IRb, GRb, args.in[16], US, vcu, G, tid, lane, wave);
        hg::HcPreS PS; if (vcu < 512) hg::hc_issue_sample(PS, LOGF, QRb, IRb, args.in[4], vcu, tid);
        hg::hc_phase_sample(L, LOGF, QRb, AOR, IRb, GRb, args.in[16], args.in[4], args.out + O_SST, PS, vcu, G, tid, lane, wave);
        VM_WAIT(); __syncthreads();
    }
    SEAM(6);
    if (IN(7)) {
        { pg8::Gemm g{AOR, WUA, MP, D, D}; pg8::StaticOrder S; S.init(MP, D, G, bx); mk::EpiUpR E{MRG, (const unsigned char*)SGA, (const unsigned char*)SGR};
if (tail_first) mk::gemm_tail(L + RING_OFF, AOR, WUA, D, MP, 16, 16, vcu, G, E, tid, lane, wave);
        pg8::gemm_phase<mk::EpiUpR, pg8::StaticOrder, true, true>(L + RING_OFF, g, S, E);
        if (!tail_first) mk::gemm_tail(L + RING_OFF, AOR, WUA, D, MP, 16, 16, vcu, G, E, tid, lane, wave); }
    }
    SEAM(7);
    if (IN(8)) {
        pg8::Gemm g{MRG, WOUT, MP, D, D}; pg8::StaticOrder S; S.init(MP, D, G, bx);
        mk::EpiResidB<false> E{AB, nullptr, SSQ2, 1.0f};
if (tail_first) mk::gemm_tail(L + RING_OFF, MRG, WOUT, D, MP, 16, 16, vcu, G, E, tid, lane, wave);
        pg8::gemm_phase<mk::EpiResidB<false>, pg8::StaticOrder, true, true>(L + RING_OFF, g, S, E);
        if (!tail_first) mk::gemm_tail(L + RING_OFF, MRG, WOUT, D, MP, 16, 16, vcu, G, E, tid, lane, wave);
    }
    SEAM(8);
    if (IN(9)) {
        pg8::Gemm g{AB, W13, M, 2 * DFF, D}; pg8::StaticOrder S; S.init(M, 2 * DFF, G, bx);
        mk::EpiSwiglu<true> E{HID, SSQ2, L + mk::RTAB_OFF};
        mk::build_rstd_table<true>(L, S, SSQ2, tid);
        pg8::gemm_phase<mk::EpiSwiglu<true>, pg8::StaticOrder, true, true>(L + RING_OFF, g, S, E);
    }
    SEAM(9);
    if (IN(10)) {
        pg8::Gemm g{HID, W2, MP, D, DFF}; pg8::StaticOrder S; S.init(MP, D, G, bx);
        mk::EpiResidB<true> E{AB, args.out, nullptr, 0.5f};
if (tail_first) mk::gemm_tail(L + RING_OFF, HID, W2, DFF, MP, 16, 16, vcu, G, E, tid, lane, wave);
        pg8::gemm_phase<mk::EpiResidB<true>, pg8::StaticOrder, true, true>(L + RING_OFF, g, S, E);
        if (!tail_first) mk::gemm_tail(L + RING_OFF, HID, W2, DFF, MP, 16, 16, vcu, G, E, tid, lane, wave);
    }
#undef IN
#undef SEAM
}

extern "C" void kernel_launch(void* const* d_in, const int* in_sizes, int n_in, void* d_out, int out_size, void* d_ws, size_t ws_size, hipStream_t stream) {
    static int grid = 0;
    if (grid == 0) {
        int dev = 0, cus = 0;
        if (hipGetDevice(&dev) != hipSuccess || hipDeviceGetAttribute(&cus, hipDeviceAttributeMultiprocessorCount, dev) != hipSuccess) { fprintf(stderr, "kernel_launch: device query failed\n"); grid = -1; return; }
        if (hipFuncSetAttribute((const void*)mega, hipFuncAttributeMaxDynamicSharedMemorySize, LDS_BYTES) != hipSuccess) { fprintf(stderr, "kernel_launch: hipFuncSetAttribute failed\n"); grid = -1; return; }
        if (ws_size < WS_END) { fprintf(stderr, "kernel_launch: workspace too small: %zu < %zu\n", ws_size, (size_t)WS_END); grid = -1; return; }
        grid = cus;
    }
    if (grid < 0) return;
    (void)hipMemsetAsync((char*)d_ws + WS_CTL + CW_BAR * 4, 0, 16384, stream);
    Args a{};
    for (int i = 0; i < 24; ++i) a.in[i] = (const float*)d_in[i];
    a.out = (float*)d_out; a.ws = (unsigned char*)d_ws;
    unsigned char* ws = (unsigned char*)d_ws; float* out = (float*)d_out;
    int nl = 0;
    auto launch = [&](int lo, int hi) { a.ph_lo = lo; a.ph_hi = hi; a.li = nl++; hipLaunchKernelGGL(mega, dim3(grid), dim3(NWAVES * 64), LDS_BYTES, stream, a); };
    launch(0, 11);
}
```

```cpp
#include <hip/hip_runtime.h>
#include <cstdio>
#include <cstdint>
namespace pg8 {
#define PG8_LAS __attribute__((address_space(3)))
typedef unsigned short bf16_t;
typedef short bf16x8 __attribute__((ext_vector_type(8)));
typedef float f32x4 __attribute__((ext_vector_type(4)));
typedef unsigned u32x4 __attribute__((ext_vector_type(4)));
constexpr int BM = 256, BK = 64, HALF = 128, HTB = HALF * BK * 2  , STAGE_BYTES = 8 * HTB, NXCD = 8, WGM = 8;

__host__ __device__ __forceinline__ int lds_byte(int r, int c) { const int st = (r >> 4) * 2 + (c >> 5), rr = r & 15, cc = c & 31, ob = rr * 64 + cc * 2; return st * 1024 + (ob ^ (((ob >> 9) & 1) << 5)); }
__host__ __device__ __forceinline__ void stage_rc(int b, int& R, int& C) { const int st = b / 1024, sb = b % 1024, swz = sb ^ (((sb >> 9) & 1) << 5); R = (st >> 1) * 16 + swz / 64; C = (st & 1) * 32 + (swz % 64) / 2; }
__host__ __device__ __forceinline__ int perm32(int rho) { const int n = rho >> 4, i = rho & 15; return 8 * (i >> 2) + 4 * n + (i & 3); }

struct Unit { int pm, pn, idx; };
struct Gemm { const bf16_t* A; const bf16_t* Bt; int M, N, K; };

struct StaticOrder {
    int nM, nN, nwg, G, c;
    __host__ __device__ void init(int M, int N, int G_, int c_) { nM = M / BM; nN = N / BM; nwg = nM * nN; G = G_; c = c_; }
    __host__ __device__ bool next(int i, Unit& u) const {
        const long L = (long)i * G + c; if (L >= nwg) return false;
        int wgid = (int)L; { const int q = nwg / NXCD, r = nwg % NXCD, xcd = wgid % NXCD, off = wgid / NXCD; wgid = (xcd < r ? xcd * (q + 1) : r * (q + 1) + (xcd - r) * q) + off; }
        const int nig = WGM * nN, gid = wgid / nig, fm = gid * WGM, gsz = (nM - fm) < WGM ? (nM - fm) : WGM;
        u.pm = fm + ((wgid % nig) % gsz); u.pn = (wgid % nig) / gsz; u.idx = i; return true;
    }
    __device__ __forceinline__ void a_ready(const Unit&) const {}
    __device__ __forceinline__ void done(const Unit&) const {}
};

typedef float f32x2_cv __attribute__((ext_vector_type(2))); typedef __bf16 bf16x2_cv __attribute__((ext_vector_type(2)));
__device__ __forceinline__ unsigned cvt_pk_bf16(float lo, float hi) { const f32x2_cv v = {lo, hi}; const bf16x2_cv b = __builtin_convertvector(v, bf16x2_cv); return __builtin_bit_cast(unsigned, b); }
typedef float f32x2 __attribute__((ext_vector_type(2)));
template <class Epi, class Sched, bool ALIGN_EPI = false, bool SP2 = false>
__device__ __forceinline__ void gemm_phase(PG8_LAS unsigned char* lds, const Gemm g, const Sched& S, const Epi& E) {
    const int tid = threadIdx.x, wid = __builtin_amdgcn_readfirstlane(tid >> 6), lane = tid & 63, wr = wid >> 2, wc = wid & 3, fr = lane & 15, fq = lane >> 4;
    constexpr bool KS = Epi::MIDT > 0;
    const int K = g.K, nt = KS ? Epi::MIDT : K / BK;
    unsigned voffA[2], voffB[2];
#pragma unroll
    for (int i = 0; i < 2; ++i) { int R, C; stage_rc(tid * 16 + i * 8192, R, C); const int Rb = Epi::PERM ? ((R & ~31) + perm32(R & 31)) : R;
        voffA[i] = (unsigned)(R * K + C) * 2u; voffB[i] = (unsigned)(Rb * K + C) * 2u; }
    const size_t kstep = (size_t)(BK * 2);
    const size_t hstep = (size_t)HALF * K * 2;
    const size_t tstep = 2 * hstep;
    const unsigned ldsw = (unsigned)wid * 1024u;
    const int aoff = lds_byte(wr * 64 + fr, fq * 8), boff = lds_byte(wc * 32 + fr, fq * 8);
#define PG8_SA(b, h) (((b) * 2 + (h)) * HTB)
#define PG8_SB(b, h) ((4 + (b) * 2 + (h)) * HTB)
#define PG8_STAGE(bufoff, gbase, voff) do { _Pragma("unroll") for (int _i = 0; _i < 2; ++_i) \
        __builtin_amdgcn_global_load_lds((const unsigned*)((const char*)(gbase) + (voff)[_i]), (PG8_LAS unsigned*)(lds + (bufoff) + ldsw + _i * 8192), 16, 0, 0); } while (0)
#define PG8_LDA(dst, b, h) do { _Pragma("unroll") for (int m = 0; m < 4; ++m) _Pragma("unroll") for (int k = 0; k < 2; ++k) dst[m][k] = *(const PG8_LAS bf16x8*)(lds + PG8_SA(b, h) + aoff + m * 2048 + k * 1024); } while (0)
#define PG8_LDB(dst, b, h) do { _Pragma("unroll") for (int n = 0; n < 2; ++n) _Pragma("unroll") for (int k = 0; k < 2; ++k) dst[n][k] = *(const PG8_LAS bf16x8*)(lds + PG8_SB(b, h) + boff + n * 2048 + k * 1024); } while (0)
#define PG8_MMA(ai, bj, At, Bt) do { __builtin_amdgcn_s_setprio(0); _Pragma("unroll") for (int m = 0; m < 4; ++m) _Pragma("unroll") for (int n = 0; n < 2; ++n) _Pragma("unroll") for (int k = 0; k < 2; ++k) \
        acc[ai][bj][m][n] = __builtin_amdgcn_mfma_f32_16x16x32_bf16(Bt[n][k], At[m][k], acc[ai][bj][m][n], 0, 0, 0); __builtin_amdgcn_s_setprio(1); } while (0)
#define PG8_WAIT_V(n) asm volatile("s_waitcnt vmcnt(" #n ")" ::: "memory")
#define PG8_WAIT_V8R(t_) do { if constexpr (Epi::EPI_VM == 8) asm volatile("s_waitcnt vmcnt(16)\n\ts_cmp_eq_u32 %0, 0\n\ts_cbranch_scc1 1f\n\ts_waitcnt vmcnt(8)\n1:" :: "s"(t_) : "scc", "memory"); \
        else if constexpr (Epi::EPI_VM == 16) asm volatile("s_waitcnt vmcnt(24)\n\ts_cmp_eq_u32 %0, 0\n\ts_cbranch_scc1 1f\n\ts_waitcnt vmcnt(8)\n1:" :: "s"(t_) : "scc", "memory"); \
        else { static_assert(Epi::EPI_VM == 0, "EPI_VM: 0, 8 or 16"); PG8_WAIT_V(8); } } while (0)
#define PG8_WAIT_L(n) asm volatile("s_waitcnt lgkmcnt(" #n ")" ::: "memory")
#define PG8_BAR __builtin_amdgcn_s_barrier()
#define PG8_SCHED __builtin_amdgcn_sched_barrier(0)
    Unit cur, nxt; int ui = 0;
    if (!S.next(0, cur)) return;
    f32x4 acc[2][2][4][2];
    u32x4 ipre[Epi::INIT ? 16 : 1];
    if constexpr (Epi::INIT) E.init_issue(ipre, cur, wr, wc, fr, fq);
    else {
#pragma unroll
    for (int a = 0; a < 2; ++a)
#pragma unroll
        for (int b = 0; b < 2; ++b)
#pragma unroll
            for (int m = 0; m < 4; ++m)
#pragma unroll
                for (int n = 0; n < 2; ++n) acc[a][b][m][n] = (f32x4){0.f, 0.f, 0.f, 0.f};
    }
    bf16x8 At[4][2], B0[2][2], B1[2][2];
    const char* cA = (const char*)g.A + (size_t)cur.pm * tstep; const char* cB = (const char*)g.Bt + (size_t)cur.pn * tstep;
    S.a_ready(cur);
    if constexpr (SP2) {
        PG8_STAGE(PG8_SB(0, 0), cB, voffB); PG8_STAGE(PG8_SB(0, 1), cB + hstep, voffB); PG8_STAGE(PG8_SA(0, 0), cA, voffA); PG8_STAGE(PG8_SA(0, 1), cA + hstep, voffA);
        if (wr == 1) PG8_BAR;
        PG8_WAIT_V(2); PG8_BAR;
        PG8_STAGE(PG8_SB(1, 0), cB + kstep, voffB); PG8_STAGE(PG8_SA(1, 0), cA + kstep, voffA); PG8_STAGE(PG8_SB(1, 1), cB + hstep + kstep, voffB);
        if constexpr (Epi::EPI_VM > 0) PG8_WAIT_V(0); else PG8_WAIT_V(6);
        PG8_BAR;
    } else {
        PG8_STAGE(PG8_SB(0, 0), cB, voffB); PG8_STAGE(PG8_SA(0, 0), cA, voffA); PG8_STAGE(PG8_SB(0, 1), cB + hstep, voffB); PG8_STAGE(PG8_SA(0, 1), cA + hstep, voffA);
        if (wr == 1) PG8_BAR;
        PG8_WAIT_V(4); PG8_BAR;
        PG8_STAGE(PG8_SB(1, 0), cB + kstep, voffB); PG8_STAGE(PG8_SA(1, 0), cA + kstep, voffA); PG8_STAGE(PG8_SB(1, 1), cB + hstep + kstep, voffB);
        PG8_WAIT_V(6); PG8_BAR;
    }
    if constexpr (Epi::INIT) E.init_finish(acc, ipre);
    for (;;) {
        const bool has_next = KS ? S.next((ui + 1) >> 1, nxt) : S.next(ui + 1, nxt);
        const size_t nko = (KS && ((ui + 1) & 1)) ? (size_t)nt * kstep : (size_t)0;
        const char* nA = has_next ? (const char*)g.A + (size_t)nxt.pm * tstep + nko : cA; const char* nB = has_next ? (const char*)g.Bt + (size_t)nxt.pn * tstep + nko : cB;
        for (int t = 0; t < nt; t += 2) {
            const bool last = (t == nt - 2);
            const char* a1 = cA + (size_t)(t + 1) * kstep;
            const char* a2 = last ? nA : cA + (size_t)(t + 2) * kstep; const char* b2 = last ? nB : cB + (size_t)(t + 2) * kstep;
            const char* a3 = a2 + kstep; const char* b3 = b2 + kstep;
            if (last && has_next) S.a_ready(nxt);
            if constexpr (SP2) {
            PG8_LDB(B0, 0, 0); PG8_LDB(B1, 0, 1); PG8_SCHED; PG8_LDA(At, 0, 0); PG8_STAGE(PG8_SA(1, 1), a1 + hstep, voffA);
            PG8_WAIT_V8R(t); PG8_WAIT_L(0); PG8_BAR; PG8_MMA(0, 0, At, B0); PG8_MMA(0, 1, At, B1); PG8_BAR; PG8_SCHED;
            PG8_LDA(At, 0, 1); PG8_STAGE(PG8_SB(0, 0), b2, voffB); PG8_STAGE(PG8_SB(0, 1), b2 + hstep, voffB); PG8_STAGE(PG8_SA(0, 0), a2, voffA);
            PG8_WAIT_V8R(t); PG8_WAIT_L(0); PG8_BAR; PG8_MMA(1, 0, At, B0); PG8_MMA(1, 1, At, B1); PG8_BAR; PG8_SCHED;
            PG8_LDB(B0, 1, 0); PG8_LDB(B1, 1, 1); PG8_SCHED; PG8_LDA(At, 1, 0); PG8_STAGE(PG8_SA(0, 1), a2 + hstep, voffA);
            PG8_WAIT_V(8); PG8_WAIT_L(0); PG8_BAR; PG8_MMA(0, 0, At, B0); PG8_MMA(0, 1, At, B1); PG8_BAR; PG8_SCHED;
            PG8_LDA(At, 1, 1); PG8_STAGE(PG8_SB(1, 0), b3, voffB); PG8_STAGE(PG8_SB(1, 1), b3 + hstep, voffB); PG8_STAGE(PG8_SA(1, 0), a3, voffA);
            PG8_WAIT_V(8); PG8_WAIT_L(0); PG8_BAR; PG8_MMA(1, 0, At, B0); PG8_MMA(1, 1, At, B1); PG8_BAR; PG8_SCHED;
            } else {
            PG8_LDB(B0, 0, 0); PG8_SCHED; PG8_LDA(At, 0, 0); PG8_STAGE(PG8_SA(1, 1), a1 + hstep, voffA);
            PG8_WAIT_L(8); PG8_BAR; PG8_WAIT_L(0); PG8_MMA(0, 0, At, B0); PG8_BAR; PG8_SCHED;
            PG8_LDB(B1, 0, 1); PG8_STAGE(PG8_SB(0, 0), b2, voffB);
            PG8_BAR; PG8_WAIT_L(0); PG8_MMA(0, 1, At, B1); PG8_BAR;
            PG8_LDA(At, 0, 1); PG8_STAGE(PG8_SA(0, 0), a2, voffA);
            PG8_BAR; PG8_WAIT_L(0); PG8_MMA(1, 0, At, B0); PG8_BAR; PG8_SCHED;
            PG8_STAGE(PG8_SB(0, 1), b2 + hstep, voffB);
            PG8_WAIT_V(6); PG8_BAR; PG8_MMA(1, 1, At, B1); PG8_BAR;
            PG8_LDB(B0, 1, 0); PG8_SCHED; PG8_LDA(At, 1, 0); PG8_STAGE(PG8_SA(0, 1), a2 + hstep, voffA);
            PG8_WAIT_L(8); PG8_BAR; PG8_WAIT_L(0); PG8_MMA(0, 0, At, B0); PG8_BAR; PG8_SCHED;
            PG8_LDB(B1, 1, 1); PG8_STAGE(PG8_SB(1, 0), b3, voffB);
            PG8_BAR; PG8_WAIT_L(0); PG8_MMA(0, 1, At, B1); PG8_BAR;
            PG8_LDA(At, 1, 1); PG8_STAGE(PG8_SA(1, 0), a3, voffA);
            PG8_BAR; PG8_WAIT_L(0); PG8_MMA(1, 0, At, B0); PG8_BAR; PG8_SCHED;
            PG8_STAGE(PG8_SB(1, 1), b3 + hstep, voffB);
            PG8_WAIT_V(6); PG8_BAR; PG8_MMA(1, 1, At, B1); PG8_BAR;
            }
        }
        if constexpr (ALIGN_EPI) { if (wr == 0) PG8_BAR; }
        if constexpr (KS) { if (ui & 1) { E(acc, cur, wr, wc, fr, fq); S.done(cur); } else E.mid(acc, cur, wr, wc, fr, fq); }
        else if constexpr (!Epi::AFTER_DRAIN) { E(acc, cur, wr, wc, fr, fq); S.done(cur); }
        if (!has_next) break;
        if constexpr (Epi::INIT) { E.init_issue(ipre, nxt, wr, wc, fr, fq); E.init_finish(acc, ipre); }
        else if (!KS || (ui & 1)) {
#pragma unroll
        for (int a = 0; a < 2; ++a)
#pragma unroll
            for (int b = 0; b < 2; ++b)
#pragma unroll
                for (int m = 0; m < 4; ++m)
#pragma unroll
                    for (int n = 0; n < 2; ++n) acc[a][b][m][n] = (f32x4){0.f, 0.f, 0.f, 0.f};
        }
        cur = nxt; cA = nA; cB = nB; ++ui;
        if constexpr (ALIGN_EPI) { if (wr == 1) PG8_BAR; }
    }
    __builtin_amdgcn_s_setprio(0);
    PG8_WAIT_V(0);
    if constexpr (!ALIGN_EPI) { if (wr == 0) PG8_BAR; }
    PG8_BAR;
    if constexpr (Epi::AFTER_DRAIN) { E.fused(acc, cur, wr, wc, fr, fq, lds, wid, lane); S.done(cur); }
#undef PG8_SA
#undef PG8_SB
#undef PG8_STAGE
#undef PG8_LDA
#undef PG8_LDB
#undef PG8_MMA
#undef PG8_WAIT_V
#undef PG8_WAIT_L
#undef PG8_WAIT_V8R
#undef PG8_BAR
#undef PG8_SCHED
}
}
#define GAS __attribute__((address_space(1)))
#define LAS __attribute__((address_space(3)))
typedef unsigned short bf16;
typedef unsigned v4u __attribute__((ext_vector_type(4)));
typedef float f32x4 __attribute__((ext_vector_type(4)));
typedef short bf16x8 __attribute__((ext_vector_type(8)));
typedef GAS unsigned gu32;
typedef GAS unsigned long long gu64;
#define RLX_AGENT __ATOMIC_RELAXED, __HIP_MEMORY_SCOPE_AGENT
#define LDS_WAIT() asm volatile("s_waitcnt lgkmcnt(0)" ::: "memory")
#define VM_WAIT() asm volatile("s_waitcnt vmcnt(0)" ::: "memory")
__device__ __forceinline__ unsigned long long rt() { return __builtin_amdgcn_s_memrealtime(); }
__device__ __forceinline__ unsigned f2bf(float f) { unsigned u = __builtin_bit_cast(unsigned, f); return (u + 0x7fffu + ((u >> 16) & 1u)) >> 16; }
__device__ __forceinline__ unsigned pk2(float lo, float hi) { return f2bf(lo) | (f2bf(hi) << 16); }
#define XB_TMO      128
#define XB_XCNT(j)  (256  + 64 * (j))
#define XB_XSUB(j)  (1280 + 64 * (j))
#define XB_XGEN(j)  (2304 + 64 * (j))
#define XB_TOP      3328
#define XB_TOPGEN   3392
#define XCD_BAR_WORDS 3456
#define XB_SPIN_CAP (1u << 18)

__device__ __forceinline__ unsigned xb_ld(unsigned* p)              { return __hip_atomic_load(p, __ATOMIC_RELAXED, __HIP_MEMORY_SCOPE_AGENT); }
__device__ __forceinline__ unsigned xb_add(unsigned* p, unsigned v) { return __hip_atomic_fetch_add(p, v, __ATOMIC_RELAXED, __HIP_MEMORY_SCOPE_AGENT); }
__device__ __forceinline__ unsigned xb_xcc_id() { return (unsigned)__builtin_amdgcn_s_getreg((3 << 11) | 20) & 0xFu; }
#define XB_SPIN(cond, bar) do { unsigned _sp = 0; while (cond) { __builtin_amdgcn_s_sleep(1); \
    if ((++_sp & 255u) == 0u) { if (xb_ld(&(bar)[XB_TMO])) break; if (_sp > XB_SPIN_CAP) { atomicAdd(&(bar)[XB_TMO], 1u); break; } } } } while (0)

struct XcdBarrier {
    unsigned* bar; unsigned x;
    volatile LAS unsigned* st;
};

__device__ __forceinline__ XcdBarrier xcd_barrier_post(unsigned* bar, volatile LAS unsigned* st) {
    XcdBarrier b; b.bar = bar; b.x = xb_xcc_id(); b.st = st;
    if (threadIdx.x == 0) (void)xb_add(&bar[XB_XCNT(b.x)], 1u);
    return b;
}
__device__ __forceinline__ void xcd_barrier_complete(unsigned* bar, unsigned x, unsigned& nloc, unsigned& nx) {
    const unsigned G = gridDim.x * gridDim.y * gridDim.z;
    unsigned sum, cnt, mine, sp = 0u;
    for (;;) {
        sum = 0u; cnt = 0u; mine = 0u;
#pragma unroll
        for (unsigned j = 0; j < 16; ++j) { const unsigned c = xb_ld(&bar[XB_XCNT(j)]); sum += c; cnt += (c > 0u) ? 1u : 0u; mine = (j == x) ? c : mine; }
        if (sum == G) break;
        __builtin_amdgcn_s_sleep(1);
        if ((++sp & 255u) == 0u) { if (xb_ld(&bar[XB_TMO])) break; if (sp > XB_SPIN_CAP) { atomicAdd(&bar[XB_TMO], 1u); break; } }
    }
    nloc = mine > 0u ? mine : 1u; nx = cnt > 0u ? cnt : 1u;
}

__device__ __forceinline__ void xcd_barrier(const XcdBarrier& b) {
    asm volatile("s_waitcnt vmcnt(0)" ::: "memory");
    __syncthreads();
    if (threadIdx.x == 0) {
        unsigned* bar = b.bar;
        __builtin_amdgcn_s_waitcnt(0);
        unsigned nloc = b.st[0], nx = b.st[1];
        if (nloc == 0u) { xcd_barrier_complete(bar, b.x, nloc, nx); b.st[0] = nloc; b.st[1] = nx; }
        const unsigned old = xb_add(&bar[XB_XSUB(b.x)], 1u);
        const unsigned gen = old / nloc;
        if (old + 1u == (gen + 1u) * nloc) {
            __builtin_amdgcn_fence(__ATOMIC_RELEASE, "agent");
            asm volatile("s_waitcnt vmcnt(0)" ::: "memory");
            const unsigned og = xb_add(&bar[XB_TOP], 1u);
            const unsigned tg = og / nx;
            if (og + 1u == (tg + 1u) * nx) xb_add(&bar[XB_TOPGEN], 1u);
            else XB_SPIN(xb_ld(&bar[XB_TOPGEN]) == tg, bar);
            __builtin_amdgcn_fence(__ATOMIC_ACQUIRE, "agent");
            xb_add(&bar[XB_XGEN(b.x)], 1u);
            asm volatile("s_waitcnt vmcnt(0)" ::: "memory");
        } else {
            XB_SPIN(xb_ld(&bar[XB_XGEN(b.x)]) == gen, bar);
            __builtin_amdgcn_fence(__ATOMIC_ACQUIRE, "agent");
            asm volatile("s_waitcnt vmcnt(0)" ::: "memory");
        }
    }
    __syncthreads();
}

template <class BG> __device__ __forceinline__ void xcd_barrier_bg(const XcdBarrier& b, const BG& bg) {
    asm volatile("s_waitcnt vmcnt(0)" ::: "memory");
    __syncthreads();
    if (threadIdx.x == 0) {
        unsigned* bar = b.bar;
        __builtin_amdgcn_s_waitcnt(0);
        unsigned nloc = b.st[0], nx = b.st[1];
        if (nloc == 0u) { xcd_barrier_complete(bar, b.x, nloc, nx); b.st[0] = nloc; b.st[1] = nx; }
        const unsigned old = xb_add(&bar[XB_XSUB(b.x)], 1u);
        const unsigned gen = old / nloc;
        if (old + 1u == (gen + 1u) * nloc) {
            __builtin_amdgcn_fence(__ATOMIC_RELEASE, "agent");
            asm volatile("s_waitcnt vmcnt(0)" ::: "memory");
            const unsigned og = xb_add(&bar[XB_TOP], 1u);
            const unsigned tg = og / nx;
            if (og + 1u == (tg + 1u) * nx) xb_add(&bar[XB_TOPGEN], 1u);
            else XB_SPIN(xb_ld(&bar[XB_TOPGEN]) == tg, bar);
            __builtin_amdgcn_fence(__ATOMIC_ACQUIRE, "agent");
            xb_add(&bar[XB_XGEN(b.x)], 1u);
            asm volatile("s_waitcnt vmcnt(0)" ::: "memory");
        } else {
            XB_SPIN(xb_ld(&bar[XB_XGEN(b.x)]) == gen, bar);
            __builtin_amdgcn_fence(__ATOMIC_ACQUIRE, "agent");
            asm volatile("s_waitcnt vmcnt(0)" ::: "memory");
        }
    } else if (threadIdx.x >= 64) bg();
    __syncthreads();
}

constexpr int D = 1024, MP = 16384, MS = 1024, M = MP + MS, DFF = 2816, INW = 4864;
constexpr float EPS = 1e-6f;
constexpr size_t O_YS = (size_t)MP * D, O_PWK = O_YS + (size_t)MS * D, O_PWV = O_PWK + 65536, O_PST = O_PWV + 65536, O_SWK = O_PST + 262144, O_SWV = O_SWK + 2097152, O_SST = O_SWV + 2097152;
constexpr size_t MiB = 1u << 20, HMiB = 1u << 19;
constexpr size_t WS_CTL = 0, CTL_ZERO_BYTES = 1 * MiB;
constexpr size_t WS_W13 = 1 * MiB, WS_W2 = 12 * MiB, WS_WIN = 17 * MiB + HMiB, WS_WUA = 27 * MiB, WS_WUR = 28 * MiB, WS_WOUT = 29 * MiB;
constexpr size_t WS_DEC = 31 * MiB, WS_RSTD1 = 31 * MiB + HMiB, WS_SSQ1 = 32 * MiB, WS_SSQ2 = 34 * MiB;
constexpr size_t WS_AB = 36 * MiB, WS_BIG = 70 * MiB;
constexpr size_t WS_HID = WS_BIG, WS_Q = WS_BIG, WS_KV = WS_BIG + 17 * MiB, WS_QR = WS_KV + 8 * MiB + HMiB, WS_LOGF = WS_QR + 17 * MiB, WS_MRG = WS_LOGF, WS_IR = WS_LOGF + 34 * MiB,
                 WS_GR = WS_IR + 17 * MiB, WS_SGA = WS_GR + 17 * MiB, WS_SGR = WS_SGA + 17 * MiB, WS_AOR = WS_SGR + 17 * MiB, WS_END = WS_AOR + 34 * MiB;
static_assert(WS_END <= 256 * MiB && WS_HID + (size_t)M * DFF * 2 <= WS_END, "ws map");
constexpr int CW_BAR = 4096;
constexpr int RING_OFF = 0, RING_BYTES = 131072, LDSCTL_OFF = 139264, MISC_OFF = LDSCTL_OFF + 320, LDS_BYTES = 147456;
constexpr int NWAVES = 8;

namespace mk {
using pg8::f32x4; using pg8::u32x4; using pg8::Unit; using pg8::bf16_t; using pg8::cvt_pk_bf16;
typedef unsigned u32x2 __attribute__((ext_vector_type(2)));
__device__ __forceinline__ float fsigmoid(float x) { return __builtin_amdgcn_rcpf(1.f + __expf(-x)); }
__device__ __forceinline__ float fsilu(float x) { return x * fsigmoid(x); }
__device__ __forceinline__ float bflo(unsigned w) { return __uint_as_float(w << 16); }
__device__ __forceinline__ float bfhi(unsigned w) { return __uint_as_float(w & 0xffff0000u); }
__device__ __forceinline__ float bf2f(bf16_t h) { return __uint_as_float((unsigned)h << 16); }
__device__ __forceinline__ u32x4 pack8(const f32x4 a, const f32x4 b) { u32x4 w; w.x = cvt_pk_bf16(a[0], a[1]); w.y = cvt_pk_bf16(a[2], a[3]); w.z = cvt_pk_bf16(b[0], b[1]); w.w = cvt_pk_bf16(b[2], b[3]); return w; }
__device__ __forceinline__ float dot4(const f32x4 a) { return (a[0] * a[0] + a[1] * a[1]) + (a[2] * a[2] + a[3] * a[3]); }
__device__ __forceinline__ unsigned q16(float s) { return (unsigned)(s * 65535.f + 0.5f); }
__device__ __forceinline__ unsigned q8(float s) { return (unsigned)(s * 255.f + 0.5f); }
__device__ __forceinline__ unsigned pack4q8(const f32x4 s) { return q8(s[0]) | (q8(s[1]) << 8) | (q8(s[2]) << 16) | (q8(s[3]) << 24); }
__device__ __forceinline__ f32x4 unpack4q8(unsigned w) { return (f32x4){(float)(w & 0xffu), (float)((w >> 8) & 0xffu), (float)((w >> 16) & 0xffu), (float)(w >> 24)} * (1.f / 255.f); }
__device__ __forceinline__ float row_rstd16(const float* ssqp, int r) {
    const f32x4* p = (const f32x4*)(ssqp + (size_t)r * 16); const f32x4 a = p[0], b = p[1], c = p[2], d = p[3]; const f32x4 s = (a + b) + (c + d);
    return rsqrtf(((s[0] + s[1]) + (s[2] + s[3])) * (1.f / 1024.f) + EPS);
}

constexpr int RTAB_OFF = LDSCTL_OFF + 1024;
template <bool FROM_SSQ, class Sched> __device__ __forceinline__ void build_rstd_table(LAS unsigned char* L, const Sched& S, const float* src, int tid) {
    Unit u;
    for (int i = 0; i < 6 && S.next(i, u); ++i) if (tid < 256) *(LAS float*)(L + RTAB_OFF + (i * 256 + tid) * 4) = FROM_SSQ ? row_rstd16(src, u.pm * 256 + tid) : src[u.pm * 256 + tid];
    __syncthreads();
}
template <bool FROM_SSQ> struct EpiSwiglu {
    static constexpr bool PERM = true, AFTER_DRAIN = false, INIT = false; static constexpr int MIDT = 0, EPI_VM = 8;
    bf16_t* H; const float* rs; LAS unsigned char* tab;
    __device__ __forceinline__ void operator()(const f32x4 (&acc)[2][2][4][2], const Unit& u, int wr, int wc, int fr, int fq) const {
        const int row0 = u.pm * 256 + wr * 64 + fr, col0 = u.pn * 128 + wc * 32 + 8 * fq;
#pragma unroll
        for (int ai = 0; ai < 2; ++ai)
#pragma unroll
            for (int m = 0; m < 4; ++m) {
                const int r = row0 + ai * 128 + m * 16;
                const float s = u.idx < 6 ? *(const LAS float*)(tab + (u.idx * 256 + (r & 255)) * 4) : (FROM_SSQ ? row_rstd16(rs, r) : rs[r]);
                f32x4 h0, h1;
#pragma unroll
                for (int e = 0; e < 4; ++e) { h0[e] = fsilu(acc[ai][0][m][0][e] * s) * (acc[ai][1][m][0][e] * s); h1[e] = fsilu(acc[ai][0][m][1][e] * s) * (acc[ai][1][m][1][e] * s); }
                *(u32x4*)(H + (size_t)r * DFF + col0) = pack8(h0, h1);
            }
    }
};
template <bool WRITE_B> struct EpiResid {
    static constexpr bool PERM = false, AFTER_DRAIN = false, INIT = false; static constexpr int MIDT = 0, EPI_VM = 0;
    const float* xp; const float* xs; float* Hout; bf16_t* HB; float* ssqp; float scale; int base_is_x;
    __device__ __forceinline__ void operator()(const f32x4 (&acc)[2][2][4][2], const Unit& u, int wr, int wc, int fr, int fq) const {
        const int row0 = u.pm * 256 + wr * 64 + fr, col0 = u.pn * 256 + wc * 32 + 4 * fq;
        f32x4 pre[3][4];
#define ER_BASE(g_) (base_is_x ? (row0 + ((g_) >> 2) * 128 + ((g_) & 3) * 16 < MP ? xp + (size_t)(row0 + ((g_) >> 2) * 128 + ((g_) & 3) * 16) * D : xs + (size_t)(row0 + ((g_) >> 2) * 128 + ((g_) & 3) * 16 - MP) * D) : Hout + (size_t)(row0 + ((g_) >> 2) * 128 + ((g_) & 3) * 16) * D)
#define ER_LOAD(g_) do { const float* bp_ = ER_BASE(g_); _Pragma("unroll") for (int q_ = 0; q_ < 4; ++q_) pre[(g_) % 3][q_] = *(const f32x4*)(bp_ + col0 + (q_ >> 1) * 128 + (q_ & 1) * 16); } while (0)
        ER_LOAD(0); ER_LOAD(1);
#pragma unroll
        for (int g = 0; g < 8; ++g) {
            if (g + 2 < 8) ER_LOAD(g + 2);
            const int ai = g >> 2, m = g & 3, r = row0 + ai * 128 + m * 16;
            float* op = Hout + (size_t)r * D; float ss = 0.f;
#pragma unroll
            for (int q = 0; q < 4; ++q) {
                const int bj = q >> 1, n = q & 1, c = col0 + bj * 128 + n * 16; const f32x4 o = pre[g % 3][q] + acc[ai][bj][m][n] * scale;
                if (WRITE_B) *(f32x4*)(op + c) = o; else __builtin_nontemporal_store(o, (f32x4*)(op + c));
                if (WRITE_B) { ss += dot4(o); u32x2 w; w.x = cvt_pk_bf16(o[0], o[1]); w.y = cvt_pk_bf16(o[2], o[3]); *(u32x2*)(HB + (size_t)r * D + c) = w; }
            }
            if (WRITE_B) { ss += __shfl_xor(ss, 16); ss += __shfl_xor(ss, 32); if (fq == 0) ssqp[(size_t)r * 16 + u.pn * 4 + wc] = ss; }
            __builtin_amdgcn_sched_barrier(0);
        }
#undef ER_LOAD
#undef ER_BASE
    }
    __device__ __forceinline__ void tail(const f32x4 (&acc)[4], int r, int c0, int fq) const {
        const float* bp = base_is_x ? (r < MP ? xp + (size_t)r * D : xs + (size_t)(r - MP) * D) : Hout + (size_t)r * D;
        float* op = Hout + (size_t)r * D; float ss = 0.f;
#pragma unroll
        for (int n = 0; n < 4; ++n) {
            const int c = c0 + 16 * n + 4 * fq; const f32x4 b = *(const f32x4*)(bp + c); const f32x4 o = b + acc[n] * scale; if (WRITE_B) *(f32x4*)(op + c) = o; else __builtin_nontemporal_store(o, (f32x4*)(op + c));
            if (WRITE_B) { ss += dot4(o); u32x2 w; w.x = cvt_pk_bf16(o[0], o[1]); w.y = cvt_pk_bf16(o[2], o[3]); *(u32x2*)(HB + (size_t)r * D + c) = w; }
        }
        if (WRITE_B) { ss += __shfl_xor(ss, 16); ss += __shfl_xor(ss, 32); if (fq == 0) ssqp[(size_t)r * 16 + (c0 >> 6)] = ss; }
    }
};
template <bool FINAL> struct EpiResidB {
    static constexpr bool PERM = true, AFTER_DRAIN = false, INIT = true; static constexpr int MIDT = 0, EPI_VM = 0;
    bf16_t* HB; float* Y; float* ssqp; float scale;
    __device__ __forceinline__ void init_issue(u32x4 (&pre)[16], const Unit& u, int wr, int wc, int fr, int fq) const {
        const int row0 = u.pm * 256 + wr * 64 + fr, col0 = u.pn * 256 + wc * 32 + 8 * fq;
#pragma unroll
        for (int g = 0; g < 8; ++g)
#pragma unroll
            for (int bj = 0; bj < 2; ++bj) pre[2 * g + bj] = *(const u32x4*)(HB + (size_t)(row0 + (g >> 2) * 128 + (g & 3) * 16) * D + col0 + 128 * bj);
    }
    __device__ __forceinline__ void init_finish(f32x4 (&acc)[2][2][4][2], const u32x4 (&pre)[16]) const {
        const float inv = 1.f / scale;
#pragma unroll
        for (int g = 0; g < 8; ++g)
#pragma unroll
            for (int bj = 0; bj < 2; ++bj) { const u32x4 b = pre[2 * g + bj];
                acc[g >> 2][bj][g & 3][0] = (f32x4){bflo(b.x), bfhi(b.x), bflo(b.y), bfhi(b.y)} * inv; acc[g >> 2][bj][g & 3][1] = (f32x4){bflo(b.z), bfhi(b.z), bflo(b.w), bfhi(b.w)} * inv; }
    }
    __device__ __forceinline__ void operator()(const f32x4 (&acc)[2][2][4][2], const Unit& u, int wr, int wc, int fr, int fq) const {
        const int row0 = u.pm * 256 + wr * 64 + fr, col0 = u.pn * 256 + wc * 32 + 8 * fq;
#pragma unroll
        for (int g = 0; g < 8; ++g) {
            const int ai = g >> 2, m = g & 3, r = row0 + ai * 128 + m * 16; float ss = 0.f;
#pragma unroll
            for (int bj = 0; bj < 2; ++bj) {
                const f32x4 o0 = acc[ai][bj][m][0] * scale, o1 = acc[ai][bj][m][1] * scale;
                if (FINAL) { float* yp = Y + (size_t)r * D + col0 + 128 * bj; __builtin_nontemporal_store(o0, (f32x4*)yp); __builtin_nontemporal_store(o1, (f32x4*)(yp + 4)); }
                else { ss += dot4(o0) + dot4(o1); *(u32x4*)(HB + (size_t)r * D + col0 + 128 * bj) = pack8(o0, o1); }
            }
            if (!FINAL) { ss += __shfl_xor(ss, 16); ss += __shfl_xor(ss, 32); if (fq == 0) ssqp[(size_t)r * 16 + u.pn * 4 + wc] = ss; }
        }
    }
    __device__ __forceinline__ void tail(const f32x4 (&acc)[4], int r, int c0, int fq) const {
        bf16_t* bp = HB + (size_t)r * D + c0 + 4 * fq; float ss = 0.f; u32x2 b[4];
#pragma unroll
        for (int n = 0; n < 4; ++n) b[n] = *(const u32x2*)(bp + 16 * n);
#pragma unroll
        for (int n = 0; n < 4; ++n) {
            const f32x4 o = (f32x4){bflo(b[n].x), bfhi(b[n].x), bflo(b[n].y), bfhi(b[n].y)} + acc[n] * scale;
            if (FINAL) __builtin_nontemporal_store(o, (f32x4*)(Y + (size_t)r * D + c0 + 16 * n + 4 * fq));
            else { ss += dot4(o); u32x2 w; w.x = cvt_pk_bf16(o[0], o[1]); w.y = cvt_pk_bf16(o[2], o[3]); *(u32x2*)(bp + 16 * n) = w; }
        }
        if (!FINAL) { ss += __shfl_xor(ss, 16); ss += __shfl_xor(ss, 32); if (fq == 0) ssqp[(size_t)r * 16 + (c0 >> 6)] = ss; }
    }
};
struct EpiProj {
    static constexpr bool PERM = true, AFTER_DRAIN = false, INIT = false; static constexpr int MIDT = 0, EPI_VM = 16;
    const float* ssqp; unsigned char* ws; float* out; const float *qn, *kn, *lbl; LAS unsigned char* tab;
    __device__ __forceinline__ void operator()(const f32x4 (&acc)[2][2][4][2], const Unit& u, int wr, int wc, int fr, int fq) const {
        const int pn = u.pn, row0 = u.pm * 256 + wr * 64 + fr, pc = wc * 32 + 8 * fq;
        bf16_t* const Q = (bf16_t*)(ws + WS_Q); bf16_t* const KV = (bf16_t*)(ws + WS_KV); unsigned short* const LOGF = (unsigned short*)(ws + WS_LOGF);
        if (pn < 3) {
            const bool isv = (pn == 2 && wc >= 2);
            const float* gp = (pn < 2) ? qn : kn;
            f32x4 gn[2][2];
#pragma unroll
            for (int bj = 0; bj < 2; ++bj)
#pragma unroll
                for (int n = 0; n < 2; ++n) gn[bj][n] = isv ? (f32x4){1.f, 1.f, 1.f, 1.f} : *(const f32x4*)(gp + 32 * bj + 8 * fq + 4 * n);
#pragma unroll
            for (int ai = 0; ai < 2; ++ai)
#pragma unroll
                for (int m = 0; m < 4; ++m) {
                    const int r = row0 + ai * 128 + m * 16; const float s = u.idx < 6 ? *(const LAS float*)(tab + (u.idx * 256 + (r & 255)) * 4) : row_rstd16(ssqp, r);
                    f32x4 v[2][2]; float ss = 0.f;
#pragma unroll
                    for (int bj = 0; bj < 2; ++bj)
#pragma unroll
                        for (int n = 0; n < 2; ++n) { v[bj][n] = acc[ai][bj][m][n] * s; ss += dot4(v[bj][n]); }
                    ss += __shfl_xor(ss, 16); ss += __shfl_xor(ss, 32);
                    const float nr = isv ? 1.f : rsqrtf(ss * (1.f / 64.f) + EPS);
#pragma unroll
                    for (int bj = 0; bj < 2; ++bj)
#pragma unroll
                        for (int n = 0; n < 2; ++n) v[bj][n] = v[bj][n] * nr * gn[bj][n];
                    bf16_t* dst = (pn < 2) ? Q + (size_t)r * 512 + (4 * pn + wc) * 64 + 8 * fq : KV + (size_t)r * 256 + wc * 64 + 8 * fq;
#pragma unroll
                    for (int bj = 0; bj < 2; ++bj) *(u32x4*)(dst + 32 * bj) = pack8(v[bj][0], v[bj][1]);
                    if (pn == 2) {
                        float* o = nullptr; const int kvh = wc & 1;
                        if (r < MP) { const int t = r & 4095; if (t >= 3968) o = out + (wc < 2 ? O_PWK : O_PWV) + ((size_t)((r >> 12) * 128 + (t - 3968)) * 2 + kvh) * 64; }
                        else { const int rr = r - MP; o = out + (wc < 2 ? O_SWK : O_SWV) + ((size_t)((rr >> 3) * 128 + 120 + (rr & 7)) * 2 + kvh) * 64; }
                        if (o) {
#pragma unroll
                            for (int bj = 0; bj < 2; ++bj)
#pragma unroll
                                for (int n = 0; n < 2; ++n) *(f32x4*)(o + 32 * bj + 8 * fq + 4 * n) = v[bj][n];
                        }
                    }
                }
        } else if (pn >= 5 && pn < 7) {
            const int tc = (pn - 5) * 256 + pc;
            f32x4 lb[2][2];
#pragma unroll
            for (int bj = 0; bj < 2; ++bj)
#pragma unroll
                for (int n = 0; n < 2; ++n) { const f32x4 l0 = *(const f32x4*)(lbl + tc + 128 * bj + 4 * n), l1 = *(const f32x4*)(lbl + 512 + tc + 128 * bj + 4 * n);
#pragma unroll
                    for (int e = 0; e < 4; ++e) lb[bj][n][e] = 1.f / (1.f + __expf(l1[e] - l0[e])); }
#pragma unroll
            for (int ai = 0; ai < 2; ++ai)
#pragma unroll
                for (int m = 0; m < 4; ++m) {
                    const int r = row0 + ai * 128 + m * 16; const float s = u.idx < 6 ? *(const LAS float*)(tab + (u.idx * 256 + (r & 255)) * 4) : row_rstd16(ssqp, r);
#pragma unroll
                    for (int bj = 0; bj < 2; ++bj)
#pragma unroll
                        for (int n = 0; n < 2; ++n) { f32x4 lf;
#pragma unroll
                            for (int e = 0; e < 4; ++e) { const float f = lb[bj][n][e] + (1.f - lb[bj][n][e]) * fsigmoid(acc[ai][bj][m][n][e] * s); lf[e] = f; }
                            u32x2 w; w.x = q16(lf[0]) | (q16(lf[1]) << 16); w.y = q16(lf[2]) | (q16(lf[3]) << 16);
                            *(u32x2*)(LOGF + (size_t)r * 512 + tc + 128 * bj + 4 * n) = w; }
                }
        } else {
            int act, ld, tc; size_t boff;
            if (pn < 5) { act = 1; boff = WS_QR; ld = 512; tc = (pn - 3) * 256 + pc; }
            else if (pn < 9) { act = 0; boff = WS_IR; ld = 512; tc = (pn - 7) * 256 + pc; }
            else if (pn < 11) { act = 1; boff = WS_GR; ld = 512; tc = (pn - 9) * 256 + pc; }
            else if (pn < 15) { act = 2; boff = WS_SGA; ld = 1024; tc = (pn - 11) * 256 + pc; }
            else { act = 2; boff = WS_SGR; ld = 1024; tc = (pn - 15) * 256 + pc; }
            bf16_t* const base = (bf16_t*)(ws + boff);
#pragma unroll
            for (int ai = 0; ai < 2; ++ai)
#pragma unroll
                for (int m = 0; m < 4; ++m) {
                    const int r = row0 + ai * 128 + m * 16; const float s = u.idx < 6 ? *(const LAS float*)(tab + (u.idx * 256 + (r & 255)) * 4) : row_rstd16(ssqp, r);
#pragma unroll
                    for (int bj = 0; bj < 2; ++bj) { f32x4 a, b;
#pragma unroll
                        for (int e = 0; e < 4; ++e) { const float x0 = acc[ai][bj][m][0][e] * s, x1 = acc[ai][bj][m][1][e] * s;
                            a[e] = act == 0 ? x0 : (act == 1 ? fsilu(x0) : fsigmoid(x0)); b[e] = act == 0 ? x1 : (act == 1 ? fsilu(x1) : fsigmoid(x1)); }
                        if (act == 2) { u32x2 w; w.x = pack4q8(a); w.y = pack4q8(b); *(u32x2*)((unsigned char*)base + (size_t)r * ld + tc + 128 * bj) = w; }
                        else *(u32x4*)(base + (size_t)r * ld + tc + 128 * bj) = pack8(a, b); }
                }
        }
    }
};
struct ProjOrder {
    pg8::StaticOrder P; int G, c;
    __device__ void init(int G_, int c_) { P.init(MP, INW, G_, c_); G = G_; c = c_; }
    __device__ bool next(int i, Unit& u) const {
        if (P.next(i, u)) return true;
        const long L = (long)i * G + c - 1216; if (L >= 64) return false;
        const int q = (int)L & 15; u.pm = 64 + ((int)L >> 4); u.pn = q < 11 ? q : q + 3; u.idx = i; return true;
    }
    __device__ __forceinline__ void a_ready(const Unit&) const {}
    __device__ __forceinline__ void done(const Unit&) const {}
};
struct EpiProjTail {
    static constexpr int MIDT = 0, EPI_VM = 0;
    const float* ssqp; bf16_t* SGA;
    __device__ __forceinline__ void tail(const f32x4 (&acc)[4], int r, int c0, int fq) const {
        const float s = row_rstd16(ssqp, r);
#pragma unroll
        for (int n = 0; n < 4; ++n) { f32x4 a;
#pragma unroll
            for (int e = 0; e < 4; ++e) a[e] = fsigmoid(acc[n][e] * s);
            *(unsigned*)((unsigned char*)SGA + (size_t)r * 1024 + c0 + 16 * n + 4 * fq) = pack4q8(a); }
    }
};
template <int PASS> struct EpiUp {
    static constexpr bool PERM = true, AFTER_DRAIN = false, INIT = false; static constexpr int MIDT = 0, EPI_VM = 0;
    bf16_t* MRG; const bf16_t* G;
    __device__ __forceinline__ void operator()(const f32x4 (&acc)[2][2][4][2], const Unit& u, int wr, int wc, int fr, int fq) const {
        const int row0 = u.pm * 256 + wr * 64 + fr, c0 = u.pn * 256 + wc * 32 + 8 * fq;
#pragma unroll
        for (int ai = 0; ai < 2; ++ai)
#pragma unroll
            for (int m = 0; m < 4; ++m) {
                const int r = row0 + ai * 128 + m * 16;
#pragma unroll
                for (int bj = 0; bj < 2; ++bj) {
                    const size_t off = (size_t)r * 1024 + c0 + 128 * bj; const u32x2 g = *(const u32x2*)((const unsigned char*)G + off); const f32x4 ga = unpack4q8(g.x), gb = unpack4q8(g.y);
                    f32x4 a = acc[ai][bj][m][0], b = acc[ai][bj][m][1];
                    a = a * ga; b = b * gb;
                    if (PASS == 1) { const u32x4 p = *(const u32x4*)(MRG + off);
                        a[0] += bflo(p.x); a[1] += bfhi(p.x); a[2] += bflo(p.y); a[3] += bfhi(p.y); b[0] += bflo(p.z); b[1] += bfhi(p.z); b[2] += bflo(p.w); b[3] += bfhi(p.w); }
                    *(u32x4*)(MRG + off) = pack8(a, b);
                }
            }
    }
    __device__ __forceinline__ void tail(const f32x4 (&acc)[4], int r, int c0, int fq) const {
#pragma unroll
        for (int n = 0; n < 4; ++n) {
            const size_t off = (size_t)r * 1024 + c0 + 16 * n + 4 * fq; const f32x4 gq = unpack4q8(*(const unsigned*)((const unsigned char*)G + off));
            f32x4 a = acc[n] * gq;
            if (PASS == 1) { const u32x2 p = *(const u32x2*)(MRG + off); a[0] += bflo(p.x); a[1] += bfhi(p.x); a[2] += bflo(p.y); a[3] += bfhi(p.y); }
            u32x2 w; w.x = cvt_pk_bf16(a[0], a[1]); w.y = cvt_pk_bf16(a[2], a[3]); *(u32x2*)(MRG + off) = w;
        }
    }
};
struct EpiUpR {
    static constexpr bool PERM = true, AFTER_DRAIN = false, INIT = false; static constexpr int MIDT = 8, EPI_VM = 0;
    static constexpr float EPSQ = 1e-18f;
    bf16_t* MRG; const unsigned char* GA; const unsigned char* GR;
    static __device__ __forceinline__ f32x4 q4(unsigned w) { return (f32x4){(float)(w & 0xffu), (float)((w >> 8) & 0xffu), (float)((w >> 16) & 0xffu), (float)(w >> 24)}; }
    static __device__ __forceinline__ f32x4 ratio4(unsigned wa, unsigned wr_) { const f32x4 a = q4(wa), r = q4(wr_);
        return (f32x4){a[0] * __builtin_amdgcn_rcpf(fmaxf(r[0], EPSQ)), a[1] * __builtin_amdgcn_rcpf(fmaxf(r[1], EPSQ)), a[2] * __builtin_amdgcn_rcpf(fmaxf(r[2], EPSQ)), a[3] * __builtin_amdgcn_rcpf(fmaxf(r[3], EPSQ))}; }
    static __device__ __forceinline__ f32x4 gate4(unsigned wr_) { const f32x4 r = q4(wr_); return (f32x4){fmaxf(r[0], EPSQ), fmaxf(r[1], EPSQ), fmaxf(r[2], EPSQ), fmaxf(r[3], EPSQ)} * (1.f / 255.f); }
    __device__ __forceinline__ void mid(f32x4 (&acc)[2][2][4][2], const Unit& u, int wr, int wc, int fr, int fq) const {
        const int row0 = u.pm * 256 + wr * 64 + fr, c0 = u.pn * 256 + wc * 32 + 8 * fq;
#pragma unroll
        for (int ai = 0; ai < 2; ++ai)
#pragma unroll
            for (int m = 0; m < 4; ++m) {
                const int r = row0 + ai * 128 + m * 16;
#pragma unroll
                for (int bj = 0; bj < 2; ++bj) {
                    const size_t off = (size_t)r * 1024 + c0 + 128 * bj; const u32x2 ga = *(const u32x2*)(GA + off), gr = *(const u32x2*)(GR + off);
                    acc[ai][bj][m][0] = acc[ai][bj][m][0] * ratio4(ga.x, gr.x); acc[ai][bj][m][1] = acc[ai][bj][m][1] * ratio4(ga.y, gr.y);
                }
                if (m == 1 || m == 3) __builtin_amdgcn_sched_barrier(0);
            }
    }
    __device__ __forceinline__ void operator()(const f32x4 (&acc)[2][2][4][2], const Unit& u, int wr, int wc, int fr, int fq) const {
        const int row0 = u.pm * 256 + wr * 64 + fr, c0 = u.pn * 256 + wc * 32 + 8 * fq;
#pragma unroll
        for (int ai = 0; ai < 2; ++ai)
#pragma unroll
            for (int m = 0; m < 4; ++m) {
                const int r = row0 + ai * 128 + m * 16;
#pragma unroll
                for (int bj = 0; bj < 2; ++bj) {
                    const size_t off = (size_t)r * 1024 + c0 + 128 * bj; const u32x2 gr = *(const u32x2*)(GR + off);
                    *(u32x4*)(MRG + off) = pack8(acc[ai][bj][m][0] * gate4(gr.x), acc[ai][bj][m][1] * gate4(gr.y));
                }
            }
    }
    __device__ __forceinline__ void mid_tail(f32x4 (&acc)[4], int r, int c0, int fq) const {
#pragma unroll
        for (int n = 0; n < 4; ++n) { const size_t off = (size_t)r * 1024 + c0 + 16 * n + 4 * fq; acc[n] = acc[n] * ratio4(*(const unsigned*)(GA + off), *(const unsigned*)(GR + off)); }
    }
    __device__ __forceinline__ void tail(const f32x4 (&acc)[4], int r, int c0, int fq) const {
#pragma unroll
        for (int n = 0; n < 4; ++n) { const size_t off = (size_t)r * 1024 + c0 + 16 * n + 4 * fq; const f32x4 a = acc[n] * gate4(*(const unsigned*)(GR + off));
            u32x2 w; w.x = cvt_pk_bf16(a[0], a[1]); w.y = cvt_pk_bf16(a[2], a[3]); *(u32x2*)(MRG + off) = w; }
    }
};
template <class Epi> __device__ __forceinline__ void gemm_tail(LAS unsigned char* L, const bf16_t* A, const bf16_t* Bt, int K, int row_base, int ntr, int ntc, int v, int G, const Epi& E, int tid, int lane, int wave) {
    constexpr int RS = 528, OPB = 64 * RS, BUF = 2 * OPB, XCH = 0;
    static_assert(2 * BUF <= LDSCTL_OFF, "tail buffers must stay below the LDS control words");
    const int fr = lane & 15, fq = lane >> 4, rw = wave & 3, kh = wave >> 2, nc = K / 256;
    const int lrow = tid >> 5, lch = tid & 31;
    for (int tt = v; tt < ntr * ntc; tt += G) {
        int tr = tt / ntc, tc = tt % ntc;
        if (ntr == 16 && ntc == 16 && G == 256) { const int x = tt >> 5, q = tt & 31; tr = (x >> 1) * 4 + (q >> 3); tc = (x & 1) * 8 + (q & 7); }
        const int r0 = row_base + 64 * tr, c0 = 64 * tc;
        const bf16_t* Ag = A + (size_t)(r0 + lrow) * K + 8 * lch; const bf16_t* Bg = Bt + (size_t)(c0 + lrow) * K + 8 * lch; const size_t h16 = (size_t)16 * K;
        u32x4 ra0[4], rb0[4], ra1[4], rb1[4], ra2[4], rb2[4];
#define TL_LOAD(ra, rb, c) do { _Pragma("unroll") for (int j_ = 0; j_ < 4; ++j_) { ra[j_] = *(const u32x4*)(Ag + j_ * h16 + 256 * (c)); rb[j_] = *(const u32x4*)(Bg + j_ * h16 + 256 * (c)); } } while (0)
#define TL_WRITE(ra, rb, b) do { LAS unsigned char* p_ = L + (b) * BUF + lrow * RS + lch * 16; _Pragma("unroll") for (int j_ = 0; j_ < 4; ++j_) { *(LAS u32x4*)(p_ + j_ * 16 * RS) = ra[j_]; *(LAS u32x4*)(p_ + OPB + j_ * 16 * RS) = rb[j_]; } } while (0)
#define TL_COMP(b) do { _Pragma("unroll") for (int i_ = 0; i_ < 4; ++i_) { const int ko_ = (32 * (4 * kh + i_) + 8 * fq) * 2; \
            const pg8::bf16x8 a_ = *(const LAS pg8::bf16x8*)(L + (b) * BUF + (16 * rw + fr) * RS + ko_); \
            _Pragma("unroll") for (int n = 0; n < 4; ++n) { const pg8::bf16x8 b_ = *(const LAS pg8::bf16x8*)(L + (b) * BUF + OPB + (16 * n + fr) * RS + ko_); acc[n] = __builtin_amdgcn_mfma_f32_16x16x32_bf16(b_, a_, acc[n], 0, 0, 0); } } } while (0)
#define TL_STEP(ra, rb, rna, rnb, b, cc) do { if ((cc) < nc) { if ((cc) + 1 < nc) TL_WRITE(rna, rnb, (b) ^ 1); if constexpr (Epi::MIDT > 0) { if ((cc) == Epi::MIDT / 4) E.mid_tail(acc, r0 + 16 * rw + fr, c0, fq); } TL_COMP(b); if ((cc) + 3 < nc) TL_LOAD(ra, rb, (cc) + 3); __syncthreads(); } } while (0)
        f32x4 acc[4];
#pragma unroll
        for (int n = 0; n < 4; ++n) acc[n] = (f32x4){0.f, 0.f, 0.f, 0.f};
        TL_LOAD(ra0, rb0, 0); if (1 < nc) TL_LOAD(ra1, rb1, 1); if (2 < nc) TL_LOAD(ra2, rb2, 2);
        TL_WRITE(ra0, rb0, 0); __syncthreads();
#pragma unroll 1
        for (int c = 0; c < nc; c += 6) { TL_STEP(ra0, rb0, ra1, rb1, 0, c); TL_STEP(ra1, rb1, ra2, rb2, 1, c + 1); TL_STEP(ra2, rb2, ra0, rb0, 0, c + 2); TL_STEP(ra0, rb0, ra1, rb1, 1, c + 3); TL_STEP(ra1, rb1, ra2, rb2, 0, c + 4); TL_STEP(ra2, rb2, ra0, rb0, 1, c + 5); }
#undef TL_STEP
#undef TL_LOAD
#undef TL_WRITE
#undef TL_COMP
        if (kh == 1) {
#pragma unroll
            for (int n = 0; n < 4; ++n) *(LAS f32x4*)(L + XCH + ((rw * 4 + n) * 64 + lane) * 16) = acc[n];
        }
        __syncthreads();
        if (kh == 0) {
#pragma unroll
            for (int n = 0; n < 4; ++n) acc[n] += *(const LAS f32x4*)(L + XCH + ((rw * 4 + n) * 64 + lane) * 16);
            E.tail(acc, r0 + 16 * rw + fr, c0, fq);
        }
        __syncthreads();
    }
}
__device__ __forceinline__ float wave_sum(float v) {
#pragma unroll
    for (int o = 1; o < 64; o <<= 1) v += __shfl_xor(v, o);
    return v;
}
struct WI { const float* W; const float* gain; bf16_t* WT; int ldw, K, dr, sc, k0; };
__device__ __forceinline__ void wi_set(WI& w, int kind, const float* W, const float* W2, int ldw, int K, bf16_t* WT, int nrg, const float* gain, int it) {
    const int kb = it / nrg, rg = it % nrg, p0 = rg * 32; int sc = p0; const float* Ws = W;
    if (kind == 1) { if ((p0 & 255) >> 7) Ws = W2; sc = 128 * (p0 >> 8) + (p0 & 127); }
    else if (kind == 2) { const int tile = p0 >> 8; if (tile < 3) sc = 256 * tile + 64 * ((p0 & 127) >> 5) + 32 * ((p0 & 255) >> 7); }
    w.W = Ws; w.gain = gain; w.WT = WT; w.ldw = ldw; w.K = K; w.dr = p0; w.sc = sc; w.k0 = 64 * kb;
}
__device__ __forceinline__ void wi_load(const WI& w, f32x4 (&r)[8], int lane) {
    const int lr = lane >> 3, lc4 = (lane & 7) * 4;
#pragma unroll
    for (int i = 0; i < 8; ++i) r[i] = __builtin_nontemporal_load((const GAS f32x4*)(w.W + (size_t)(w.k0 + 8 * i + lr) * w.ldw + w.sc + lc4));
}
__device__ __forceinline__ void wi_proc(const WI& w, const f32x4 (&r)[8], LAS float* scr, int lane) {
    const int lr = lane >> 3, lc4 = (lane & 7) * 4;
#pragma unroll
    for (int i = 0; i < 8; ++i) { const int kk = 8 * i + lr; const float gsc = w.gain ? w.gain[w.k0 + kk] : 1.f;
        scr[kk * 33 + lc4 + 0] = r[i][0] * gsc; scr[kk * 33 + lc4 + 1] = r[i][1] * gsc; scr[kk * 33 + lc4 + 2] = r[i][2] * gsc; scr[kk * 33 + lc4 + 3] = r[i][3] * gsc; }
    LDS_WAIT(); asm volatile("" ::: "memory");
    const int c = lane & 7;
#pragma unroll
    for (int j = 0; j < 4; ++j) { const int n = (lane >> 3) + 8 * j; const LAS float* s = scr + (8 * c) * 33 + n;
        v4u o; o.x = pk2(s[0 * 33], s[1 * 33]); o.y = pk2(s[2 * 33], s[3 * 33]); o.z = pk2(s[4 * 33], s[5 * 33]); o.w = pk2(s[6 * 33], s[7 * 33]);
        *(GAS v4u*)(w.WT + (size_t)(w.dr + n) * w.K + w.k0 + 8 * c) = o; }
    LDS_WAIT(); asm volatile("" ::: "memory");
}
}


namespace at {
using pg8::bf16_t; using pg8::bf16x8; using pg8::u32x4; using pg8::cvt_pk_bf16;
typedef float f32x16 __attribute__((ext_vector_type(16)));
typedef short v4i16_t __attribute__((ext_vector_type(4)));
typedef unsigned u32x2 __attribute__((ext_vector_type(2)));
constexpr int KS_OFF = 0, VS_OFF = 46080, LUT_OFF = 87040, KROW = 144;
__device__ const unsigned char T5LUT[129] = {0, 1, 2, 3, 4, 5, 6, 7, 8, 9, 10, 11, 12, 13, 14, 15, 16, 16, 16, 17, 17, 18, 18, 18, 19, 19, 19, 20, 20, 20, 20, 21, 21, 21, 21, 22, 22, 22, 22, 22, 23, 23, 23, 23, 23, 23, 24, 24, 24, 24, 24, 24, 25, 25, 25, 25, 25, 25, 25, 26, 26, 26, 26, 26, 26, 26, 26, 27, 27, 27, 27, 27, 27, 27, 27, 27, 27, 28, 28, 28, 28, 28, 28, 28, 28, 28, 28, 29, 29, 29, 29, 29, 29, 29, 29, 29, 29, 29, 29, 30, 30, 30, 30, 30, 30, 30, 30, 30, 30, 30, 30, 30, 30, 31, 31, 31, 31, 31, 31, 31, 31, 31, 31, 31, 31, 31, 31, 31, 31};
__device__ __forceinline__ v4i16_t trr(LAS const unsigned char* p) { return __builtin_amdgcn_ds_read_tr16_b64_v4i16((LAS v4i16_t*)p); }
__device__ __forceinline__ void attn_wave(const bf16x8 (&qf)[4], LAS const unsigned char* Kt, LAS const unsigned char* Vt, int vdh, LAS const float* lut, float sink, int iq, int jmin, int kb0, int lane, f32x16 (&o)[2]) {
    const int ql = lane & 31, h = lane >> 5;
    f32x16 acc[5];
#pragma unroll
    for (int kb = 0; kb < 5; ++kb) {
        acc[kb] = (f32x16){};
        LAS const unsigned char* kp = Kt + (32 * (kb0 + kb) + ql) * KROW + 16 * h;
#pragma unroll
        for (int ds = 0; ds < 4; ++ds) { const bf16x8 a = *(LAS const bf16x8*)(kp + 32 * ds); acc[kb] = __builtin_amdgcn_mfma_f32_32x32x16_bf16(a, qf[ds], acc[kb], 0, 0, 0); }
    }
    const int base = iq + 128 - 4 * h - 32 * kb0, dmax0 = iq + 128 - jmin; const unsigned dmax = (unsigned)(dmax0 < 128 ? dmax0 : 128);
    const float sink2 = sink * 1.4426950408889634f; float mx = sink2;
#pragma unroll
    for (int kb = 0; kb < 5; ++kb)
#pragma unroll
        for (int r = 0; r < 16; ++r) {
            const int dist = base - (32 * kb + (r & 3) + 8 * (r >> 2));
            const float s = ((unsigned)dist <= dmax) ? __builtin_fmaf(acc[kb][r], 0.125f * 1.4426950408889634f, lut[dist]) : -INFINITY;
            acc[kb][r] = s; mx = fmaxf(mx, s);
        }
    mx = fmaxf(mx, __shfl_xor(mx, 32));
    float l = 0.f;
#pragma unroll
    for (int kb = 0; kb < 5; ++kb)
#pragma unroll
        for (int r = 0; r < 16; ++r) { const float p = __builtin_amdgcn_exp2f(acc[kb][r] - mx); acc[kb][r] = p; l += p; }
    l += __shfl_xor(l, 32);
    l += __builtin_amdgcn_exp2f(sink2 - mx);
    const float inv = 1.f / l;
    o[0] = (f32x16){}; o[1] = (f32x16){};
    const int g16 = (lane >> 4) & 1, q4 = (lane & 15) >> 2, p4 = lane & 3;
#pragma unroll
    for (int kb = 0; kb < 5; ++kb)
#pragma unroll
        for (int s2 = 0; s2 < 2; ++s2) {
            u32x4 pw; pw.x = cvt_pk_bf16(acc[kb][8 * s2 + 0], acc[kb][8 * s2 + 1]); pw.y = cvt_pk_bf16(acc[kb][8 * s2 + 2], acc[kb][8 * s2 + 3]);
            pw.z = cvt_pk_bf16(acc[kb][8 * s2 + 4], acc[kb][8 * s2 + 5]); pw.w = cvt_pk_bf16(acc[kb][8 * s2 + 6], acc[kb][8 * s2 + 7]);
            const bf16x8 pf = __builtin_bit_cast(bf16x8, pw);
            const int key = 32 * (kb0 + kb) + 16 * s2 + 4 * h + q4;
#pragma unroll
            for (int db = 0; db < 2; ++db) {
                LAS const unsigned char* vp = Vt + db * vdh + key * 64 + (16 * g16 + 4 * p4) * 2;
                const v4i16_t lo = trr(vp), hi = trr(vp + 8 * 64);
                const bf16x8 a = (bf16x8){lo[0], lo[1], lo[2], lo[3], hi[0], hi[1], hi[2], hi[3]};
                o[db] = __builtin_amdgcn_mfma_f32_32x32x16_bf16(a, pf, o[db], 0, 0, 0);
            }
        }
#pragma unroll
    for (int db = 0; db < 2; ++db)
#pragma unroll
        for (int r = 0; r < 16; ++r) o[db][r] *= inv;
}
__device__ __forceinline__ void attn_store(bf16_t* dst, const f32x16 (&o)[2], int h) {
#pragma unroll
    for (int db = 0; db < 2; ++db)
#pragma unroll
        for (int rg = 0; rg < 4; ++rg) { u32x2 w; w.x = cvt_pk_bf16(o[db][4 * rg + 0], o[db][4 * rg + 1]); w.y = cvt_pk_bf16(o[db][4 * rg + 2], o[db][4 * rg + 3]);
            *(u32x2*)(dst + 32 * db + 8 * rg + 4 * h) = w; }
}
__device__ __forceinline__ void attn_prompt_task(LAS unsigned char* L, const bf16_t* Q, bf16_t* AOR, const bf16_t* KV, const float* table, const float* sinks, int b, int n, int kvh, int tid, int lane, int wave) {
    const int m0 = b * 4096 + 128 * n;
    for (int c = tid; c < 2048; c += 512) {
        const int j = c >> 3, ch = c & 7; u32x4 kx = (u32x4){0u, 0u, 0u, 0u}, vx = kx;
        if (n > 0 || j >= 128) { const bf16_t* src = KV + (size_t)(m0 - 128 + j) * 256 + kvh * 64 + 8 * ch; kx = *(const u32x4*)src; vx = *(const u32x4*)(src + 128); }
        *(LAS u32x4*)(L + KS_OFF + j * KROW + 16 * ch) = kx;
        *(LAS u32x4*)(L + VS_OFF + (ch >> 2) * 16384 + j * 64 + (ch & 3) * 16) = vx;
    }
    for (int e = tid; e < 4 * 129; e += 512) { const int hl = e / 129, d = e % 129; ((LAS float*)(L + LUT_OFF))[hl * 132 + d] = table[T5LUT[d] * 8 + 4 * kvh + hl] * 1.4426950408889634f; }
    __syncthreads();
    const int ql = lane & 31, h = lane >> 5, hl = wave & 3, head = 4 * kvh + hl;
    const float sink = sinks[head];
#pragma unroll 1
    for (int rep = 0; rep < 2; ++rep) {
        const int qb = (wave >> 2) + 2 * rep, iq = 32 * qb + ql;
        const bf16_t* qp = Q + (size_t)(m0 + iq) * 512 + head * 64;
        bf16x8 qf[4];
#pragma unroll
        for (int ds = 0; ds < 4; ++ds) qf[ds] = *(const bf16x8*)(qp + 16 * ds + 8 * h);
        f32x16 o[2];
        attn_wave(qf, L + KS_OFF, L + VS_OFF, 16384, (LAS const float*)(L + LUT_OFF) + hl * 132, sink, iq, n == 0 ? 128 : 0, qb, lane, o);
        attn_store(AOR + (size_t)(m0 + iq) * 1024 + head * 64, o, h);
    }
    __syncthreads();
}
__device__ __forceinline__ void attn_sample_task(LAS unsigned char* L, const bf16_t* Q, bf16_t* AOR, const bf16_t* KV, const float* wk, const float* wv, const float* table, const float* sinks, int bd, int kvh, int tid, int lane, int wave) {
    for (int c = tid; c < 1280; c += 512) {
        const int j = c >> 3, ch = c & 7; u32x4 kx = (u32x4){0u, 0u, 0u, 0u}, vx = kx;
        if (j < 128) {
            const size_t so = ((size_t)(bd * 128 + j) * 2 + kvh) * 64 + 8 * ch;
            const f32x4 k0 = *(const f32x4*)(wk + so), k1 = *(const f32x4*)(wk + so + 4), v0 = *(const f32x4*)(wv + so), v1 = *(const f32x4*)(wv + so + 4);
            kx = mk::pack8(k0, k1); vx = mk::pack8(v0, v1);
        } else if (j < 136) { const bf16_t* src = KV + (size_t)(MP + bd * 8 + (j - 128)) * 256 + kvh * 64 + 8 * ch; kx = *(const u32x4*)src; vx = *(const u32x4*)(src + 128); }
        *(LAS u32x4*)(L + KS_OFF + j * KROW + 16 * ch) = kx;
        *(LAS u32x4*)(L + VS_OFF + (ch >> 2) * 10240 + j * 64 + (ch & 3) * 16) = vx;
    }
    for (int e = tid; e < 4 * 129; e += 512) { const int hl = e / 129, d = e % 129; ((LAS float*)(L + LUT_OFF))[hl * 132 + d] = table[T5LUT[d] * 8 + 4 * kvh + hl] * 1.4426950408889634f; }
    __syncthreads();
    if (wave == 0) {
        const int ql = lane & 31, h = lane >> 5, hl = ql >> 3, iq = ql & 7, head = 4 * kvh + hl;
        const bf16_t* qp = Q + (size_t)(MP + bd * 8 + iq) * 512 + head * 64;
        bf16x8 qf[4];
#pragma unroll
        for (int ds = 0; ds < 4; ++ds) qf[ds] = *(const bf16x8*)(qp + 16 * ds + 8 * h);
        f32x16 o[2];
        attn_wave(qf, L + KS_OFF, L + VS_OFF, 10240, (LAS const float*)(L + LUT_OFF) + hl * 132, sinks[head], iq, 0, 0, lane, o);
        attn_store(AOR + (size_t)(MP + bd * 8 + iq) * 1024 + head * 64, o, h);
    }
    __syncthreads();
}
}

namespace hg {
using pg8::bf16_t; using pg8::bf16x8; using pg8::f32x4; using pg8::u32x4; using pg8::cvt_pk_bf16;
typedef short v4i16_t __attribute__((ext_vector_type(4)));
typedef unsigned u32x2 __attribute__((ext_vector_type(2)));
__device__ __forceinline__ v4i16_t trr(LAS const unsigned char* p) { return __builtin_amdgcn_ds_read_tr16_b64_v4i16((LAS v4i16_t*)p); }
constexpr int TS = 288;
constexpr float FQ = 1.f / 65535.f;
struct HaPre { unsigned short lf[16]; u32x4 vch[2]; };
__device__ __forceinline__ void ha_issue(HaPre& P, const unsigned short* LOGF, const bf16_t* IR, int task, int tid) {
    const int bh = task >> 6, c = task & 63, h = bh & 3; const size_t m0 = (size_t)(bh >> 2) * 4096 + 64 * c; const int kd = tid & 127, seg = tid >> 7;
#pragma unroll
    for (int i = 0; i < 16; ++i) P.lf[i] = LOGF[(m0 + 16 * seg + i) * 512 + h * 128 + kd];
#pragma unroll
    for (int q = 0; q < 2; ++q) { const int cid = tid + 512 * q, t = cid >> 4, ch = cid & 15; P.vch[q] = *(const u32x4*)(IR + (m0 + t) * 512 + h * 128 + 8 * ch); }
}
__device__ __forceinline__ void ha_phase(LAS unsigned char* L, HaPre& P, const unsigned short* LOGF, const bf16_t* IR, bf16_t* US, float* DEC, int v, int G, int tid, int lane, int wave) {
    constexpr int KT = 0, VT = 64 * TS, SEG = 2 * 64 * TS, DCS = SEG + 2048;
#pragma unroll 1
    for (int grp = v; grp < 256; grp += G) {
        const int kd = tid & 127, seg = tid >> 7, g = lane >> 4, q4 = (lane & 15) >> 2, p4 = lane & 3;
        f32x4 acc[8];
#pragma unroll
        for (int i = 0; i < 8; ++i) acc[i] = (f32x4){0.f, 0.f, 0.f, 0.f};
        float dg = 1.f;
#pragma unroll 1
        for (int cc = 0; cc < 4; ++cc) {
            float lf[16]; float run = 1.f;
#pragma unroll
            for (int i = 0; i < 16; ++i) { lf[i] = (float)P.lf[i] * FQ; run *= lf[i]; }
            ((LAS float*)(L + SEG))[seg * 128 + kd] = run;
#pragma unroll
            for (int q = 0; q < 2; ++q) { const int cid = tid + 512 * q, t = cid >> 4, ch = cid & 15; *(LAS u32x4*)(L + VT + t * TS + ch * 16) = P.vch[q]; }
            const int nxt = cc < 3 ? 4 * grp + cc + 1 : 4 * (grp + G);
            if (nxt < 1024) ha_issue(P, LOGF, IR, nxt, tid);
            __syncthreads();
            {
                const LAS float* sg = (const LAS float*)(L + SEG);
                const float s0 = sg[kd], s1 = sg[128 + kd], s2 = sg[256 + kd], s3 = sg[384 + kd];
                float suf = seg == 3 ? 1.f : (seg == 2 ? s3 : (seg == 1 ? s2 * s3 : s1 * (s2 * s3)));
#pragma unroll
                for (int i = 15; i >= 0; --i) { const float kt = (1.f - lf[i]) * suf; suf *= lf[i]; *(LAS bf16_t*)(L + KT + (16 * seg + i) * TS + kd * 2) = (bf16_t)cvt_pk_bf16(kt, 0.f); }
                const float dcv = (s0 * s1) * (s2 * s3); dg *= dcv;
                if (seg == 0) ((LAS float*)(L + DCS))[kd] = dcv;
            }
            __syncthreads();
            {
                bf16x8 bv[2];
#pragma unroll
                for (int ks = 0; ks < 2; ++ks) { LAS const unsigned char* vp = L + VT + (32 * ks + 4 * g + q4) * TS + (16 * wave + 4 * p4) * 2; const v4i16_t lo = trr(vp), hi = trr(vp + 16 * TS);
                    bv[ks] = (bf16x8){lo[0], lo[1], lo[2], lo[3], hi[0], hi[1], hi[2], hi[3]}; }
#pragma unroll
                for (int i = 0; i < 8; ++i) {
                    const f32x4 dc = *(const LAS f32x4*)(L + DCS + (16 * i + 4 * g) * 4);
                    acc[i] = acc[i] * dc;
#pragma unroll
                    for (int ks = 0; ks < 2; ++ks) { LAS const unsigned char* kp = L + KT + (32 * ks + 4 * g + q4) * TS + (16 * i + 4 * p4) * 2; const v4i16_t lo = trr(kp), hi = trr(kp + 16 * TS);
                        const bf16x8 a = (bf16x8){lo[0], lo[1], lo[2], lo[3], hi[0], hi[1], hi[2], hi[3]};
                        acc[i] = __builtin_amdgcn_mfma_f32_16x16x32_bf16(a, bv[ks], acc[i], 0, 0, 0); }
                }
            }
            __syncthreads();
        }
        const size_t ub = ((size_t)grp * 128 + 16 * wave + (lane & 15)) * 128 + 4 * g;
#pragma unroll
        for (int i = 0; i < 8; ++i) { u32x2 w; w.x = cvt_pk_bf16(acc[i][0], acc[i][1]); w.y = cvt_pk_bf16(acc[i][2], acc[i][3]); *(u32x2*)(US + ub + 16 * i) = w; }
        if (seg == 0) DEC[(size_t)grp * 128 + kd] = dg;
    }
}
__device__ __forceinline__ void hb_scan(unsigned* US32, const float* DEC, float* out_pst, int idx) {
    const int bh = idx >> 13, pair = idx & 8191, vd = pair >> 6, kd0 = (pair & 63) * 2;
    float s0 = 0.f, s1 = 0.f;
    unsigned* up = US32 + (size_t)bh * 16 * 8192 + pair; const float* dp = DEC + (size_t)bh * 16 * 128 + kd0;
#pragma unroll 1
    for (int c0 = 0; c0 < 16; c0 += 8) {
        unsigned w[8]; float d0[8], d1[8];
#pragma unroll
        for (int i = 0; i < 8; ++i) { w[i] = up[(size_t)(c0 + i) * 8192]; const float2 dd = *(const float2*)(dp + (c0 + i) * 128); d0[i] = dd.x; d1[i] = dd.y; }
#pragma unroll
        for (int i = 0; i < 8; ++i) { up[(size_t)(c0 + i) * 8192] = cvt_pk_bf16(s0, s1); s0 = d0[i] * s0 + mk::bflo(w[i]); s1 = d1[i] * s1 + mk::bfhi(w[i]); }
    }
    out_pst[((size_t)bh * 128 + kd0) * 128 + vd] = s0; out_pst[((size_t)bh * 128 + kd0 + 1) * 128 + vd] = s1;
}
struct HcPre { unsigned short lf[16], q[16]; u32x4 vch[2]; u32x2 st[8]; };
__device__ __forceinline__ float dpp_xor1(float x) { return __builtin_bit_cast(float, __builtin_amdgcn_mov_dpp(__builtin_bit_cast(int, x), 0xB1, 0xF, 0xF, true)); }
__device__ __forceinline__ void hc_issue_prompt(HcPre& P, const unsigned short* LOGF, const bf16_t* QR, const bf16_t* IR, const bf16_t* US, int task, bool st, int tid, int lane, int wave) {
    const int bh = task >> 6, c = task & 63, h = bh & 3; const size_t m0 = (size_t)(bh >> 2) * 4096 + 64 * c;
    { const int kd = tid & 127, sub = tid >> 7;
#pragma unroll
      for (int t = 0; t < 16; ++t) { const size_t off = (m0 + 16 * sub + t) * 512 + h * 128 + kd; P.lf[t] = LOGF[off]; P.q[t] = QR[off]; } }
#pragma unroll
    for (int q = 0; q < 2; ++q) { const int cid = tid + 512 * q, t = cid >> 4, ch = cid & 15; P.vch[q] = *(const u32x4*)(IR + (m0 + t) * 512 + h * 128 + 8 * ch); }
    if (st) {
        const bf16_t* USt = US + (size_t)(task >> 2) * 16384; const int g = lane >> 4, vd = 16 * wave + (lane & 15);
#pragma unroll
        for (int i = 0; i < 8; ++i) P.st[i] = *(const u32x2*)(USt + (size_t)vd * 128 + 16 * i + 4 * g);
    }
}
__device__ __forceinline__ void hc_phase_prompt(LAS unsigned char* L, const unsigned short* LOGF, const bf16_t* QR, bf16_t* AOR, const bf16_t* IR, const bf16_t* GR, const float* hgn, const bf16_t* US, int v, int G, int tid, int lane, int wave) {
    constexpr int QH = 0, KH = 17408, KT = 34816, VT = 53248, AT = 71680, DECS = 73728, OT = 75776, QS = 272, OS = 132;
    const int g = lane >> 4, lc = lane & 15, q4 = lc >> 2, p4 = lane & 3, vd = 16 * wave + lc;
    const int et = tid >> 3, ec = (tid & 7) * 16;
    const f32x4 n0 = *(const f32x4*)(hgn + ec), n1 = *(const f32x4*)(hgn + ec + 4), n2 = *(const f32x4*)(hgn + ec + 8), n3 = *(const f32x4*)(hgn + ec + 12);
    HcPre P;
    if (v < 256) hc_issue_prompt(P, LOGF, QR, IR, US, 4 * v, true, tid, lane, wave);
    f32x4 sacc[8];
#pragma unroll
    for (int i = 0; i < 8; ++i) sacc[i] = (f32x4){0.f, 0.f, 0.f, 0.f};
#pragma unroll 1
    for (int grp = v; grp < 256; grp += G)
#pragma unroll 1
    for (int cc = 0; cc < 4; ++cc) {
        const int task = 4 * grp + cc;
        const int bh = task >> 6, c = task & 63, h = bh & 3; const size_t m0 = (size_t)(bh >> 2) * 4096 + 64 * c;
        if (cc == 0) {
#pragma unroll
            for (int i = 0; i < 8; ++i) sacc[i] = (f32x4){mk::bflo(P.st[i].x), mk::bfhi(P.st[i].x), mk::bflo(P.st[i].y), mk::bfhi(P.st[i].y)};
        }
        float lf[16], qv[16];
#pragma unroll
        for (int t = 0; t < 16; ++t) { lf[t] = (float)P.lf[t] * FQ; qv[t] = mk::bf2f(P.q[t]); }
#pragma unroll
        for (int q = 0; q < 2; ++q) { const int cid = tid + 512 * q, t = cid >> 4, ch = cid & 15; *(LAS u32x4*)(L + VT + t * TS + ch * 16) = P.vch[q]; }
        const size_t eoff = (m0 + et) * 512 + h * 128 + ec;
        const u32x4 g0 = *(const u32x4*)(GR + eoff), g1 = *(const u32x4*)(GR + eoff + 8);
        { const int nxt = cc < 3 ? task + 1 : 4 * (grp + G); if (nxt < 1024) hc_issue_prompt(P, LOGF, QR, IR, US, nxt, cc == 3, tid, lane, wave); }
        {
            const int kd = tid & 127, sub = tid >> 7, odd = lane & 1, kde = kd & ~1; float pp[16]; float p = 1.f;
#pragma unroll
            for (int t = 0; t < 16; ++t) { p *= lf[t]; pp[t] = p; }
            float suf = 1.f;
#pragma unroll
            for (int t = 14; t >= 0; t -= 2) {
                const float kk1 = 1.f - lf[t + 1], kk0 = 1.f - lf[t];
                const float qh1 = qv[t + 1] * pp[t + 1], kh1 = kk1 * __builtin_amdgcn_rcpf(fmaxf(pp[t + 1], 1e-30f)), kt1 = kk1 * suf; suf *= lf[t + 1];
                const float qh0 = qv[t] * pp[t], kh0 = kk0 * __builtin_amdgcn_rcpf(fmaxf(pp[t], 1e-30f)), kt0 = kk0 * suf; suf *= lf[t];
                const int ro = 16 * sub + t + odd;
                const float rq = dpp_xor1(odd ? qh0 : qh1), rk = dpp_xor1(odd ? kh0 : kh1), rt = dpp_xor1(odd ? kt0 : kt1);
                *(LAS unsigned*)(L + QH + ro * QS + kde * 2) = odd ? cvt_pk_bf16(rq, qh1) : cvt_pk_bf16(qh0, rq);
                *(LAS unsigned*)(L + KH + ro * QS + kde * 2) = odd ? cvt_pk_bf16(rk, kh1) : cvt_pk_bf16(kh0, rk);
                *(LAS unsigned*)(L + KT + ro * TS + kde * 2) = odd ? cvt_pk_bf16(rt, kt1) : cvt_pk_bf16(kt0, rt);
            }
            *(LAS float*)(L + DECS + (sub * 128 + kd) * 4) = p;
        }
        __syncthreads();
        if (wave < 4) {
            f32x4 acc = (f32x4){0.f, 0.f, 0.f, 0.f};
#pragma unroll
            for (int ks = 0; ks < 4; ++ks) { const bf16x8 a = *(const LAS bf16x8*)(L + QH + (16 * wave + lc) * QS + (32 * ks + 8 * g) * 2), b = *(const LAS bf16x8*)(L + KH + (16 * wave + lc) * QS + (32 * ks + 8 * g) * 2);
                acc = __builtin_amdgcn_mfma_f32_16x16x32_bf16(a, b, acc, 0, 0, 0); }
#pragma unroll
            for (int e = 0; e < 4; ++e) { const int t = 4 * g + e; *(LAS bf16_t*)(L + AT + wave * 512 + t * 32 + lc * 2) = (bf16_t)cvt_pk_bf16(lc <= t ? acc[e] : 0.f, 0.f); }
        }
        __syncthreads();
#pragma unroll 1
        for (int sb = 0; sb < 4; ++sb) {
            f32x4 oacc = (f32x4){0.f, 0.f, 0.f, 0.f};
#pragma unroll
            for (int ks = 0; ks < 4; ++ks) {
                u32x4 bw; bw.x = cvt_pk_bf16(sacc[2 * ks][0], sacc[2 * ks][1]); bw.y = cvt_pk_bf16(sacc[2 * ks][2], sacc[2 * ks][3]); bw.z = cvt_pk_bf16(sacc[2 * ks + 1][0], sacc[2 * ks + 1][1]); bw.w = cvt_pk_bf16(sacc[2 * ks + 1][2], sacc[2 * ks + 1][3]);
                const u32x2 a0 = *(const LAS u32x2*)(L + QH + (16 * sb + lc) * QS + (32 * ks + 4 * g) * 2), a1 = *(const LAS u32x2*)(L + QH + (16 * sb + lc) * QS + (32 * ks + 16 + 4 * g) * 2);
                u32x4 aw; aw.x = a0.x; aw.y = a0.y; aw.z = a1.x; aw.w = a1.y;
                oacc = __builtin_amdgcn_mfma_f32_16x16x32_bf16(__builtin_bit_cast(bf16x8, aw), __builtin_bit_cast(bf16x8, bw), oacc, 0, 0, 0);
            }
            bf16x8 bv;
            { const v4i16_t lo = trr(L + VT + (16 * sb + 4 * g + q4) * TS + (16 * wave + 4 * p4) * 2); bv = (bf16x8){lo[0], lo[1], lo[2], lo[3], 0, 0, 0, 0}; }
            { const u32x2 a0 = *(const LAS u32x2*)(L + AT + sb * 512 + lc * 32 + 8 * g); u32x4 aw; aw.x = a0.x; aw.y = a0.y; aw.z = 0u; aw.w = 0u;
              oacc = __builtin_amdgcn_mfma_f32_16x16x32_bf16(__builtin_bit_cast(bf16x8, aw), bv, oacc, 0, 0, 0); }
#pragma unroll
            for (int e = 0; e < 4; ++e) *(LAS float*)(L + OT + ((16 * sb + 4 * g + e) * OS + vd) * 4) = oacc[e];
            if (sb < 3 || cc < 3) {
#pragma unroll
                for (int i = 0; i < 8; ++i) {
                    const f32x4 dc = *(const LAS f32x4*)(L + DECS + (sb * 128 + 16 * i + 4 * g) * 4);
                    const v4i16_t lo = trr(L + KT + (16 * sb + 4 * g + q4) * TS + (16 * i + 4 * p4) * 2);
                    const bf16x8 a = (bf16x8){lo[0], lo[1], lo[2], lo[3], 0, 0, 0, 0};
                    sacc[i] = __builtin_amdgcn_mfma_f32_16x16x32_bf16(a, bv, sacc[i] * dc, 0, 0, 0);
                }
            }
        }
        __syncthreads();
        {
            f32x4 x[4]; float ss = 0.f;
#pragma unroll
            for (int k = 0; k < 4; ++k) { x[k] = *(const LAS f32x4*)(L + OT + (et * OS + ec + 4 * k) * 4); ss += mk::dot4(x[k]); }
            ss += __shfl_xor(ss, 1); ss += __shfl_xor(ss, 2); ss += __shfl_xor(ss, 4);
            const float rs = rsqrtf(ss * (1.f / 128.f) + EPS);
            const f32x4 y0 = x[0] * rs * n0 * (f32x4){mk::bflo(g0.x), mk::bfhi(g0.x), mk::bflo(g0.y), mk::bfhi(g0.y)}, y1 = x[1] * rs * n1 * (f32x4){mk::bflo(g0.z), mk::bfhi(g0.z), mk::bflo(g0.w), mk::bfhi(g0.w)};
            const f32x4 y2 = x[2] * rs * n2 * (f32x4){mk::bflo(g1.x), mk::bfhi(g1.x), mk::bflo(g1.y), mk::bfhi(g1.y)}, y3 = x[3] * rs * n3 * (f32x4){mk::bflo(g1.z), mk::bfhi(g1.z), mk::bflo(g1.w), mk::bfhi(g1.w)};
            { bf16_t* op = AOR + (m0 + et) * 1024 + 512 + h * 128 + ec; *(u32x4*)op = mk::pack8(y0, y1); *(u32x4*)(op + 8) = mk::pack8(y2, y3); }
        }
    }
    __syncthreads();
}

struct HcPreS { f32x4 sreg[8]; unsigned short lf[8]; unsigned short qv[8]; u32x4 vch; };
__device__ __forceinline__ void hc_issue_sample(HcPreS& P, const unsigned short* LOGF, const bf16_t* QR, const bf16_t* IR, const float* S0, int id, int tid) {
    const int bd = id >> 2, h = id & 3; const size_t m0 = (size_t)MP + bd * 8; const float* s0 = S0 + (size_t)id * 16384;
#pragma unroll
    for (int q = 0; q < 8; ++q) { const int cid = tid + 512 * q; P.sreg[q] = __builtin_nontemporal_load((const f32x4*)(s0 + (size_t)cid * 4)); }
    if (tid < 128) {
#pragma unroll
        for (int t = 0; t < 8; ++t) { const size_t off = (m0 + t) * 512 + h * 128 + tid; P.lf[t] = LOGF[off]; P.qv[t] = QR[off]; }
        P.vch = *(const u32x4*)(IR + (m0 + (tid >> 4)) * 512 + h * 128 + 8 * (tid & 15));
    }
}
__device__ __forceinline__ void hc_phase_sample(LAS unsigned char* L, const unsigned short* LOGF, const bf16_t* QR, bf16_t* AOR, const bf16_t* IR, const bf16_t* GR, const float* hgn, const float* S0, float* Sout, HcPreS& P, int v, int G, int tid, int lane, int wave) {
    constexpr int QH = 0, KH = 4352, KT = 8704, VT = 13312, AT = 17920, DECS = 18432, OT = 18944, ST = 27392, QS = 272, OS = 132, SS = 528;
    const int g = lane >> 4, lc = lane & 15, q4 = lc >> 2, p4 = lane & 3, vd = 16 * wave + lc;
    const int et = tid >> 3, ec = (tid & 7) * 16;
#pragma unroll 1
    for (int id = v; id < 512; id += G) {
        const int bd = id >> 2, h = id & 3; const size_t m0 = (size_t)MP + bd * 8;
#pragma unroll
        for (int q = 0; q < 8; ++q) { const int cid = tid + 512 * q, row = cid >> 5, c4 = cid & 31; *(LAS f32x4*)(L + ST + row * SS + c4 * 16) = P.sreg[q]; }
        if (tid < 128) {
            const int kd = tid; float pp[8], lfs[8]; float p = 1.f;
#pragma unroll
            for (int t = 0; t < 8; ++t) { lfs[t] = (float)P.lf[t] * FQ; p *= lfs[t]; pp[t] = p; }
            float suf = 1.f;
#pragma unroll
            for (int t = 7; t >= 0; --t) {
                const float kk = 1.f - lfs[t];
                *(LAS bf16_t*)(L + QH + t * QS + kd * 2) = (bf16_t)cvt_pk_bf16(mk::bf2f(P.qv[t]) * pp[t], 0.f);
                *(LAS bf16_t*)(L + KH + t * QS + kd * 2) = (bf16_t)cvt_pk_bf16(kk * __builtin_amdgcn_rcpf(fmaxf(pp[t], 1e-30f)), 0.f);
                *(LAS bf16_t*)(L + KT + t * TS + kd * 2) = (bf16_t)cvt_pk_bf16(kk * suf, 0.f);
                suf *= lfs[t];
            }
#pragma unroll
            for (int t = 8; t < 16; ++t) { *(LAS bf16_t*)(L + QH + t * QS + kd * 2) = 0; *(LAS bf16_t*)(L + KH + t * QS + kd * 2) = 0; *(LAS bf16_t*)(L + KT + t * TS + kd * 2) = 0; }
            *(LAS float*)(L + DECS + kd * 4) = p;
            *(LAS u32x4*)(L + VT + (tid >> 4) * TS + (tid & 15) * 16) = P.vch;
        } else if (tid < 256) { const int c = tid - 128; *(LAS u32x4*)(L + VT + (8 + (c >> 4)) * TS + (c & 15) * 16) = (u32x4){0u, 0u, 0u, 0u}; }
        const size_t eoff = (m0 + et) * 512 + h * 128 + ec; u32x4 g0 = (u32x4){0u, 0u, 0u, 0u}, g1 = g0;
        if (tid < 64) { g0 = *(const u32x4*)(GR + eoff); g1 = *(const u32x4*)(GR + eoff + 8); }
        if (id + G < 512) hc_issue_sample(P, LOGF, QR, IR, S0, id + G, tid);
        __syncthreads();
        f32x4 sacc[8];
#pragma unroll
        for (int i = 0; i < 8; ++i)
#pragma unroll
            for (int e = 0; e < 4; ++e) sacc[i][e] = *(const LAS float*)(L + ST + (16 * i + 4 * g + e) * SS + vd * 4);
        if (wave == 0) {
            f32x4 acc = (f32x4){0.f, 0.f, 0.f, 0.f};
#pragma unroll
            for (int ks = 0; ks < 4; ++ks) { const bf16x8 a = *(const LAS bf16x8*)(L + QH + lc * QS + (32 * ks + 8 * g) * 2), b = *(const LAS bf16x8*)(L + KH + lc * QS + (32 * ks + 8 * g) * 2);
                acc = __builtin_amdgcn_mfma_f32_16x16x32_bf16(a, b, acc, 0, 0, 0); }
#pragma unroll
            for (int e = 0; e < 4; ++e) { const int t = 4 * g + e; *(LAS bf16_t*)(L + AT + t * 32 + lc * 2) = (bf16_t)cvt_pk_bf16(lc <= t ? acc[e] : 0.f, 0.f); }
        }
        __syncthreads();
        {
            f32x4 oacc = (f32x4){0.f, 0.f, 0.f, 0.f};
#pragma unroll
            for (int ks = 0; ks < 4; ++ks) {
                u32x4 bw; bw.x = cvt_pk_bf16(sacc[2 * ks][0], sacc[2 * ks][1]); bw.y = cvt_pk_bf16(sacc[2 * ks][2], sacc[2 * ks][3]); bw.z = cvt_pk_bf16(sacc[2 * ks + 1][0], sacc[2 * ks + 1][1]); bw.w = cvt_pk_bf16(sacc[2 * ks + 1][2], sacc[2 * ks + 1][3]);
                const u32x2 a0 = *(const LAS u32x2*)(L + QH + lc * QS + (32 * ks + 4 * g) * 2), a1 = *(const LAS u32x2*)(L + QH + lc * QS + (32 * ks + 16 + 4 * g) * 2);
                u32x4 aw; aw.x = a0.x; aw.y = a0.y; aw.z = a1.x; aw.w = a1.y;
                oacc = __builtin_amdgcn_mfma_f32_16x16x32_bf16(__builtin_bit_cast(bf16x8, aw), __builtin_bit_cast(bf16x8, bw), oacc, 0, 0, 0);
            }
            bf16x8 bv;
            { const v4i16_t lo = trr(L + VT + (4 * g + q4) * TS + (16 * wave + 4 * p4) * 2); bv = (bf16x8){lo[0], lo[1], lo[2], lo[3], 0, 0, 0, 0}; }
            { const u32x2 a0 = *(const LAS u32x2*)(L + AT + lc * 32 + 8 * g); u32x4 aw; aw.x = a0.x; aw.y = a0.y; aw.z = 0u; aw.w = 0u;
              oacc = __builtin_amdgcn_mfma_f32_16x16x32_bf16(__builtin_bit_cast(bf16x8, aw), bv, oacc, 0, 0, 0); }
#pragma unroll
            for (int e = 0; e < 4; ++e) *(LAS float*)(L + OT + ((4 * g + e) * OS + vd) * 4) = oacc[e];
#pragma unroll
            for (int i = 0; i < 8; ++i) {
                const f32x4 dc = *(const LAS f32x4*)(L + DECS + (16 * i + 4 * g) * 4);
                const v4i16_t lo = trr(L + KT + (4 * g + q4) * TS + (16 * i + 4 * p4) * 2);
                const bf16x8 a = (bf16x8){lo[0], lo[1], lo[2], lo[3], 0, 0, 0, 0};
                sacc[i] = __builtin_amdgcn_mfma_f32_16x16x32_bf16(a, bv, sacc[i] * dc, 0, 0, 0);
            }
#pragma unroll
            for (int i = 0; i < 8; ++i)
#pragma unroll
                for (int e = 0; e < 4; ++e) *(LAS float*)(L + ST + (16 * i + 4 * g + e) * SS + vd * 4) = sacc[i][e];
        }
        __syncthreads();
        if (tid < 64) {
            const f32x4 n0 = *(const f32x4*)(hgn + ec), n1 = *(const f32x4*)(hgn + ec + 4), n2 = *(const f32x4*)(hgn + ec + 8), n3 = *(const f32x4*)(hgn + ec + 12);
            f32x4 x[4]; float ss = 0.f;
#pragma unroll
            for (int k = 0; k < 4; ++k) { x[k] = *(const LAS f32x4*)(L + OT + (et * OS + ec + 4 * k) * 4); ss += mk::dot4(x[k]); }
            ss += __shfl_xor(ss, 1); ss += __shfl_xor(ss, 2); ss += __shfl_xor(ss, 4);
            const float rs = rsqrtf(ss * (1.f / 128.f) + EPS);
            const f32x4 y0 = x[0] * rs * n0 * (f32x4){mk::bflo(g0.x), mk::bfhi(g0.x), mk::bflo(g0.y), mk::bfhi(g0.y)}, y1 = x[1] * rs * n1 * (f32x4){mk::bflo(g0.z), mk::bfhi(g0.z), mk::bflo(g0.w), mk::bfhi(g0.w)};
            const f32x4 y2 = x[2] * rs * n2 * (f32x4){mk::bflo(g1.x), mk::bfhi(g1.x), mk::bflo(g1.y), mk::bfhi(g1.y)}, y3 = x[3] * rs * n3 * (f32x4){mk::bflo(g1.z), mk::bfhi(g1.z), mk::bflo(g1.w), mk::bfhi(g1.w)};
            { bf16_t* op = AOR + (m0 + et) * 1024 + 512 + h * 128 + ec; *(u32x4*)op = mk::pack8(y0, y1); *(u32x4*)(op + 8) = mk::pack8(y2, y3); }
        }
        { float* so = Sout + (size_t)id * 16384;
#pragma unroll
          for (int q = 0; q < 8; ++q) { const int cid = tid + 512 * q, row = cid >> 5, c4 = cid & 31; __builtin_nontemporal_store(*(const LAS f32x4*)(L + ST + row * SS + c4 * 16), (f32x4*)(so + (size_t)cid * 4)); } }
        __syncthreads();
    }
}
}
struct Args { const float* in[24]; float* out; unsigned char* ws; int ph_lo, ph_hi, li, pad; };
__global__ void __launch_bounds__(NWAVES * 64, 2) mega(Args args) {
    extern __shared__ __attribute__((aligned(16))) unsigned char lds[];
    LAS unsigned char* L = (LAS unsigned char*)lds;
    volatile LAS unsigned* MISC = (volatile LAS unsigned*)(L + MISC_OFF);
    const int tid = threadIdx.x, lane = tid & 63, wave = __builtin_amdgcn_readfirstlane(tid >> 6);
    const int G = gridDim.x; const int bx = blockIdx.x; const int vcu = (G % 8 == 0) ? (bx % 8) * (G / 8) + bx / 8 : bx;
    unsigned char* ws = args.ws;
    gu32* ctl = (gu32*)(ws + WS_CTL);
    for (int u = tid; u < (LDS_BYTES - LDSCTL_OFF) / 4; u += NWAVES * 64) ((LAS unsigned*)(L + LDSCTL_OFF))[u] = 0u;
    __syncthreads();
    const int lo = args.ph_lo, hi = args.ph_hi;
    XcdBarrier bar; bar.bar = (unsigned*)(ctl + CW_BAR) + args.li * XCD_BAR_WORDS; bar.x = 0; bar.st = nullptr;
    if (hi - lo > 1) bar = xcd_barrier_post((unsigned*)(ctl + CW_BAR) + args.li * XCD_BAR_WORDS, MISC + 8);
#define IN(k) (lo <= (k) && (k) < hi)
#define SEAM(k) do { if (IN(k) && IN((k) + 1)) xcd_barrier_bg(bar, [&]() { BG_WORK(k); }); } while (0)
#define BG_RUN(lo_, hi_, SET_) do { const int st_ = G * (NWAVES - 1); int j_ = (lo_) + vcu * (NWAVES - 1) + wave - 1; mk::WI w_, wn_; f32x4 r_[8], rn_[8]; \
        if (j_ < (hi_)) { SET_(w_, j_); mk::wi_load(w_, r_, lane); } \
        for (; j_ < (hi_); j_ += st_) { const bool hn_ = j_ + st_ < (hi_); if (hn_) { SET_(wn_, j_ + st_); mk::wi_load(wn_, rn_, lane); } mk::wi_proc(w_, r_, scr, lane); \
            if (hn_) { w_ = wn_; _Pragma("unroll") for (int i_ = 0; i_ < 8; ++i_) r_[i_] = rn_[i_]; } } } while (0)
#define BG_SET0(w, j) do { if ((j) < 1408) mk::wi_set(w, 0, args.in[8], nullptr, D, DFF, W2, 32, nullptr, (j)); else mk::wi_set(w, 2, args.in[10], nullptr, INW, D, WIN, 152, args.in[9], (j) - 1408); } while (0)
#define BG_SET1(w, j) do { if ((j) < 256) mk::wi_set(w, 0, args.in[17], nullptr, D, 1024, WUA, 32, nullptr, (j)); else if ((j) < 512) mk::wi_set(w, 0, args.in[18], nullptr, D, 1024, WUA + 512, 32, nullptr, (j) - 256); \
        else if ((j) < 1024) mk::wi_set(w, 0, args.in[19], nullptr, D, D, WOUT, 32, nullptr, (j) - 512); else mk::wi_set(w, 2, args.in[10], nullptr, INW, D, WIN, 152, args.in[9], (j) - 1024 + 1216); } while (0)
#define BG_SET2(w, j) mk::wi_set(w, 1, args.in[21], args.in[22], DFF, D, W13, 176, args.in[20], (j))
#define BG_SET4(w, j) mk::wi_set(w, 0, args.in[23], nullptr, D, DFF, W2, 32, nullptr, (j))
#define BG_COPY(lo_, hi_) do { for (int c_ = (lo_) + vcu * (NWAVES - 1) + wave - 1; c_ < (hi_); c_ += G * (NWAVES - 1)) { f32x4 v_[8]; \
        _Pragma("unroll") for (int i_ = 0; i_ < 8; ++i_) { const int u_ = c_ * 512 + i_ * 64 + lane, ten_ = u_ / (128 * 3840), rem_ = u_ % (128 * 3840), bd_ = rem_ / 3840, q_ = rem_ % 3840; \
            v_[i_] = __builtin_nontemporal_load((const f32x4*)(args.in[2 + ten_] + (size_t)bd_ * 16384 + 1024) + q_); } \
        _Pragma("unroll") for (int i_ = 0; i_ < 8; ++i_) { const int u_ = c_ * 512 + i_ * 64 + lane, ten_ = u_ / (128 * 3840), rem_ = u_ % (128 * 3840), bd_ = rem_ / 3840, q_ = rem_ % 3840; \
            __builtin_nontemporal_store(v_[i_], (f32x4*)(args.out + (ten_ ? O_SWV : O_SWK) + (size_t)bd_ * 16384) + q_); } } } while (0)
#define BG_WORK(k) do { \
        if ((k) == 0) BG_RUN(0, 1408 + 1216, BG_SET0); \
        else if ((k) == 1) BG_RUN(0, 1024 + 1216, BG_SET1); \
        else if ((k) == 2) BG_RUN(0, 1792, BG_SET2); \
        else if ((k) == 3) BG_RUN(1792, 2816, BG_SET2); \
        else if ((k) == 4) BG_RUN(0, 1408, BG_SET4); \
        else if ((k) == 5) BG_COPY(0, 1792); \
        else if ((k) == 6) BG_COPY(1792, 1920); \
    } while (0)
    const float* xp = args.in[0]; const float* xs = args.in[1];
    pg8::bf16_t* W13 = (pg8::bf16_t*)(ws + WS_W13); pg8::bf16_t* W2 = (pg8::bf16_t*)(ws + WS_W2); pg8::bf16_t* WIN = (pg8::bf16_t*)(ws + WS_WIN);
    pg8::bf16_t* WUA = (pg8::bf16_t*)(ws + WS_WUA); pg8::bf16_t* WUR = (pg8::bf16_t*)(ws + WS_WUR); pg8::bf16_t* WOUT = (pg8::bf16_t*)(ws + WS_WOUT);
    float* RSTD1 = (float*)(ws + WS_RSTD1); float* SSQ1 = (float*)(ws + WS_SSQ1); float* SSQ2 = (float*)(ws + WS_SSQ2);
    pg8::bf16_t* AB = (pg8::bf16_t*)(ws + WS_AB); pg8::bf16_t* HID = (pg8::bf16_t*)(ws + WS_HID);
    pg8::bf16_t* Qb = (pg8::bf16_t*)(ws + WS_Q); pg8::bf16_t* KVb = (pg8::bf16_t*)(ws + WS_KV); pg8::bf16_t* QRb = (pg8::bf16_t*)(ws + WS_QR); const unsigned short* LOGF = (const unsigned short*)(ws + WS_LOGF);
    pg8::bf16_t* MRG = (pg8::bf16_t*)(ws + WS_MRG); pg8::bf16_t* IRb = (pg8::bf16_t*)(ws + WS_IR); pg8::bf16_t* GRb = (pg8::bf16_t*)(ws + WS_GR);
    pg8::bf16_t* SGA = (pg8::bf16_t*)(ws + WS_SGA); pg8::bf16_t* SGR = (pg8::bf16_t*)(ws + WS_SGR); pg8::bf16_t* AOR = (pg8::bf16_t*)(ws + WS_AOR);
    const bool tail_first = ((bx >> 3) & 1) != 0;
    LAS float* scr = (LAS float*)(L + RING_OFF + wave * 16384);
    const int gw = vcu * NWAVES + wave, NGW = G * NWAVES;

    if (IN(0)) {
        constexpr int NIT = 176 * 16;
#define WI_DEC0(w, it_) mk::wi_set(w, 1, args.in[6], args.in[7], DFF, D, W13, 176, args.in[5], (it_))
        { mk::WI wc, wn; f32x4 rc[8], rn[8]; int it = gw;
          if (it < NIT) { WI_DEC0(wc, it); mk::wi_load(wc, rc, lane); }
          for (; it < NIT; it += NGW) {
              const bool hn = it + NGW < NIT;
              if (hn) { WI_DEC0(wn, it + NGW); mk::wi_load(wn, rn, lane); }
              mk::wi_proc(wc, rc, scr, lane);
              if (hn) { wc = wn;
#pragma unroll
                  for (int i = 0; i < 8; ++i) rc[i] = rn[i]; }
          } }
#undef WI_DEC0
#define X_ISSUE(v, m0_) do { _Pragma("unroll") for (int q = 0; q < 4; ++q) { const int m = (m0_) + q * NGW; if (m < M) { const float* xr = m < MP ? xp + (size_t)m * D : xs + (size_t)(m - MP) * D; const GAS f32x4* p = (const GAS f32x4*)xr + lane; \
            _Pragma("unroll") for (int j = 0; j < 4; ++j) v[q][j] = __builtin_nontemporal_load(p + 64 * j); } } } while (0)
        { f32x4 v[4][4], vn[4][4]; int m0 = gw;
          if (m0 < M) X_ISSUE(v, m0);
          for (; m0 < M; m0 += 4 * NGW) {
            const bool hn = m0 + 4 * NGW < M;
            if (hn) X_ISSUE(vn, m0 + 4 * NGW);
#pragma unroll
            for (int q = 0; q < 4; ++q) { const int m = m0 + q * NGW; if (m < M) { float ss = 0.f;
#pragma unroll
                for (int j = 0; j < 4; ++j) ss += mk::dot4(v[q][j]);
                ss = mk::wave_sum(ss);
                if (lane == 0) RSTD1[m] = rsqrtf(ss * (1.f / 1024.f) + EPS);
                GAS unsigned long long* o8 = (GAS unsigned long long*)(AB + (size_t)m * D) + lane;
#pragma unroll
                for (int j = 0; j < 4; ++j) o8[64 * j] = (unsigned long long)pk2(v[q][j][0], v[q][j][1]) | ((unsigned long long)pk2(v[q][j][2], v[q][j][3]) << 32); } }
            if (hn) {
#pragma unroll
                for (int q = 0; q < 4; ++q)
#pragma unroll
                    for (int j = 0; j < 4; ++j) v[q][j] = vn[q][j]; }
          } }
#undef X_ISSUE
        VM_WAIT(); __syncthreads();
    }
    SEAM(0);
    if (IN(1)) {
        pg8::Gemm g{AB, W13, M, 2 * DFF, D}; pg8::StaticOrder S; S.init(M, 2 * DFF, G, bx);
        mk::EpiSwiglu<false> E{HID, RSTD1, L + mk::RTAB_OFF};
        mk::build_rstd_table<false>(L, S, RSTD1, tid);
        pg8::gemm_phase<mk::EpiSwiglu<false>, pg8::StaticOrder, true, true>(L + RING_OFF, g, S, E);
    }
    SEAM(1);
    if (IN(2)) {
        pg8::Gemm g{HID, W2, MP, D, DFF}; pg8::StaticOrder S; S.init(MP, D, G, bx);
        mk::EpiResidB<false> E{AB, nullptr, SSQ1, 0.5f};
if (tail_first) mk::gemm_tail(L + RING_OFF, HID, W2, DFF, MP, 16, 16, vcu, G, E, tid, lane, wave);
        pg8::gemm_phase<mk::EpiResidB<false>, pg8::StaticOrder, true, true>(L + RING_OFF, g, S, E);
        if (!tail_first) mk::gemm_tail(L + RING_OFF, HID, W2, DFF, MP, 16, 16, vcu, G, E, tid, lane, wave);
    }
    SEAM(2);
    if (IN(3)) {
        pg8::Gemm g{AB, WIN, M, INW, D}; mk::ProjOrder S; S.init(G, bx);
        mk::EpiProj E{SSQ1, ws, args.out, args.in[11], args.in[12], args.in[15], L + mk::RTAB_OFF};
        mk::build_rstd_table<true>(L, S, SSQ1, tid);
        pg8::gemm_phase<mk::EpiProj, mk::ProjOrder, true, true>(L + RING_OFF, g, S, E);
        mk::EpiProjTail ET{SSQ1, SGA};
        mk::gemm_tail(L + RING_OFF, AB, WIN + (size_t)2816 * D, D, MP, 16, 12, vcu, G, ET, tid, lane, wave);
    }
    SEAM(3);
    pg8::bf16_t* US = (pg8::bf16_t*)args.out;
    float* DEC = (float*)(ws + WS_DEC);
    if (IN(4)) {
        for (int t = vcu; t < 512; t += G) {
            if (t < 256) at::attn_prompt_task(L, Qb, AOR, KVb, args.in[14], args.in[13], t >> 6, (t >> 1) & 31, t & 1, tid, lane, wave);
            else at::attn_sample_task(L, Qb, AOR, KVb, args.in[2], args.in[3], args.in[14], args.in[13], (t - 256) >> 1, t & 1, tid, lane, wave);
        }
        hg::HaPre HP; if (vcu < 256) hg::ha_issue(HP, LOGF, IRb, 4 * vcu, tid);
        hg::ha_phase(L, HP, LOGF, IRb, US, DEC, vcu, G, tid, lane, wave);
        VM_WAIT(); __syncthreads();
    }
    SEAM(4);
    if (IN(5)) {
        for (int idx = bx * (NWAVES * 64) + tid; idx < 131072; idx += G * NWAVES * 64) hg::hb_scan((unsigned*)US, DEC, args.out + O_PST, idx);
        VM_WAIT(); __syncthreads();
    }
    SEAM(5);
    if (IN(6)) {
        hg::hc_phase_prompt(L, LOGF, QRb, AOR, IRb, GRb, args.in[16], US, vcu, G, tid, lane, wave);
        hg::HcPreS PS; if (vcu < 512) hg::hc_issue_sample(PS, LOGF, QRb, IRb, args.in[4], vcu, tid);
        hg::hc_phase_sample(L, LOGF, QRb, AOR, IRb, GRb, args.in[16], args.in[4], args.out + O_SST, PS, vcu, G, tid, lane, wave);
        VM_WAIT(); __syncthreads();
    }
    SEAM(6);
    if (IN(7)) {
        { pg8::Gemm g{AOR, WUA, MP, D, D}; pg8::StaticOrder S; S.init(MP, D, G, bx); mk::EpiUpR E{MRG, (const unsigned char*)SGA, (const unsigned char*)SGR};
if (tail_first) mk::gemm_tail(L + RING_OFF, AOR, WUA, D, MP, 16, 16, vcu, G, E, tid, lane, wave);
        pg8::gemm_phase<mk::EpiUpR, pg8::StaticOrder, true, true>(L + RING_OFF, g, S, E);
        if (!tail_first) mk::gemm_tail(L + RING_OFF, AOR, WUA, D, MP, 16, 16, vcu, G, E, tid, lane, wave); }
    }
    SEAM(7);
    if (IN(8)) {
        pg8::Gemm g{MRG, WOUT, MP, D, D}; pg8::StaticOrder S; S.init(MP, D, G, bx);
        mk::EpiResidB<false> E{AB, nullptr, SSQ2, 1.0f};
if (tail_first) mk::gemm_tail(L + RING_OFF, MRG, WOUT, D, MP, 16, 16, vcu, G, E, tid, lane, wave);
        pg8::gemm_phase<mk::EpiResidB<false>, pg8::StaticOrder, true, true>(L + RING_OFF, g, S, E);
        if (!tail_first) mk::gemm_tail(L + RING_OFF, MRG, WOUT, D, MP, 16, 16, vcu, G, E, tid, lane, wave);
    }
    SEAM(8);
    if (IN(9)) {
        pg8::Gemm g{AB, W13, M, 2 * DFF, D}; pg8::StaticOrder S; S.init(M, 2 * DFF, G, bx);
        mk::EpiSwiglu<true> E{HID, SSQ2, L + mk::RTAB_OFF};
        mk::build_rstd_table<true>(L, S, SSQ2, tid);
        pg8::gemm_phase<mk::EpiSwiglu<true>, pg8::StaticOrder, true, true>(L + RING_OFF, g, S, E);
    }
    SEAM(9);
    if (IN(10)) {
        pg8::Gemm g{HID, W2, MP, D, DFF}; pg8::StaticOrder S; S.init(MP, D, G, bx);
        mk::EpiResidB<true> E{AB, args.out, nullptr, 0.5f};
if (tail_first) mk::gemm_tail(L + RING_OFF, HID, W2, DFF, MP, 16, 16, vcu, G, E, tid, lane, wave);
        pg8::gemm_phase<mk::EpiResidB<true>, pg8::StaticOrder, true, true>(L + RING_OFF, g, S, E);
        if (!tail_first) mk::gemm_tail(L + RING_OFF, HID, W2, DFF, MP, 16, 16, vcu, G, E, tid, lane, wave);
    }
#undef IN
#undef SEAM
}

extern "C" void kernel_launch(void* const* d_in, const int* in_sizes, int n_in, void* d_out, int out_size, void* d_ws, size_t ws_size, hipStream_t stream) {
    static int grid = 0;
    if (grid == 0) {
        int dev = 0, cus = 0;
        if (hipGetDevice(&dev) != hipSuccess || hipDeviceGetAttribute(&cus, hipDeviceAttributeMultiprocessorCount, dev) != hipSuccess) { fprintf(stderr, "kernel_launch: device query failed\n"); grid = -1; return; }
        if (hipFuncSetAttribute((const void*)mega, hipFuncAttributeMaxDynamicSharedMemorySize, LDS_BYTES) != hipSuccess) { fprintf(stderr, "kernel_launch: hipFuncSetAttribute failed\n"); grid = -1; return; }
        if (ws_size < WS_END) { fprintf(stderr, "kernel_launch: workspace too small: %zu < %zu\n", ws_size, (size_t)WS_END); grid = -1; return; }
        grid = cus;
    }
    if (grid < 0) return;
    (void)hipMemsetAsync((char*)d_ws + WS_CTL + CW_BAR * 4, 0, 16384, stream);
    Args a{};
    for (int i = 0; i < 24; ++i) a.in[i] = (const float*)d_in[i];
    a.out = (float*)d_out; a.ws = (unsigned char*)d_ws;
    unsigned char* ws = (unsigned char*)d_ws; float* out = (float*)d_out;
    int nl = 0;
    auto launch = [&](int lo, int hi) { a.ph_lo = lo; a.ph_hi = hi; a.li = nl++; hipLaunchKernelGGL(mega, dim3(grid), dim3(NWAVES * 64), LDS_BYTES, stream, a); };
    launch(0, 11);
}
```

```cpp
#include <hip/hip_runtime.h>
#include <cstdio>
#include <cstdint>
namespace pg8 {
#define PG8_LAS __attribute__((address_space(3)))
typedef unsigned short bf16_t;
typedef short bf16x8 __attribute__((ext_vector_type(8)));
typedef float f32x4 __attribute__((ext_vector_type(4)));
typedef unsigned u32x4 __attribute__((ext_vector_type(4)));
typedef int v4i32_t __attribute__((ext_vector_type(4)));
typedef int v8i32_t __attribute__((ext_vector_type(8)));
constexpr int BM = 256, BK = 64, HALF = 128, HTB = HALF * BK * 2  , STAGE_BYTES = 8 * HTB, NXCD = 8, WGM = 8;

__host__ __device__ __forceinline__ int lds_byte(int r, int c) { const int st = (r >> 4) * 2 + (c >> 5), rr = r & 15, cc = c & 31, ob = rr * 64 + cc * 2; return st * 1024 + (ob ^ (((ob >> 9) & 1) << 5)); }
__host__ __device__ __forceinline__ void stage_rc(int b, int& R, int& C) { const int st = b / 1024, sb = b % 1024, swz = sb ^ (((sb >> 9) & 1) << 5); R = (st >> 1) * 16 + swz / 64; C = (st & 1) * 32 + (swz % 64) / 2; }
__host__ __device__ __forceinline__ int perm32(int rho) { const int n = rho >> 4, i = rho & 15; return 8 * (i >> 2) + 4 * n + (i & 3); }

struct Unit { int pm, pn, idx; };
struct Gemm { const bf16_t* A; const bf16_t* Bt; int M, N, K; };

struct StaticOrder {
    int nM, nN, nwg, G, c;
    __host__ __device__ void init(int M, int N, int G_, int c_) { nM = M / BM; nN = N / BM; nwg = nM * nN; G = G_; c = c_; }
    __host__ __device__ bool next(int i, Unit& u) const {
        const long L = (long)i * G + c; if (L >= nwg) return false;
        int wgid = (int)L; { const int q = nwg / NXCD, r = nwg % NXCD, xcd = wgid % NXCD, off = wgid / NXCD; wgid = (xcd < r ? xcd * (q + 1) : r * (q + 1) + (xcd - r) * q) + off; }
        const int nig = WGM * nN, gid = wgid / nig, fm = gid * WGM, gsz = (nM - fm) < WGM ? (nM - fm) : WGM;
        u.pm = fm + ((wgid % nig) % gsz); u.pn = (wgid % nig) / gsz; u.idx = i; return true;
    }
    __device__ __forceinline__ void a_ready(const Unit&) const {}
    __device__ __forceinline__ void done(const Unit&) const {}
};

typedef float f32x2_cv __attribute__((ext_vector_type(2))); typedef __bf16 bf16x2_cv __attribute__((ext_vector_type(2)));
__device__ __forceinline__ unsigned cvt_pk_bf16(float lo, float hi) { const f32x2_cv v = {lo, hi}; const bf16x2_cv b = __builtin_convertvector(v, bf16x2_cv); return __builtin_bit_cast(unsigned, b); }
typedef float f32x2 __attribute__((ext_vector_type(2)));
template <class Epi, class Sched, bool ALIGN_EPI = false, bool SP2 = false>
__device__ __forceinline__ void gemm_phase(PG8_LAS unsigned char* lds, const Gemm g, const Sched& S, const Epi& E) {
    const int tid = threadIdx.x, wid = __builtin_amdgcn_readfirstlane(tid >> 6), lane = tid & 63, wr = wid >> 2, wc = wid & 3, fr = lane & 15, fq = lane >> 4;
    constexpr bool KS = Epi::MIDT > 0;
    constexpr bool F8 = Epi::FP8;
    const int K = g.K, nt = KS ? Epi::MIDT : (F8 ? K / 128 : K / BK);
    const unsigned RBY = F8 ? (unsigned)K : (unsigned)K * 2u;
    unsigned voffA[2], voffB[2];
#pragma unroll
    for (int i = 0; i < 2; ++i) { int R, C; stage_rc(tid * 16 + i * 8192, R, C); const int Rb = Epi::PERM ? ((R & ~31) + perm32(R & 31)) : R;
        voffA[i] = (unsigned)R * RBY + (unsigned)C * 2u; voffB[i] = (unsigned)Rb * RBY + (unsigned)C * 2u; }
    const size_t kstep = (size_t)(BK * 2);
    const size_t hstep = (size_t)HALF * RBY;
    const size_t tstep = 2 * hstep;
    constexpr bool SX = Epi::STRIP;
    const int hsw = SX ? wr : 0;
    static_assert(!SX || (SP2 && Epi::EPI_VM == 0), "STRIP: SP2 loop, no relaxed waits");
    const size_t tstepA = SX ? (size_t)272 * RBY : tstep;
    unsigned voffX = 0u;
    if constexpr (SX) { const int o = wid * 256 + lane * 4, ps = o >> 4, row = ps >> 3, kc = (ps & 7) ^ (row & 7); voffX = (unsigned)(256 + row) * RBY + (unsigned)(8 * kc + 2 * (lane & 3)) * 2u; }
    const int xoff0 = (fr * 8 + ((0 + fq) ^ (fr & 7))) * 16, xoff1 = (fr * 8 + ((4 + fq) ^ (fr & 7))) * 16;
    const __amdgpu_buffer_rsrc_t rsA = __builtin_amdgcn_make_buffer_rsrc((void*)g.A, 0, 0x7fffffff, 0x00020000), rsB = __builtin_amdgcn_make_buffer_rsrc((void*)g.Bt, 0, 0x7fffffff, 0x00020000);
    const unsigned ldsw = (unsigned)wid * 1024u;
    const int aoff = lds_byte(wr * 64 + fr, fq * 8), boff = lds_byte(wc * 32 + fr, fq * 8);
#define PG8_SA(b, h) (((b) * 2 + (h)) * HTB)
#define PG8_SB(b, h) ((4 + (b) * 2 + (h)) * HTB)
#define PG8_STAGEA(bufoff, gbase) do { const unsigned so_ = (unsigned)((const char*)(gbase) - (const char*)g.A); _Pragma("unroll") for (int _i = 0; _i < 2; ++_i) \
        __builtin_amdgcn_raw_ptr_buffer_load_lds(rsA, (PG8_LAS void*)(lds + (bufoff) + ldsw + _i * 8192), 16, (int)voffA[_i], (int)so_, 0, 0); } while (0)
#define PG8_STAGEB(bufoff, gbase) do { const unsigned so_ = (unsigned)((const char*)(gbase) - (const char*)g.Bt); _Pragma("unroll") for (int _i = 0; _i < 2; ++_i) \
        __builtin_amdgcn_raw_ptr_buffer_load_lds(rsB, (PG8_LAS void*)(lds + (bufoff) + ldsw + _i * 8192), 16, (int)voffB[_i], (int)so_, 0, 0); } while (0)
#define PG8_AX(b) (STAGE_BYTES + (b) * 2048)
#define PG8_STAGEX(b, gbase) do { if constexpr (SX) __builtin_amdgcn_raw_ptr_buffer_load_lds(rsA, (PG8_LAS void*)(lds + PG8_AX(b) + wid * 256), 4, (int)voffX, (int)(unsigned)((const char*)(gbase) - (const char*)g.A), 0, 0); } while (0)
#define PG8_LDX(b) do { if constexpr (SX) { if constexpr (F8) { Axf8.lo = *(const PG8_LAS v4i32_t*)(lds + PG8_AX(b) + xoff0); Axf8.hi = *(const PG8_LAS v4i32_t*)(lds + PG8_AX(b) + xoff1); } else { Axf[0] = *(const PG8_LAS bf16x8*)(lds + PG8_AX(b) + xoff0); Axf[1] = *(const PG8_LAS bf16x8*)(lds + PG8_AX(b) + xoff1); } } } while (0)
#define PG8_MMAX() do { if constexpr (SX) { __builtin_amdgcn_s_setprio(0); \
        if constexpr (F8) { _Pragma("unroll") for (int n = 0; n < 2; ++n) accx[n] = __builtin_amdgcn_mfma_scale_f32_16x16x128_f8f6f4(B08[n], Axf8, accx[n], 0, 0, 0, 0x7f7f7f7f, 0, 0x7f7f7f7f); } \
        else { _Pragma("unroll") for (int n = 0; n < 2; ++n) _Pragma("unroll") for (int k = 0; k < 2; ++k) accx[n] = __builtin_amdgcn_mfma_f32_16x16x32_bf16(B0[n][k], Axf[k], accx[n], 0, 0, 0); } \
        __builtin_amdgcn_s_setprio(1); } } while (0)
#define PG8_WAIT_V8S() do { if constexpr (SX) PG8_WAIT_V(9); else PG8_WAIT_V(8); } while (0)
#define PG8_LDA(dst, b, h) do { if constexpr (F8) { _Pragma("unroll") for (int m = 0; m < 4; ++m) { dst##8[m].lo = *(const PG8_LAS v4i32_t*)(lds + PG8_SA(b, h) + aoff + m * 2048); dst##8[m].hi = *(const PG8_LAS v4i32_t*)(lds + PG8_SA(b, h) + aoff + m * 2048 + 1024); } } \
        else { _Pragma("unroll") for (int m = 0; m < 4; ++m) _Pragma("unroll") for (int k = 0; k < 2; ++k) dst[m][k] = *(const PG8_LAS bf16x8*)(lds + PG8_SA(b, h) + aoff + m * 2048 + k * 1024); } } while (0)
#define PG8_LDB(dst, b, h) do { if constexpr (F8) { _Pragma("unroll") for (int n = 0; n < 2; ++n) { dst##8[n].lo = *(const PG8_LAS v4i32_t*)(lds + PG8_SB(b, 0) + ((h) ^ hsw) * HTB + boff + n * 2048); dst##8[n].hi = *(const PG8_LAS v4i32_t*)(lds + PG8_SB(b, 0) + ((h) ^ hsw) * HTB + boff + n * 2048 + 1024); } } \
        else { _Pragma("unroll") for (int n = 0; n < 2; ++n) _Pragma("unroll") for (int k = 0; k < 2; ++k) dst[n][k] = *(const PG8_LAS bf16x8*)(lds + PG8_SB(b, 0) + ((h) ^ hsw) * HTB + boff + n * 2048 + k * 1024); } } while (0)
#define PG8_CAT8(x, y) __builtin_shufflevector(__builtin_bit_cast(v4i32_t, x), __builtin_bit_cast(v4i32_t, y), 0, 1, 2, 3, 4, 5, 6, 7)
#define PG8_MMA(ai, bj, At, Bt) do { __builtin_amdgcn_s_setprio(0); \
        if constexpr (F8) { _Pragma("unroll") for (int m = 0; m < 4; ++m) _Pragma("unroll") for (int n = 0; n < 2; ++n) \
            acc[ai][bj][m][n] = __builtin_amdgcn_mfma_scale_f32_16x16x128_f8f6f4(Bt##8[n], At##8[m], acc[ai][bj][m][n], 0, 0, 0, 0x7f7f7f7f, 0, 0x7f7f7f7f); } \
        else { _Pragma("unroll") for (int m = 0; m < 4; ++m) _Pragma("unroll") for (int n = 0; n < 2; ++n) _Pragma("unroll") for (int k = 0; k < 2; ++k) \
            acc[ai][bj][m][n] = __builtin_amdgcn_mfma_f32_16x16x32_bf16(Bt[n][k], At[m][k], acc[ai][bj][m][n], 0, 0, 0); } \
        __builtin_amdgcn_s_setprio(1); } while (0)
#define PG8_WAIT_V(n) asm volatile("s_waitcnt vmcnt(" #n ")" ::: "memory")
#define PG8_WAIT_V8R(t_) do { if constexpr (Epi::STRIP) PG8_WAIT_V(9); else if constexpr (Epi::EPI_VM == 8) asm volatile("s_waitcnt vmcnt(16)\n\ts_cmp_eq_u32 %0, 0\n\ts_cbranch_scc1 1f\n\ts_waitcnt vmcnt(8)\n1:" :: "s"(t_) : "scc", "memory"); \
        else if constexpr (Epi::EPI_VM == 16) asm volatile("s_waitcnt vmcnt(24)\n\ts_cmp_eq_u32 %0, 0\n\ts_cbranch_scc1 1f\n\ts_waitcnt vmcnt(8)\n1:" :: "s"(t_) : "scc", "memory"); \
        else { static_assert(Epi::EPI_VM == 0, "EPI_VM: 0, 8 or 16"); PG8_WAIT_V(8); } } while (0)
#define PG8_WAIT_L(n) asm volatile("s_waitcnt lgkmcnt(" #n ")" ::: "memory")
#define PG8_BAR __builtin_amdgcn_s_barrier()
#define PG8_SCHED __builtin_amdgcn_sched_barrier(0)
    Unit cur, nxt; int ui = 0;
    if (!S.next(0, cur)) return;
    f32x4 acc[2][2][4][2];
    f32x4 accx[2] = {(f32x4){0.f, 0.f, 0.f, 0.f}, (f32x4){0.f, 0.f, 0.f, 0.f}}; bf16x8 Axf[2]; u32x4 ipreX = (u32x4){0u, 0u, 0u, 0u};
    if constexpr (SX && Epi::INIT) ipreX = E.strip_init_issue(cur, wr, wc, fr, fq);
    u32x4 ipre[Epi::INIT ? 16 : 1];
    if constexpr (Epi::INIT) E.init_issue(ipre, cur, wr, wc, fr, fq);
    else {
#pragma unroll
    for (int a = 0; a < 2; ++a)
#pragma unroll
        for (int b = 0; b < 2; ++b)
#pragma unroll
            for (int m = 0; m < 4; ++m)
#pragma unroll
                for (int n = 0; n < 2; ++n) acc[a][b][m][n] = (f32x4){0.f, 0.f, 0.f, 0.f};
    }
    bf16x8 At[4][2], B0[2][2], B1[2][2];
    v8i32_t At8[4], B08[2], B18[2], Axf8;
    const char* cA = (const char*)g.A + (size_t)cur.pm * tstepA; const char* cB = (const char*)g.Bt + (size_t)cur.pn * tstep;
    S.a_ready(cur);
    if constexpr (SP2) {
        PG8_STAGEB(PG8_SB(0, 0), cB); PG8_STAGEB(PG8_SB(0, 1), cB + hstep); PG8_STAGEA(PG8_SA(0, 0), cA); PG8_STAGEA(PG8_SA(0, 1), cA + hstep); PG8_STAGEX(0, cA);
        if (wr == 1) PG8_BAR;
        if constexpr (SX) PG8_WAIT_V(3); else PG8_WAIT_V(2);
        PG8_BAR;
        PG8_STAGEB(PG8_SB(1, 0), cB + kstep); PG8_STAGEA(PG8_SA(1, 0), cA + kstep); PG8_STAGEB(PG8_SB(1, 1), cB + hstep + kstep);
        if constexpr (Epi::EPI_VM > 0) PG8_WAIT_V(0); else PG8_WAIT_V(6);
        PG8_BAR;
    } else {
        PG8_STAGEB(PG8_SB(0, 0), cB); PG8_STAGEA(PG8_SA(0, 0), cA); PG8_STAGEB(PG8_SB(0, 1), cB + hstep); PG8_STAGEA(PG8_SA(0, 1), cA + hstep);
        if (wr == 1) PG8_BAR;
        PG8_WAIT_V(4); PG8_BAR;
        PG8_STAGEB(PG8_SB(1, 0), cB + kstep); PG8_STAGEA(PG8_SA(1, 0), cA + kstep); PG8_STAGEB(PG8_SB(1, 1), cB + hstep + kstep);
        PG8_WAIT_V(6); PG8_BAR;
    }
    if constexpr (Epi::INIT) E.init_finish(acc, ipre);
    if constexpr (SX && Epi::INIT) E.strip_init_finish(accx, ipreX);
    for (;;) {
        const bool has_next = KS ? S.next((ui + 1) >> 1, nxt) : S.next(ui + 1, nxt);
        const size_t nko = (KS && ((ui + 1) & 1)) ? (size_t)nt * kstep : (size_t)0;
        const char* nA = has_next ? (const char*)g.A + (size_t)nxt.pm * tstepA + nko : cA; const char* nB = has_next ? (const char*)g.Bt + (size_t)nxt.pn * tstep + nko : cB;
#pragma unroll 1
        for (int t = 0; t < nt; t += 2) {
            const bool last = (t == nt - 2);
            const char* a1 = cA + (size_t)(t + 1) * kstep;
            const char* a2 = last ? nA : cA + (size_t)(t + 2) * kstep; const char* b2 = last ? nB : cB + (size_t)(t + 2) * kstep;
            const char* a3 = a2 + kstep; const char* b3 = b2 + kstep;
            if (last && has_next) S.a_ready(nxt);
            if constexpr (SP2) {
            PG8_LDB(B0, 0, 0); PG8_LDB(B1, 0, 1); PG8_SCHED; PG8_LDA(At, 0, 0); PG8_STAGEA(PG8_SA(1, 1), a1 + hstep); PG8_STAGEX(1, a1);
            PG8_WAIT_V8R(t); PG8_WAIT_L(0); PG8_BAR; PG8_MMA(0, 0, At, B0); PG8_MMA(0, 1, At, B1); PG8_BAR; PG8_SCHED;
            PG8_LDA(At, 0, 1); PG8_LDX(0); PG8_STAGEB(PG8_SB(0, 0), b2); PG8_STAGEB(PG8_SB(0, 1), b2 + hstep); PG8_STAGEA(PG8_SA(0, 0), a2);
            PG8_WAIT_V8R(t); PG8_WAIT_L(0); PG8_BAR; PG8_MMA(1, 0, At, B0); PG8_MMA(1, 1, At, B1); PG8_MMAX(); PG8_BAR; PG8_SCHED;
            PG8_LDB(B0, 1, 0); PG8_LDB(B1, 1, 1); PG8_SCHED; PG8_LDA(At, 1, 0); PG8_STAGEA(PG8_SA(0, 1), a2 + hstep); PG8_STAGEX(0, a2);
            PG8_WAIT_V8S(); PG8_WAIT_L(0); PG8_BAR; PG8_MMA(0, 0, At, B0); PG8_MMA(0, 1, At, B1); PG8_BAR; PG8_SCHED;
            PG8_LDA(At, 1, 1); PG8_LDX(1); PG8_STAGEB(PG8_SB(1, 0), b3); PG8_STAGEB(PG8_SB(1, 1), b3 + hstep); PG8_STAGEA(PG8_SA(1, 0), a3);
            PG8_WAIT_V8S(); PG8_WAIT_L(0); PG8_BAR; PG8_MMA(1, 0, At, B0); PG8_MMA(1, 1, At, B1); PG8_MMAX(); PG8_BAR; PG8_SCHED;
            } else {
            PG8_LDB(B0, 0, 0); PG8_SCHED; PG8_LDA(At, 0, 0); PG8_STAGEA(PG8_SA(1, 1), a1 + hstep);
            PG8_WAIT_L(8); PG8_BAR; PG8_WAIT_L(0); PG8_MMA(0, 0, At, B0); PG8_BAR; PG8_SCHED;
            PG8_LDB(B1, 0, 1); PG8_STAGEB(PG8_SB(0, 0), b2);
            PG8_BAR; PG8_WAIT_L(0); PG8_MMA(0, 1, At, B1); PG8_BAR;
            PG8_LDA(At, 0, 1); PG8_STAGEA(PG8_SA(0, 0), a2);
            PG8_BAR; PG8_WAIT_L(0); PG8_MMA(1, 0, At, B0); PG8_BAR; PG8_SCHED;
            PG8_STAGEB(PG8_SB(0, 1), b2 + hstep);
            PG8_WAIT_V(6); PG8_BAR; PG8_MMA(1, 1, At, B1); PG8_BAR;
            PG8_LDB(B0, 1, 0); PG8_SCHED; PG8_LDA(At, 1, 0); PG8_STAGEA(PG8_SA(0, 1), a2 + hstep);
            PG8_WAIT_L(8); PG8_BAR; PG8_WAIT_L(0); PG8_MMA(0, 0, At, B0); PG8_BAR; PG8_SCHED;
            PG8_LDB(B1, 1, 1); PG8_STAGEB(PG8_SB(1, 0), b3);
            PG8_BAR; PG8_WAIT_L(0); PG8_MMA(0, 1, At, B1); PG8_BAR;
            PG8_LDA(At, 1, 1); PG8_STAGEA(PG8_SA(1, 0), a3);
            PG8_BAR; PG8_WAIT_L(0); PG8_MMA(1, 0, At, B0); PG8_BAR; PG8_SCHED;
            PG8_STAGEB(PG8_SB(1, 1), b3 + hstep);
            PG8_WAIT_V(6); PG8_BAR; PG8_MMA(1, 1, At, B1); PG8_BAR;
            }
        }
        if constexpr (ALIGN_EPI) { if (wr == 0) PG8_BAR; }
        int tide_ = threadIdx.x; asm volatile("" : "+v"(tide_)); const int fre = tide_ & 15, fqe = (tide_ & 63) >> 4;
        if constexpr (KS) { if (ui & 1) { E(acc, cur, wr, wc, fre, fqe); if constexpr (SX) E.strip(accx, cur, wr, wc, fre, fqe); S.done(cur); } else { E.mid(acc, cur, wr, wc, fre, fqe); if constexpr (SX) E.strip_mid(accx, cur, wr, wc, fre, fqe); } }
        else if constexpr (!Epi::AFTER_DRAIN) { E(acc, cur, wr, wc, fre, fqe); if constexpr (SX) E.strip(accx, cur, wr, wc, fre, fqe); S.done(cur); }
        if (!has_next) break;
        if constexpr (SX) { if (!KS || (ui & 1)) { if constexpr (Epi::INIT) { ipreX = E.strip_init_issue(nxt, wr, wc, fr, fq); E.strip_init_finish(accx, ipreX); } else { accx[0] = (f32x4){0.f, 0.f, 0.f, 0.f}; accx[1] = accx[0]; } } }
        if constexpr (Epi::INIT) { E.init_issue(ipre, nxt, wr, wc, fr, fq); E.init_finish(acc, ipre); }
        else if (!KS || (ui & 1)) {
#pragma unroll
        for (int a = 0; a < 2; ++a)
#pragma unroll
            for (int b = 0; b < 2; ++b)
#pragma unroll
                for (int m = 0; m < 4; ++m)
#pragma unroll
                    for (int n = 0; n < 2; ++n) acc[a][b][m][n] = (f32x4){0.f, 0.f, 0.f, 0.f};
        }
        cur = nxt; cA = nA; cB = nB; ++ui;
        if constexpr (ALIGN_EPI) { if (wr == 1) PG8_BAR; }
    }
    __builtin_amdgcn_s_setprio(0);
    PG8_WAIT_V(0);
    if constexpr (!ALIGN_EPI) { if (wr == 0) PG8_BAR; }
    PG8_BAR;
    if constexpr (Epi::AFTER_DRAIN) { E.fused(acc, cur, wr, wc, fr, fq, lds, wid, lane); S.done(cur); }
#undef PG8_SA
#undef PG8_SB
#undef PG8_STAGEA
#undef PG8_STAGEB
#undef PG8_LDA
#undef PG8_LDB
#undef PG8_MMA
#undef PG8_WAIT_V
#undef PG8_WAIT_L
#undef PG8_WAIT_V8R
#undef PG8_WAIT_V8S
#undef PG8_AX
#undef PG8_STAGEX
#undef PG8_LDX
#undef PG8_MMAX
#undef PG8_CAT8
#undef PG8_BAR
#undef PG8_SCHED
}
}
#define GAS __attribute__((address_space(1)))
#define LAS __attribute__((address_space(3)))
typedef unsigned short bf16;
typedef unsigned v4u __attribute__((ext_vector_type(4)));
typedef float f32x4 __attribute__((ext_vector_type(4)));
typedef short bf16x8 __attribute__((ext_vector_type(8)));
typedef GAS unsigned gu32;
typedef GAS unsigned long long gu64;
#define RLX_AGENT __ATOMIC_RELAXED, __HIP_MEMORY_SCOPE_AGENT
#define LDS_WAIT() asm volatile("s_waitcnt lgkmcnt(0)" ::: "memory")
#define VM_WAIT() asm volatile("s_waitcnt vmcnt(0)" ::: "memory")
__device__ __forceinline__ unsigned long long rt() { return __builtin_amdgcn_s_memrealtime(); }
__device__ __forceinline__ unsigned f2bf(float f) { unsigned u = __builtin_bit_cast(unsigned, f); return (u + 0x7fffu + ((u >> 16) & 1u)) >> 16; }
__device__ __forceinline__ unsigned pk2(float lo, float hi) { return f2bf(lo) | (f2bf(hi) << 16); }
#define XB_TMO      128
#define XB_XCNT(j)  (256  + 64 * (j))
#define XB_XSUB(j)  (1280 + 64 * (j))
#define XB_XGEN(j)  (2304 + 64 * (j))
#define XB_TOP      3328
#define XB_TOPGEN   3392
#define XCD_BAR_WORDS 3456
#define XB_SPIN_CAP (1u << 18)

__device__ __forceinline__ unsigned xb_ld(unsigned* p)              { return __hip_atomic_load(p, __ATOMIC_RELAXED, __HIP_MEMORY_SCOPE_AGENT); }
__device__ __forceinline__ unsigned xb_add(unsigned* p, unsigned v) { return __hip_atomic_fetch_add(p, v, __ATOMIC_RELAXED, __HIP_MEMORY_SCOPE_AGENT); }
__device__ __forceinline__ unsigned xb_xcc_id() { return (unsigned)__builtin_amdgcn_s_getreg((3 << 11) | 20) & 0xFu; }
#define XB_SPIN(cond, bar) do { unsigned _sp = 0; while (cond) { __builtin_amdgcn_s_sleep(1); \
    if ((++_sp & 255u) == 0u) { if (xb_ld(&(bar)[XB_TMO])) break; if (_sp > XB_SPIN_CAP) { atomicAdd(&(bar)[XB_TMO], 1u); break; } } } } while (0)

struct XcdBarrier {
    unsigned* bar; unsigned x;
    volatile LAS unsigned* st;
};

__device__ __forceinline__ XcdBarrier xcd_barrier_post(unsigned* bar, volatile LAS unsigned* st) {
    XcdBarrier b; b.bar = bar; b.x = xb_xcc_id(); b.st = st;
    if (threadIdx.x == 0) (void)xb_add(&bar[XB_XCNT(b.x)], 1u);
    return b;
}
__device__ __forceinline__ void xcd_barrier_complete(unsigned* bar, unsigned x, unsigned& nloc, unsigned& nx) {
    const unsigned G = gridDim.x * gridDim.y * gridDim.z;
    unsigned sum, cnt, mine, sp = 0u;
    for (;;) {
        sum = 0u; cnt = 0u; mine = 0u;
#pragma unroll
        for (unsigned j = 0; j < 16; ++j) { const unsigned c = xb_ld(&bar[XB_XCNT(j)]); sum += c; cnt += (c > 0u) ? 1u : 0u; mine = (j == x) ? c : mine; }
        if (sum == G) break;
        __builtin_amdgcn_s_sleep(1);
        if ((++sp & 255u) == 0u) { if (xb_ld(&bar[XB_TMO])) break; if (sp > XB_SPIN_CAP) { atomicAdd(&bar[XB_TMO], 1u); break; } }
    }
    nloc = mine > 0u ? mine : 1u; nx = cnt > 0u ? cnt : 1u;
}

__device__ __forceinline__ void xcd_barrier(const XcdBarrier& b) {
    asm volatile("s_waitcnt vmcnt(0)" ::: "memory");
    __syncthreads();
    if (threadIdx.x == 0) {
        unsigned* bar = b.bar;
        __builtin_amdgcn_s_waitcnt(0);
        unsigned nloc = b.st[0], nx = b.st[1];
        if (nloc == 0u) { xcd_barrier_complete(bar, b.x, nloc, nx); b.st[0] = nloc; b.st[1] = nx; }
        const unsigned old = xb_add(&bar[XB_XSUB(b.x)], 1u);
        const unsigned gen = old / nloc;
        if (old + 1u == (gen + 1u) * nloc) {
            __builtin_amdgcn_fence(__ATOMIC_RELEASE, "agent");
            asm volatile("s_waitcnt vmcnt(0)" ::: "memory");
            const unsigned og = xb_add(&bar[XB_TOP], 1u);
            const unsigned tg = og / nx;
            if (og + 1u == (tg + 1u) * nx) xb_add(&bar[XB_TOPGEN], 1u);
            else XB_SPIN(xb_ld(&bar[XB_TOPGEN]) == tg, bar);
            __builtin_amdgcn_fence(__ATOMIC_ACQUIRE, "agent");
            xb_add(&bar[XB_XGEN(b.x)], 1u);
            asm volatile("s_waitcnt vmcnt(0)" ::: "memory");
        } else {
            XB_SPIN(xb_ld(&bar[XB_XGEN(b.x)]) == gen, bar);
            __builtin_amdgcn_fence(__ATOMIC_ACQUIRE, "agent");
            asm volatile("s_waitcnt vmcnt(0)" ::: "memory");
        }
    }
    __syncthreads();
}

template <class BG> __device__ __forceinline__ void xcd_barrier_bg(const XcdBarrier& b, const BG& bg) {
    asm volatile("s_waitcnt vmcnt(0)" ::: "memory");
    __syncthreads();
    if (threadIdx.x == 0) {
        unsigned* bar = b.bar;
        __builtin_amdgcn_s_waitcnt(0);
        unsigned nloc = b.st[0], nx = b.st[1];
        if (nloc == 0u) { xcd_barrier_complete(bar, b.x, nloc, nx); b.st[0] = nloc; b.st[1] = nx; }
        const unsigned old = xb_add(&bar[XB_XSUB(b.x)], 1u);
        const unsigned gen = old / nloc;
        if (old + 1u == (gen + 1u) * nloc) {
            __builtin_amdgcn_fence(__ATOMIC_RELEASE, "agent");
            asm volatile("s_waitcnt vmcnt(0)" ::: "memory");
            const unsigned og = xb_add(&bar[XB_TOP], 1u);
            const unsigned tg = og / nx;
            if (og + 1u == (tg + 1u) * nx) xb_add(&bar[XB_TOPGEN], 1u);
            else XB_SPIN(xb_ld(&bar[XB_TOPGEN]) == tg, bar);
            __builtin_amdgcn_fence(__ATOMIC_ACQUIRE, "agent");
            xb_add(&bar[XB_XGEN(b.x)], 1u);
            asm volatile("s_waitcnt vmcnt(0)" ::: "memory");
        } else {
            XB_SPIN(xb_ld(&bar[XB_XGEN(b.x)]) == gen, bar);
            __builtin_amdgcn_fence(__ATOMIC_ACQUIRE, "agent");
            asm volatile("s_waitcnt vmcnt(0)" ::: "memory");
        }
    } else if (threadIdx.x >= 64) bg();
    __syncthreads();
}

constexpr int D = 1024, MP = 16384, MS = 1024, M = MP + MS, DFF = 2816, INW = 4864;
constexpr float EPS = 1e-6f;
constexpr size_t O_YS = (size_t)MP * D, O_PWK = O_YS + (size_t)MS * D, O_PWV = O_PWK + 65536, O_PST = O_PWV + 65536, O_SWK = O_PST + 262144, O_SWV = O_SWK + 2097152, O_SST = O_SWV + 2097152;
constexpr size_t MiB = 1u << 20, HMiB = 1u << 19;
constexpr size_t WS_CTL = 0, CTL_ZERO_BYTES = 1 * MiB;
constexpr size_t WS_W13 = 1 * MiB, WS_W2 = 12 * MiB, WS_WIN = 17 * MiB + HMiB, WS_WUA = 27 * MiB, WS_WUR = 28 * MiB, WS_WOUT = 29 * MiB;
constexpr size_t WS_DEC = 31 * MiB, WS_RSTD1 = 31 * MiB + HMiB, WS_SSQ1 = 32 * MiB, WS_SSQ2 = 34 * MiB;
constexpr size_t WS_AB = 36 * MiB, WS_BIG = 70 * MiB;
constexpr size_t WS_HID = WS_BIG, WS_Q = WS_BIG, WS_KV = WS_BIG + 17 * MiB, WS_QR = WS_KV + 8 * MiB + HMiB, WS_LOGF = WS_QR + 17 * MiB, WS_MRG = WS_LOGF, WS_IR = WS_LOGF + 34 * MiB,
                 WS_GR = WS_IR + 17 * MiB, WS_SGA = WS_GR + 17 * MiB, WS_SGR = WS_SGA + 17 * MiB, WS_AOR = WS_SGR + 17 * MiB, WS_END = WS_AOR + 34 * MiB;
static_assert(WS_END <= 256 * MiB && WS_HID + (size_t)M * DFF * 2 <= WS_END, "ws map");
constexpr int CW_BAR = 4096;
constexpr int RING_OFF = 0, RING_BYTES = 131072, LDSCTL_OFF = 139264, MISC_OFF = LDSCTL_OFF + 320, LDS_BYTES = 147456;
constexpr int NWAVES = 8;

namespace mk {
using pg8::f32x4; using pg8::u32x4; using pg8::Unit; using pg8::bf16_t; using pg8::cvt_pk_bf16;
typedef unsigned u32x2 __attribute__((ext_vector_type(2)));
__device__ __forceinline__ float fsigmoid(float x) { return __builtin_amdgcn_rcpf(1.f + __expf(-x)); }
__device__ __forceinline__ float fsilu(float x) { return x * fsigmoid(x); }
__device__ __forceinline__ float bflo(unsigned w) { return __uint_as_float(w << 16); }
__device__ __forceinline__ float bfhi(unsigned w) { return __uint_as_float(w & 0xffff0000u); }
__device__ __forceinline__ float bf2f(bf16_t h) { return __uint_as_float((unsigned)h << 16); }
__device__ __forceinline__ u32x4 pack8(const f32x4 a, const f32x4 b) { u32x4 w; w.x = cvt_pk_bf16(a[0], a[1]); w.y = cvt_pk_bf16(a[2], a[3]); w.z = cvt_pk_bf16(b[0], b[1]); w.w = cvt_pk_bf16(b[2], b[3]); return w; }
__device__ __forceinline__ float dot4(const f32x4 a) { return (a[0] * a[0] + a[1] * a[1]) + (a[2] * a[2] + a[3] * a[3]); }
__device__ __forceinline__ unsigned q16(float s) { return (unsigned)(s * 65535.f + 0.5f); }
__device__ __forceinline__ unsigned q8(float s) { return (unsigned)(s * 255.f + 0.5f); }
__device__ __forceinline__ unsigned pack4q8(const f32x4 s) { return q8(s[0]) | (q8(s[1]) << 8) | (q8(s[2]) << 16) | (q8(s[3]) << 24); }
__device__ __forceinline__ f32x4 unpack4q8(unsigned w) { return (f32x4){(float)(w & 0xffu), (float)((w >> 8) & 0xffu), (float)((w >> 16) & 0xffu), (float)(w >> 24)} * (1.f / 255.f); }
constexpr float HS8 = 8.f, WS8 = 128.f, HS8B = 16.f;
__device__ __forceinline__ unsigned pk4f8(const f32x4 v) {
    const float a = fminf(fmaxf(v[0], -448.f), 448.f), b = fminf(fmaxf(v[1], -448.f), 448.f), c = fminf(fmaxf(v[2], -448.f), 448.f), d = fminf(fmaxf(v[3], -448.f), 448.f);
    int w = 0; w = __builtin_amdgcn_cvt_pk_fp8_f32(a, b, w, false); w = __builtin_amdgcn_cvt_pk_fp8_f32(c, d, w, true); return (unsigned)w; }
__device__ __forceinline__ float row_rstd16(const float* ssqp, int r) {
    const f32x4* p = (const f32x4*)(ssqp + (size_t)r * 16); const f32x4 a = p[0], b = p[1], c = p[2], d = p[3]; f32x4 s = (a + b) + (c + d);
    const int ub = r / 272, rr = r - ub * 272;
    if (rr >= 256) { const f32x4* q = (const f32x4*)(ssqp + (size_t)M * 16 + ((size_t)ub * 16 + (rr - 256)) * 16); s = s + ((q[0] + q[1]) + (q[2] + q[3])); }
    return rsqrtf(((s[0] + s[1]) + (s[2] + s[3])) * (1.f / 1024.f) + EPS);
}

constexpr int RTAB_OFF = LDSCTL_OFF + 1024;
template <bool FROM_SSQ, class Sched> __device__ __forceinline__ void build_rstd_table(LAS unsigned char* L, const Sched& S, const float* src, int tid, int slot0 = 0, int nslot = 6, bool sync = true) {
    Unit u;
    for (int i = 0; i < nslot && S.next(i, u); ++i) if (tid < 256) *(LAS float*)(L + RTAB_OFF + ((slot0 + i) * 256 + tid) * 4) = FROM_SSQ ? row_rstd16(src, u.pm * 256 + tid) : src[u.pm * 256 + tid];
    if (sync) __syncthreads();
}
template <bool FROM_SSQ, bool F8OUT = false, bool F8IN = false> struct EpiSwiglu {
    static constexpr bool PERM = true, AFTER_DRAIN = false, INIT = false; static constexpr int MIDT = 0, EPI_VM = F8IN ? 0 : 8; static constexpr bool STRIP = false, FP8 = F8IN;
    bf16_t* H; const float* rs; LAS unsigned char* tab;
    __device__ __forceinline__ void operator()(const f32x4 (&acc)[2][2][4][2], const Unit& u, int wr, int wc, int fr, int fq) const {
        const int row0 = u.pm * 256 + wr * 64 + fr, col0 = u.pn * 128 + wc * 32 + 8 * fq;
#pragma unroll
        for (int ai = 0; ai < 2; ++ai)
#pragma unroll
            for (int m = 0; m < 4; ++m) {
                const int r = row0 + ai * 128 + m * 16;
                const float s_ = u.idx < 6 ? *(const LAS float*)(tab + (u.idx * 256 + (r & 255)) * 4) : (FROM_SSQ ? row_rstd16(rs, r) : rs[r]); const float s = F8IN ? s_ * (1.f / (HS8B * WS8)) : s_;
                f32x4 h0, h1;
                const float c1 = s * -1.4426950408889634f, s2 = s * s;
#pragma unroll
                for (int e = 0; e < 4; ++e) {
                    h0[e] = (acc[ai][0][m][0][e] * acc[ai][1][m][0][e]) * (s2 * __builtin_amdgcn_rcpf(1.f + __builtin_amdgcn_exp2f(acc[ai][0][m][0][e] * c1)));
                    h1[e] = (acc[ai][0][m][1][e] * acc[ai][1][m][1][e]) * (s2 * __builtin_amdgcn_rcpf(1.f + __builtin_amdgcn_exp2f(acc[ai][0][m][1][e] * c1))); }
                if constexpr (F8OUT) { u32x2 w; w.x = pk4f8(h0 * HS8); w.y = pk4f8(h1 * HS8); *(u32x2*)((unsigned char*)H + (size_t)r * DFF + col0) = w; }
                else *(u32x4*)(H + (size_t)r * DFF + col0) = pack8(h0, h1);
            }
    }
};
template <bool WRITE_B> struct EpiResid {
    static constexpr bool PERM = false, AFTER_DRAIN = false, INIT = false; static constexpr int MIDT = 0, EPI_VM = 0; static constexpr bool STRIP = false, FP8 = false;
    const float* xp; const float* xs; float* Hout; bf16_t* HB; float* ssqp; float scale; int base_is_x;
    __device__ __forceinline__ void operator()(const f32x4 (&acc)[2][2][4][2], const Unit& u, int wr, int wc, int fr, int fq) const {
        const int row0 = u.pm * 256 + wr * 64 + fr, col0 = u.pn * 256 + wc * 32 + 4 * fq;
        f32x4 pre[3][4];
#define ER_BASE(g_) (base_is_x ? (row0 + ((g_) >> 2) * 128 + ((g_) & 3) * 16 < MP ? xp + (size_t)(row0 + ((g_) >> 2) * 128 + ((g_) & 3) * 16) * D : xs + (size_t)(row0 + ((g_) >> 2) * 128 + ((g_) & 3) * 16 - MP) * D) : Hout + (size_t)(row0 + ((g_) >> 2) * 128 + ((g_) & 3) * 16) * D)
#define ER_LOAD(g_) do { const float* bp_ = ER_BASE(g_); _Pragma("unroll") for (int q_ = 0; q_ < 4; ++q_) pre[(g_) % 3][q_] = *(const f32x4*)(bp_ + col0 + (q_ >> 1) * 128 + (q_ & 1) * 16); } while (0)
        ER_LOAD(0); ER_LOAD(1);
#pragma unroll
        for (int g = 0; g < 8; ++g) {
            if (g + 2 < 8) ER_LOAD(g + 2);
            const int ai = g >> 2, m = g & 3, r = row0 + ai * 128 + m * 16;
            float* op = Hout + (size_t)r * D; float ss = 0.f;
#pragma unroll
            for (int q = 0; q < 4; ++q) {
                const int bj = q >> 1, n = q & 1, c = col0 + bj * 128 + n * 16; const f32x4 o = pre[g % 3][q] + acc[ai][bj][m][n] * scale;
                if (WRITE_B) *(f32x4*)(op + c) = o; else __builtin_nontemporal_store(o, (f32x4*)(op + c));
                if (WRITE_B) { ss += dot4(o); u32x2 w; w.x = cvt_pk_bf16(o[0], o[1]); w.y = cvt_pk_bf16(o[2], o[3]); *(u32x2*)(HB + (size_t)r * D + c) = w; }
            }
            if (WRITE_B) { ss += __shfl_xor(ss, 16); ss += __shfl_xor(ss, 32); if (fq == 0) ssqp[(size_t)r * 16 + u.pn * 4 + wc] = ss; }
            __builtin_amdgcn_sched_barrier(0);
        }
#undef ER_LOAD
#undef ER_BASE
    }
    __device__ __forceinline__ void tail(const f32x4 (&acc)[4], int r, int c0, int fq) const {
        const float* bp = base_is_x ? (r < MP ? xp + (size_t)r * D : xs + (size_t)(r - MP) * D) : Hout + (size_t)r * D;
        float* op = Hout + (size_t)r * D; float ss = 0.f;
#pragma unroll
        for (int n = 0; n < 4; ++n) {
            const int c = c0 + 16 * n + 4 * fq; const f32x4 b = *(const f32x4*)(bp + c); const f32x4 o = b + acc[n] * scale; if (WRITE_B) *(f32x4*)(op + c) = o; else __builtin_nontemporal_store(o, (f32x4*)(op + c));
            if (WRITE_B) { ss += dot4(o); u32x2 w; w.x = cvt_pk_bf16(o[0], o[1]); w.y = cvt_pk_bf16(o[2], o[3]); *(u32x2*)(HB + (size_t)r * D + c) = w; }
        }
        if (WRITE_B) { ss += __shfl_xor(ss, 16); ss += __shfl_xor(ss, 32); if (fq == 0) ssqp[(size_t)r * 16 + (c0 >> 6)] = ss; }
    }
};
template <bool FINAL, bool SXB = false, bool F8 = false, bool W8 = false> struct EpiResidB {
    static constexpr bool PERM = true, AFTER_DRAIN = false, INIT = true; static constexpr int MIDT = 0, EPI_VM = 0; static constexpr bool STRIP = SXB, FP8 = F8; static constexpr int RB = SXB ? 272 : 256;
    bf16_t* HB; float* Y; float* ssqp; float scale;
    __device__ __forceinline__ void init_issue(u32x4 (&pre)[16], const Unit& u, int wr, int wc, int fr, int fq) const {
        const int row0 = u.pm * RB + wr * 64 + fr, col0 = u.pn * 256 + wc * 32 + 8 * fq;
#pragma unroll
        for (int g = 0; g < 8; ++g)
#pragma unroll
            for (int bj = 0; bj < 2; ++bj) pre[2 * g + bj] = *(const u32x4*)(HB + (size_t)(row0 + (g >> 2) * 128 + (g & 3) * 16) * D + col0 + 128 * (SXB ? (bj ^ wr) : bj));
    }
    __device__ __forceinline__ void init_finish(f32x4 (&acc)[2][2][4][2], const u32x4 (&pre)[16]) const {
        const float inv = 1.f / scale;
#pragma unroll
        for (int g = 0; g < 8; ++g)
#pragma unroll
            for (int bj = 0; bj < 2; ++bj) { const u32x4 b = pre[2 * g + bj];
                acc[g >> 2][bj][g & 3][0] = (f32x4){bflo(b.x), bfhi(b.x), bflo(b.y), bfhi(b.y)} * inv; acc[g >> 2][bj][g & 3][1] = (f32x4){bflo(b.z), bfhi(b.z), bflo(b.w), bfhi(b.w)} * inv; }
    }
    __device__ __forceinline__ u32x4 strip_init_issue(const Unit& u, int wr, int wc, int fr, int fq) const { return *(const u32x4*)(HB + (size_t)(u.pm * RB + 256 + fr) * D + u.pn * 256 + 128 * wr + wc * 32 + 8 * fq); }
    __device__ __forceinline__ void strip_init_finish(f32x4 (&accx)[2], const u32x4 b) const { const float inv = 1.f / scale;
        accx[0] = (f32x4){bflo(b.x), bfhi(b.x), bflo(b.y), bfhi(b.y)} * inv; accx[1] = (f32x4){bflo(b.z), bfhi(b.z), bflo(b.w), bfhi(b.w)} * inv; }
    __device__ __forceinline__ void strip(const f32x4 (&accx)[2], const Unit& u, int wr, int wc, int fr, int fq) const {
        const int r = u.pm * RB + 256 + fr, c = u.pn * 256 + 128 * wr + wc * 32 + 8 * fq; const f32x4 o0 = accx[0] * scale, o1 = accx[1] * scale;
        if (FINAL) { float* yp = Y + (size_t)r * D + c; *(f32x4*)yp = o0; *(f32x4*)(yp + 4) = o1; }
        else { float ss = dot4(o0) + dot4(o1); *(u32x4*)(HB + (size_t)r * D + c) = pack8(o0, o1); ss += __shfl_xor(ss, 16); ss += __shfl_xor(ss, 32);
            if constexpr (W8) { u32x2 w8; w8.x = pk4f8(o0 * HS8B); w8.y = pk4f8(o1 * HS8B); *(u32x2*)((unsigned char*)Y + (size_t)r * D + c) = w8; }
            if (fq == 0) { if (wr == 0) ssqp[(size_t)r * 16 + u.pn * 4 + wc] = ss; else ssqp[(size_t)M * 16 + ((size_t)u.pm * 16 + fr) * 16 + u.pn * 4 + wc] = ss; } }
    }
    __device__ __forceinline__ void operator()(const f32x4 (&acc)[2][2][4][2], const Unit& u, int wr, int wc, int fr, int fq) const {
        const int row0 = u.pm * RB + wr * 64 + fr, col0 = u.pn * 256 + wc * 32 + 8 * fq;
#pragma unroll
        for (int g = 0; g < 8; ++g) {
            const int ai = g >> 2, m = g & 3, r = row0 + ai * 128 + m * 16; float ss = 0.f;
#pragma unroll
            for (int bj = 0; bj < 2; ++bj) {
                const f32x4 o0 = acc[ai][bj][m][0] * scale, o1 = acc[ai][bj][m][1] * scale;
                if (FINAL) { float* yp = Y + (size_t)r * D + col0 + 128 * (SXB ? (bj ^ wr) : bj); *(f32x4*)yp = o0; *(f32x4*)(yp + 4) = o1; }
                else { ss += dot4(o0) + dot4(o1); *(u32x4*)(HB + (size_t)r * D + col0 + 128 * (SXB ? (bj ^ wr) : bj)) = pack8(o0, o1);
                    if constexpr (W8) { u32x2 w8; w8.x = pk4f8(o0 * HS8B); w8.y = pk4f8(o1 * HS8B); *(u32x2*)((unsigned char*)Y + (size_t)r * D + col0 + 128 * (SXB ? (bj ^ wr) : bj)) = w8; } }
            }
            if (!FINAL) { ss += __shfl_xor(ss, 16); ss += __shfl_xor(ss, 32); if (fq == 0) ssqp[(size_t)r * 16 + u.pn * 4 + wc] = ss; }
        }
    }
    __device__ __forceinline__ void tail(const f32x4 (&acc)[4], int r, int c0, int fq) const {
        bf16_t* bp = HB + (size_t)r * D + c0 + 4 * fq; float ss = 0.f; u32x2 b[4];
#pragma unroll
        for (int n = 0; n < 4; ++n) b[n] = *(const u32x2*)(bp + 16 * n);
#pragma unroll
        for (int n = 0; n < 4; ++n) {
            const f32x4 o = (f32x4){bflo(b[n].x), bfhi(b[n].x), bflo(b[n].y), bfhi(b[n].y)} + acc[n] * scale;
            if (FINAL) __builtin_nontemporal_store(o, (f32x4*)(Y + (size_t)r * D + c0 + 16 * n + 4 * fq));
            else { ss += dot4(o); u32x2 w; w.x = cvt_pk_bf16(o[0], o[1]); w.y = cvt_pk_bf16(o[2], o[3]); *(u32x2*)(bp + 16 * n) = w; }
        }
        if (!FINAL) { ss += __shfl_xor(ss, 16); ss += __shfl_xor(ss, 32); if (fq == 0) ssqp[(size_t)r * 16 + (c0 >> 6)] = ss; }
    }
};
template <bool F8G = false> struct EpiProj {
    static constexpr bool PERM = true, AFTER_DRAIN = false, INIT = false; static constexpr int MIDT = 0, EPI_VM = 16; static constexpr bool STRIP = false, FP8 = F8G;
    const float* ssqp; unsigned char* ws; float* out; const float *qn, *kn, *lbl; LAS unsigned char* tab; int tabn;
    __device__ __forceinline__ void operator()(const f32x4 (&acc)[2][2][4][2], const Unit& u, int wr, int wc, int fr, int fq) const {
        const int pn = u.pn + (F8G ? 11 : 0), row0 = u.pm * 256 + wr * 64 + fr, pc = wc * 32 + 8 * fq;
        bf16_t* const Q = (bf16_t*)(ws + WS_Q); bf16_t* const KV = (bf16_t*)(ws + WS_KV); unsigned short* const LOGF = (unsigned short*)(ws + WS_LOGF);
        if (pn < 3) {
            const bool isv = (pn == 2 && wc >= 2);
            const float* gp = (pn < 2) ? qn : kn;
            f32x4 gn[2][2];
#pragma unroll
            for (int bj = 0; bj < 2; ++bj)
#pragma unroll
                for (int n = 0; n < 2; ++n) gn[bj][n] = isv ? (f32x4){1.f, 1.f, 1.f, 1.f} : *(const f32x4*)(gp + 32 * bj + 8 * fq + 4 * n);
#pragma unroll
            for (int ai = 0; ai < 2; ++ai)
#pragma unroll
                for (int m = 0; m < 4; ++m) {
                    const int r = row0 + ai * 128 + m * 16; const float s = u.idx < tabn ? *(const LAS float*)(tab + (u.idx * 256 + (r & 255)) * 4) : row_rstd16(ssqp, r);
                    f32x4 v[2][2]; float ss = 0.f;
#pragma unroll
                    for (int bj = 0; bj < 2; ++bj)
#pragma unroll
                        for (int n = 0; n < 2; ++n) { v[bj][n] = acc[ai][bj][m][n] * s; ss += dot4(v[bj][n]); }
                    ss += __shfl_xor(ss, 16); ss += __shfl_xor(ss, 32);
                    const float nr = isv ? 1.f : rsqrtf(ss * (1.f / 64.f) + EPS);
#pragma unroll
                    for (int bj = 0; bj < 2; ++bj)
#pragma unroll
                        for (int n = 0; n < 2; ++n) v[bj][n] = v[bj][n] * nr * gn[bj][n];
                    bf16_t* dst = (pn < 2) ? Q + (size_t)r * 512 + (4 * pn + wc) * 64 + 8 * fq : KV + (size_t)r * 256 + wc * 64 + 8 * fq;
#pragma unroll
                    for (int bj = 0; bj < 2; ++bj) *(u32x4*)(dst + 32 * bj) = pack8(v[bj][0], v[bj][1]);
                    if (pn == 2) {
                        float* o = nullptr; const int kvh = wc & 1;
                        if (r < MP) { const int t = r & 4095; if (t >= 3968) o = out + (wc < 2 ? O_PWK : O_PWV) + ((size_t)((r >> 12) * 128 + (t - 3968)) * 2 + kvh) * 64; }
                        else { const int rr = r - MP; o = out + (wc < 2 ? O_SWK : O_SWV) + ((size_t)((rr >> 3) * 128 + 120 + (rr & 7)) * 2 + kvh) * 64; }
                        if (o) {
#pragma unroll
                            for (int bj = 0; bj < 2; ++bj)
#pragma unroll
                                for (int n = 0; n < 2; ++n) *(f32x4*)(o + 32 * bj + 8 * fq + 4 * n) = v[bj][n];
                        }
                    }
                }
        } else if (pn >= 5 && pn < 7) {
            const int tc = (pn - 5) * 256 + pc;
            f32x4 la[2][2], lq[2][2];
#pragma unroll
            for (int bj = 0; bj < 2; ++bj)
#pragma unroll
                for (int n = 0; n < 2; ++n) { const f32x4 l0 = *(const f32x4*)(lbl + tc + 128 * bj + 4 * n), l1 = *(const f32x4*)(lbl + 512 + tc + 128 * bj + 4 * n);
#pragma unroll
                    for (int e = 0; e < 4; ++e) { const float lbv = __builtin_amdgcn_rcpf(1.f + __builtin_amdgcn_exp2f((l1[e] - l0[e]) * 1.4426950408889634f)); la[bj][n][e] = (1.f - lbv) * 65535.f; lq[bj][n][e] = lbv * 65535.f + 0.5f; } }
#pragma unroll
            for (int ai = 0; ai < 2; ++ai)
#pragma unroll
                for (int m = 0; m < 4; ++m) {
                    const int r = row0 + ai * 128 + m * 16; const float s = u.idx < tabn ? *(const LAS float*)(tab + (u.idx * 256 + (r & 255)) * 4) : row_rstd16(ssqp, r);
                    const float c1 = s * -1.4426950408889634f;
#pragma unroll
                    for (int bj = 0; bj < 2; ++bj) { u32x4 w;
#pragma unroll
                        for (int n = 0; n < 2; ++n) { f32x4 q;
#pragma unroll
                            for (int e = 0; e < 4; ++e) q[e] = __builtin_fmaf(__builtin_amdgcn_rcpf(1.f + __builtin_amdgcn_exp2f(acc[ai][bj][m][n][e] * c1)), la[bj][n][e], lq[bj][n][e]);
                            const unsigned w0 = (unsigned)q[0] | ((unsigned)q[1] << 16), w1 = (unsigned)q[2] | ((unsigned)q[3] << 16);
                            if (n == 0) { w.x = w0; w.y = w1; } else { w.z = w0; w.w = w1; } }
                        *(u32x4*)(LOGF + (size_t)r * 512 + tc + 128 * bj) = w; }
                }
        } else {
            int act, ld, tc; size_t boff;
            if (pn < 5) { act = 1; boff = WS_QR; ld = 512; tc = (pn - 3) * 256 + pc; }
            else if (pn < 9) { act = 0; boff = WS_IR; ld = 512; tc = (pn - 7) * 256 + pc; }
            else if (pn < 11) { act = 1; boff = WS_GR; ld = 512; tc = (pn - 9) * 256 + pc; }
            else if (pn < 15) { act = 2; boff = WS_SGA; ld = 1024; tc = (pn - 11) * 256 + pc; }
            else { act = 2; boff = WS_SGR; ld = 1024; tc = (pn - 15) * 256 + pc; }
            bf16_t* const base = (bf16_t*)(ws + boff);
#pragma unroll
            for (int ai = 0; ai < 2; ++ai)
#pragma unroll
                for (int m = 0; m < 4; ++m) {
                    const int r = row0 + ai * 128 + m * 16; const float s = (u.idx < tabn ? *(const LAS float*)(tab + (u.idx * 256 + (r & 255)) * 4) : row_rstd16(ssqp, r)) * (F8G ? 1.f / (HS8B * WS8) : 1.f);
                    const float c1 = s * -1.4426950408889634f;
                    if (act == 2) {
#pragma unroll
                        for (int bj = 0; bj < 2; ++bj) { f32x4 a, b;
#pragma unroll
                            for (int e = 0; e < 4; ++e) { a[e] = 255.f * __builtin_amdgcn_rcpf(1.f + __builtin_amdgcn_exp2f(acc[ai][bj][m][0][e] * c1)); b[e] = 255.f * __builtin_amdgcn_rcpf(1.f + __builtin_amdgcn_exp2f(acc[ai][bj][m][1][e] * c1)); }
                            u32x2 w; w.x = 0u; w.y = 0u;
#pragma unroll
                            for (int e = 0; e < 4; ++e) { w.x = __builtin_amdgcn_cvt_pk_u8_f32(a[e], e, w.x); w.y = __builtin_amdgcn_cvt_pk_u8_f32(b[e], e, w.y); }
                            *(u32x2*)((unsigned char*)base + (size_t)r * ld + tc + 128 * bj) = w; }
                    } else if (act == 1) {
#pragma unroll
                        for (int bj = 0; bj < 2; ++bj) { f32x4 a, b;
#pragma unroll
                            for (int e = 0; e < 4; ++e) { a[e] = (acc[ai][bj][m][0][e] * s) * __builtin_amdgcn_rcpf(1.f + __builtin_amdgcn_exp2f(acc[ai][bj][m][0][e] * c1)); b[e] = (acc[ai][bj][m][1][e] * s) * __builtin_amdgcn_rcpf(1.f + __builtin_amdgcn_exp2f(acc[ai][bj][m][1][e] * c1)); }
                            *(u32x4*)(base + (size_t)r * ld + tc + 128 * bj) = pack8(a, b); }
                    } else {
#pragma unroll
                        for (int bj = 0; bj < 2; ++bj) *(u32x4*)(base + (size_t)r * ld + tc + 128 * bj) = pack8(acc[ai][bj][m][0] * s, acc[ai][bj][m][1] * s);
                    }
                }
        }
    }
};
struct GateOrder {
    pg8::StaticOrder P; int G, c;
    __device__ void init(int G_, int c_) { P.init(M, 2048, G_, c_); G = G_; c = c_; }
    __device__ bool next(int i, Unit& u) const {
        if (G != 256) return P.next(i, u);
        pg8::StaticOrder Q = P; int ii;
        if (i < 2) { Q.c = c; ii = i; } else if (i == 2 && c >= 236) { Q.c = c - 236; ii = 2; } else if (i == 3 && c >= 236 && c < 248) { Q.c = 20 + c - 236; ii = 2; } else return false;
        const bool ok = Q.next(ii, u); u.idx = i; return ok;
    }
    __device__ __forceinline__ void a_ready(const Unit&) const {}
    __device__ __forceinline__ void done(const Unit&) const {}
};
struct ProjOrder {
    pg8::StaticOrder P; int G, c;
    __device__ void init(int G_, int c_) { P.init(MP, INW, G_, c_); G = G_; c = c_; }
    __device__ bool next(int i, Unit& u) const {
        if (P.next(i, u)) return true;
        const long L = (long)i * G + c - 1216; if (L >= 64) return false;
        const int q = (int)L & 15; u.pm = 64 + ((int)L >> 4); u.pn = q < 11 ? q : q + 3; u.idx = i; return true;
    }
    __device__ __forceinline__ void a_ready(const Unit&) const {}
    __device__ __forceinline__ void done(const Unit&) const {}
};
struct EpiProjTail {
    static constexpr int MIDT = 0, EPI_VM = 0; static constexpr bool STRIP = false, FP8 = false;
    const float* ssqp; bf16_t* SGA;
    __device__ __forceinline__ void tail(const f32x4 (&acc)[4], int r, int c0, int fq) const {
        const float s = row_rstd16(ssqp, r);
#pragma unroll
        for (int n = 0; n < 4; ++n) { f32x4 a;
#pragma unroll
            for (int e = 0; e < 4; ++e) a[e] = fsigmoid(acc[n][e] * s);
            *(unsigned*)((unsigned char*)SGA + (size_t)r * 1024 + c0 + 16 * n + 4 * fq) = pack4q8(a); }
    }
};
template <int PASS> struct EpiUp {
    static constexpr bool PERM = true, AFTER_DRAIN = false, INIT = false; static constexpr int MIDT = 0, EPI_VM = 0; static constexpr bool STRIP = false, FP8 = false;
    bf16_t* MRG; const bf16_t* G;
    __device__ __forceinline__ void operator()(const f32x4 (&acc)[2][2][4][2], const Unit& u, int wr, int wc, int fr, int fq) const {
        const int row0 = u.pm * 256 + wr * 64 + fr, c0 = u.pn * 256 + wc * 32 + 8 * fq;
#pragma unroll
        for (int ai = 0; ai < 2; ++ai)
#pragma unroll
            for (int m = 0; m < 4; ++m) {
                const int r = row0 + ai * 128 + m * 16;
#pragma unroll
                for (int bj = 0; bj < 2; ++bj) {
                    const size_t off = (size_t)r * 1024 + c0 + 128 * bj; const u32x2 g = *(const u32x2*)((const unsigned char*)G + off); const f32x4 ga = unpack4q8(g.x), gb = unpack4q8(g.y);
                    f32x4 a = acc[ai][bj][m][0], b = acc[ai][bj][m][1];
                    a = a * ga; b = b * gb;
                    if (PASS == 1) { const u32x4 p = *(const u32x4*)(MRG + off);
                        a[0] += bflo(p.x); a[1] += bfhi(p.x); a[2] += bflo(p.y); a[3] += bfhi(p.y); b[0] += bflo(p.z); b[1] += bfhi(p.z); b[2] += bflo(p.w); b[3] += bfhi(p.w); }
                    *(u32x4*)(MRG + off) = pack8(a, b);
                }
            }
    }
    __device__ __forceinline__ void tail(const f32x4 (&acc)[4], int r, int c0, int fq) const {
#pragma unroll
        for (int n = 0; n < 4; ++n) {
            const size_t off = (size_t)r * 1024 + c0 + 16 * n + 4 * fq; const f32x4 gq = unpack4q8(*(const unsigned*)((const unsigned char*)G + off));
            f32x4 a = acc[n] * gq;
            if (PASS == 1) { const u32x2 p = *(const u32x2*)(MRG + off); a[0] += bflo(p.x); a[1] += bfhi(p.x); a[2] += bflo(p.y); a[3] += bfhi(p.y); }
            u32x2 w; w.x = cvt_pk_bf16(a[0], a[1]); w.y = cvt_pk_bf16(a[2], a[3]); *(u32x2*)(MRG + off) = w;
        }
    }
};
template <bool SXB = false> struct EpiUpR {
    static constexpr bool PERM = true, AFTER_DRAIN = false, INIT = false; static constexpr int MIDT = 8, EPI_VM = 0; static constexpr bool STRIP = SXB, FP8 = false;
    static constexpr float EPSQ = 1e-18f;
    bf16_t* MRG; const unsigned char* GA; const unsigned char* GR;
    static __device__ __forceinline__ f32x4 q4(unsigned w) { return (f32x4){(float)(w & 0xffu), (float)((w >> 8) & 0xffu), (float)((w >> 16) & 0xffu), (float)(w >> 24)}; }
    static __device__ __forceinline__ f32x4 ratio4(unsigned wa, unsigned wr_) { const f32x4 a = q4(wa), r = q4(wr_);
        return (f32x4){a[0] * __builtin_amdgcn_rcpf(fmaxf(r[0], EPSQ)), a[1] * __builtin_amdgcn_rcpf(fmaxf(r[1], EPSQ)), a[2] * __builtin_amdgcn_rcpf(fmaxf(r[2], EPSQ)), a[3] * __builtin_amdgcn_rcpf(fmaxf(r[3], EPSQ))}; }
    static __device__ __forceinline__ f32x4 gate4(unsigned wr_) { const f32x4 r = q4(wr_); return (f32x4){fmaxf(r[0], EPSQ), fmaxf(r[1], EPSQ), fmaxf(r[2], EPSQ), fmaxf(r[3], EPSQ)} * (1.f / 255.f); }
    __device__ __forceinline__ void mid(f32x4 (&acc)[2][2][4][2], const Unit& u, int wr, int wc, int fr, int fq) const {
        const int row0 = u.pm * (SXB ? 272 : 256) + wr * 64 + fr, c0 = u.pn * 256 + wc * 32 + 8 * fq;
#pragma unroll
        for (int ai = 0; ai < 2; ++ai)
#pragma unroll
            for (int m = 0; m < 4; ++m) {
                const int r = row0 + ai * 128 + m * 16;
#pragma unroll
                for (int bj = 0; bj < 2; ++bj) {
                    const size_t off = (size_t)r * 1024 + c0 + 128 * (SXB ? (bj ^ wr) : bj); const u32x2 ga = *(const u32x2*)(GA + off), gr = *(const u32x2*)(GR + off);
                    acc[ai][bj][m][0] = acc[ai][bj][m][0] * ratio4(ga.x, gr.x); acc[ai][bj][m][1] = acc[ai][bj][m][1] * ratio4(ga.y, gr.y);
                }
                if (m == 1 || m == 3) __builtin_amdgcn_sched_barrier(0);
            }
    }
    __device__ __forceinline__ void operator()(const f32x4 (&acc)[2][2][4][2], const Unit& u, int wr, int wc, int fr, int fq) const {
        const int row0 = u.pm * (SXB ? 272 : 256) + wr * 64 + fr, c0 = u.pn * 256 + wc * 32 + 8 * fq;
#pragma unroll
        for (int ai = 0; ai < 2; ++ai)
#pragma unroll
            for (int m = 0; m < 4; ++m) {
                const int r = row0 + ai * 128 + m * 16;
#pragma unroll
                for (int bj = 0; bj < 2; ++bj) {
                    const size_t off = (size_t)r * 1024 + c0 + 128 * (SXB ? (bj ^ wr) : bj); const u32x2 gr = *(const u32x2*)(GR + off);
                    *(u32x4*)(MRG + off) = pack8(acc[ai][bj][m][0] * gate4(gr.x), acc[ai][bj][m][1] * gate4(gr.y));
                }
            }
    }
    __device__ __forceinline__ void strip_mid(f32x4 (&accx)[2], const Unit& u, int wr, int wc, int fr, int fq) const {
        const size_t off = (size_t)(u.pm * 272 + 256 + fr) * 1024 + u.pn * 256 + 128 * wr + wc * 32 + 8 * fq; const u32x2 ga = *(const u32x2*)(GA + off), gr = *(const u32x2*)(GR + off);
        accx[0] = accx[0] * ratio4(ga.x, gr.x); accx[1] = accx[1] * ratio4(ga.y, gr.y);
    }
    __device__ __forceinline__ void strip(const f32x4 (&accx)[2], const Unit& u, int wr, int wc, int fr, int fq) const {
        const size_t off = (size_t)(u.pm * 272 + 256 + fr) * 1024 + u.pn * 256 + 128 * wr + wc * 32 + 8 * fq; const u32x2 gr = *(const u32x2*)(GR + off);
        *(u32x4*)(MRG + off) = pack8(accx[0] * gate4(gr.x), accx[1] * gate4(gr.y));
    }
    __device__ __forceinline__ void mid_tail(f32x4 (&acc)[4], int r, int c0, int fq) const {
#pragma unroll
        for (int n = 0; n < 4; ++n) { const size_t off = (size_t)r * 1024 + c0 + 16 * n + 4 * fq; acc[n] = acc[n] * ratio4(*(const unsigned*)(GA + off), *(const unsigned*)(GR + off)); }
    }
    __device__ __forceinline__ void tail(const f32x4 (&acc)[4], int r, int c0, int fq) const {
#pragma unroll
        for (int n = 0; n < 4; ++n) { const size_t off = (size_t)r * 1024 + c0 + 16 * n + 4 * fq; const f32x4 a = acc[n] * gate4(*(const unsigned*)(GR + off));
            u32x2 w; w.x = cvt_pk_bf16(a[0], a[1]); w.y = cvt_pk_bf16(a[2], a[3]); *(u32x2*)(MRG + off) = w; }
    }
};
template <class Epi> __device__ __forceinline__ void gemm_tail(LAS unsigned char* L, const bf16_t* A, const bf16_t* Bt, int K, int row_base, int ntr, int ntc, int v, int G, const Epi& E, int tid, int lane, int wave) {
    constexpr int RS = 528, OPB = 64 * RS, BUF = 2 * OPB, XCH = 0;
    static_assert(2 * BUF <= LDSCTL_OFF, "tail buffers must stay below the LDS control words");
    const int fr = lane & 15, fq = lane >> 4, rw = wave & 3, kh = wave >> 2, nc = K / 256;
    const int lrow = tid >> 5, lch = tid & 31;
    for (int tt = v; tt < ntr * ntc; tt += G) {
        int tr = tt / ntc, tc = tt % ntc;
        if (ntr == 16 && ntc == 16 && G == 256) { const int x = tt >> 5, q = tt & 31; tr = (x >> 1) * 4 + (q >> 3); tc = (x & 1) * 8 + (q & 7); }
        const int r0 = row_base + 64 * tr, c0 = 64 * tc;
        const bf16_t* Ag = A + (size_t)(r0 + lrow) * K + 8 * lch; const bf16_t* Bg = Bt + (size_t)(c0 + lrow) * K + 8 * lch; const size_t h16 = (size_t)16 * K;
        u32x4 ra0[4], rb0[4], ra1[4], rb1[4], ra2[4], rb2[4];
#define TL_LOAD(ra, rb, c) do { _Pragma("unroll") for (int j_ = 0; j_ < 4; ++j_) { ra[j_] = *(const u32x4*)(Ag + j_ * h16 + 256 * (c)); rb[j_] = *(const u32x4*)(Bg + j_ * h16 + 256 * (c)); } } while (0)
#define TL_WRITE(ra, rb, b) do { LAS unsigned char* p_ = L + (b) * BUF + lrow * RS + lch * 16; _Pragma("unroll") for (int j_ = 0; j_ < 4; ++j_) { *(LAS u32x4*)(p_ + j_ * 16 * RS) = ra[j_]; *(LAS u32x4*)(p_ + OPB + j_ * 16 * RS) = rb[j_]; } } while (0)
#define TL_COMP(b) do { _Pragma("unroll") for (int i_ = 0; i_ < 4; ++i_) { const int ko_ = (32 * (4 * kh + i_) + 8 * fq) * 2; \
            const pg8::bf16x8 a_ = *(const LAS pg8::bf16x8*)(L + (b) * BUF + (16 * rw + fr) * RS + ko_); \
            _Pragma("unroll") for (int n = 0; n < 4; ++n) { const pg8::bf16x8 b_ = *(const LAS pg8::bf16x8*)(L + (b) * BUF + OPB + (16 * n + fr) * RS + ko_); acc[n] = __builtin_amdgcn_mfma_f32_16x16x32_bf16(b_, a_, acc[n], 0, 0, 0); } } } while (0)
#define TL_STEP(ra, rb, rna, rnb, b, cc) do { if ((cc) < nc) { if ((cc) + 1 < nc) TL_WRITE(rna, rnb, (b) ^ 1); if constexpr (Epi::MIDT > 0) { if ((cc) == Epi::MIDT / 4) E.mid_tail(acc, r0 + 16 * rw + fr, c0, fq); } TL_COMP(b); if ((cc) + 3 < nc) TL_LOAD(ra, rb, (cc) + 3); __syncthreads(); } } while (0)
        f32x4 acc[4];
#pragma unroll
        for (int n = 0; n < 4; ++n) acc[n] = (f32x4){0.f, 0.f, 0.f, 0.f};
        TL_LOAD(ra0, rb0, 0); if (1 < nc) TL_LOAD(ra1, rb1, 1); if (2 < nc) TL_LOAD(ra2, rb2, 2);
        TL_WRITE(ra0, rb0, 0); __syncthreads();
#pragma unroll 1
        for (int c = 0; c < nc; c += 6) { TL_STEP(ra0, rb0, ra1, rb1, 0, c); TL_STEP(ra1, rb1, ra2, rb2, 1, c + 1); TL_STEP(ra2, rb2, ra0, rb0, 0, c + 2); TL_STEP(ra0, rb0, ra1, rb1, 1, c + 3); TL_STEP(ra1, rb1, ra2, rb2, 0, c + 4); TL_STEP(ra2, rb2, ra0, rb0, 1, c + 5); }
#undef TL_STEP
#undef TL_LOAD
#undef TL_WRITE
#undef TL_COMP
        if (kh == 1) {
#pragma unroll
            for (int n = 0; n < 4; ++n) *(LAS f32x4*)(L + XCH + ((rw * 4 + n) * 64 + lane) * 16) = acc[n];
        }
        __syncthreads();
        if (kh == 0) {
#pragma unroll
            for (int n = 0; n < 4; ++n) acc[n] += *(const LAS f32x4*)(L + XCH + ((rw * 4 + n) * 64 + lane) * 16);
            E.tail(acc, r0 + 16 * rw + fr, c0, fq);
        }
        __syncthreads();
    }
}
__device__ __forceinline__ float wave_sum(float v) {
#pragma unroll
    for (int o = 1; o < 64; o <<= 1) v += __shfl_xor(v, o);
    return v;
}
struct WI { const float* W; const float* gain; bf16_t* WT; int ldw, K, dr, sc, k0, f8; };
__device__ __forceinline__ void wi_set(WI& w, int kind, const float* W, const float* W2, int ldw, int K, bf16_t* WT, int nrg, const float* gain, int it) {
    const int kb = it / nrg, rg = it % nrg, p0 = rg * 32; int sc = p0; const float* Ws = W;
    if (kind == 1 || kind == 3) { if ((p0 & 255) >> 7) Ws = W2; sc = 128 * (p0 >> 8) + (p0 & 127); }
    w.f8 = 0;
    if (kind == 3 && p0 >= 3840) { w.f8 = 1; WT = (bf16_t*)((unsigned char*)WT + (size_t)3840 * 1024); }
    if (kind == 2) { const int tile = p0 >> 8; if (tile < 3) sc = 256 * tile + 64 * ((p0 & 127) >> 5) + 32 * ((p0 & 255) >> 7);
        if (tile >= 11) { w.f8 = 1; WT = (bf16_t*)((unsigned char*)WT + (size_t)2816 * 2048 - (size_t)2816 * 1024); } }
    w.W = Ws; w.gain = gain; w.WT = WT; w.ldw = ldw; w.K = K; w.dr = p0; w.sc = sc; w.k0 = 64 * kb;
}
__device__ __forceinline__ void wi_load(const WI& w, f32x4 (&r)[8], int lane) {
    const int lr = lane >> 3, lc4 = (lane & 7) * 4;
#pragma unroll
    for (int i = 0; i < 8; ++i) r[i] = __builtin_nontemporal_load((const GAS f32x4*)(w.W + (size_t)(w.k0 + 8 * i + lr) * w.ldw + w.sc + lc4));
}
__device__ __forceinline__ void wi_proc(const WI& w, const f32x4 (&r)[8], LAS float* scr, int lane) {
    const int lr = lane >> 3, lc4 = (lane & 7) * 4;
#pragma unroll
    for (int i = 0; i < 8; ++i) { const int kk = 8 * i + lr; const float gsc = w.gain ? w.gain[w.k0 + kk] : 1.f;
        scr[kk * 33 + lc4 + 0] = r[i][0] * gsc; scr[kk * 33 + lc4 + 1] = r[i][1] * gsc; scr[kk * 33 + lc4 + 2] = r[i][2] * gsc; scr[kk * 33 + lc4 + 3] = r[i][3] * gsc; }
    LDS_WAIT(); asm volatile("" ::: "memory");
    const int c = lane & 7;
#pragma unroll
    for (int j = 0; j < 4; ++j) { const int n = (lane >> 3) + 8 * j; const LAS float* s = scr + (8 * c) * 33 + n;
        v4u o; o.x = pk2(s[0 * 33], s[1 * 33]); o.y = pk2(s[2 * 33], s[3 * 33]); o.z = pk2(s[4 * 33], s[5 * 33]); o.w = pk2(s[6 * 33], s[7 * 33]);
        *(GAS v4u*)(w.WT + (size_t)(w.dr + n) * w.K + w.k0 + 8 * c) = o; }
    LDS_WAIT(); asm volatile("" ::: "memory");
}
__device__ __forceinline__ void wi_proc8(const WI& w, const f32x4 (&r)[8], LAS float* scr, int lane) {
    const int lr = lane >> 3, lc4 = (lane & 7) * 4;
#pragma unroll
    for (int i = 0; i < 8; ++i) { const int kk = 8 * i + lr; const float gsc = (w.gain ? w.gain[w.k0 + kk] : 1.f) * WS8;
        scr[kk * 33 + lc4 + 0] = r[i][0] * gsc; scr[kk * 33 + lc4 + 1] = r[i][1] * gsc; scr[kk * 33 + lc4 + 2] = r[i][2] * gsc; scr[kk * 33 + lc4 + 3] = r[i][3] * gsc; }
    LDS_WAIT(); asm volatile("" ::: "memory");
    const int c = lane & 7;
#pragma unroll
    for (int j = 0; j < 4; ++j) { const int n = (lane >> 3) + 8 * j; const LAS float* s = scr + (8 * c) * 33 + n;
        u32x2 o; o.x = pk4f8((f32x4){s[0 * 33], s[1 * 33], s[2 * 33], s[3 * 33]}); o.y = pk4f8((f32x4){s[4 * 33], s[5 * 33], s[6 * 33], s[7 * 33]});
        *(GAS u32x2*)((GAS unsigned char*)w.WT + (size_t)(w.dr + n) * w.K + w.k0 + 8 * c) = o; }
    LDS_WAIT(); asm volatile("" ::: "memory");
}
__device__ __forceinline__ void wi_proc_any(const WI& w, const f32x4 (&r)[8], LAS float* scr, int lane) { if (w.f8) wi_proc8(w, r, scr, lane); else wi_proc(w, r, scr, lane); }
}


namespace at {
using pg8::bf16_t; using pg8::bf16x8; using pg8::u32x4; using pg8::cvt_pk_bf16;
typedef float f32x16 __attribute__((ext_vector_type(16)));
typedef short v4i16_t __attribute__((ext_vector_type(4)));
typedef unsigned u32x2 __attribute__((ext_vector_type(2)));
constexpr int KS_OFF = 0, VS_OFF = 46080, LUT_OFF = 87040, KROW = 144;
__device__ const unsigned char T5LUT[129] = {0, 1, 2, 3, 4, 5, 6, 7, 8, 9, 10, 11, 12, 13, 14, 15, 16, 16, 16, 17, 17, 18, 18, 18, 19, 19, 19, 20, 20, 20, 20, 21, 21, 21, 21, 22, 22, 22, 22, 22, 23, 23, 23, 23, 23, 23, 24, 24, 24, 24, 24, 24, 25, 25, 25, 25, 25, 25, 25, 26, 26, 26, 26, 26, 26, 26, 26, 27, 27, 27, 27, 27, 27, 27, 27, 27, 27, 28, 28, 28, 28, 28, 28, 28, 28, 28, 28, 29, 29, 29, 29, 29, 29, 29, 29, 29, 29, 29, 29, 30, 30, 30, 30, 30, 30, 30, 30, 30, 30, 30, 30, 30, 30, 31, 31, 31, 31, 31, 31, 31, 31, 31, 31, 31, 31, 31, 31, 31, 31};
__device__ __forceinline__ v4i16_t trr(LAS const unsigned char* p) { return __builtin_amdgcn_ds_read_tr16_b64_v4i16((LAS v4i16_t*)p); }
__device__ __forceinline__ void attn_wave(const bf16x8 (&qf)[4], LAS const unsigned char* Kt, LAS const unsigned char* Vt, int vdh, LAS const float* lut, float sink, int iq, int jmin, int kb0, int lane, f32x16 (&o)[2]) {
    const int ql = lane & 31, h = lane >> 5;
    f32x16 acc[5];
#pragma unroll
    for (int kb = 0; kb < 5; ++kb) {
        acc[kb] = (f32x16){};
        LAS const unsigned char* kp = Kt + (32 * (kb0 + kb) + ql) * KROW + 16 * h;
#pragma unroll
        for (int ds = 0; ds < 4; ++ds) { const bf16x8 a = *(LAS const bf16x8*)(kp + 32 * ds); acc[kb] = __builtin_amdgcn_mfma_f32_32x32x16_bf16(a, qf[ds], acc[kb], 0, 0, 0); }
    }
    const int base = iq + 128 - 4 * h - 32 * kb0, dmax0 = iq + 128 - jmin; const unsigned dmax = (unsigned)(dmax0 < 128 ? dmax0 : 128);
    const float sink2 = sink * 1.4426950408889634f; float mx = sink2;
    if (jmin == 0) {
#pragma unroll
        for (int kb = 0; kb < 5; ++kb)
#pragma unroll
            for (int r = 0; r < 16; ++r) {
                const float s = __builtin_fmaf(acc[kb][r], 0.125f * 1.4426950408889634f, lut[base - (32 * kb + (r & 3) + 8 * (r >> 2))]);
                acc[kb][r] = s; mx = fmaxf(mx, s);
            }
    } else {
#pragma unroll
        for (int kb = 0; kb < 5; ++kb)
#pragma unroll
            for (int r = 0; r < 16; ++r) {
                const int dist = base - (32 * kb + (r & 3) + 8 * (r >> 2));
                const float s = ((unsigned)dist <= dmax) ? __builtin_fmaf(acc[kb][r], 0.125f * 1.4426950408889634f, lut[dist]) : -INFINITY;
                acc[kb][r] = s; mx = fmaxf(mx, s);
            }
    }
    mx = fmaxf(mx, __shfl_xor(mx, 32));
    float l = 0.f;
#pragma unroll
    for (int kb = 0; kb < 5; ++kb)
#pragma unroll
        for (int r = 0; r < 16; ++r) { const float p = __builtin_amdgcn_exp2f(acc[kb][r] - mx); acc[kb][r] = p; l += p; }
    l += __shfl_xor(l, 32);
    l += __builtin_amdgcn_exp2f(sink2 - mx);
    const float inv = 1.f / l;
    o[0] = (f32x16){}; o[1] = (f32x16){};
    const int g16 = (lane >> 4) & 1, q4 = (lane & 15) >> 2, p4 = lane & 3;
#pragma unroll
    for (int kb = 0; kb < 5; ++kb)
#pragma unroll
        for (int s2 = 0; s2 < 2; ++s2) {
            u32x4 pw; pw.x = cvt_pk_bf16(acc[kb][8 * s2 + 0], acc[kb][8 * s2 + 1]); pw.y = cvt_pk_bf16(acc[kb][8 * s2 + 2], acc[kb][8 * s2 + 3]);
            pw.z = cvt_pk_bf16(acc[kb][8 * s2 + 4], acc[kb][8 * s2 + 5]); pw.w = cvt_pk_bf16(acc[kb][8 * s2 + 6], acc[kb][8 * s2 + 7]);
            const bf16x8 pf = __builtin_bit_cast(bf16x8, pw);
            const int key = 32 * (kb0 + kb) + 16 * s2 + 4 * h + q4;
#pragma unroll
            for (int db = 0; db < 2; ++db) {
                LAS const unsigned char* vp = Vt + db * vdh + key * 64 + (16 * g16 + 4 * p4) * 2;
                const v4i16_t lo = trr(vp), hi = trr(vp + 8 * 64);
                const bf16x8 a = (bf16x8){lo[0], lo[1], lo[2], lo[3], hi[0], hi[1], hi[2], hi[3]};
                o[db] = __builtin_amdgcn_mfma_f32_32x32x16_bf16(a, pf, o[db], 0, 0, 0);
            }
        }
#pragma unroll
    for (int db = 0; db < 2; ++db)
#pragma unroll
        for (int r = 0; r < 16; ++r) o[db][r] *= inv;
}
__device__ __forceinline__ void attn_store(bf16_t* dst, const f32x16 (&o)[2], int h) {
#pragma unroll
    for (int db = 0; db < 2; ++db)
#pragma unroll
        for (int rg = 0; rg < 4; ++rg) { u32x2 w; w.x = cvt_pk_bf16(o[db][4 * rg + 0], o[db][4 * rg + 1]); w.y = cvt_pk_bf16(o[db][4 * rg + 2], o[db][4 * rg + 3]);
            *(u32x2*)(dst + 32 * db + 8 * rg + 4 * h) = w; }
}
__device__ __forceinline__ void attn_prompt_task(LAS unsigned char* L, const bf16_t* Q, bf16_t* AOR, const bf16_t* KV, const float* table, const float* sinks, int b, int n, int kvh, int tid, int lane, int wave) {
    const int m0 = b * 4096 + 128 * n;
    {
        u32x4 kx[4], vx[4];
#pragma unroll
        for (int it = 0; it < 4; ++it) { const int c = tid + 512 * it, j = c >> 3, ch = c & 7; const bool ok = (n > 0) || (j >= 128);
            const bf16_t* src = KV + (size_t)(ok ? m0 - 128 + j : m0) * 256 + kvh * 64 + 8 * ch; kx[it] = *(const u32x4*)src; vx[it] = *(const u32x4*)(src + 128);
            if (!ok) { kx[it] = (u32x4){0u, 0u, 0u, 0u}; vx[it] = kx[it]; } }
#pragma unroll
        for (int it = 0; it < 4; ++it) { const int c = tid + 512 * it, j = c >> 3, ch = c & 7;
            *(LAS u32x4*)(L + KS_OFF + j * KROW + 16 * ch) = kx[it];
            *(LAS u32x4*)(L + VS_OFF + (ch >> 2) * 16384 + j * 64 + (ch & 3) * 16) = vx[it]; }
    }
    for (int e = tid; e < 4 * 192; e += 512) { const int hl = e / 192, d = e % 192 - 32;
        ((LAS float*)(L + LUT_OFF))[e] = (d >= 0 && d <= 128) ? table[(4 * kvh + hl) * 129 + d] : -INFINITY; }
    __syncthreads();
    const int ql = lane & 31, h = lane >> 5, hl = wave & 3, head = 4 * kvh + hl;
    const float sink = sinks[head];
#pragma unroll 1
    for (int rep = 0; rep < 2; ++rep) {
        const int qb = (wave >> 2) + 2 * rep, iq = 32 * qb + ql;
        const bf16_t* qp = Q + (size_t)(m0 + iq) * 512 + head * 64;
        bf16x8 qf[4];
#pragma unroll
        for (int ds = 0; ds < 4; ++ds) qf[ds] = *(const bf16x8*)(qp + 16 * ds + 8 * h);
        f32x16 o[2];
        attn_wave(qf, L + KS_OFF, L + VS_OFF, 16384, (LAS const float*)(L + LUT_OFF) + hl * 192 + 32, sink, iq, n == 0 ? 128 : 0, qb, lane, o);
        attn_store(AOR + (size_t)(m0 + iq) * 1024 + head * 64, o, h);
    }
    __syncthreads();
}
__device__ __forceinline__ void attn_sample_task(LAS unsigned char* L, const bf16_t* Q, bf16_t* AOR, const bf16_t* KV, const float* wk, const float* wv, const float* table, const float* sinks, int bd, int kvh, int tid, int lane, int wave) {
    {
        f32x4 ck[2][2], cv[2][2]; u32x4 nk = (u32x4){0u, 0u, 0u, 0u}, nv = nk;
#pragma unroll
        for (int it = 0; it < 2; ++it) { const int c = tid + 512 * it, j = c >> 3, ch = c & 7; const size_t so = ((size_t)(bd * 128 + j) * 2 + kvh) * 64 + 8 * ch;
            ck[it][0] = *(const f32x4*)(wk + so); ck[it][1] = *(const f32x4*)(wk + so + 4); cv[it][0] = *(const f32x4*)(wv + so); cv[it][1] = *(const f32x4*)(wv + so + 4); }
        if (tid < 64) { const int j = 128 + (tid >> 3), ch = tid & 7; const bf16_t* src = KV + (size_t)(MP + bd * 8 + (j - 128)) * 256 + kvh * 64 + 8 * ch; nk = *(const u32x4*)src; nv = *(const u32x4*)(src + 128); }
#pragma unroll
        for (int it = 0; it < 2; ++it) { const int c = tid + 512 * it, j = c >> 3, ch = c & 7;
            *(LAS u32x4*)(L + KS_OFF + j * KROW + 16 * ch) = mk::pack8(ck[it][0], ck[it][1]);
            *(LAS u32x4*)(L + VS_OFF + (ch >> 2) * 10240 + j * 64 + (ch & 3) * 16) = mk::pack8(cv[it][0], cv[it][1]); }
        if (tid < 256) { const int j = 128 + (tid >> 3), ch = tid & 7;
            *(LAS u32x4*)(L + KS_OFF + j * KROW + 16 * ch) = nk;
            *(LAS u32x4*)(L + VS_OFF + (ch >> 2) * 10240 + j * 64 + (ch & 3) * 16) = nv; }
    }
    for (int e = tid; e < 4 * 192; e += 512) { const int hl = e / 192, d = e % 192 - 32;
        ((LAS float*)(L + LUT_OFF))[e] = (d >= 0 && d <= 128) ? table[(4 * kvh + hl) * 129 + d] : -INFINITY; }
    __syncthreads();
    if (wave == 0) {
        const int ql = lane & 31, h = lane >> 5, hl = ql >> 3, iq = ql & 7, head = 4 * kvh + hl;
        const bf16_t* qp = Q + (size_t)(MP + bd * 8 + iq) * 512 + head * 64;
        bf16x8 qf[4];
#pragma unroll
        for (int ds = 0; ds < 4; ++ds) qf[ds] = *(const bf16x8*)(qp + 16 * ds + 8 * h);
        f32x16 o[2];
        attn_wave(qf, L + KS_OFF, L + VS_OFF, 10240, (LAS const float*)(L + LUT_OFF) + hl * 192 + 32, sinks[head], iq, 0, 0, lane, o);
        attn_store(AOR + (size_t)(MP + bd * 8 + iq) * 1024 + head * 64, o, h);
    }
    __syncthreads();
}
}

namespace hg {
using pg8::bf16_t; using pg8::bf16x8; using pg8::f32x4; using pg8::u32x4; using pg8::cvt_pk_bf16;
typedef short v4i16_t __attribute__((ext_vector_type(4)));
typedef unsigned u32x2 __attribute__((ext_vector_type(2)));
__device__ __forceinline__ v4i16_t trr(LAS const unsigned char* p) { return __builtin_amdgcn_ds_read_tr16_b64_v4i16((LAS v4i16_t*)p); }
constexpr int TS = 288;
constexpr float FQ = 1.f / 65535.f;
struct HaPre { unsigned short lf[16]; u32x4 vch[2]; };
__device__ __forceinline__ void ha_issue(HaPre& P, const unsigned short* LOGF, const bf16_t* IR, int task, int tid) {
    const int bh = task >> 6, c = task & 63, h = bh & 3; const size_t m0 = (size_t)(bh >> 2) * 4096 + 64 * c; const int kd = tid & 127, seg = tid >> 7;
#pragma unroll
    for (int i = 0; i < 16; ++i) P.lf[i] = LOGF[(m0 + 16 * seg + i) * 512 + h * 128 + kd];
#pragma unroll
    for (int q = 0; q < 2; ++q) { const int cid = tid + 512 * q, t = cid >> 4, ch = cid & 15; P.vch[q] = *(const u32x4*)(IR + (m0 + t) * 512 + h * 128 + 8 * ch); }
}
__device__ __forceinline__ void ha_phase(LAS unsigned char* L, HaPre& P, const unsigned short* LOGF, const bf16_t* IR, bf16_t* US, float* DEC, int v, int G, int tid, int lane, int wave) {
    constexpr int KT = 0, VT = 64 * TS, SEG = 2 * 64 * TS, DCS = SEG + 2048;
#pragma unroll 1
    for (int grp = v; grp < 256; grp += G) {
        const int kd = tid & 127, seg = tid >> 7, g = lane >> 4, q4 = (lane & 15) >> 2, p4 = lane & 3;
        f32x4 acc[8];
#pragma unroll
        for (int i = 0; i < 8; ++i) acc[i] = (f32x4){0.f, 0.f, 0.f, 0.f};
        float dg = 1.f;
#pragma unroll 1
        for (int cc = 0; cc < 4; ++cc) {
            float lf[16]; float run = 1.f;
#pragma unroll
            for (int i = 0; i < 16; ++i) { lf[i] = (float)P.lf[i] * FQ; run *= lf[i]; }
            ((LAS float*)(L + SEG))[seg * 128 + kd] = run;
#pragma unroll
            for (int q = 0; q < 2; ++q) { const int cid = tid + 512 * q, t = cid >> 4, ch = cid & 15; *(LAS u32x4*)(L + VT + t * TS + ch * 16) = P.vch[q]; }
            const int nxt = cc < 3 ? 4 * grp + cc + 1 : 4 * (grp + G);
            if (nxt < 1024) ha_issue(P, LOGF, IR, nxt, tid);
            __syncthreads();
            {
                const LAS float* sg = (const LAS float*)(L + SEG);
                const float s0 = sg[kd], s1 = sg[128 + kd], s2 = sg[256 + kd], s3 = sg[384 + kd];
                float suf = seg == 3 ? 1.f : (seg == 2 ? s3 : (seg == 1 ? s2 * s3 : s1 * (s2 * s3)));
#pragma unroll
                for (int i = 15; i >= 0; --i) { const float kt = (1.f - lf[i]) * suf; suf *= lf[i]; *(LAS bf16_t*)(L + KT + (16 * seg + i) * TS + kd * 2) = (bf16_t)cvt_pk_bf16(kt, 0.f); }
                const float dcv = (s0 * s1) * (s2 * s3); dg *= dcv;
                if (seg == 0) ((LAS float*)(L + DCS))[kd] = dcv;
            }
            __syncthreads();
            {
                bf16x8 bv[2];
#pragma unroll
                for (int ks = 0; ks < 2; ++ks) { LAS const unsigned char* vp = L + VT + (32 * ks + 4 * g + q4) * TS + (16 * wave + 4 * p4) * 2; const v4i16_t lo = trr(vp), hi = trr(vp + 16 * TS);
                    bv[ks] = (bf16x8){lo[0], lo[1], lo[2], lo[3], hi[0], hi[1], hi[2], hi[3]}; }
#pragma unroll
                for (int i = 0; i < 8; ++i) {
                    const f32x4 dc = *(const LAS f32x4*)(L + DCS + (16 * i + 4 * g) * 4);
                    acc[i] = acc[i] * dc;
#pragma unroll
                    for (int ks = 0; ks < 2; ++ks) { LAS const unsigned char* kp = L + KT + (32 * ks + 4 * g + q4) * TS + (16 * i + 4 * p4) * 2; const v4i16_t lo = trr(kp), hi = trr(kp + 16 * TS);
                        const bf16x8 a = (bf16x8){lo[0], lo[1], lo[2], lo[3], hi[0], hi[1], hi[2], hi[3]};
                        acc[i] = __builtin_amdgcn_mfma_f32_16x16x32_bf16(a, bv[ks], acc[i], 0, 0, 0); }
                }
            }
            __syncthreads();
        }
        const size_t ub = ((size_t)grp * 128 + 16 * wave + (lane & 15)) * 128 + 4 * g;
#pragma unroll
        for (int i = 0; i < 8; ++i) { u32x2 w; w.x = cvt_pk_bf16(acc[i][0], acc[i][1]); w.y = cvt_pk_bf16(acc[i][2], acc[i][3]); *(u32x2*)(US + ub + 16 * i) = w; }
        if (seg == 0) DEC[(size_t)grp * 128 + kd] = dg;
    }
}
__device__ __forceinline__ void hb_scan(unsigned* US32, const float* DEC, float* out_pst, int idx) {
    const int bh = idx >> 13, pair = idx & 8191, vd = pair >> 6, kd0 = (pair & 63) * 2;
    float s0 = 0.f, s1 = 0.f;
    unsigned* up = US32 + (size_t)bh * 16 * 8192 + pair; const float* dp = DEC + (size_t)bh * 16 * 128 + kd0;
#pragma unroll 1
    for (int c0 = 0; c0 < 16; c0 += 8) {
        unsigned w[8]; float d0[8], d1[8];
#pragma unroll
        for (int i = 0; i < 8; ++i) { w[i] = up[(size_t)(c0 + i) * 8192]; const float2 dd = *(const float2*)(dp + (c0 + i) * 128); d0[i] = dd.x; d1[i] = dd.y; }
#pragma unroll
        for (int i = 0; i < 8; ++i) { up[(size_t)(c0 + i) * 8192] = cvt_pk_bf16(s0, s1); s0 = d0[i] * s0 + mk::bflo(w[i]); s1 = d1[i] * s1 + mk::bfhi(w[i]); }
    }
    out_pst[((size_t)bh * 128 + kd0) * 128 + vd] = s0; out_pst[((size_t)bh * 128 + kd0 + 1) * 128 + vd] = s1;
}
__device__ __forceinline__ void hc_prefix(LAS unsigned char* L, const bf16_t* US, const float* DEC, bf16_t* US2, float* out_pst, int v, int G, int tid, int lane, int wave) {
    constexpr int PS = 272, PT = 128 * PS, PD = 3 * PT;
    const int g = lane >> 4, lc = lane & 15, vd = 16 * wave + lc;
#pragma unroll 1
    for (int grp = v; grp < 256; grp += G) {
        const int gi = grp & 15, base = grp - gi;
        f32x4 sacc[8];
#pragma unroll
        for (int i = 0; i < 8; ++i) sacc[i] = (f32x4){0.f, 0.f, 0.f, 0.f};
        u32x4 r[3][4];
        const u32x4* Ub = (const u32x4*)(US + (size_t)base * 16384) + tid;
#pragma unroll
        for (int jj = 0; jj < 3; ++jj) if (jj < gi) {
#pragma unroll
            for (int q = 0; q < 4; ++q) r[jj][q] = Ub[(size_t)jj * 2048 + 512 * q]; }
        for (int e = tid; e < gi * 128; e += 512) *(LAS float*)(L + PD + e * 4) = DEC[(size_t)base * 128 + e];
#pragma unroll 1
        for (int j0 = 0; j0 < gi; j0 += 3) {
#pragma unroll
            for (int jj = 0; jj < 3; ++jj) if (j0 + jj < gi) {
#pragma unroll
                for (int q = 0; q < 4; ++q) { const int p = tid + 512 * q; *(LAS u32x4*)(L + jj * PT + (p >> 4) * PS + (p & 15) * 16) = r[jj][q]; } }
#pragma unroll
            for (int jj = 0; jj < 3; ++jj) if (j0 + 3 + jj < gi) {
#pragma unroll
                for (int q = 0; q < 4; ++q) r[jj][q] = Ub[(size_t)(j0 + 3 + jj) * 2048 + 512 * q]; }
            __syncthreads();
#pragma unroll
            for (int jj = 0; jj < 3; ++jj) if (j0 + jj < gi) {
#pragma unroll
                for (int i = 0; i < 8; ++i) { const u32x2 w = *(const LAS u32x2*)(L + jj * PT + vd * PS + (16 * i + 4 * g) * 2); const f32x4 dc = *(const LAS f32x4*)(L + PD + ((j0 + jj) * 128 + 16 * i + 4 * g) * 4);
                    sacc[i] = sacc[i] * dc + (f32x4){mk::bflo(w.x), mk::bfhi(w.x), mk::bflo(w.y), mk::bfhi(w.y)}; } }
            __syncthreads();
        }
        { bf16_t* o = US2 + (size_t)grp * 16384 + (size_t)vd * 128 + 4 * g;
#pragma unroll
          for (int i = 0; i < 8; ++i) { u32x2 w; w.x = cvt_pk_bf16(sacc[i][0], sacc[i][1]); w.y = cvt_pk_bf16(sacc[i][2], sacc[i][3]); *(u32x2*)(o + 16 * i) = w; } }
        if (gi == 15) {
            const bf16_t* Ul = US + (size_t)grp * 16384 + (size_t)vd * 128 + 4 * g; const float* Dl = DEC + (size_t)grp * 128 + 4 * g;
#pragma unroll
            for (int i = 0; i < 8; ++i) { const u32x2 w = *(const u32x2*)(Ul + 16 * i); const f32x4 dc = *(const f32x4*)(Dl + 16 * i);
                const f32x4 s = sacc[i] * dc + (f32x4){mk::bflo(w.x), mk::bfhi(w.x), mk::bflo(w.y), mk::bfhi(w.y)};
#pragma unroll
                for (int e = 0; e < 4; ++e) out_pst[((size_t)(grp >> 4) * 128 + 16 * i + 4 * g + e) * 128 + vd] = s[e]; }
        }
    }
    asm volatile("s_waitcnt vmcnt(0)" ::: "memory");
    __syncthreads();
}
struct HcPre { unsigned short lf[16], q[16]; u32x4 vch[2]; u32x2 st[8]; };
__device__ __forceinline__ float dpp_xor1(float x) { return __builtin_bit_cast(float, __builtin_amdgcn_mov_dpp(__builtin_bit_cast(int, x), 0xB1, 0xF, 0xF, true)); }
__device__ __forceinline__ void hc_issue_prompt(HcPre& P, const unsigned short* LOGF, const bf16_t* QR, const bf16_t* IR, const bf16_t* US, int task, bool st, int tid, int lane, int wave) {
    const int bh = task >> 6, c = task & 63, h = bh & 3; const size_t m0 = (size_t)(bh >> 2) * 4096 + 64 * c;
    { const int kd = tid & 127, sub = tid >> 7;
#pragma unroll
      for (int t = 0; t < 16; ++t) { const size_t off = (m0 + 16 * sub + t) * 512 + h * 128 + kd; P.lf[t] = LOGF[off]; P.q[t] = QR[off]; } }
#pragma unroll
    for (int q = 0; q < 2; ++q) { const int cid = tid + 512 * q, t = cid >> 4, ch = cid & 15; P.vch[q] = *(const u32x4*)(IR + (m0 + t) * 512 + h * 128 + 8 * ch); }
    if (st) {
        const bf16_t* USt = US + (size_t)(task >> 2) * 16384; const int g = lane >> 4, vd = 16 * wave + (lane & 15);
#pragma unroll
        for (int i = 0; i < 8; ++i) P.st[i] = *(const u32x2*)(USt + (size_t)vd * 128 + 16 * i + 4 * g);
    }
}
__device__ __forceinline__ void hc_phase_prompt(LAS unsigned char* L, const unsigned short* LOGF, const bf16_t* QR, bf16_t* AOR, const bf16_t* IR, const bf16_t* GR, const float* hgn, const bf16_t* US, int v, int G, int tid, int lane, int wave) {
    constexpr int QH = 0, KH = 17408, KT = 34816, VT = 53248, AT = 71680, DECS = 73728, OT = 75776, QS = 272, OS = 132;
    const int g = lane >> 4, lc = lane & 15, q4 = lc >> 2, p4 = lane & 3, vd = 16 * wave + lc;
    const int et = tid >> 3, ec = (tid & 7) * 16;
    const f32x4 n0 = *(const f32x4*)(hgn + ec), n1 = *(const f32x4*)(hgn + ec + 4), n2 = *(const f32x4*)(hgn + ec + 8), n3 = *(const f32x4*)(hgn + ec + 12);
    HcPre P;
    if (v < 256) hc_issue_prompt(P, LOGF, QR, IR, US, 4 * v, true, tid, lane, wave);
    f32x4 sacc[8];
#pragma unroll
    for (int i = 0; i < 8; ++i) sacc[i] = (f32x4){0.f, 0.f, 0.f, 0.f};
#pragma unroll 1
    for (int grp = v; grp < 256; grp += G)
#pragma unroll 1
    for (int cc = 0; cc < 4; ++cc) {
        const int task = 4 * grp + cc;
        const int bh = task >> 6, c = task & 63, h = bh & 3; const size_t m0 = (size_t)(bh >> 2) * 4096 + 64 * c;
        if (cc == 0) {
#pragma unroll
            for (int i = 0; i < 8; ++i) sacc[i] = (f32x4){mk::bflo(P.st[i].x), mk::bfhi(P.st[i].x), mk::bflo(P.st[i].y), mk::bfhi(P.st[i].y)};
        }
        float lf[16], qv[16];
#pragma unroll
        for (int t = 0; t < 16; ++t) { lf[t] = (float)P.lf[t] * FQ; qv[t] = mk::bf2f(P.q[t]); }
#pragma unroll
        for (int q = 0; q < 2; ++q) { const int cid = tid + 512 * q, t = cid >> 4, ch = cid & 15; *(LAS u32x4*)(L + VT + t * TS + ch * 16) = P.vch[q]; }
        const size_t eoff = (m0 + et) * 512 + h * 128 + ec;
        const u32x4 g0 = *(const u32x4*)(GR + eoff), g1 = *(const u32x4*)(GR + eoff + 8);
        { const int nxt = cc < 3 ? task + 1 : 4 * (grp + G); if (nxt < 1024) hc_issue_prompt(P, LOGF, QR, IR, US, nxt, cc == 3, tid, lane, wave); }
        {
            const int kd = tid & 127, sub = tid >> 7, odd = lane & 1, kde = kd & ~1; float pp[16]; float p = 1.f;
#pragma unroll
            for (int t = 0; t < 16; ++t) { p *= lf[t]; pp[t] = p; }
            float suf = 1.f;
#pragma unroll
            for (int t = 14; t >= 0; t -= 2) {
                const float kk1 = 1.f - lf[t + 1], kk0 = 1.f - lf[t];
                const float qh1 = qv[t + 1] * pp[t + 1], kh1 = kk1 * __builtin_amdgcn_rcpf(fmaxf(pp[t + 1], 1e-30f)), kt1 = kk1 * suf; suf *= lf[t + 1];
                const float qh0 = qv[t] * pp[t], kh0 = kk0 * __builtin_amdgcn_rcpf(fmaxf(pp[t], 1e-30f)), kt0 = kk0 * suf; suf *= lf[t];
                const int ro = 16 * sub + t + odd;
                const float rq = dpp_xor1(odd ? qh0 : qh1), rk = dpp_xor1(odd ? kh0 : kh1), rt = dpp_xor1(odd ? kt0 : kt1);
                *(LAS unsigned*)(L + QH + ro * QS + kde * 2) = odd ? cvt_pk_bf16(rq, qh1) : cvt_pk_bf16(qh0, rq);
                *(LAS unsigned*)(L + KH + ro * QS + kde * 2) = odd ? cvt_pk_bf16(rk, kh1) : cvt_pk_bf16(kh0, rk);
                *(LAS unsigned*)(L + KT + ro * TS + kde * 2) = odd ? cvt_pk_bf16(rt, kt1) : cvt_pk_bf16(kt0, rt);
            }
            *(LAS float*)(L + DECS + (sub * 128 + kd) * 4) = p;
        }
        __syncthreads();
        if (wave < 4) {
            f32x4 acc = (f32x4){0.f, 0.f, 0.f, 0.f};
#pragma unroll
            for (int ks = 0; ks < 4; ++ks) { const bf16x8 a = *(const LAS bf16x8*)(L + QH + (16 * wave + lc) * QS + (32 * ks + 8 * g) * 2), b = *(const LAS bf16x8*)(L + KH + (16 * wave + lc) * QS + (32 * ks + 8 * g) * 2);
                acc = __builtin_amdgcn_mfma_f32_16x16x32_bf16(a, b, acc, 0, 0, 0); }
#pragma unroll
            for (int e = 0; e < 4; ++e) { const int t = 4 * g + e; *(LAS bf16_t*)(L + AT + wave * 512 + t * 32 + lc * 2) = (bf16_t)cvt_pk_bf16(lc <= t ? acc[e] : 0.f, 0.f); }
        }
        __syncthreads();
#pragma unroll 1
        for (int sb = 0; sb < 4; ++sb) {
            f32x4 oacc = (f32x4){0.f, 0.f, 0.f, 0.f};
#pragma unroll
            for (int ks = 0; ks < 4; ++ks) {
                u32x4 bw; bw.x = cvt_pk_bf16(sacc[2 * ks][0], sacc[2 * ks][1]); bw.y = cvt_pk_bf16(sacc[2 * ks][2], sacc[2 * ks][3]); bw.z = cvt_pk_bf16(sacc[2 * ks + 1][0], sacc[2 * ks + 1][1]); bw.w = cvt_pk_bf16(sacc[2 * ks + 1][2], sacc[2 * ks + 1][3]);
                const u32x2 a0 = *(const LAS u32x2*)(L + QH + (16 * sb + lc) * QS + (32 * ks + 4 * g) * 2), a1 = *(const LAS u32x2*)(L + QH + (16 * sb + lc) * QS + (32 * ks + 16 + 4 * g) * 2);
                u32x4 aw; aw.x = a0.x; aw.y = a0.y; aw.z = a1.x; aw.w = a1.y;
                oacc = __builtin_amdgcn_mfma_f32_16x16x32_bf16(__builtin_bit_cast(bf16x8, aw), __builtin_bit_cast(bf16x8, bw), oacc, 0, 0, 0);
            }
            bf16x8 bv;
            { const v4i16_t lo = trr(L + VT + (16 * sb + 4 * g + q4) * TS + (16 * wave + 4 * p4) * 2); bv = (bf16x8){lo[0], lo[1], lo[2], lo[3], 0, 0, 0, 0}; }
            { const u32x2 a0 = *(const LAS u32x2*)(L + AT + sb * 512 + lc * 32 + 8 * g); u32x4 aw; aw.x = a0.x; aw.y = a0.y; aw.z = 0u; aw.w = 0u;
              oacc = __builtin_amdgcn_mfma_f32_16x16x32_bf16(__builtin_bit_cast(bf16x8, aw), bv, oacc, 0, 0, 0); }
#pragma unroll
            for (int e = 0; e < 4; ++e) *(LAS float*)(L + OT + ((16 * sb + 4 * g + e) * OS + vd) * 4) = oacc[e];
            if (sb < 3 || cc < 3) {
#pragma unroll
                for (int i = 0; i < 8; ++i) {
                    const f32x4 dc = *(const LAS f32x4*)(L + DECS + (sb * 128 + 16 * i + 4 * g) * 4);
                    const v4i16_t lo = trr(L + KT + (16 * sb + 4 * g + q4) * TS + (16 * i + 4 * p4) * 2);
                    const bf16x8 a = (bf16x8){lo[0], lo[1], lo[2], lo[3], 0, 0, 0, 0};
                    sacc[i] = __builtin_amdgcn_mfma_f32_16x16x32_bf16(a, bv, sacc[i] * dc, 0, 0, 0);
                }
            }
        }
        __syncthreads();
        {
            f32x4 x[4]; float ss = 0.f;
#pragma unroll
            for (int k = 0; k < 4; ++k) { x[k] = *(const LAS f32x4*)(L + OT + (et * OS + ec + 4 * k) * 4); ss += mk::dot4(x[k]); }
            ss += __shfl_xor(ss, 1); ss += __shfl_xor(ss, 2); ss += __shfl_xor(ss, 4);
            const float rs = rsqrtf(ss * (1.f / 128.f) + EPS);
            const f32x4 y0 = x[0] * rs * n0 * (f32x4){mk::bflo(g0.x), mk::bfhi(g0.x), mk::bflo(g0.y), mk::bfhi(g0.y)}, y1 = x[1] * rs * n1 * (f32x4){mk::bflo(g0.z), mk::bfhi(g0.z), mk::bflo(g0.w), mk::bfhi(g0.w)};
            const f32x4 y2 = x[2] * rs * n2 * (f32x4){mk::bflo(g1.x), mk::bfhi(g1.x), mk::bflo(g1.y), mk::bfhi(g1.y)}, y3 = x[3] * rs * n3 * (f32x4){mk::bflo(g1.z), mk::bfhi(g1.z), mk::bflo(g1.w), mk::bfhi(g1.w)};
            { bf16_t* op = AOR + (m0 + et) * 1024 + 512 + h * 128 + ec; *(u32x4*)op = mk::pack8(y0, y1); *(u32x4*)(op + 8) = mk::pack8(y2, y3); }
        }
    }
    __syncthreads();
}

struct HcPreS { f32x4 sreg[8]; unsigned short lf[8]; unsigned short qv[8]; u32x4 vch; };
__device__ __forceinline__ void hc_issue_sample(HcPreS& P, const unsigned short* LOGF, const bf16_t* QR, const bf16_t* IR, const float* S0, int id, int tid) {
    const int bd = id >> 2, h = id & 3; const size_t m0 = (size_t)MP + bd * 8; const float* s0 = S0 + (size_t)id * 16384;
#pragma unroll
    for (int q = 0; q < 8; ++q) { const int cid = tid + 512 * q; P.sreg[q] = __builtin_nontemporal_load((const f32x4*)(s0 + (size_t)cid * 4)); }
    if (tid < 128) {
#pragma unroll
        for (int t = 0; t < 8; ++t) { const size_t off = (m0 + t) * 512 + h * 128 + tid; P.lf[t] = LOGF[off]; P.qv[t] = QR[off]; }
        P.vch = *(const u32x4*)(IR + (m0 + (tid >> 4)) * 512 + h * 128 + 8 * (tid & 15));
    }
}
__device__ __forceinline__ void hc_phase_sample(LAS unsigned char* L, const unsigned short* LOGF, const bf16_t* QR, bf16_t* AOR, const bf16_t* IR, const bf16_t* GR, const float* hgn, const float* S0, float* Sout, HcPreS& P, int v, int G, int cnt, int tid, int lane, int wave) {
    constexpr int QH = 0, KH = 4352, KT = 8704, VT = 13312, AT = 17920, DECS = 18432, OT = 18944, ST = 27392, QS = 272, OS = 132, SS = 528;
    const int g = lane >> 4, lc = lane & 15, q4 = lc >> 2, p4 = lane & 3, vd = 16 * wave + lc;
    const int et = tid >> 3, ec = (tid & 7) * 16;
#pragma unroll 1
    for (int kk = 0, id = v; kk < cnt; ++kk, id += G) {
        const int bd = id >> 2, h = id & 3; const size_t m0 = (size_t)MP + bd * 8;
#pragma unroll
        for (int q = 0; q < 8; ++q) { const int cid = tid + 512 * q, row = cid >> 5, c4 = cid & 31; *(LAS f32x4*)(L + ST + row * SS + c4 * 16) = P.sreg[q]; }
        if (tid < 128) {
            const int kd = tid; float pp[8], lfs[8]; float p = 1.f;
#pragma unroll
            for (int t = 0; t < 8; ++t) { lfs[t] = (float)P.lf[t] * FQ; p *= lfs[t]; pp[t] = p; }
            float suf = 1.f;
#pragma unroll
            for (int t = 7; t >= 0; --t) {
                const float kk = 1.f - lfs[t];
                *(LAS bf16_t*)(L + QH + t * QS + kd * 2) = (bf16_t)cvt_pk_bf16(mk::bf2f(P.qv[t]) * pp[t], 0.f);
                *(LAS bf16_t*)(L + KH + t * QS + kd * 2) = (bf16_t)cvt_pk_bf16(kk * __builtin_amdgcn_rcpf(fmaxf(pp[t], 1e-30f)), 0.f);
                *(LAS bf16_t*)(L + KT + t * TS + kd * 2) = (bf16_t)cvt_pk_bf16(kk * suf, 0.f);
                suf *= lfs[t];
            }
#pragma unroll
            for (int t = 8; t < 16; ++t) { *(LAS bf16_t*)(L + QH + t * QS + kd * 2) = 0; *(LAS bf16_t*)(L + KH + t * QS + kd * 2) = 0; *(LAS bf16_t*)(L + KT + t * TS + kd * 2) = 0; }
            *(LAS float*)(L + DECS + kd * 4) = p;
            *(LAS u32x4*)(L + VT + (tid >> 4) * TS + (tid & 15) * 16) = P.vch;
        } else if (tid < 256) { const int c = tid - 128; *(LAS u32x4*)(L + VT + (8 + (c >> 4)) * TS + (c & 15) * 16) = (u32x4){0u, 0u, 0u, 0u}; }
        const size_t eoff = (m0 + et) * 512 + h * 128 + ec; u32x4 g0 = (u32x4){0u, 0u, 0u, 0u}, g1 = g0;
        if (tid < 64) { g0 = *(const u32x4*)(GR + eoff); g1 = *(const u32x4*)(GR + eoff + 8); }
        if (kk + 1 < cnt) hc_issue_sample(P, LOGF, QR, IR, S0, id + G, tid);
        __syncthreads();
        f32x4 sacc[8];
#pragma unroll
        for (int i = 0; i < 8; ++i)
#pragma unroll
            for (int e = 0; e < 4; ++e) sacc[i][e] = *(const LAS float*)(L + ST + (16 * i + 4 * g + e) * SS + vd * 4);
        if (wave == 0) {
            f32x4 acc = (f32x4){0.f, 0.f, 0.f, 0.f};
#pragma unroll
            for (int ks = 0; ks < 4; ++ks) { const bf16x8 a = *(const LAS bf16x8*)(L + QH + lc * QS + (32 * ks + 8 * g) * 2), b = *(const LAS bf16x8*)(L + KH + lc * QS + (32 * ks + 8 * g) * 2);
                acc = __builtin_amdgcn_mfma_f32_16x16x32_bf16(a, b, acc, 0, 0, 0); }
#pragma unroll
            for (int e = 0; e < 4; ++e) { const int t = 4 * g + e; *(LAS bf16_t*)(L + AT + t * 32 + lc * 2) = (bf16_t)cvt_pk_bf16(lc <= t ? acc[e] : 0.f, 0.f); }
        }
        __syncthreads();
        {
            f32x4 oacc = (f32x4){0.f, 0.f, 0.f, 0.f};
#pragma unroll
            for (int ks = 0; ks < 4; ++ks) {
                u32x4 bw; bw.x = cvt_pk_bf16(sacc[2 * ks][0], sacc[2 * ks][1]); bw.y = cvt_pk_bf16(sacc[2 * ks][2], sacc[2 * ks][3]); bw.z = cvt_pk_bf16(sacc[2 * ks + 1][0], sacc[2 * ks + 1][1]); bw.w = cvt_pk_bf16(sacc[2 * ks + 1][2], sacc[2 * ks + 1][3]);
                const u32x2 a0 = *(const LAS u32x2*)(L + QH + lc * QS + (32 * ks + 4 * g) * 2), a1 = *(const LAS u32x2*)(L + QH + lc * QS + (32 * ks + 16 + 4 * g) * 2);
                u32x4 aw; aw.x = a0.x; aw.y = a0.y; aw.z = a1.x; aw.w = a1.y;
                oacc = __builtin_amdgcn_mfma_f32_16x16x32_bf16(__builtin_bit_cast(bf16x8, aw), __builtin_bit_cast(bf16x8, bw), oacc, 0, 0, 0);
            }
            bf16x8 bv;
            { const v4i16_t lo = trr(L + VT + (4 * g + q4) * TS + (16 * wave + 4 * p4) * 2); bv = (bf16x8){lo[0], lo[1], lo[2], lo[3], 0, 0, 0, 0}; }
            { const u32x2 a0 = *(const LAS u32x2*)(L + AT + lc * 32 + 8 * g); u32x4 aw; aw.x = a0.x; aw.y = a0.y; aw.z = 0u; aw.w = 0u;
              oacc = __builtin_amdgcn_mfma_f32_16x16x32_bf16(__builtin_bit_cast(bf16x8, aw), bv, oacc, 0, 0, 0); }
#pragma unroll
            for (int e = 0; e < 4; ++e) *(LAS float*)(L + OT + ((4 * g + e) * OS + vd) * 4) = oacc[e];
#pragma unroll
            for (int i = 0; i < 8; ++i) {
                const f32x4 dc = *(const LAS f32x4*)(L + DECS + (16 * i + 4 * g) * 4);
                const v4i16_t lo = trr(L + KT + (4 * g + q4) * TS + (16 * i + 4 * p4) * 2);
                const bf16x8 a = (bf16x8){lo[0], lo[1], lo[2], lo[3], 0, 0, 0, 0};
                sacc[i] = __builtin_amdgcn_mfma_f32_16x16x32_bf16(a, bv, sacc[i] * dc, 0, 0, 0);
            }
#pragma unroll
            for (int i = 0; i < 8; ++i)
#pragma unroll
                for (int e = 0; e < 4; ++e) *(LAS float*)(L + ST + (16 * i + 4 * g + e) * SS + vd * 4) = sacc[i][e];
        }
        __syncthreads();
        if (tid < 64) {
            const f32x4 n0 = *(const f32x4*)(hgn + ec), n1 = *(const f32x4*)(hgn + ec + 4), n2 = *(const f32x4*)(hgn + ec + 8), n3 = *(const f32x4*)(hgn + ec + 12);
            f32x4 x[4]; float ss = 0.f;
#pragma unroll
            for (int k = 0; k < 4; ++k) { x[k] = *(const LAS f32x4*)(L + OT + (et * OS + ec + 4 * k) * 4); ss += mk::dot4(x[k]); }
            ss += __shfl_xor(ss, 1); ss += __shfl_xor(ss, 2); ss += __shfl_xor(ss, 4);
            const float rs = rsqrtf(ss * (1.f / 128.f) + EPS);
            const f32x4 y0 = x[0] * rs * n0 * (f32x4){mk::bflo(g0.x), mk::bfhi(g0.x), mk::bflo(g0.y), mk::bfhi(g0.y)}, y1 = x[1] * rs * n1 * (f32x4){mk::bflo(g0.z), mk::bfhi(g0.z), mk::bflo(g0.w), mk::bfhi(g0.w)};
            const f32x4 y2 = x[2] * rs * n2 * (f32x4){mk::bflo(g1.x), mk::bfhi(g1.x), mk::bflo(g1.y), mk::bfhi(g1.y)}, y3 = x[3] * rs * n3 * (f32x4){mk::bflo(g1.z), mk::bfhi(g1.z), mk::bflo(g1.w), mk::bfhi(g1.w)};
            { bf16_t* op = AOR + (m0 + et) * 1024 + 512 + h * 128 + ec; *(u32x4*)op = mk::pack8(y0, y1); *(u32x4*)(op + 8) = mk::pack8(y2, y3); }
        }
        { float* so = Sout + (size_t)id * 16384;
#pragma unroll
          for (int q = 0; q < 8; ++q) { const int cid = tid + 512 * q, row = cid >> 5, c4 = cid & 31; __builtin_nontemporal_store(*(const LAS f32x4*)(L + ST + row * SS + c4 * 16), (f32x4*)(so + (size_t)cid * 4)); } }
        __syncthreads();
    }
}
}
struct Args { const float* in[24]; float* out; unsigned char* ws; int ph_lo, ph_hi, li, pad; };
__global__ void __launch_bounds__(NWAVES * 64, 2) mega(Args args) {
    extern __shared__ __attribute__((aligned(16))) unsigned char lds[];
    LAS unsigned char* L = (LAS unsigned char*)lds;
    volatile LAS unsigned* MISC = (volatile LAS unsigned*)(L + MISC_OFF);
    const int tid = threadIdx.x, lane = tid & 63, wave = __builtin_amdgcn_readfirstlane(tid >> 6);
    const int G = gridDim.x; const int bx = blockIdx.x; const int vcu = (G % 8 == 0) ? (bx % 8) * (G / 8) + bx / 8 : bx;
    unsigned char* ws = args.ws;
    gu32* ctl = (gu32*)(ws + WS_CTL);
    for (int u = tid; u < (LDS_BYTES - LDSCTL_OFF) / 4; u += NWAVES * 64) ((LAS unsigned*)(L + LDSCTL_OFF))[u] = 0u;
    __syncthreads();
    const int lo = args.ph_lo, hi = args.ph_hi;
    XcdBarrier bar; bar.bar = (unsigned*)(ctl + CW_BAR) + args.li * XCD_BAR_WORDS; bar.x = 0; bar.st = nullptr;
    if (hi - lo > 1) bar = xcd_barrier_post((unsigned*)(ctl + CW_BAR) + args.li * XCD_BAR_WORDS, MISC + 8);
#define IN(k) (lo <= (k) && (k) < hi)
#define SEAM(k) do { if (IN(k) && IN((k) + 1)) xcd_barrier_bg(bar, [&]() { BG_WORK(k); }); } while (0)
#define BG_RUNXP(first_, step_, lo_, hi_, SET_, PROC_) do { const int st_ = (step_); int j_ = (lo_) + (first_); mk::WI w_, wn_; f32x4 r_[8], rn_[8]; \
        if (j_ < (hi_)) { SET_(w_, j_); mk::wi_load(w_, r_, lane); } \
        for (; j_ < (hi_); j_ += st_) { const bool hn_ = j_ + st_ < (hi_); if (hn_) { SET_(wn_, j_ + st_); mk::wi_load(wn_, rn_, lane); } PROC_(w_, r_, scr, lane); \
            if (hn_) { w_ = wn_; _Pragma("unroll") for (int i_ = 0; i_ < 8; ++i_) r_[i_] = rn_[i_]; } } } while (0)
#define BG_RUNX(first_, step_, lo_, hi_, SET_) BG_RUNXP(first_, step_, lo_, hi_, SET_, mk::wi_proc_any)
#define BG_RUN(lo_, hi_, SET_) BG_RUNX(vcu * (NWAVES - 1) + wave - 1, G * (NWAVES - 1), lo_, hi_, SET_)
#define BG_SET0(w, j) do { if ((j) < 1408) mk::wi_set(w, 0, args.in[8], nullptr, D, DFF, W2, 32, nullptr, (j)); else mk::wi_set(w, 2, args.in[10], nullptr, INW, D, WIN, 152, args.in[9], (j) - 1408); } while (0)
#define BG_SET1(w, j) do { if ((j) < 256) mk::wi_set(w, 0, args.in[17], nullptr, D, 1024, WUA, 32, nullptr, (j)); else if ((j) < 512) mk::wi_set(w, 0, args.in[18], nullptr, D, 1024, WUA + 512, 32, nullptr, (j) - 256); \
        else if ((j) < 1024) mk::wi_set(w, 0, args.in[19], nullptr, D, D, WOUT, 32, nullptr, (j) - 512); else mk::wi_set(w, 2, args.in[10], nullptr, INW, D, WIN, 152, args.in[9], (j) - 1024 + 1216); } while (0)
#define BG_SET2(w, j) mk::wi_set(w, 3, args.in[21], args.in[22], DFF, D, W13, 176, args.in[20], (j))
#define BG_SET4(w, j) mk::wi_set(w, 0, args.in[23], nullptr, D, DFF, W2, 32, nullptr, (j))
#define BG_COPYX(first_, step_, lo_, hi_) do { for (int c_ = (lo_) + (first_); c_ < (hi_); c_ += (step_)) { f32x4 v_[8]; \
        _Pragma("unroll") for (int i_ = 0; i_ < 8; ++i_) { const int u_ = c_ * 512 + i_ * 64 + lane, ten_ = u_ / (128 * 3840), rem_ = u_ % (128 * 3840), bd_ = rem_ / 3840, q_ = rem_ % 3840; \
            v_[i_] = __builtin_nontemporal_load((const f32x4*)(args.in[2 + ten_] + (size_t)bd_ * 16384 + 1024) + q_); } \
        _Pragma("unroll") for (int i_ = 0; i_ < 8; ++i_) { const int u_ = c_ * 512 + i_ * 64 + lane, ten_ = u_ / (128 * 3840), rem_ = u_ % (128 * 3840), bd_ = rem_ / 3840, q_ = rem_ % 3840; \
            __builtin_nontemporal_store(v_[i_], (f32x4*)(args.out + (ten_ ? O_SWV : O_SWK) + (size_t)bd_ * 16384) + q_); } } } while (0)
#define BG_COPY(lo_, hi_) BG_COPYX(vcu * (NWAVES - 1) + wave - 1, G * (NWAVES - 1), lo_, hi_)
#define BG_WORK(k) do { \
        if (G != 256) { \
            if ((k) == 0) BG_RUN(0, 1408 + 1216, BG_SET0); else if ((k) == 1) BG_RUN(0, 1024 + 1216, BG_SET1); else if ((k) == 2) BG_RUN(0, 1792, BG_SET2); else if ((k) == 3) BG_RUN(1792, 2816, BG_SET2); \
            else if ((k) == 4) BG_RUN(0, 1408, BG_SET4); else if ((k) == 5) BG_COPY(0, 1792); else if ((k) == 6) BG_COPY(1792, 1920); \
        } else { \
            if ((k) == 0) BG_RUN(0, 1408 + 1216, BG_SET0); \
            else if ((k) == 1) { if (bx >= 216) BG_RUNX((bx - 216) * 7 + wave - 1, 280, 0, 1960, BG_SET1); else BG_RUNX(bx * 7 + wave - 1, 1512, 1960, 2240, BG_SET1); } \
            else if ((k) == 2) BG_RUN(0, 1472, BG_SET2); \
            else if ((k) == 3) BG_RUN(1472, 2816, BG_SET2); \
            else if ((k) == 4) BG_RUN(0, 1408, BG_SET4); \
            else if ((k) == 9) { if (bx >= 220) BG_COPYX((bx - 220) * 7 + wave - 1, 252, 0, 1920); }     \
        } \
    } while (0)
    const float* xp = args.in[0]; const float* xs = args.in[1];
    pg8::bf16_t* W13 = (pg8::bf16_t*)(ws + WS_W13); pg8::bf16_t* W2 = (pg8::bf16_t*)(ws + WS_W2); pg8::bf16_t* WIN = (pg8::bf16_t*)(ws + WS_WIN);
    pg8::bf16_t* WUA = (pg8::bf16_t*)(ws + WS_WUA); pg8::bf16_t* WUR = (pg8::bf16_t*)(ws + WS_WUR); pg8::bf16_t* WOUT = (pg8::bf16_t*)(ws + WS_WOUT);
    float* RSTD1 = (float*)(ws + WS_RSTD1); float* SSQ1 = (float*)(ws + WS_SSQ1); float* SSQ2 = (float*)(ws + WS_SSQ2);
    pg8::bf16_t* AB = (pg8::bf16_t*)(ws + WS_AB); pg8::bf16_t* HID = (pg8::bf16_t*)(ws + WS_HID);
    pg8::bf16_t* Qb = (pg8::bf16_t*)(ws + WS_Q); pg8::bf16_t* KVb = (pg8::bf16_t*)(ws + WS_KV); pg8::bf16_t* QRb = (pg8::bf16_t*)(ws + WS_QR); const unsigned short* LOGF = (const unsigned short*)(ws + WS_LOGF);
    pg8::bf16_t* MRG = (pg8::bf16_t*)(ws + WS_MRG); pg8::bf16_t* IRb = (pg8::bf16_t*)(ws + WS_IR); pg8::bf16_t* GRb = (pg8::bf16_t*)(ws + WS_GR);
    pg8::bf16_t* SGA = (pg8::bf16_t*)(ws + WS_SGA); pg8::bf16_t* SGR = (pg8::bf16_t*)(ws + WS_SGR); pg8::bf16_t* AOR = (pg8::bf16_t*)(ws + WS_AOR);
    LAS float* scr = (LAS float*)(L + RING_OFF + wave * 16384);
    const int gw = vcu * NWAVES + wave, NGW = G * NWAVES;

    float* LUTG = (float*)(ws + WS_DEC + 262144);
    if (IN(0)) {
        constexpr int NIT = 176 * 16;
#define WI_DEC0(w, it_) mk::wi_set(w, 1, args.in[6], args.in[7], DFF, D, W13, 176, args.in[5], (it_))
        { mk::WI wc, wn; f32x4 rc[8], rn[8]; int it = gw;
          if (it < NIT) { WI_DEC0(wc, it); mk::wi_load(wc, rc, lane); }
          for (; it < NIT; it += NGW) {
              const bool hn = it + NGW < NIT;
              if (hn) { WI_DEC0(wn, it + NGW); mk::wi_load(wn, rn, lane); }
              mk::wi_proc(wc, rc, scr, lane);
              if (hn) { wc = wn;
#pragma unroll
                  for (int i = 0; i < 8; ++i) rc[i] = rn[i]; }
          } }
#undef WI_DEC0
#define X_ISSUE(v, m0_) do { _Pragma("unroll") for (int q = 0; q < 4; ++q) { const int m = (m0_) + q * NGW; if (m < M) { const float* xr = m < MP ? xp + (size_t)m * D : xs + (size_t)(m - MP) * D; const GAS f32x4* p = (const GAS f32x4*)xr + lane; \
            _Pragma("unroll") for (int j = 0; j < 4; ++j) v[q][j] = __builtin_nontemporal_load(p + 64 * j); } } } while (0)
        { f32x4 v[4][4], vn[4][4]; int m0 = gw;
          if (m0 < M) X_ISSUE(v, m0);
          for (; m0 < M; m0 += 4 * NGW) {
            const bool hn = m0 + 4 * NGW < M;
            if (hn) X_ISSUE(vn, m0 + 4 * NGW);
#pragma unroll
            for (int q = 0; q < 4; ++q) { const int m = m0 + q * NGW; if (m < M) { float ss = 0.f;
#pragma unroll
                for (int j = 0; j < 4; ++j) ss += mk::dot4(v[q][j]);
                ss = mk::wave_sum(ss);
                if (lane == 0) RSTD1[m] = rsqrtf(ss * (1.f / 1024.f) + EPS);
                GAS unsigned long long* o8 = (GAS unsigned long long*)(AB + (size_t)m * D) + lane;
#pragma unroll
                for (int j = 0; j < 4; ++j) o8[64 * j] = (unsigned long long)pk2(v[q][j][0], v[q][j][1]) | ((unsigned long long)pk2(v[q][j][2], v[q][j][3]) << 32); } }
            if (hn) {
#pragma unroll
                for (int q = 0; q < 4; ++q)
#pragma unroll
                    for (int j = 0; j < 4; ++j) v[q][j] = vn[q][j]; }
          } }
#undef X_ISSUE
        VM_WAIT(); __syncthreads();
    }
    SEAM(0);
    if (IN(1)) {
        pg8::Gemm g{AB, W13, M, 2 * DFF, D}; pg8::StaticOrder S; S.init(M, 2 * DFF, G, bx);
        mk::EpiSwiglu<false> E{HID, RSTD1, L + mk::RTAB_OFF};
        mk::build_rstd_table<false>(L, S, RSTD1, tid);
        pg8::gemm_phase<mk::EpiSwiglu<false>, pg8::StaticOrder, true, true>(L + RING_OFF, g, S, E);
        if (bx == G - 1) for (int e = tid; e < 8 * 129; e += NWAVES * 64) { const int hd = e / 129, d = e % 129; LUTG[e] = args.in[14][at::T5LUT[d] * 8 + hd] * 1.4426950408889634f; }
    }
    SEAM(1);
    if (IN(2)) {
        pg8::Gemm g{HID, W2, MP, D, DFF}; pg8::StaticOrder S; S.init(MP, D, G, bx);
        mk::EpiResidB<false, true, false, true> E{AB, (float*)(ws + WS_AOR), SSQ1, 0.5f};
        pg8::gemm_phase<mk::EpiResidB<false, true, false, true>, pg8::StaticOrder, true, true>(L + RING_OFF, g, S, E);
    }
    SEAM(2);
    if (IN(3)) {
        pg8::StaticOrder SA; SA.init(M, 2816, G, bx); mk::GateOrder SB; SB.init(G, bx);
        mk::build_rstd_table<true>(L, SA, SSQ1, tid, 0, 3, false); mk::build_rstd_table<true>(L, SB, SSQ1, tid, 3, 4, true);
        { pg8::Gemm g{AB, WIN, M, 2816, D};
          mk::EpiProj<false> E{SSQ1, ws, args.out, args.in[11], args.in[12], args.in[15], L + mk::RTAB_OFF, 3};
          pg8::gemm_phase<mk::EpiProj<false>, pg8::StaticOrder, true, true>(L + RING_OFF, g, SA, E); }
        { pg8::Gemm g{(const pg8::bf16_t*)(ws + WS_AOR), (const pg8::bf16_t*)((const unsigned char*)WIN + (size_t)2816 * 2048), M, 2048, D};
          mk::EpiProj<true> E{SSQ1, ws, args.out, args.in[11], args.in[12], args.in[15], L + mk::RTAB_OFF + 3072, 4};
          pg8::gemm_phase<mk::EpiProj<true>, mk::GateOrder, true, true>(L + RING_OFF, g, SB, E); }
    }
    SEAM(3);
    pg8::bf16_t* US = (pg8::bf16_t*)args.out;
    float* DEC = (float*)(ws + WS_DEC);
    if (IN(4)) {
        for (int t = vcu; t < 512; t += G) {
            if (t < 256) at::attn_prompt_task(L, Qb, AOR, KVb, LUTG, args.in[13], t >> 6, (t >> 1) & 31, t & 1, tid, lane, wave);
            else at::attn_sample_task(L, Qb, AOR, KVb, args.in[2], args.in[3], LUTG, args.in[13], (t - 256) >> 1, t & 1, tid, lane, wave);
        }
        hg::HaPre HP; if (vcu < 256) hg::ha_issue(HP, LOGF, IRb, 4 * vcu, tid);
        hg::ha_phase(L, HP, LOGF, IRb, US, DEC, vcu, G, tid, lane, wave);
        VM_WAIT(); __syncthreads();
    }
    SEAM(4);
    if (IN(6)) {
        pg8::bf16_t* US2 = US + (size_t)256 * 16384;
        hg::hc_prefix(L, US, DEC, US2, args.out + O_PST, vcu, G, tid, lane, wave);
        hg::hc_phase_prompt(L, LOGF, QRb, AOR, IRb, GRb, args.in[16], US2, vcu, G, tid, lane, wave);
        int sid0 = vcu, sst = G, scnt = (vcu < 512) ? (512 - vcu + G - 1) / G : 0;
        if (G == 256) { const int gi = vcu & 15, bhh = vcu >> 4; sst = 1;
            if (gi >= 14) { sid0 = bhh * 2 + (gi - 14); scnt = 1; } else if (gi >= 2) { sid0 = 32 + 2 * (bhh * 12 + (gi - 2)); scnt = 2; } else { sid0 = 416 + 3 * (bhh * 2 + gi); scnt = 3; } }
        hg::HcPreS PS; if (scnt > 0) hg::hc_issue_sample(PS, LOGF, QRb, IRb, args.in[4], sid0, tid);
        hg::hc_phase_sample(L, LOGF, QRb, AOR, IRb, GRb, args.in[16], args.in[4], args.out + O_SST, PS, sid0, sst, scnt, tid, lane, wave);
        VM_WAIT(); __syncthreads();
    }
    SEAM(6);
    if (IN(7)) {
        { pg8::Gemm g{AOR, WUA, MP, D, D}; pg8::StaticOrder S; S.init(MP, D, G, bx); mk::EpiUpR<true> E{MRG, (const unsigned char*)SGA, (const unsigned char*)SGR};
        pg8::gemm_phase<mk::EpiUpR<true>, pg8::StaticOrder, true, true>(L + RING_OFF, g, S, E);
        }
    }
    SEAM(7);
    if (IN(8)) {
        pg8::Gemm g{MRG, WOUT, MP, D, D}; pg8::StaticOrder S; S.init(MP, D, G, bx);
        mk::EpiResidB<false, true, false, true> E{AB, (float*)(ws + WS_AOR), SSQ2, 1.0f};
        pg8::gemm_phase<mk::EpiResidB<false, true, false, true>, pg8::StaticOrder, true, true>(L + RING_OFF, g, S, E);
    }
    SEAM(8);
    if (IN(9)) {
        pg8::StaticOrder SA; SA.init(M, 3840, G, bx); pg8::StaticOrder SB; SB.init(M, 1792, G, bx);
        mk::build_rstd_table<true>(L, SA, SSQ2, tid, 0, 4, false); mk::build_rstd_table<true>(L, SB, SSQ2, tid, 4, 2, true);
        { pg8::Gemm g{AB, W13, M, 3840, D};
          mk::EpiSwiglu<true> E{HID, SSQ2, L + mk::RTAB_OFF};
          pg8::gemm_phase<mk::EpiSwiglu<true>, pg8::StaticOrder, true, true>(L + RING_OFF, g, SA, E); }
        { pg8::Gemm g{(const pg8::bf16_t*)(ws + WS_AOR), (const pg8::bf16_t*)((const unsigned char*)W13 + (size_t)3840 * 2048), M, 1792, D};
          mk::EpiSwiglu<true, false, true> E{HID + 1920, SSQ2, L + mk::RTAB_OFF + 4096};
          pg8::gemm_phase<mk::EpiSwiglu<true, false, true>, pg8::StaticOrder, true, true>(L + RING_OFF, g, SB, E); }
    }
    SEAM(9);
    if (IN(10)) {
        pg8::Gemm g{HID, W2, MP, D, DFF}; pg8::StaticOrder S; S.init(MP, D, G, bx);
        mk::EpiResidB<true, true> E{AB, args.out, nullptr, 0.5f};
        pg8::gemm_phase<mk::EpiResidB<true, true>, pg8::StaticOrder, true, true>(L + RING_OFF, g, S, E);
    }
#undef IN
#undef SEAM
}

extern "C" void kernel_launch(void* const* d_in, const int* in_sizes, int n_in, void* d_out, int out_size, void* d_ws, size_t ws_size, hipStream_t stream) {
    static int grid = 0;
    if (grid == 0) {
        int dev = 0, cus = 0;
        if (hipGetDevice(&dev) != hipSuccess || hipDeviceGetAttribute(&cus, hipDeviceAttributeMultiprocessorCount, dev) != hipSuccess) { fprintf(stderr, "kernel_launch: device query failed\n"); grid = -1; return; }
        if (hipFuncSetAttribute((const void*)mega, hipFuncAttributeMaxDynamicSharedMemorySize, LDS_BYTES) != hipSuccess) { fprintf(stderr, "kernel_launch: hipFuncSetAttribute failed\n"); grid = -1; return; }
        if (ws_size < WS_END) { fprintf(stderr, "kernel_launch: workspace too small: %zu < %zu\n", ws_size, (size_t)WS_END); grid = -1; return; }
        grid = cus;
    }
    if (grid < 0) return;
    (void)hipMemsetAsync((char*)d_ws + WS_CTL + CW_BAR * 4, 0, 16384, stream);
    Args a{};
    for (int i = 0; i < 24; ++i) a.in[i] = (const float*)d_in[i];
    a.out = (float*)d_out; a.ws = (unsigned char*)d_ws;
    unsigned char* ws = (unsigned char*)d_ws; float* out = (float*)d_out;
    int nl = 0;
    auto launch = [&](int lo, int hi) { a.ph_lo = lo; a.ph_hi = hi; a.li = nl++; hipLaunchKernelGGL(mega, dim3(grid), dim3(NWAVES * 64), LDS_BYTES, stream, a); };
    launch(0, 11);
}
```
